# Optimizing an MI355X kernel written in HIP

```python
import jax, jax.numpy as jnp
from jax import lax
import numpy as np

D_MODEL = 1024
BATCH = 32
SEQ = 2048
DEPTH = 2

GRID_W = 64
CTX_LEN = 256
CONV_DIM = 512
MLSTM_DIM = D_MODEL - CONV_DIM
MLSTM_HEADS = 4
MLSTM_HEAD_DIM = MLSTM_DIM // MLSTM_HEADS
CHUNK = 128
D_FF = 2816
N_EXPERTS = 8
TOP_K = 2
ROUTE_BLOCK = 256
N_DENSE = (DEPTH + 1) // 2
N_MOE = DEPTH // 2
EPS = 1e-6
Q0 = 3 * CONV_DIM
O0 = Q0 + 3 * MLSTM_DIM + 4 * MLSTM_HEADS
P_IN = O0 + MLSTM_DIM

kernel_name = "hybrid_conv_mlstm_prefix_dit"


def rmsnorm(x, g):
    xf = x.astype(jnp.float32)
    y = xf * lax.rsqrt(jnp.mean(xf * xf, axis=-1, keepdims=True) + EPS)
    return (y * g.astype(jnp.float32)).astype(x.dtype)


def modulate(u, shift, scale):
    return u * (1 + scale) + shift


def conv3(z, w):
    L = z.shape[-2]
    zp = jnp.pad(z, [(0, 0)] * (z.ndim - 2) + [(1, 1), (0, 0)])
    return zp[..., :L, :] * w[0] + zp[..., 1:L + 1, :] * w[1] + zp[..., 2:, :] * w[2]


def short_conv_mixer(u, w_cols, cw, rows):
    b, t, _ = u.shape
    gb, gc, hh = jnp.split(u @ w_cols, 3, axis=-1)
    y = gc * hh
    if rows is None:
        y = conv3(y, cw)
    else:
        y = conv3(y.reshape(b, rows, GRID_W, CONV_DIM), cw).reshape(b, t, CONV_DIM)
    return gb * y


def to_heads(z):
    b, t, _ = z.shape
    return z.reshape(b, t, MLSTM_HEADS, MLSTM_HEAD_DIM).transpose(0, 2, 1, 3).astype(jnp.float32)


def mlstm_inputs(u, w_cols, bg):
    b, t, _ = u.shape
    q, k, v, g = jnp.split(u @ w_cols, [MLSTM_DIM, 2 * MLSTM_DIM, 3 * MLSTM_DIM], axis=-1)
    g = (g.reshape(b, t, 4, MLSTM_HEADS) + bg).astype(jnp.float32).transpose(0, 2, 3, 1)
    return to_heads(q), to_heads(k) * (MLSTM_HEAD_DIM ** -0.5), to_heads(v), g


def mlstm_scan(q, k, v, log_i, log_f, state, return_h):
    b, h, t, d = q.shape
    nc = t // CHUNK
    lower = jnp.tril(jnp.ones((CHUNK, CHUNK), dtype=bool))

    def blocks(a):
        return jnp.moveaxis(a.reshape((b, h, nc, CHUNK) + a.shape[3:]), 2, 0)

    def step(carry, xs):
        C, n, m = carry
        qc, kc, vc, ic, fc = xs
        bcum = jnp.cumsum(fc, axis=-1)
        bL = bcum[..., -1]
        w_end = bL[..., None] - bcum + ic
        m_new = jnp.maximum(bL + m, jnp.max(w_end, axis=-1))
        dec = jnp.exp(bL + m - m_new)
        wk = jnp.exp(w_end - m_new[..., None])
        C_new = dec[..., None, None] * C + jnp.einsum('bhl,bhld,bhle->bhde', wk, kc, vc)
        n_new = dec[..., None] * n + jnp.einsum('bhl,bhld->bhd', wk, kc)
        if not return_h:
            return (C_new, n_new, m_new), None
        dmat = bcum[..., :, None] - bcum[..., None, :] + ic[..., None, :]
        dmat = jnp.where(lower, dmat, -jnp.inf)
        inter = bcum + m[..., None]
        m_t = jnp.maximum(inter, jnp.max(dmat, axis=-1))
        s = jnp.einsum('bhtd,bhsd->bhts', qc, kc) * jnp.exp(dmat - m_t[..., None])
        w_int = jnp.exp(inter - m_t)
        num = jnp.einsum('bhts,bhsd->bhtd', s, vc) + w_int[..., None] * jnp.einsum('bhtd,bhde->bhte', qc, C)
        den = jnp.sum(s, axis=-1) + w_int * jnp.einsum('bhtd,bhd->bht', qc, n)
        hout = num / jnp.maximum(jnp.abs(den), jnp.exp(-m_t))[..., None]
        return (C_new, n_new, m_new), hout

    state, hs = lax.scan(step, state, (blocks(q), blocks(k), blocks(v), blocks(log_i), blocks(log_f)))
    if return_h:
        hs = jnp.moveaxis(hs, 0, 2).reshape(b, h, t, d)
    return state, hs


def mlstm_bidirectional(lat, ctxs, need_ctx):
    q, k, v, g = lat
    qc, kc, vc, gc = ctxs
    b, h, _, d = q.shape
    out_lat, out_ctx = None, None
    for direction in range(2):
        rev = direction == 1
        orient = (lambda a: jnp.flip(a, axis=2)) if rev else (lambda a: a)
        state0 = (jnp.zeros((b, h, d, d), jnp.float32), jnp.zeros((b, h, d), jnp.float32),
                  jnp.zeros((b, h), jnp.float32))
        st, hc = mlstm_scan(orient(qc), orient(kc), orient(vc), orient(gc[:, 2 * direction]),
                            orient(jax.nn.log_sigmoid(gc[:, 2 * direction + 1])), state0, need_ctx)
        _, hl = mlstm_scan(orient(q), orient(k), orient(v), orient(g[:, 2 * direction]),
                           orient(jax.nn.log_sigmoid(g[:, 2 * direction + 1])), st, True)
        out_lat = orient(hl) if out_lat is None else out_lat + orient(hl)
        if need_ctx:
            out_ctx = orient(hc) if out_ctx is None else out_ctx + orient(hc)
    return out_lat, out_ctx


def mlstm_merge(hh, g_norm, o):
    hn = hh * lax.rsqrt(jnp.mean(hh * hh, axis=-1, keepdims=True) + EPS)
    b, _, t, _ = hn.shape
    hn = hn.transpose(0, 2, 1, 3).reshape(b, t, MLSTM_DIM) * g_norm.astype(jnp.float32)
    return hn.astype(o.dtype) * o


def swiglu(u, w1, w3, w2):
    return (jax.nn.silu(u @ w1) * (u @ w3)) @ w2


def moe_swiglu(xf, router, w1, w3, w2):
    n, dm = xf.shape
    logits = xf.astype(jnp.float32) @ router.astype(jnp.float32)
    top_v, top_i = lax.top_k(logits, TOP_K)
    gates = jax.nn.softmax(top_v, axis=-1).astype(xf.dtype)
    a = n * TOP_K
    flat_e = top_i.reshape(-1)
    flat_t = jnp.repeat(jnp.arange(n, dtype=jnp.int32), TOP_K)
    flat_g = gates.reshape(-1)
    order = jnp.argsort(flat_e)
    se = flat_e[order]
    counts = jnp.bincount(flat_e, length=N_EXPERTS)
    padded = (counts + ROUTE_BLOCK - 1) // ROUTE_BLOCK * ROUTE_BLOCK
    start = jnp.cumsum(counts) - counts
    pend = jnp.cumsum(padded)
    pstart = pend - padded
    dest = pstart[se] + (jnp.arange(a, dtype=jnp.int32) - start[se])
    cap = -(-a // ROUTE_BLOCK) * ROUTE_BLOCK + N_EXPERTS * ROUTE_BLOCK
    tok_buf = jnp.zeros((cap,), jnp.int32).at[dest].set(flat_t[order])
    gate_buf = jnp.zeros((cap,), xf.dtype).at[dest].set(flat_g[order])
    nblk = cap // ROUTE_BLOCK
    blk_e = jnp.minimum(jnp.searchsorted(pend, jnp.arange(nblk) * ROUTE_BLOCK, side='right'), N_EXPERTS - 1)
    xb = xf[tok_buf].reshape(nblk, ROUTE_BLOCK, dm)

    def expert_block(args):
        xblk, e = args
        return swiglu(xblk, w1[e], w3[e], w2[e])

    yb = lax.map(expert_block, (xb, blk_e)).reshape(cap, dm)
    return jnp.zeros_like(xf).at[tok_buf].add(yb * gate_buf[:, None])


def channel_mixer(layer, u, ffn_w1, ffn_w3, ffn_w2, moe_router, moe_w1, moe_w3, moe_w2):
    j = layer // 2
    if layer % 2 == 0:
        return swiglu(u, ffn_w1[j], ffn_w3[j], ffn_w2[j])
    b, t, dm = u.shape
    return moe_swiglu(u.reshape(b * t, dm), moe_router[j], moe_w1[j], moe_w3[j], moe_w2[j]).reshape(b, t, dm)


def setup_inputs(seed: int = 0) -> dict:
    key = jax.random.key(seed)
    ks = jax.random.split(key, 24)
    nrm = lambda k, s, sc: jax.random.normal(k, s, jnp.float32) * sc
    D, H = D_MODEL, MLSTM_HEADS
    ib = nrm(ks[10], (DEPTH, 2, H), 0.1)
    fb = jnp.linspace(3.0, 6.0, H, dtype=jnp.float32)[None, None] + nrm(ks[11], (DEPTH, 2, H), 0.1)
    b_gates = jnp.stack([ib[:, 0], fb[:, 0], ib[:, 1], fb[:, 1]], axis=1)
    return {
        "x": nrm(ks[0], (BATCH, SEQ, D), 1.0),
        "c": nrm(ks[1], (BATCH, D), 1.0),
        "ctx": nrm(ks[2], (BATCH, CTX_LEN, D), 1.0),
        "c_ctx": nrm(ks[3], (D,), 1.0),
        "norm1_g": 1.0 + nrm(ks[4], (DEPTH, D), 0.05),
        "norm2_g": 1.0 + nrm(ks[5], (DEPTH, D), 0.05),
        "w_ada": nrm(ks[6], (DEPTH, D, 6 * D), 0.5 * D ** -0.5),
        "b_ada": nrm(ks[7], (DEPTH, 6 * D), 0.02),
        "w_in": nrm(ks[8], (DEPTH, D, P_IN), D ** -0.5),
        "conv_w": nrm(ks[9], (DEPTH, 3, CONV_DIM), 0.5),
        "b_gates": b_gates,
        "mlstm_norm_g": 1.0 + nrm(ks[12], (DEPTH, MLSTM_DIM), 0.05),
        "w_out": nrm(ks[13], (DEPTH, D, D), D ** -0.5),
        "ffn_w1": nrm(ks[14], (N_DENSE, D, D_FF), D ** -0.5),
        "ffn_w3": nrm(ks[15], (N_DENSE, D, D_FF), D ** -0.5),
        "ffn_w2": nrm(ks[16], (N_DENSE, D_FF, D), D_FF ** -0.5),
        "moe_router": nrm(ks[17], (N_MOE, D, N_EXPERTS), D ** -0.5),
        "moe_w1": nrm(ks[18], (N_MOE, N_EXPERTS, D, D_FF), D ** -0.5),
        "moe_w3": nrm(ks[19], (N_MOE, N_EXPERTS, D, D_FF), D ** -0.5),
        "moe_w2": nrm(ks[20], (N_MOE, N_EXPERTS, D_FF, D), D_FF ** -0.5),
        "final_norm_g": 1.0 + nrm(ks[21], (D,), 0.05),
    }


def reference(x, c, ctx, c_ctx, norm1_g, norm2_g, w_ada, b_ada, w_in, conv_w, b_gates,
              mlstm_norm_g, w_out, ffn_w1, ffn_w3, ffn_w2, moe_router, moe_w1, moe_w3, moe_w2,
              final_norm_g):
    rows = x.shape[1] // GRID_W
    s_lat = jax.nn.silu(c)
    s_ctx = jax.nn.silu(c_ctx)
    h, hc = x, ctx
    for layer in range(DEPTH):
        last = layer == DEPTH - 1
        mod = s_lat @ w_ada[layer] + b_ada[layer]
        mod_c = s_ctx @ w_ada[layer] + b_ada[layer]
        sh1, sc1, g1, sh2, sc2, g2 = jnp.split(mod[:, None, :], 6, axis=-1)
        csh1, csc1, cg1, csh2, csc2, cg2 = jnp.split(mod_c, 6, axis=-1)
        w = w_in[layer]

        u = modulate(rmsnorm(h, norm1_g[layer]), sh1, sc1)
        uc = modulate(rmsnorm(hc, norm1_g[layer]), csh1, csc1)
        lat_in = mlstm_inputs(u, w[:, Q0:O0], b_gates[layer])
        ctx_in = mlstm_inputs(uc, w[:, Q0:O0], b_gates[layer])
        m_lat, m_ctx = mlstm_bidirectional(lat_in, ctx_in, not last)
        y_conv = short_conv_mixer(u, w[:, :Q0], conv_w[layer], rows)
        y_mlstm = mlstm_merge(m_lat, mlstm_norm_g[layer], jax.nn.sigmoid(u @ w[:, O0:]))
        h = h + g1 * (jnp.concatenate([y_conv, y_mlstm], axis=-1) @ w_out[layer])

        u2 = modulate(rmsnorm(h, norm2_g[layer]), sh2, sc2)
        h = h + g2 * channel_mixer(layer, u2, ffn_w1, ffn_w3, ffn_w2, moe_router, moe_w1, moe_w3, moe_w2)

        if not last:
            yc_conv = short_conv_mixer(uc, w[:, :Q0], conv_w[layer], None)
            yc_mlstm = mlstm_merge(m_ctx, mlstm_norm_g[layer], jax.nn.sigmoid(uc @ w[:, O0:]))
            hc = hc + cg1 * (jnp.concatenate([yc_conv, yc_mlstm], axis=-1) @ w_out[layer])
            uc2 = modulate(rmsnorm(hc, norm2_g[layer]), csh2, csc2)
            hc = hc + cg2 * channel_mixer(layer, uc2, ffn_w1, ffn_w3, ffn_w2, moe_router, moe_w1, moe_w3, moe_w2)
    return rmsnorm(h, final_norm_g)
```

```cpp
#include <hip/hip_runtime.h>
#include <cstdio>
#include <cstdint>

#ifndef MK_PER_PHASE
#define MK_PER_PHASE 0
#endif

#define LAS __attribute__((address_space(3)))
typedef unsigned short bf16_t;
typedef short bf16x8 __attribute__((ext_vector_type(8)));
typedef short s16x4 __attribute__((ext_vector_type(4)));
typedef float f32x4 __attribute__((ext_vector_type(4)));
typedef unsigned u32x4 __attribute__((ext_vector_type(4)));
typedef unsigned u32x2 __attribute__((ext_vector_type(2)));

constexpr int D = 1024, NB = 32, SEQ = 2048, CTXL = 256;
constexpr int NL = NB * SEQ;
constexpr int NCX = NB * CTXL;
constexpr int MT = NL + NCX;
constexpr int PIN = 3600, NPROJ = 3584, NPAD = 3840;
constexpr int DFF = 2816, NE = 8;
constexpr float EPS = 1e-6f;
constexpr int RT_STRIDE = 65536;

constexpr size_t WS_CTL = 0;
constexpr size_t CTL_BYTES = 65536;
constexpr size_t CTL_GCNT = 16384;
constexpr size_t WS_MOD = 65536;
constexpr size_t WS_WIN = 2097152;
constexpr size_t WS_WOUT = WS_WIN + (size_t)2 * NPAD * D * 2;
constexpr size_t WS_WUP = WS_WOUT + (size_t)2 * D * D * 2;
constexpr size_t WS_WDN = WS_WUP + (size_t)2 * DFF * D * 2;
constexpr size_t WS_MUP = WS_WDN + (size_t)D * DFF * 2;
constexpr size_t WS_MDN = WS_MUP + (size_t)NE * 2 * DFF * D * 2;
constexpr size_t WS_HC = WS_MDN + (size_t)NE * D * DFF * 2;
constexpr size_t WS_U = WS_HC + (size_t)NCX * D * 4;
constexpr size_t WS_PROJ = WS_U + (size_t)MT * D * 2;
constexpr size_t WS_GATES = WS_PROJ + (size_t)MT * NPROJ * 2;
constexpr size_t WS_HL = WS_GATES + (size_t)MT * 16 * 4;
constexpr size_t WS_RTOK = WS_HL + (size_t)2 * MT * 512 * 2;
constexpr size_t WS_RGATE = WS_RTOK + (size_t)16 * RT_STRIDE * 4;
constexpr size_t WS_END = WS_RGATE + (size_t)16 * RT_STRIDE * 4;

constexpr int LDS_BYTES = 147456;
constexpr int MISC_OFF = 145408;

__device__ __forceinline__ unsigned cvt_pk_bf16(float lo, float hi) { unsigned r; asm volatile("v_cvt_pk_bf16_f32 %0, %1, %2" : "=v"(r) : "v"(lo), "v"(hi)); return r; }
__device__ __forceinline__ float bf2f(unsigned short b) { return __uint_as_float(((unsigned)b) << 16); }
__device__ __forceinline__ float bflo(unsigned w) { return __uint_as_float(w << 16); }
__device__ __forceinline__ float bfhi(unsigned w) { return __uint_as_float(w & 0xffff0000u); }
__device__ __forceinline__ float wave_sum(float v) {
#pragma unroll
    for (int o = 32; o >= 1; o >>= 1) v += __shfl_xor(v, o);
    return v;
}
__device__ __forceinline__ int lane_id() { int l; asm volatile("v_mbcnt_lo_u32_b32 %0, -1, 0\n\tv_mbcnt_hi_u32_b32 %0, -1, %0" : "=v"(l)); return l; }
__device__ __forceinline__ float sigmoidf_(float x) { return 1.0f / (1.0f + __expf(-x)); }

#define XB_TMO      128
#define XB_XCNT(j)  (256  + 64 * (j))
#define XB_XSUB(j)  (1280 + 64 * (j))
#define XB_XGEN(j)  (2304 + 64 * (j))
#define XB_TOP      3328
#define XB_TOPGEN   3392
#define XCD_BAR_WORDS 3456
#define XB_SPIN_CAP (1u << 18)

__device__ __forceinline__ unsigned xb_ld(unsigned* p)              { return __hip_atomic_load(p, __ATOMIC_RELAXED, __HIP_MEMORY_SCOPE_AGENT); }
__device__ __forceinline__ unsigned xb_add(unsigned* p, unsigned v) { return __hip_atomic_fetch_add(p, v, __ATOMIC_RELAXED, __HIP_MEMORY_SCOPE_AGENT); }
__device__ __forceinline__ unsigned xb_xcc_id() { return (unsigned)__builtin_amdgcn_s_getreg((3 << 11) | 20) & 0xFu; }
#define XB_SPIN(cond, bar) do { unsigned _sp = 0; while (cond) { __builtin_amdgcn_s_sleep(1); \
    if ((++_sp & 255u) == 0u) { if (xb_ld(&(bar)[XB_TMO])) break; if (_sp > XB_SPIN_CAP) { atomicAdd(&(bar)[XB_TMO], 1u); break; } } } } while (0)

struct XcdBarrier {
    unsigned* bar; unsigned x;
    volatile LAS unsigned* st;
    int wid;
};
#define XB_THREAD0(b) ((b).wid == 0 && lane_id() == 0)
__device__ __forceinline__ XcdBarrier xcd_barrier_post(unsigned* bar, volatile LAS unsigned* st, int wid) {
    XcdBarrier b; b.bar = bar; b.x = xb_xcc_id(); b.st = st; b.wid = wid;
    if (XB_THREAD0(b)) (void)xb_add(&bar[XB_XCNT(b.x)], 1u);
    return b;
}
__device__ __forceinline__ void xcd_barrier_complete(unsigned* bar, unsigned x, unsigned& nloc, unsigned& nx) {
    const unsigned G = gridDim.x * gridDim.y * gridDim.z;
    unsigned sum, cnt, mine, sp = 0u;
    for (;;) {
        sum = 0u; cnt = 0u; mine = 0u;
#pragma unroll
        for (unsigned j = 0; j < 16; ++j) { const unsigned c = xb_ld(&bar[XB_XCNT(j)]); sum += c; cnt += (c > 0u) ? 1u : 0u; mine = (j == x) ? c : mine; }
        if (sum == G) break;
        __builtin_amdgcn_s_sleep(1);
        if ((++sp & 255u) == 0u) { if (xb_ld(&bar[XB_TMO])) break; if (sp > XB_SPIN_CAP) { atomicAdd(&bar[XB_TMO], 1u); break; } }
    }
    nloc = mine > 0u ? mine : 1u; nx = cnt > 0u ? cnt : 1u;
}
__device__ __forceinline__ void xcd_barrier(const XcdBarrier& b) {
    asm volatile("s_waitcnt vmcnt(0)" ::: "memory");
    __syncthreads();
    if (XB_THREAD0(b)) {
        unsigned* bar = b.bar;
        __builtin_amdgcn_s_waitcnt(0);
        unsigned nloc = b.st[0], nx = b.st[1];
        if (nloc == 0u) { xcd_barrier_complete(bar, b.x, nloc, nx); b.st[0] = nloc; b.st[1] = nx; }
        const unsigned old = xb_add(&bar[XB_XSUB(b.x)], 1u);
        const unsigned gen = old / nloc;
        if (old + 1u == (gen + 1u) * nloc) {
            __builtin_amdgcn_fence(__ATOMIC_RELEASE, "agent");
            asm volatile("s_waitcnt vmcnt(0)" ::: "memory");
            const unsigned og = xb_add(&bar[XB_TOP], 1u);
            const unsigned tg = og / nx;
            if (og + 1u == (tg + 1u) * nx) xb_add(&bar[XB_TOPGEN], 1u);
            else XB_SPIN(xb_ld(&bar[XB_TOPGEN]) == tg, bar);
            __builtin_amdgcn_fence(__ATOMIC_ACQUIRE, "agent");
            xb_add(&bar[XB_XGEN(b.x)], 1u);
            asm volatile("s_waitcnt vmcnt(0)" ::: "memory");
        } else {
            XB_SPIN(xb_ld(&bar[XB_XGEN(b.x)]) == gen, bar);
            __builtin_amdgcn_fence(__ATOMIC_ACQUIRE, "agent");
            asm volatile("s_waitcnt vmcnt(0)" ::: "memory");
        }
    }
    __syncthreads();
}

namespace pg8 {
constexpr int BM = 256, BK = 64, HALF = 128, HTB = HALF * BK * 2, STAGE_BYTES = 8 * HTB, NXCD = 8, WGM = 8;
__device__ __forceinline__ int lds_byte(int r, int c) { const int st = (r >> 4) * 2 + (c >> 5), rr = r & 15, cc = c & 31, ob = rr * 64 + cc * 2; return st * 1024 + (ob ^ (((ob >> 9) & 1) << 5)); }
__device__ __forceinline__ void stage_rc(int b, int& R, int& C) { const int st = b / 1024, sb = b % 1024, swz = sb ^ (((sb >> 9) & 1) << 5); R = (st >> 1) * 16 + swz / 64; C = (st & 1) * 32 + (swz % 64) / 2; }
__device__ __forceinline__ int perm32(int rho) { const int n = rho >> 4, i = rho & 15; return 8 * (i >> 2) + 4 * n + (i & 3); }

struct Unit { int pm, pn; const char* B; int g; };

__device__ __forceinline__ void tile_map(int L, int nM, int nN, int& pm, int& pn) {
    const int nwg = nM * nN; int wgid = L;
    { const int q = nwg / NXCD, r = nwg % NXCD, xcd = wgid % NXCD, off = wgid / NXCD; wgid = (xcd < r ? xcd * (q + 1) : r * (q + 1) + (xcd - r) * q) + off; }
    const int nig = WGM * nN, gid = wgid / nig, fm = gid * WGM, gsz = (nM - fm) < WGM ? (nM - fm) : WGM;
    pm = fm + ((wgid % nig) % gsz); pn = (wgid % nig) / gsz;
}

template <class Epi, class Sched>
__device__ __forceinline__ void gemm_phase(LAS unsigned char* lds, const int wid, const char* Abase, const int K, const Sched& S, const Epi& E) {
    const int lane = lane_id(), tid = wid * 64 + lane, wr = wid >> 2, wc = wid & 3, fr = lane & 15, fq = lane >> 4;
    const int nt = K / BK;
    int R0, C0; stage_rc(tid * 16, R0, C0);
    unsigned voffB[2];
#pragma unroll
    for (int i = 0; i < 2; ++i) { const int R = R0 + 64 * i; const int Rb = Epi::PERM ? ((R & ~31) + perm32(R & 31)) : R; voffB[i] = (unsigned)(Rb * K + C0) * 2u; }
    const size_t kstep = (size_t)(BK * 2);
    const size_t hstep = (size_t)HALF * K * 2;
    const unsigned ldsw = (unsigned)wid * 1024u;
    const int aoff = lds_byte(wr * 64 + fr, fq * 8), boff = lds_byte(wc * 32 + fr, fq * 8);
#define PG8_SA(b, h) (((b) * 2 + (h)) * HTB)
#define PG8_SB(b, h) ((4 + (b) * 2 + (h)) * HTB)
#define PG8_STAGE(bufoff, gbase, voff) do { _Pragma("unroll") for (int _i = 0; _i < 2; ++_i) \
        __builtin_amdgcn_global_load_lds((const unsigned*)((const char*)(gbase) + (voff)[_i]), (LAS unsigned*)(lds + (bufoff) + ldsw + _i * 8192), 16, 0, 0); } while (0)
#define PG8_STAGE_A(bufoff, o0, o1, kb) do { \
        __builtin_amdgcn_global_load_lds((const unsigned*)(Abase + (size_t)(o0) + (size_t)(kb)), (LAS unsigned*)(lds + (bufoff) + ldsw), 16, 0, 0); \
        __builtin_amdgcn_global_load_lds((const unsigned*)(Abase + (size_t)(o1) + (size_t)(kb)), (LAS unsigned*)(lds + (bufoff) + ldsw + 8192), 16, 0, 0); } while (0)
#define PG8_LDA(dst, b, h) do { _Pragma("unroll") for (int m = 0; m < 4; ++m) _Pragma("unroll") for (int k = 0; k < 2; ++k) dst[m][k] = *(const LAS bf16x8*)(lds + PG8_SA(b, h) + aoff + m * 2048 + k * 1024); } while (0)
#define PG8_LDB(dst, b, h) do { _Pragma("unroll") for (int n = 0; n < 2; ++n) _Pragma("unroll") for (int k = 0; k < 2; ++k) dst[n][k] = *(const LAS bf16x8*)(lds + PG8_SB(b, h) + boff + n * 2048 + k * 1024); } while (0)
#define PG8_MMA(ai, bj, At, Bt) do { __builtin_amdgcn_s_setprio(1); _Pragma("unroll") for (int m = 0; m < 4; ++m) _Pragma("unroll") for (int n = 0; n < 2; ++n) _Pragma("unroll") for (int k = 0; k < 2; ++k) \
        acc[ai][bj][m][n] = __builtin_amdgcn_mfma_f32_16x16x32_bf16(Bt[n][k], At[m][k], acc[ai][bj][m][n], 0, 0, 0); __builtin_amdgcn_s_setprio(0); } while (0)
#define PG8_WAIT_V(n) asm volatile("s_waitcnt vmcnt(" #n ")" ::: "memory")
#define PG8_WAIT_L(n) asm volatile("s_waitcnt lgkmcnt(" #n ")" ::: "memory")
#define PG8_BAR __builtin_amdgcn_s_barrier()
#define PG8_SCHED __builtin_amdgcn_sched_barrier(0)
    Unit cur, nxt; int ui = 0;
    if (!S.next(0, cur)) return;
    f32x4 acc[2][2][4][2];
#pragma unroll
    for (int a = 0; a < 2; ++a)
#pragma unroll
        for (int b = 0; b < 2; ++b)
#pragma unroll
            for (int m = 0; m < 4; ++m)
#pragma unroll
                for (int n = 0; n < 2; ++n) acc[a][b][m][n] = (f32x4){0.f, 0.f, 0.f, 0.f};
    bf16x8 At[4][2], B0[2][2], B1[2][2];
    unsigned oc00, oc01, oc10, oc11;
    unsigned on00, on01, on10, on11;
    S.aoff(cur, R0, C0, oc00, oc01, oc10, oc11);
    asm volatile("" : "+v"(oc00), "+v"(oc01), "+v"(oc10), "+v"(oc11));
    const char* cB = cur.B;
    PG8_STAGE(PG8_SB(0, 0), cB, voffB); PG8_STAGE_A(PG8_SA(0, 0), oc00, oc01, 0); PG8_STAGE(PG8_SB(0, 1), cB + hstep, voffB); PG8_STAGE_A(PG8_SA(0, 1), oc10, oc11, 0);
    if (wr == 1) PG8_BAR;
    PG8_WAIT_V(4); PG8_BAR;
    PG8_STAGE(PG8_SB(1, 0), cB + kstep, voffB); PG8_STAGE_A(PG8_SA(1, 0), oc00, oc01, kstep); PG8_STAGE(PG8_SB(1, 1), cB + hstep + kstep, voffB);
    PG8_WAIT_V(6); PG8_BAR;
    for (;;) {
        const bool has_next = S.next(ui + 1, nxt);
        if (has_next) { S.aoff(nxt, R0, C0, on00, on01, on10, on11); } else { on00 = oc00; on01 = oc01; on10 = oc10; on11 = oc11; }
        asm volatile("" : "+v"(on00), "+v"(on01), "+v"(on10), "+v"(on11));
        const char* nB = has_next ? nxt.B : cB;
        for (int t = 0; t < nt; t += 2) {
            const bool last = (t == nt - 2);
            const size_t k1 = (size_t)(t + 1) * kstep;
            const size_t k2 = last ? (size_t)0 : (size_t)(t + 2) * kstep; const size_t k3 = k2 + kstep;
            const unsigned o00 = last ? on00 : oc00, o01 = last ? on01 : oc01, o10 = last ? on10 : oc10, o11 = last ? on11 : oc11;
            const char* b2 = last ? nB : cB + (size_t)(t + 2) * kstep; const char* b3 = b2 + kstep;
            PG8_LDB(B0, 0, 0); PG8_SCHED; PG8_LDA(At, 0, 0); PG8_STAGE_A(PG8_SA(1, 1), oc10, oc11, k1);
            PG8_WAIT_L(8); PG8_BAR; PG8_WAIT_L(0); PG8_MMA(0, 0, At, B0); PG8_BAR; PG8_SCHED;
            PG8_LDB(B1, 0, 1); PG8_STAGE(PG8_SB(0, 0), b2, voffB);
            PG8_BAR; PG8_WAIT_L(0); PG8_MMA(0, 1, At, B1); PG8_BAR;
            PG8_LDA(At, 0, 1); PG8_STAGE_A(PG8_SA(0, 0), o00, o01, k2);
            PG8_BAR; PG8_WAIT_L(0); PG8_MMA(1, 0, At, B0); PG8_BAR; PG8_SCHED;
            PG8_STAGE(PG8_SB(0, 1), b2 + hstep, voffB);
            PG8_WAIT_V(6); PG8_BAR; PG8_MMA(1, 1, At, B1); PG8_BAR;
            PG8_LDB(B0, 1, 0); PG8_SCHED; PG8_LDA(At, 1, 0); PG8_STAGE_A(PG8_SA(0, 1), o10, o11, k2);
            PG8_WAIT_L(8); PG8_BAR; PG8_WAIT_L(0); PG8_MMA(0, 0, At, B0); PG8_BAR; PG8_SCHED;
            PG8_LDB(B1, 1, 1); PG8_STAGE(PG8_SB(1, 0), b3, voffB);
            PG8_BAR; PG8_WAIT_L(0); PG8_MMA(0, 1, At, B1); PG8_BAR;
            PG8_LDA(At, 1, 1); PG8_STAGE_A(PG8_SA(1, 0), o00, o01, k3);
            PG8_BAR; PG8_WAIT_L(0); PG8_MMA(1, 0, At, B0); PG8_BAR; PG8_SCHED;
            PG8_STAGE(PG8_SB(1, 1), b3 + hstep, voffB);
            PG8_WAIT_V(6); PG8_BAR; PG8_MMA(1, 1, At, B1); PG8_BAR;
        }
        E(acc, cur, wr, wc, fr, fq);
        if (!has_next) break;
#pragma unroll
        for (int a = 0; a < 2; ++a)
#pragma unroll
            for (int b = 0; b < 2; ++b)
#pragma unroll
                for (int m = 0; m < 4; ++m)
#pragma unroll
                    for (int n = 0; n < 2; ++n) acc[a][b][m][n] = (f32x4){0.f, 0.f, 0.f, 0.f};
        cur = nxt; cB = nB; oc00 = on00; oc01 = on01; oc10 = on10; oc11 = on11; ++ui;
    }
    PG8_WAIT_V(0);
    if (wr == 0) PG8_BAR;
    PG8_BAR;
#undef PG8_SA
#undef PG8_SB
#undef PG8_STAGE
#undef PG8_STAGE_A
#undef PG8_LDA
#undef PG8_LDB
#undef PG8_MMA
#undef PG8_WAIT_V
#undef PG8_WAIT_L
#undef PG8_BAR
#undef PG8_SCHED
}

struct DenseSched {
    int nM, nN, G, c, K; const char* Bt;
    __device__ __forceinline__ bool next(int i, Unit& u) const {
        const long L = (long)i * G + c; if (L >= (long)nM * nN) return false;
        tile_map((int)L, nM, nN, u.pm, u.pn); u.B = Bt + (size_t)u.pn * 256 * K * 2; u.g = 0; return true;
    }
    __device__ __forceinline__ void aoff(const Unit& u, int R0, int C0, unsigned& o00, unsigned& o01, unsigned& o10, unsigned& o11) const {
        const unsigned base = (unsigned)((u.pm * 256 + R0) * K + C0) * 2u, r64 = (unsigned)(64 * K) * 2u;
        o00 = base; o01 = base + r64; o10 = base + 2u * r64; o11 = base + 3u * r64;
    }
};
struct InProjL1Sched {
    int G, c; const char* Bt;
    __device__ __forceinline__ bool next(int i, Unit& u) const {
        const int L = i * G + c; if (L >= 3840 + 224) return false;
        if (L < 3840) tile_map(L, 256, 15, u.pm, u.pn);
        else { const int Lc = L - 3840; u.pm = 256 + Lc / 7; const int j = Lc % 7; u.pn = j < 6 ? 6 + j : 14; }
        u.B = Bt + (size_t)u.pn * 256 * D * 2; u.g = 0; return true;
    }
    __device__ __forceinline__ void aoff(const Unit& u, int R0, int C0, unsigned& o00, unsigned& o01, unsigned& o10, unsigned& o11) const {
        const unsigned base = (unsigned)((u.pm * 256 + R0) * D + C0) * 2u, r64 = (unsigned)(64 * D) * 2u;
        o00 = base; o01 = base + r64; o10 = base + 2u * r64; o11 = base + 3u * r64;
    }
};
struct MoeUpSched {
    int G, c; const char* Bt; const int* rowtok; const volatile LAS int* tb;
    __device__ __forceinline__ bool next(int i, Unit& u) const {
        const int T = tb[8]; const int L = i * G + c; if (L >= T * 22) return false;
        tile_map(L, T, 22, u.pm, u.pn); int g = 0;
#pragma unroll
        for (int j = 1; j < 8; ++j) g += (u.pm >= tb[j]) ? 1 : 0;
        u.g = g; u.B = Bt + ((size_t)g * 5632 + (size_t)u.pn * 256) * D * 2; return true;
    }
    __device__ __forceinline__ void aoff(const Unit& u, int R0, int C0, unsigned& o00, unsigned& o01, unsigned& o10, unsigned& o11) const {
        const int s0 = (u.pm - tb[u.g]) * 256 + R0, cnt = tb[16 + u.g]; const int* rt = rowtok + (size_t)u.g * RT_STRIDE;
        const int t00 = s0 < cnt ? rt[s0] : 0, t01 = s0 + 64 < cnt ? rt[s0 + 64] : 0, t10 = s0 + 128 < cnt ? rt[s0 + 128] : 0, t11 = s0 + 192 < cnt ? rt[s0 + 192] : 0;
        o00 = (unsigned)(t00 * D + C0) * 2u; o01 = (unsigned)(t01 * D + C0) * 2u; o10 = (unsigned)(t10 * D + C0) * 2u; o11 = (unsigned)(t11 * D + C0) * 2u;
    }
};
struct MoeDownSched {
    int G, c; const char* Bt; const volatile LAS int* tb;
    __device__ __forceinline__ bool next(int i, Unit& u) const {
        const int T = tb[8]; const int L = i * G + c; if (L >= T * 4) return false;
        tile_map(L, T, 4, u.pm, u.pn); int g = 0;
#pragma unroll
        for (int j = 1; j < 8; ++j) g += (u.pm >= tb[j]) ? 1 : 0;
        u.g = g; u.B = Bt + ((size_t)g * D + (size_t)u.pn * 256) * DFF * 2; return true;
    }
    __device__ __forceinline__ void aoff(const Unit& u, int R0, int C0, unsigned& o00, unsigned& o01, unsigned& o10, unsigned& o11) const {
        const unsigned base = (unsigned)((u.pm * 256 + R0) * DFF + C0) * 2u, r64 = (unsigned)(64 * DFF) * 2u;
        o00 = base; o01 = base + r64; o10 = base + 2u * r64; o11 = base + 3u * r64;
    }
};

struct EpiProj {
    static constexpr bool PERM = true;
    bf16_t* P; float* GT; const float* bg;
    __device__ __forceinline__ void operator()(const f32x4 (&acc)[2][2][4][2], const Unit& u, int wr, int wc, int fr, int fq) const {
        const int row0 = u.pm * BM + wr * 64 + fr;
        if (u.pn < 14) {
            const int col0 = u.pn * BM + wc * 32 + 8 * fq;
#pragma unroll
            for (int ai = 0; ai < 2; ++ai)
#pragma unroll
                for (int m = 0; m < 4; ++m) { bf16_t* rowp = P + (size_t)(row0 + ai * HALF + m * 16) * NPROJ + col0;
#pragma unroll
                    for (int bj = 0; bj < 2; ++bj) { const f32x4 v0 = acc[ai][bj][m][0], v1 = acc[ai][bj][m][1];
                        u32x4 w; w.x = cvt_pk_bf16(v0[0], v0[1]); w.y = cvt_pk_bf16(v0[2], v0[3]); w.z = cvt_pk_bf16(v1[0], v1[1]); w.w = cvt_pk_bf16(v1[2], v1[3]);
                        *(u32x4*)(rowp + bj * HALF) = w; } }
        } else if (wc == 0 && fq < 2) {
            const f32x4 b0 = *(const f32x4*)(bg + 8 * fq), b1 = *(const f32x4*)(bg + 8 * fq + 4);
#pragma unroll
            for (int ai = 0; ai < 2; ++ai)
#pragma unroll
                for (int m = 0; m < 4; ++m) { float* gp = GT + (size_t)(row0 + ai * HALF + m * 16) * 16 + 8 * fq;
                    *(f32x4*)gp = acc[ai][0][m][0] + b0; *(f32x4*)(gp + 4) = acc[ai][0][m][1] + b1; }
        }
    }
};
struct EpiResid {
    static constexpr bool PERM = false;
    const float* resL; const float* resC; float* outL; float* outC; const float* gate;
    __device__ __forceinline__ void operator()(const f32x4 (&acc)[2][2][4][2], const Unit& u, int wr, int wc, int fr, int fq) const {
        const int rowg = u.pm * BM; const bool isc = rowg >= NL;
        const float* res = isc ? resC + (size_t)(rowg - NL) * D : resL + (size_t)rowg * D;
        float* out = isc ? outC + (size_t)(rowg - NL) * D : outL + (size_t)rowg * D;
        const int bidx = isc ? 32 : (rowg >> 11);
        const int col0 = u.pn * BM + wc * 32 + 4 * fq;
        const float* gv = gate + (size_t)bidx * 6144 + col0;
        f32x4 g[2][2];
#pragma unroll
        for (int bj = 0; bj < 2; ++bj)
#pragma unroll
            for (int n = 0; n < 2; ++n) g[bj][n] = *(const f32x4*)(gv + bj * HALF + n * 16);
#pragma unroll
        for (int ai = 0; ai < 2; ++ai)
#pragma unroll
            for (int m = 0; m < 4; ++m) { const size_t off = (size_t)(ai * HALF + wr * 64 + m * 16 + fr) * D + col0;
#pragma unroll
                for (int bj = 0; bj < 2; ++bj)
#pragma unroll
                    for (int n = 0; n < 2; ++n) { const f32x4 r = *(const f32x4*)(res + off + bj * HALF + n * 16);
                        *(f32x4*)(out + off + bj * HALF + n * 16) = r + g[bj][n] * acc[ai][bj][m][n]; }
                asm volatile("" ::: "memory"); }
    }
};
struct EpiSwiglu {
    static constexpr bool PERM = true;
    bf16_t* ACT;
    __device__ __forceinline__ void operator()(const f32x4 (&acc)[2][2][4][2], const Unit& u, int wr, int wc, int fr, int fq) const {
        const int row0 = u.pm * BM + wr * 64 + fr, col0 = u.pn * HALF + wc * 32 + 8 * fq;
#pragma unroll
        for (int ai = 0; ai < 2; ++ai)
#pragma unroll
            for (int m = 0; m < 4; ++m) { bf16_t* rowp = ACT + (size_t)(row0 + ai * HALF + m * 16) * DFF + col0;
                float o[8];
#pragma unroll
                for (int n = 0; n < 2; ++n)
#pragma unroll
                    for (int j = 0; j < 4; ++j) { const float a = acc[ai][0][m][n][j], b = acc[ai][1][m][n][j]; o[n * 4 + j] = a * b * __builtin_amdgcn_rcpf(1.0f + __expf(-a)); }
                u32x4 w; w.x = cvt_pk_bf16(o[0], o[1]); w.y = cvt_pk_bf16(o[2], o[3]); w.z = cvt_pk_bf16(o[4], o[5]); w.w = cvt_pk_bf16(o[6], o[7]);
                *(u32x4*)rowp = w; }
    }
};
struct EpiMoeDown {
    static constexpr bool PERM = false;
    float* H; const float* g2; const int* rowtok; const float* rowgate; const volatile LAS int* tb;
    __device__ __forceinline__ void operator()(const f32x4 (&acc)[2][2][4][2], const Unit& u, int wr, int wc, int fr, int fq) const {
        const int s0 = (u.pm - tb[u.g]) * 256, cnt = tb[16 + u.g];
        const int* rt = rowtok + (size_t)u.g * RT_STRIDE; const float* rg = rowgate + (size_t)u.g * RT_STRIDE;
        const int col0 = u.pn * BM + wc * 32 + 4 * fq;
#pragma unroll
        for (int ai = 0; ai < 2; ++ai)
#pragma unroll
            for (int m = 0; m < 4; ++m) { const int slot = s0 + ai * HALF + wr * 64 + m * 16 + fr;
                if (slot < cnt) { const int tok = rt[slot]; const float gt = rg[slot];
                    float* hp = H + (size_t)tok * D + col0; const float* gv = g2 + (size_t)(tok >> 11) * 6144 + col0;
#pragma unroll
                    for (int bj = 0; bj < 2; ++bj)
#pragma unroll
                        for (int n = 0; n < 2; ++n) { const f32x4 r = *(const f32x4*)(hp + bj * HALF + n * 16); const f32x4 gg = *(const f32x4*)(gv + bj * HALF + n * 16);
                            *(f32x4*)(hp + bj * HALF + n * 16) = r + (gg * gt) * acc[ai][bj][m][n]; } }
                asm volatile("" ::: "memory"); }
    }
};
}

struct Args { const float* in[21]; float* out; unsigned char* ws; int lo, hi; };
enum { I_X = 0, I_C, I_CTX, I_CCTX, I_N1G, I_N2G, I_WADA, I_BADA, I_WIN, I_CONVW, I_BG, I_MNG, I_WOUT, I_FW1, I_FW3, I_FW2, I_ROUTER, I_MW1, I_MW3, I_MW2, I_FNG };

struct Frame { LAS unsigned char* lds; int wid, G, wg;
    __device__ __forceinline__ int lane() const { return lane_id(); }
    __device__ __forceinline__ int tid() const { return wid * 64 + lane_id(); } };
typedef const __attribute__((address_space(4))) Args* KArgs;
#define KA() ({ KArgs _k = (KArgs)__builtin_amdgcn_kernarg_segment_ptr(); asm volatile("" : "+s"(_k)); _k; })

__device__ __forceinline__ int conv_row(int mode, int n, float& scale) {
    scale = 1.f;
    if (mode == 0) return n;
    if (mode == 1) { if (n >= 2048 && n < 2560) scale = 0.08838834764831845f; if (n < 3072) return n; if (n < 3088) return 3584 + (n - 3072); return n - 16; }
    return (n >> 7) * 256 + (n & 127) + (mode == 3 ? 128 : 0);
}
__device__ __forceinline__ void conv_tiles(const Frame& F, const float* src, bf16_t* dst, int K, int N, int mode, int& gbase) {
    LAS float* tile = (LAS float*)F.lds;
    const int tn = (N + 63) / 64, ntile = (K / 64) * tn, tid = F.tid();
    int t = (F.wg - gbase) % F.G; if (t < 0) t += F.G;
    for (; t < ntile; t += F.G) {
        const int k0 = (t / tn) * 64, n0 = (t % tn) * 64;
        { const int row = tid >> 4, c4 = (tid & 15) * 4;
#pragma unroll
          for (int j = 0; j < 2; ++j) { const int r = row + 32 * j; f32x4 v = (f32x4){0.f, 0.f, 0.f, 0.f};
              if (n0 + c4 < N) v = *(const f32x4*)(src + (size_t)(k0 + r) * N + n0 + c4);
              tile[r * 65 + c4 + 0] = v[0]; tile[r * 65 + c4 + 1] = v[1]; tile[r * 65 + c4 + 2] = v[2]; tile[r * 65 + c4 + 3] = v[3]; } }
        __syncthreads();
        { const int n = tid >> 3, kc = (tid & 7) * 8;
          if (n0 + n < N) { float sc; const int drow = conv_row(mode, n0 + n, sc); float v[8];
#pragma unroll
              for (int j = 0; j < 8; ++j) v[j] = tile[(kc + j) * 65 + n] * sc;
              u32x4 w; w.x = cvt_pk_bf16(v[0], v[1]); w.y = cvt_pk_bf16(v[2], v[3]); w.z = cvt_pk_bf16(v[4], v[5]); w.w = cvt_pk_bf16(v[6], v[7]);
              *(u32x4*)(dst + (size_t)drow * K + k0 + kc) = w; } }
        __syncthreads();
    }
    gbase = (gbase + ntile) % F.G;
}
__device__ void p0_prologue(const Frame& F) {
    const int tid = F.tid(); KArgs ka = KA(); unsigned char* const ws = ka->ws;
    if (F.wg < 192) {
        LAS float* s = (LAS float*)F.lds;
        for (int idx = tid; idx < 33 * 1024; idx += 512) { const int b = idx >> 10, k = idx & 1023; const float v = b < 32 ? ka->in[I_C][b * 1024 + k] : ka->in[I_CCTX][k]; s[idx] = v / (1.0f + __expf(-v)); }
        __syncthreads();
        const int layer = F.wg / 96, col0 = (F.wg % 96) * 64, col = tid & 63, g = tid >> 6;
        const float* W = ka->in[I_WADA] + (size_t)layer * 1024 * 6144 + col0 + col;
        float acc[33];
#pragma unroll
        for (int b = 0; b < 33; ++b) acc[b] = 0.f;
        for (int k4 = 0; k4 < 32; ++k4) { const int k = g * 128 + k4 * 4;
            const float w0 = W[(size_t)(k + 0) * 6144], w1 = W[(size_t)(k + 1) * 6144], w2 = W[(size_t)(k + 2) * 6144], w3 = W[(size_t)(k + 3) * 6144];
#pragma unroll
            for (int b = 0; b < 33; ++b) { const f32x4 s4 = *(const LAS f32x4*)(s + b * 1024 + k); acc[b] += s4[0] * w0 + s4[1] * w1 + s4[2] * w2 + s4[3] * w3; } }
        __syncthreads();
        LAS float* red = (LAS float*)F.lds;
#pragma unroll
        for (int b = 0; b < 33; ++b) red[(g * 33 + b) * 64 + col] = acc[b];
        __syncthreads();
        float* MOD = (float*)(ws + WS_MOD); const float* bada = ka->in[I_BADA];
        for (int idx = tid; idx < 33 * 64; idx += 512) { const int b = idx >> 6, cc = idx & 63; float sum = 0.f;
#pragma unroll
            for (int gg = 0; gg < 8; ++gg) sum += red[(gg * 33 + b) * 64 + cc];
            MOD[((size_t)layer * 33 + b) * 6144 + col0 + cc] = sum + bada[layer * 6144 + col0 + cc]; }
        __syncthreads();
    }
    { bf16_t* WIN = (bf16_t*)(ws + WS_WIN);
      for (int l = 0; l < 2; ++l) { u32x4* p = (u32x4*)(WIN + ((size_t)l * NPAD + PIN) * D); const int n16 = (NPAD - PIN) * D * 2 / 16;
          for (int i = F.wg * 512 + tid; i < n16; i += F.G * 512) p[i] = (u32x4){0u, 0u, 0u, 0u}; } }
    int gbase = 0;
    for (int j = 0; j < 31; ++j) {
        const float* src; bf16_t* dst; int K, N, mode;
        if (j < 2)       { src = ka->in[I_WIN] + (size_t)j * D * PIN; dst = (bf16_t*)(ws + WS_WIN) + (size_t)j * NPAD * D; K = D; N = PIN; mode = 1; }
        else if (j < 4)  { src = ka->in[I_WOUT] + (size_t)(j - 2) * D * D; dst = (bf16_t*)(ws + WS_WOUT) + (size_t)(j - 2) * D * D; K = D; N = D; mode = 0; }
        else if (j == 4) { src = ka->in[I_FW1]; dst = (bf16_t*)(ws + WS_WUP); K = D; N = DFF; mode = 2; }
        else if (j == 5) { src = ka->in[I_FW3]; dst = (bf16_t*)(ws + WS_WUP); K = D; N = DFF; mode = 3; }
        else if (j == 6) { src = ka->in[I_FW2]; dst = (bf16_t*)(ws + WS_WDN); K = DFF; N = D; mode = 0; }
        else if (j < 15) { const int e = j - 7;  src = ka->in[I_MW1] + (size_t)e * D * DFF; dst = (bf16_t*)(ws + WS_MUP) + (size_t)e * 2 * DFF * D; K = D; N = DFF; mode = 2; }
        else if (j < 23) { const int e = j - 15; src = ka->in[I_MW3] + (size_t)e * D * DFF; dst = (bf16_t*)(ws + WS_MUP) + (size_t)e * 2 * DFF * D; K = D; N = DFF; mode = 3; }
        else             { const int e = j - 23; src = ka->in[I_MW2] + (size_t)e * DFF * D; dst = (bf16_t*)(ws + WS_MDN) + (size_t)e * D * DFF; K = DFF; N = D; mode = 0; }
        conv_tiles(F, src, dst, K, N, mode, gbase);
    }
}

template <bool ROUTER>
__device__ __forceinline__ void norm_phase(const Frame& F, const float* srcL, const float* srcC, int nrows, const float* gain, const float* mod  , int chunk_shift, bf16_t* U, const float* router) {
    const int lane = F.lane(), wid = F.wid, tid = F.tid();
    const int rpw = (nrows + F.G * 8 - 1) / (F.G * 8);
    const int rbase = (F.wg * 8 + wid) * rpw;
    LAS float* rl = (LAS float*)F.lds;
    LAS int* cntl = (LAS int*)(F.lds + 32768);
    LAS int* sel = (LAS int*)(F.lds + 32768 + 256);
    if (ROUTER) {
        for (int i = tid; i < 8192; i += 512) rl[i] = router[i];
        if (tid < 32) cntl[tid] = 0;
        __syncthreads();
    }
    f32x4 gn[4];
#pragma unroll
    for (int j = 0; j < 4; ++j) gn[j] = *(const f32x4*)(gain + j * 256 + lane * 4);
    for (int rr = 0; rr < rpw; ++rr) {
        const int r = rbase + rr; if (r >= nrows) break;
        const bool isc = r >= NL;
        const float* src = isc ? srcC + (size_t)(r - NL) * D : srcL + (size_t)r * D;
        const float* mv = mod + (size_t)(isc ? 32 : (r >> 11)) * 6144 + chunk_shift * 1024;
        f32x4 x[4]; float ss = 0.f;
#pragma unroll
        for (int j = 0; j < 4; ++j) { x[j] = *(const f32x4*)(src + j * 256 + lane * 4); ss += x[j][0] * x[j][0] + x[j][1] * x[j][1] + x[j][2] * x[j][2] + x[j][3] * x[j][3]; }
        ss = wave_sum(ss);
        const float rstd = rsqrtf(ss * (1.0f / 1024.0f) + EPS);
        float lg[8];
        if (ROUTER) {
#pragma unroll
            for (int e = 0; e < 8; ++e) lg[e] = 0.f;
        }
#pragma unroll
        for (int j = 0; j < 4; ++j) {
            const f32x4 sh = *(const f32x4*)(mv + j * 256 + lane * 4), sc = *(const f32x4*)(mv + 1024 + j * 256 + lane * 4);
            f32x4 u = (x[j] * rstd * gn[j]) * (sc + 1.0f) + sh;
            u32x2 w; w.x = cvt_pk_bf16(u[0], u[1]); w.y = cvt_pk_bf16(u[2], u[3]);
            *(u32x2*)(U + (size_t)r * D + j * 256 + lane * 4) = w;
            if (ROUTER) {
#pragma unroll
                for (int i = 0; i < 4; ++i) { const LAS f32x4* rp = (const LAS f32x4*)(rl + (j * 256 + lane * 4 + i) * 8); const f32x4 r0 = rp[0], r1 = rp[1];
                    lg[0] += u[i] * r0[0]; lg[1] += u[i] * r0[1]; lg[2] += u[i] * r0[2]; lg[3] += u[i] * r0[3];
                    lg[4] += u[i] * r1[0]; lg[5] += u[i] * r1[1]; lg[6] += u[i] * r1[2]; lg[7] += u[i] * r1[3]; }
            }
        }
        if (ROUTER) {
#pragma unroll
            for (int e = 0; e < 8; ++e) lg[e] = wave_sum(lg[e]);
            int e0 = 0; float v0 = lg[0];
#pragma unroll
            for (int e = 1; e < 8; ++e) if (lg[e] > v0) { v0 = lg[e]; e0 = e; }
            int e1 = -1; float v1 = -3.0e38f;
#pragma unroll
            for (int e = 0; e < 8; ++e) if (e != e0 && lg[e] > v1) { v1 = lg[e]; e1 = e; }
            if (lane == 0) {
                const float g0 = 1.0f / (1.0f + __expf(v1 - v0)), g1 = 1.0f - g0;
                const int r0 = atomicAdd((int*)(cntl + e0), 1), r1 = atomicAdd((int*)(cntl + 8 + e1), 1);
                LAS int* sp = sel + (wid * rpw + rr) * 6;
                sp[0] = e0 | (e1 << 8); sp[1] = r0; sp[2] = r1; sp[3] = __float_as_int(g0); sp[4] = __float_as_int(g1); sp[5] = r;
            }
        }
    }
    if (ROUTER) {
        __syncthreads();
        unsigned char* const ws = KA()->ws;
        if (tid < 16) { unsigned* gc = (unsigned*)(ws + WS_CTL + CTL_GCNT); cntl[16 + tid] = (int)__hip_atomic_fetch_add(gc + tid, (unsigned)cntl[tid], __ATOMIC_RELAXED, __HIP_MEMORY_SCOPE_AGENT); }
        __syncthreads();
        int* rowtok = (int*)(ws + WS_RTOK); float* rowgate = (float*)(ws + WS_RGATE);
        for (int i = tid; i < 8 * rpw; i += 512) {
            const int w = i / rpw, rr = i % rpw; const int r = (F.wg * 8 + w) * rpw + rr;
            if (r < nrows) { const LAS int* sp = sel + i * 6; const int e0 = sp[0] & 255, e1 = sp[0] >> 8;
                const int p0 = cntl[16 + e0] + sp[1], p1 = cntl[16 + 8 + e1] + sp[2];
                rowtok[(size_t)e0 * RT_STRIDE + p0] = sp[5]; rowgate[(size_t)e0 * RT_STRIDE + p0] = __int_as_float(sp[3]);
                rowtok[(size_t)(8 + e1) * RT_STRIDE + p1] = sp[5]; rowgate[(size_t)(8 + e1) * RT_STRIDE + p1] = __int_as_float(sp[4]); }
        }
        __syncthreads();
    }
}

__device__ __forceinline__ void unpack8(const u32x4 w, float (&v)[8]) { v[0] = bflo(w.x); v[1] = bfhi(w.x); v[2] = bflo(w.y); v[3] = bfhi(w.y); v[4] = bflo(w.z); v[5] = bfhi(w.z); v[6] = bflo(w.w); v[7] = bfhi(w.w); }
__device__ __forceinline__ u32x4 pack8(const float (&v)[8]) { u32x4 w; w.x = cvt_pk_bf16(v[0], v[1]); w.y = cvt_pk_bf16(v[2], v[3]); w.z = cvt_pk_bf16(v[4], v[5]); w.w = cvt_pk_bf16(v[6], v[7]); return w; }
__device__ __forceinline__ void mix_phase(const Frame& F, int nrows, const float* convw  , const float* gnorm  ) {
    const int lane = F.lane(); unsigned char* const ws = KA()->ws;
    const bf16_t* P = (const bf16_t*)(ws + WS_PROJ); const bf16_t* HL = (const bf16_t*)(ws + WS_HL); bf16_t* A2 = (bf16_t*)(ws + WS_U);
    const int rpw = (nrows + F.G * 8 - 1) / (F.G * 8); const int rbase = (F.wg * 8 + F.wid) * rpw;
    float w0[8], w1[8], w2[8], gnv[8];
#pragma unroll
    for (int j = 0; j < 8; ++j) { w0[j] = convw[lane * 8 + j]; w1[j] = convw[512 + lane * 8 + j]; w2[j] = convw[1024 + lane * 8 + j]; gnv[j] = gnorm[lane * 8 + j]; }
    for (int rr = 0; rr < rpw; ++rr) {
        const int r = rbase + rr; if (r >= nrows) break;
        bool hasL, hasR;
        if (r < NL) { const int cc = r & 63; hasL = cc != 0; hasR = cc != 63; } else { const int t = (r - NL) & 255; hasL = t != 0; hasR = t != 255; }
        const bf16_t* pr = P + (size_t)r * NPROJ + lane * 8;
        float gb[8], zc[8], zl[8], zr[8], t0[8], t1[8];
        unpack8(*(const u32x4*)pr, gb);
        unpack8(*(const u32x4*)(pr + 512), t0); unpack8(*(const u32x4*)(pr + 1024), t1);
#pragma unroll
        for (int j = 0; j < 8; ++j) zc[j] = t0[j] * t1[j];
        if (hasL) { unpack8(*(const u32x4*)(pr - NPROJ + 512), t0); unpack8(*(const u32x4*)(pr - NPROJ + 1024), t1);
#pragma unroll
            for (int j = 0; j < 8; ++j) zl[j] = t0[j] * t1[j]; }
        else {
#pragma unroll
            for (int j = 0; j < 8; ++j) zl[j] = 0.f; }
        if (hasR) { unpack8(*(const u32x4*)(pr + NPROJ + 512), t0); unpack8(*(const u32x4*)(pr + NPROJ + 1024), t1);
#pragma unroll
            for (int j = 0; j < 8; ++j) zr[j] = t0[j] * t1[j]; }
        else {
#pragma unroll
            for (int j = 0; j < 8; ++j) zr[j] = 0.f; }
        float y[8];
#pragma unroll
        for (int j = 0; j < 8; ++j) y[j] = gb[j] * (w0[j] * zl[j] + w1[j] * zc[j] + w2[j] * zr[j]);
        *(u32x4*)(A2 + (size_t)r * D + lane * 8) = pack8(y);
        float hf[8], hb[8], og[8];
        unpack8(*(const u32x4*)(HL + (size_t)r * 512 + lane * 8), hf); unpack8(*(const u32x4*)(HL + (size_t)(MT + r) * 512 + lane * 8), hb);
        unpack8(*(const u32x4*)(pr + 3072), og);
        float ss = 0.f;
#pragma unroll
        for (int j = 0; j < 8; ++j) { hf[j] += hb[j]; ss += hf[j] * hf[j]; }
        ss += __shfl_xor(ss, 1); ss += __shfl_xor(ss, 2); ss += __shfl_xor(ss, 4); ss += __shfl_xor(ss, 8);
        const float rstd = rsqrtf(ss * (1.0f / 128.0f) + EPS);
#pragma unroll
        for (int j = 0; j < 8; ++j) y[j] = hf[j] * rstd * gnv[j] * sigmoidf_(og[j]);
        *(u32x4*)(A2 + (size_t)r * D + 512 + lane * 8) = pack8(y);
    }
}

__device__ __forceinline__ void final_phase(const Frame& F) {
    const int lane = F.lane(); KArgs ka = KA(); const float* gain = ka->in[I_FNG]; float* const outp = ka->out;
    const int rpw = (NL + F.G * 8 - 1) / (F.G * 8); const int rbase = (F.wg * 8 + F.wid) * rpw;
    f32x4 gn[4];
#pragma unroll
    for (int j = 0; j < 4; ++j) gn[j] = *(const f32x4*)(gain + j * 256 + lane * 4);
    for (int rr = 0; rr < rpw; ++rr) {
        const int r = rbase + rr; if (r >= NL) break;
        float* p = outp + (size_t)r * D;
        f32x4 x[4]; float ss = 0.f;
#pragma unroll
        for (int j = 0; j < 4; ++j) { x[j] = *(const f32x4*)(p + j * 256 + lane * 4); ss += x[j][0] * x[j][0] + x[j][1] * x[j][1] + x[j][2] * x[j][2] + x[j][3] * x[j][3]; }
        ss = wave_sum(ss);
        const float rstd = rsqrtf(ss * (1.0f / 1024.0f) + EPS);
#pragma unroll
        for (int j = 0; j < 4; ++j) *(f32x4*)(p + j * 256 + lane * 4) = x[j] * rstd * gn[j];
    }
}

constexpr int ML_RB = 272;
constexpr int ML_Q = 0, ML_K = 34816, ML_V = 69632, ML_S = 104448, ML_VEC = 139264;
__device__ __forceinline__ bf16x8 tr_frag(const LAS unsigned char* base, int row0, int col0, int lane) {
    const int g = lane >> 4, q = (lane & 15) >> 2, p = lane & 3;
    const LAS unsigned char* a = base + (row0 + 8 * g + q) * ML_RB + (col0 + 4 * p) * 2;
    const s16x4 v0 = __builtin_amdgcn_ds_read_tr16_b64_v4i16((LAS s16x4*)a);
    const s16x4 v1 = __builtin_amdgcn_ds_read_tr16_b64_v4i16((LAS s16x4*)(a + 4 * ML_RB));
    return (bf16x8){v0[0], v0[1], v0[2], v0[3], v1[0], v1[1], v1[2], v1[3]};
}
__device__ void mlstm_phase(const Frame& F, bool ctx_out) {
    const int tid = F.tid(), lane = F.lane(), wid = F.wid, fr = lane & 15, fq = lane >> 4;
    LAS unsigned char* lds = F.lds;
    LAS float* ic = (LAS float*)(lds + ML_VEC); LAS float* fc = ic + 128; LAS float* av = ic + 256; LAS float* Mv = ic + 384; LAS float* bcv = ic + 512;
    LAS float* rden = ic + 640; LAS float* wintv = ic + 768; LAS float* nvec = ic + 896; LAS float* wkv = ic + 1024;
    unsigned char* const ws = KA()->ws;
    const bf16_t* P = (const bf16_t*)(ws + WS_PROJ); const float* GT = (const float*)(ws + WS_GATES); bf16_t* HL = (bf16_t*)(ws + WS_HL);
    for (int unit = F.wg; unit < 256; unit += F.G) {
        const int b = unit >> 3, hd = (unit >> 1) & 3, dir = unit & 1;
        f32x4 Cacc[8];
#pragma unroll
        for (int a = 0; a < 8; ++a) Cacc[a] = (f32x4){0.f, 0.f, 0.f, 0.f};
        float m = 0.f;
        if (tid < 128) nvec[tid] = 0.f;
        u32x4 st[12]; float gi = 0.f, gf = 0.f;
#define ML_ROW0(ci) ((ci) < 2 ? NL + b * 256 + (dir ? 1 - (ci) : (ci)) * 128 : b * 2048 + (dir ? 15 - ((ci) - 2) : ((ci) - 2)) * 128)
#define ML_LOAD(ci) do { const int _r0 = ML_ROW0(ci); _Pragma("unroll") for (int _p = 0; _p < 4; ++_p) { const int _id = tid + 512 * _p, _row = _id >> 4, _ch = _id & 15; \
            const bf16_t* _g = P + (size_t)(_r0 + _row) * NPROJ + 1536 + hd * 128 + _ch * 8; st[_p] = *(const u32x4*)_g; st[4 + _p] = *(const u32x4*)(_g + 512); st[8 + _p] = *(const u32x4*)(_g + 1024); } \
            if (tid < 128) { gi = GT[(size_t)(_r0 + tid) * 16 + (2 * dir) * 4 + hd]; gf = GT[(size_t)(_r0 + tid) * 16 + (2 * dir + 1) * 4 + hd]; } } while (0)
        ML_LOAD(0);
        for (int ci = 0; ci < 18; ++ci) {
            const int row0 = ML_ROW0(ci);
            const bool need_out = (ci >= 2) || ctx_out;
#pragma unroll
            for (int p = 0; p < 4; ++p) { const int id = tid + 512 * p, row = id >> 4, ch = id & 15; const int o = row * ML_RB + ch * 16;
                *(LAS u32x4*)(lds + ML_Q + o) = st[p]; *(LAS u32x4*)(lds + ML_K + o) = st[4 + p]; *(LAS u32x4*)(lds + ML_V + o) = st[8 + p]; }
            if (tid < 128) { ic[tid] = gi; fc[tid] = fminf(gf, 0.f) - log1pf(__expf(-fabsf(gf))); }
            if (ci + 1 < 18) ML_LOAD(ci + 1);
            __syncthreads();
            float bL, Mlast;
            { const int p0 = 2 * lane, p1 = p0 + 1, s0 = dir ? 127 - p0 : p0, s1 = dir ? 127 - p1 : p1;
              const float f0 = fc[s0], f1 = fc[s1], i0 = ic[s0], i1 = ic[s1];
              float incl = f0 + f1;
#pragma unroll
              for (int d = 1; d < 64; d <<= 1) { const float t = __shfl_up(incl, d); if (lane >= d) incl += t; }
              const float bc1 = incl, bc0 = incl - f1;
              const float a0 = i0 - bc0, a1 = i1 - bc1;
              float im = fmaxf(a0, a1);
#pragma unroll
              for (int d = 1; d < 64; d <<= 1) { const float t = __shfl_up(im, d); if (lane >= d) im = fmaxf(im, t); }
              float ex = __shfl_up(im, 1); if (lane == 0) ex = -3.0e38f;
              const float M0 = fmaxf(fmaxf(m, ex), a0), M1 = fmaxf(m, im);
              bL = __shfl(incl, 63); Mlast = __shfl(M1, 63);
              av[s0] = a0; av[s1] = a1; Mv[s0] = M0; Mv[s1] = M1; bcv[s0] = bc0; bcv[s1] = bc1;
              wkv[s0] = __expf(a0 - Mlast); wkv[s1] = __expf(a1 - Mlast); }
            if (need_out) {
                const int t = 16 * wid + fr; const float Mt = Mv[t];
                bf16x8 Qf[4];
#pragma unroll
                for (int ks = 0; ks < 4; ++ks) Qf[ks] = *(const LAS bf16x8*)(lds + ML_Q + t * ML_RB + (32 * ks + 8 * fq) * 2);
                float rowsum = 0.f;
#pragma unroll 1
                for (int j = 0; j < 8; ++j) {
                    f32x4 acc = (f32x4){0.f, 0.f, 0.f, 0.f};
#pragma unroll
                    for (int ks = 0; ks < 4; ++ks) { const bf16x8 Kf = *(const LAS bf16x8*)(lds + ML_K + (16 * j + fr) * ML_RB + (32 * ks + 8 * fq) * 2); acc = __builtin_amdgcn_mfma_f32_16x16x32_bf16(Kf, Qf[ks], acc, 0, 0, 0); }
                    const f32x4 a4 = *(const LAS f32x4*)(av + 16 * j + 4 * fq);
                    float v[4];
#pragma unroll
                    for (int r = 0; r < 4; ++r) { const int s = 16 * j + 4 * fq + r; const bool valid = dir ? (s >= t) : (s <= t); v[r] = valid ? acc[r] * __expf(a4[r] - Mt) : 0.f; rowsum += v[r]; }
                    u32x2 w; w.x = cvt_pk_bf16(v[0], v[1]); w.y = cvt_pk_bf16(v[2], v[3]);
                    *(LAS u32x2*)(lds + ML_S + t * ML_RB + (16 * j + 4 * fq) * 2) = w;
                }
                rowsum += __shfl_xor(rowsum, 16); rowsum += __shfl_xor(rowsum, 32);
                float qn = 0.f;
#pragma unroll
                for (int ks = 0; ks < 4; ++ks) { const f32x4 n0 = *(const LAS f32x4*)(nvec + 32 * ks + 8 * fq), n1 = *(const LAS f32x4*)(nvec + 32 * ks + 8 * fq + 4);
#pragma unroll
                    for (int jj = 0; jj < 4; ++jj) { qn += bf2f((unsigned short)Qf[ks][jj]) * n0[jj]; qn += bf2f((unsigned short)Qf[ks][4 + jj]) * n1[jj]; } }
                qn += __shfl_xor(qn, 16); qn += __shfl_xor(qn, 32);
                const float wi = __expf(m - Mt), den = rowsum + wi * qn, dn = fmaxf(fabsf(den), __expf(-(bcv[t] + Mt)));
                if (fq == 0) { rden[t] = 1.0f / dn; wintv[t] = wi; }
            }
            __syncthreads();
            bf16x8 Vf[4];
#pragma unroll
            for (int ks = 0; ks < 4; ++ks) Vf[ks] = tr_frag(lds + ML_V, 32 * ks, 16 * wid, lane);
            if (need_out) {
                bf16x8 Cf[4];
#pragma unroll
                for (int kp = 0; kp < 4; ++kp) { const f32x4 c0 = Cacc[2 * kp], c1 = Cacc[2 * kp + 1]; u32x4 w; w.x = cvt_pk_bf16(c0[0], c0[1]); w.y = cvt_pk_bf16(c0[2], c0[3]); w.z = cvt_pk_bf16(c1[0], c1[1]); w.w = cvt_pk_bf16(c1[2], c1[3]);
                    Cf[kp] = __builtin_bit_cast(bf16x8, w); }
#pragma unroll 1
                for (int i = 0; i < 8; ++i) {
                    f32x4 aS = (f32x4){0.f, 0.f, 0.f, 0.f}, aC = (f32x4){0.f, 0.f, 0.f, 0.f};
                    const int tt = 16 * i + fr;
#pragma unroll
                    for (int ks = 0; ks < 4; ++ks) { const bf16x8 Sf = *(const LAS bf16x8*)(lds + ML_S + tt * ML_RB + (32 * ks + 8 * fq) * 2); aS = __builtin_amdgcn_mfma_f32_16x16x32_bf16(Vf[ks], Sf, aS, 0, 0, 0); }
#pragma unroll
                    for (int kp = 0; kp < 4; ++kp) { const s16x4 q0 = *(const LAS s16x4*)(lds + ML_Q + tt * ML_RB + (32 * kp + 4 * fq) * 2), q1 = *(const LAS s16x4*)(lds + ML_Q + tt * ML_RB + (32 * kp + 16 + 4 * fq) * 2);
                        const bf16x8 Qp = (bf16x8){q0[0], q0[1], q0[2], q0[3], q1[0], q1[1], q1[2], q1[3]};
                        aC = __builtin_amdgcn_mfma_f32_16x16x32_bf16(Cf[kp], Qp, aC, 0, 0, 0); }
                    const float wi = wintv[tt], rd = rden[tt];
                    u32x2 w; w.x = cvt_pk_bf16((aS[0] + wi * aC[0]) * rd, (aS[1] + wi * aC[1]) * rd); w.y = cvt_pk_bf16((aS[2] + wi * aC[2]) * rd, (aS[3] + wi * aC[3]) * rd);
                    *(u32x2*)(HL + ((size_t)dir * MT + row0 + tt) * 512 + hd * 128 + 16 * wid + 4 * fq) = w;
                }
            }
            {
                const float dec = __expf(m - Mlast);
                bf16x8 Vw[4];
#pragma unroll
                for (int ks = 0; ks < 4; ++ks) { const f32x4 k0 = *(const LAS f32x4*)(wkv + 32 * ks + 8 * fq), k1 = *(const LAS f32x4*)(wkv + 32 * ks + 8 * fq + 4);
                    u32x4 w;
                    w.x = cvt_pk_bf16(bf2f((unsigned short)Vf[ks][0]) * k0[0], bf2f((unsigned short)Vf[ks][1]) * k0[1]); w.y = cvt_pk_bf16(bf2f((unsigned short)Vf[ks][2]) * k0[2], bf2f((unsigned short)Vf[ks][3]) * k0[3]);
                    w.z = cvt_pk_bf16(bf2f((unsigned short)Vf[ks][4]) * k1[0], bf2f((unsigned short)Vf[ks][5]) * k1[1]); w.w = cvt_pk_bf16(bf2f((unsigned short)Vf[ks][6]) * k1[2], bf2f((unsigned short)Vf[ks][7]) * k1[3]);
                    Vw[ks] = __builtin_bit_cast(bf16x8, w); }
#pragma unroll
                for (int a = 0; a < 8; ++a) { Cacc[a] = Cacc[a] * dec;
#pragma unroll
                    for (int ks = 0; ks < 4; ++ks) { const bf16x8 Kt = tr_frag(lds + ML_K, 32 * ks, 16 * a, lane); Cacc[a] = __builtin_amdgcn_mfma_f32_16x16x32_bf16(Kt, Vw[ks], Cacc[a], 0, 0, 0); } }
                if (tid < 128) { float an = dec * nvec[tid];
#pragma unroll 8
                    for (int s = 0; s < 128; ++s) an += wkv[s] * bf2f(*(const LAS unsigned short*)(lds + ML_K + s * ML_RB + tid * 2));
                    nvec[tid] = an; }
                m = bL + Mlast;
            }
            __syncthreads();
        }
#undef ML_ROW0
#undef ML_LOAD
    }
}

constexpr int NPH = 20;
__global__ void __launch_bounds__(512, 2) mk_fwd(Args args_unused) {
    extern __shared__ __attribute__((aligned(16))) unsigned char smem[];
    Frame F;
    F.lds = (LAS unsigned char*)smem; F.wid = __builtin_amdgcn_readfirstlane((int)threadIdx.x >> 6); F.G = gridDim.x; F.wg = blockIdx.x;
    volatile LAS unsigned* misc = (volatile LAS unsigned*)(F.lds + MISC_OFF);
    if (F.tid() < 64) misc[F.tid()] = 0u;
    __syncthreads();
    int lo, hi;
    { KArgs ka = KA(); lo = ka->lo; hi = ka->hi; }
    XcdBarrier bar;
    { KArgs ka = KA(); bar.bar = (unsigned*)(ka->ws + WS_CTL); bar.x = 0; bar.st = misc; bar.wid = F.wid;
      if (hi - lo > 1) bar = xcd_barrier_post((unsigned*)(ka->ws + WS_CTL), misc, F.wid); }
#define IN(k) (lo <= (k) && (k) < hi)
#define SEAM(k) do { if (IN(k) && IN((k) + 1)) { KArgs _ka = KA(); bar.bar = (unsigned*)(_ka->ws + WS_CTL); xcd_barrier(bar); } } while (0)
    const volatile LAS int* tb = (const volatile LAS int*)(F.lds + MISC_OFF + 64);
    volatile LAS int* tbw = (volatile LAS int*)(F.lds + MISC_OFF + 64);

    if (IN(0)) { p0_prologue(F); }
    SEAM(0);
    if (IN(1)) { KArgs ka = KA(); unsigned char* ws = ka->ws;
        norm_phase<false>(F, ka->in[I_X], ka->in[I_CTX], MT, ka->in[I_N1G], (const float*)(ws + WS_MOD), 0, (bf16_t*)(ws + WS_U), nullptr); }
    SEAM(1);
    if (IN(2)) { KArgs ka = KA(); unsigned char* ws = ka->ws;
        pg8::DenseSched S{MT / 256, NPAD / 256, F.G, F.wg, D, (const char*)(ws + WS_WIN)};
        pg8::EpiProj E{(bf16_t*)(ws + WS_PROJ), (float*)(ws + WS_GATES), ka->in[I_BG]};
        pg8::gemm_phase(F.lds, F.wid, (const char*)(ws + WS_U), D, S, E); }
    SEAM(2);
    if (IN(3)) { mlstm_phase(F, true); }
    SEAM(3);
    if (IN(4)) { KArgs ka = KA(); mix_phase(F, MT, ka->in[I_CONVW], ka->in[I_MNG]); }
    SEAM(4);
    if (IN(5)) { KArgs ka = KA(); unsigned char* ws = ka->ws;
        pg8::DenseSched S{MT / 256, D / 256, F.G, F.wg, D, (const char*)(ws + WS_WOUT)};
        pg8::EpiResid E{ka->in[I_X], ka->in[I_CTX], ka->out, (float*)(ws + WS_HC), (const float*)(ws + WS_MOD) + 2 * 1024};
        pg8::gemm_phase(F.lds, F.wid, (const char*)(ws + WS_U), D, S, E); }
    SEAM(5);
    if (IN(6)) { KArgs ka = KA(); unsigned char* ws = ka->ws;
        norm_phase<false>(F, ka->out, (const float*)(ws + WS_HC), MT, ka->in[I_N2G], (const float*)(ws + WS_MOD), 3, (bf16_t*)(ws + WS_U), nullptr); }
    SEAM(6);
    if (IN(7)) { KArgs ka = KA(); unsigned char* ws = ka->ws;
        pg8::DenseSched S{MT / 256, 2 * DFF / 256, F.G, F.wg, D, (const char*)(ws + WS_WUP)};
        pg8::EpiSwiglu E{(bf16_t*)(ws + WS_PROJ)};
        pg8::gemm_phase(F.lds, F.wid, (const char*)(ws + WS_U), D, S, E); }
    SEAM(7);
    if (IN(8)) { KArgs ka = KA(); unsigned char* ws = ka->ws;
        pg8::DenseSched S{MT / 256, D / 256, F.G, F.wg, DFF, (const char*)(ws + WS_WDN)};
        pg8::EpiResid E{ka->out, (const float*)(ws + WS_HC), ka->out, (float*)(ws + WS_HC), (const float*)(ws + WS_MOD) + 5 * 1024};
        pg8::gemm_phase(F.lds, F.wid, (const char*)(ws + WS_PROJ), DFF, S, E); }
    SEAM(8);
    if (IN(9)) { KArgs ka = KA(); unsigned char* ws = ka->ws;
        norm_phase<false>(F, ka->out, (const float*)(ws + WS_HC), MT, ka->in[I_N1G] + D, (const float*)(ws + WS_MOD) + 33 * 6144, 0, (bf16_t*)(ws + WS_U), nullptr); }
    SEAM(9);
    if (IN(10)) { KArgs ka = KA(); unsigned char* ws = ka->ws;
        pg8::InProjL1Sched S{F.G, F.wg, (const char*)(ws + WS_WIN) + (size_t)NPAD * D * 2};
        pg8::EpiProj E{(bf16_t*)(ws + WS_PROJ), (float*)(ws + WS_GATES), ka->in[I_BG] + 16};
        pg8::gemm_phase(F.lds, F.wid, (const char*)(ws + WS_U), D, S, E); }
    SEAM(10);
    if (IN(11)) { mlstm_phase(F, false); }
    SEAM(11);
    if (IN(12)) { KArgs ka = KA(); mix_phase(F, NL, ka->in[I_CONVW] + 3 * 512, ka->in[I_MNG] + 512); }
    SEAM(12);
    if (IN(13)) { KArgs ka = KA(); unsigned char* ws = ka->ws;
        pg8::DenseSched S{NL / 256, D / 256, F.G, F.wg, D, (const char*)(ws + WS_WOUT) + (size_t)D * D * 2};
        pg8::EpiResid E{ka->out, nullptr, ka->out, nullptr, (const float*)(ws + WS_MOD) + 33 * 6144 + 2 * 1024};
        pg8::gemm_phase(F.lds, F.wid, (const char*)(ws + WS_U), D, S, E); }
    SEAM(13);
    if (IN(14)) { KArgs ka = KA(); unsigned char* ws = ka->ws;
        norm_phase<true>(F, ka->out, nullptr, NL, ka->in[I_N2G] + D, (const float*)(ws + WS_MOD) + 33 * 6144, 3, (bf16_t*)(ws + WS_U), ka->in[I_ROUTER]); }
    SEAM(14);
    for (int k = 0; k < 2; ++k) {
        if (IN(15 + 2 * k) || IN(16 + 2 * k)) {
            __syncthreads();
            if (F.tid() == 0) { KArgs ka = KA(); const unsigned* gc = (const unsigned*)(ka->ws + WS_CTL + CTL_GCNT) + 8 * k; int t = 0;
                for (int g = 0; g < 8; ++g) { const int c = (int)__hip_atomic_load(gc + g, __ATOMIC_RELAXED, __HIP_MEMORY_SCOPE_AGENT); tbw[g] = t; tbw[16 + g] = c; t += (c + 255) >> 8; }
                tbw[8] = t; }
            __syncthreads();
        }
        if (IN(15 + 2 * k)) { KArgs ka = KA(); unsigned char* ws = ka->ws;
            pg8::MoeUpSched S{F.G, F.wg, (const char*)(ws + WS_MUP), (const int*)(ws + WS_RTOK) + (size_t)k * 8 * RT_STRIDE, tb};
            pg8::EpiSwiglu E{(bf16_t*)(ws + WS_PROJ)};
            pg8::gemm_phase(F.lds, F.wid, (const char*)(ws + WS_U), D, S, E); }
        SEAM(15 + 2 * k);
        if (IN(16 + 2 * k)) { KArgs ka = KA(); unsigned char* ws = ka->ws;
            pg8::MoeDownSched S{F.G, F.wg, (const char*)(ws + WS_MDN), tb};
            pg8::EpiMoeDown E{ka->out, (const float*)(ws + WS_MOD) + 33 * 6144 + 5 * 1024, (const int*)(ws + WS_RTOK) + (size_t)k * 8 * RT_STRIDE, (const float*)(ws + WS_RGATE) + (size_t)k * 8 * RT_STRIDE, tb};
            pg8::gemm_phase(F.lds, F.wid, (const char*)(ws + WS_PROJ), DFF, S, E); }
        SEAM(16 + 2 * k);
    }
    if (IN(19)) { final_phase(F); }
#undef IN
#undef SEAM
}

extern "C" void kernel_launch(void* const* d_in, const int* in_sizes, int n_in, void* d_out, int out_size, void* d_ws, size_t ws_size, hipStream_t stream) {
    static int grid = 0;
    if (grid == 0) {
        if (n_in != 21 || ws_size < WS_END) { fprintf(stderr, "kernel_launch: expected 21 inputs and >= %zu bytes of workspace; got %d, %zu\n", (size_t)WS_END, n_in, ws_size); grid = -1; return; }
        int dev = 0, cus = 0, per_cu = 0;
        if (hipGetDevice(&dev) != hipSuccess || hipDeviceGetAttribute(&cus, hipDeviceAttributeMultiprocessorCount, dev) != hipSuccess) { grid = -1; return; }
        if (hipFuncSetAttribute((const void*)mk_fwd, hipFuncAttributeMaxDynamicSharedMemorySize, LDS_BYTES) != hipSuccess) { fprintf(stderr, "kernel_launch: hipFuncSetAttribute failed\n"); grid = -1; return; }
        if (hipOccupancyMaxActiveBlocksPerMultiprocessor(&per_cu, (const void*)mk_fwd, 512, LDS_BYTES) != hipSuccess || per_cu < 1) fprintf(stderr, "kernel_launch: occupancy query reports %d\n", per_cu);
        (void)hipGetLastError();
        grid = cus;
    }
    if (grid < 0) return;
    (void)hipMemsetAsync((char*)d_ws + WS_CTL, 0, CTL_BYTES, stream);
    Args a{};
    for (int i = 0; i < 21; ++i) a.in[i] = (const float*)d_in[i];
    a.out = (float*)d_out; a.ws = (unsigned char*)d_ws;
#if MK_PER_PHASE
    for (int p = 0; p < NPH; ++p) { a.lo = p; a.hi = p + 1; hipLaunchKernelGGL(mk_fwd, dim3(grid), dim3(512), LDS_BYTES, stream, a); }
#else
    a.lo = 0; a.hi = NPH; hipLaunchKernelGGL(mk_fwd, dim3(grid), dim3(512), LDS_BYTES, stream, a);
#endif
}
```

```cpp
#include <hip/hip_runtime.h>
#include <cstdio>
#include <cstdint>

#ifndef MK_PER_PHASE
#define MK_PER_PHASE 0
#endif

#define LAS __attribute__((address_space(3)))
typedef unsigned short bf16_t;
typedef short bf16x8 __attribute__((ext_vector_type(8)));
typedef short s16x4 __attribute__((ext_vector_type(4)));
typedef float f32x4 __attribute__((ext_vector_type(4)));
typedef unsigned u32x4 __attribute__((ext_vector_type(4)));
typedef unsigned u32x2 __attribute__((ext_vector_type(2)));

constexpr int D = 1024, NB = 32, SEQ = 2048, CTXL = 256;
constexpr int NL = NB * SEQ;
constexpr int NCX = NB * CTXL;
constexpr int MT = NL + NCX;
constexpr int PIN = 3600, NPROJ = 3584, NPAD = 3840;
constexpr int DFF = 2816, NE = 8;
constexpr float EPS = 1e-6f;
constexpr int RT_STRIDE = 65536;
constexpr float S_A = 16.0f, S_W13 = 256.0f, S_H = 8.0f, S_W2 = 256.0f;

constexpr size_t WS_CTL = 0;
constexpr size_t CTL_BYTES = 65536;
constexpr size_t CTL_GCNT = 16384;
constexpr size_t WS_MOD = 65536;
constexpr size_t WS_WIN = 2097152;
constexpr size_t WS_WOUT = WS_WIN + (size_t)2 * NPAD * D * 2;
constexpr size_t WS_WUP = WS_WOUT + (size_t)2 * D * D * 2;
constexpr size_t WS_WDN = WS_WUP + (size_t)2 * DFF * D * 2;
constexpr size_t WS_MUP = WS_WDN + (size_t)D * DFF * 2;
constexpr size_t WS_MDN = WS_MUP + (size_t)NE * 2 * DFF * D * 2;
constexpr size_t WS_HC = WS_MDN + (size_t)NE * D * DFF * 2;
constexpr size_t WS_U = WS_HC + (size_t)NCX * D * 4;
constexpr size_t WS_PROJ = WS_U + (size_t)MT * D * 2;
constexpr size_t WS_GATES = WS_PROJ + (size_t)MT * NPROJ * 2;
constexpr size_t WS_HL = WS_GATES + (size_t)MT * 16 * 4;
constexpr size_t WS_RTOK = WS_HL + (size_t)2 * MT * 512 * 2;
constexpr size_t WS_RGATE = WS_RTOK + (size_t)16 * RT_STRIDE * 4;
constexpr size_t WS_END = WS_RGATE + (size_t)16 * RT_STRIDE * 4;

constexpr int LDS_BYTES = 147456;
constexpr int MISC_OFF = 145408;

__device__ __forceinline__ unsigned cvt_pk_bf16(float lo, float hi) { unsigned r; asm volatile("v_cvt_pk_bf16_f32 %0, %1, %2" : "=v"(r) : "v"(lo), "v"(hi)); return r; }
__device__ __forceinline__ float bf2f(unsigned short b) { return __uint_as_float(((unsigned)b) << 16); }
__device__ __forceinline__ float bflo(unsigned w) { return __uint_as_float(w << 16); }
__device__ __forceinline__ float bfhi(unsigned w) { return __uint_as_float(w & 0xffff0000u); }
__device__ __forceinline__ float wave_sum(float v) {
#pragma unroll
    for (int o = 32; o >= 1; o >>= 1) v += __shfl_xor(v, o);
    return v;
}
__device__ __forceinline__ int lane_id() { int l; asm volatile("v_mbcnt_lo_u32_b32 %0, -1, 0\n\tv_mbcnt_hi_u32_b32 %0, -1, %0" : "=v"(l)); return l; }
__device__ __forceinline__ float sigmoidf_(float x) { return 1.0f / (1.0f + __expf(-x)); }

#define XB_TMO      128
#define XB_XCNT(j)  (256  + 64 * (j))
#define XB_XSUB(j)  (1280 + 64 * (j))
#define XB_XGEN(j)  (2304 + 64 * (j))
#define XB_TOP      3328
#define XB_TOPGEN   3392
#define XCD_BAR_WORDS 3456
#define XB_SPIN_CAP (1u << 18)

__device__ __forceinline__ unsigned xb_ld(unsigned* p)              { return __hip_atomic_load(p, __ATOMIC_RELAXED, __HIP_MEMORY_SCOPE_AGENT); }
__device__ __forceinline__ unsigned xb_add(unsigned* p, unsigned v) { return __hip_atomic_fetch_add(p, v, __ATOMIC_RELAXED, __HIP_MEMORY_SCOPE_AGENT); }
__device__ __forceinline__ unsigned xb_xcc_id() { return (unsigned)__builtin_amdgcn_s_getreg((3 << 11) | 20) & 0xFu; }
#define XB_SPIN(cond, bar) do { unsigned _sp = 0; while (cond) { __builtin_amdgcn_s_sleep(1); \
    if ((++_sp & 255u) == 0u) { if (xb_ld(&(bar)[XB_TMO])) break; if (_sp > XB_SPIN_CAP) { atomicAdd(&(bar)[XB_TMO], 1u); break; } } } } while (0)

struct XcdBarrier {
    unsigned* bar; unsigned x;
    volatile LAS unsigned* st;
    int wid;
};
#define XB_THREAD0(b) ((b).wid == 0 && lane_id() == 0)
__device__ __forceinline__ XcdBarrier xcd_barrier_post(unsigned* bar, volatile LAS unsigned* st, int wid) {
    XcdBarrier b; b.bar = bar; b.x = xb_xcc_id(); b.st = st; b.wid = wid;
    if (XB_THREAD0(b)) (void)xb_add(&bar[XB_XCNT(b.x)], 1u);
    return b;
}
__device__ __forceinline__ void xcd_barrier_complete(unsigned* bar, unsigned x, unsigned& nloc, unsigned& nx) {
    const unsigned G = gridDim.x * gridDim.y * gridDim.z;
    unsigned sum, cnt, mine, sp = 0u;
    for (;;) {
        sum = 0u; cnt = 0u; mine = 0u;
#pragma unroll
        for (unsigned j = 0; j < 16; ++j) { const unsigned c = xb_ld(&bar[XB_XCNT(j)]); sum += c; cnt += (c > 0u) ? 1u : 0u; mine = (j == x) ? c : mine; }
        if (sum == G) break;
        __builtin_amdgcn_s_sleep(1);
        if ((++sp & 255u) == 0u) { if (xb_ld(&bar[XB_TMO])) break; if (sp > XB_SPIN_CAP) { atomicAdd(&bar[XB_TMO], 1u); break; } }
    }
    nloc = mine > 0u ? mine : 1u; nx = cnt > 0u ? cnt : 1u;
}
__device__ __forceinline__ void xcd_barrier(const XcdBarrier& b) {
    asm volatile("s_waitcnt vmcnt(0)" ::: "memory");
    __syncthreads();
    if (XB_THREAD0(b)) {
        unsigned* bar = b.bar;
        __builtin_amdgcn_s_waitcnt(0);
        unsigned nloc = b.st[0], nx = b.st[1];
        if (nloc == 0u) { xcd_barrier_complete(bar, b.x, nloc, nx); b.st[0] = nloc; b.st[1] = nx; }
        const unsigned old = xb_add(&bar[XB_XSUB(b.x)], 1u);
        const unsigned gen = old / nloc;
        if (old + 1u == (gen + 1u) * nloc) {
            __builtin_amdgcn_fence(__ATOMIC_RELEASE, "agent");
            asm volatile("s_waitcnt vmcnt(0)" ::: "memory");
            const unsigned og = xb_add(&bar[XB_TOP], 1u);
            const unsigned tg = og / nx;
            if (og + 1u == (tg + 1u) * nx) xb_add(&bar[XB_TOPGEN], 1u);
            else XB_SPIN(xb_ld(&bar[XB_TOPGEN]) == tg, bar);
            __builtin_amdgcn_fence(__ATOMIC_ACQUIRE, "agent");
            xb_add(&bar[XB_XGEN(b.x)], 1u);
            asm volatile("s_waitcnt vmcnt(0)" ::: "memory");
        } else {
            XB_SPIN(xb_ld(&bar[XB_XGEN(b.x)]) == gen, bar);
            __builtin_amdgcn_fence(__ATOMIC_ACQUIRE, "agent");
            asm volatile("s_waitcnt vmcnt(0)" ::: "memory");
        }
    }
    __syncthreads();
}

namespace pg8 {
constexpr int BM = 256, BK = 64, HALF = 128, HTB = HALF * BK * 2, STAGE_BYTES = 8 * HTB, NXCD = 8, WGM = 8;
__device__ __forceinline__ int lds_byte(int r, int c) { const int st = (r >> 4) * 2 + (c >> 5), rr = r & 15, cc = c & 31, ob = rr * 64 + cc * 2; return st * 1024 + (ob ^ (((ob >> 9) & 1) << 5)); }
__device__ __forceinline__ void stage_rc(int b, int& R, int& C) { const int st = b / 1024, sb = b % 1024, swz = sb ^ (((sb >> 9) & 1) << 5); R = (st >> 1) * 16 + swz / 64; C = (st & 1) * 32 + (swz % 64) / 2; }
__device__ __forceinline__ int perm32(int rho) { const int n = rho >> 4, i = rho & 15; return 8 * (i >> 2) + 4 * n + (i & 3); }

struct Unit { int pm, pn; unsigned B; int g; };

__device__ __forceinline__ void tile_map(int L, int nM, int nN, int& pm, int& pn) {
    const int nwg = nM * nN; int wgid = L;
    { const int q = nwg / NXCD, r = nwg % NXCD, xcd = wgid % NXCD, off = wgid / NXCD; wgid = (xcd < r ? xcd * (q + 1) : r * (q + 1) + (xcd - r) * q) + off; }
    const int nig = WGM * nN, gid = wgid / nig, fm = gid * WGM, gsz = (nM - fm) < WGM ? (nM - fm) : WGM;
    pm = fm + ((wgid % nig) % gsz); pn = (wgid % nig) / gsz;
}

typedef int i32x8 __attribute__((ext_vector_type(8)));
template <bool FP8, class Epi, class Sched>
__device__ __forceinline__ void gemm_phase(LAS unsigned char* lds, const int wid, const char* Abase, const char* Bbase, const int KB, const Sched& S, const Epi& E) {
    const int lane = lane_id(), tid = wid * 64 + lane, wr = wid >> 2, wc = wid & 3, fr = lane & 15, fq = lane >> 4;
    const int nt = KB / 128;
    int R0, C0; stage_rc(tid * 16, R0, C0);
    unsigned voffB[2];
#pragma unroll
    for (int i = 0; i < 2; ++i) { const int R = R0 + 64 * i; const int Rb = Epi::PERM ? ((R & ~31) + perm32(R & 31)) : R; voffB[i] = (unsigned)(Rb * KB + C0 * 2); }
    const unsigned kstep = (unsigned)(BK * 2);
    const unsigned hstep = (unsigned)(HALF * KB);
    const __amdgpu_buffer_rsrc_t rsA = __builtin_amdgcn_make_buffer_rsrc((void*)Abase, (short)0, 0x7ffff000, 0x00020000);
    const __amdgpu_buffer_rsrc_t rsB = __builtin_amdgcn_make_buffer_rsrc((void*)Bbase, (short)0, 0x7ffff000, 0x00020000);
    const unsigned ldsw = (unsigned)wid * 1024u;
    const int aoff = lds_byte(wr * 64 + fr, fq * 8), boff = lds_byte(wc * 32 + fr, fq * 8);
#define PG8_SA(b, h) (((b) * 2 + (h)) * HTB)
#define PG8_SB(b, h) ((4 + (b) * 2 + (h)) * HTB)
#define PG8_STAGE(bufoff, soff, voff) do { _Pragma("unroll") for (int _i = 0; _i < 2; ++_i) \
        __builtin_amdgcn_raw_ptr_buffer_load_lds(rsB, (LAS unsigned*)(lds + (bufoff) + ldsw + _i * 8192), 16, (int)(voff)[_i], (int)(soff), 0, 0); } while (0)
#define PG8_STAGE_A(bufoff, o0, o1, soff) do { \
        __builtin_amdgcn_raw_ptr_buffer_load_lds(rsA, (LAS unsigned*)(lds + (bufoff) + ldsw), 16, (int)(o0), (int)(soff), 0, 0); \
        __builtin_amdgcn_raw_ptr_buffer_load_lds(rsA, (LAS unsigned*)(lds + (bufoff) + ldsw + 8192), 16, (int)(o1), (int)(soff), 0, 0); } while (0)
#define PG8_LDA(dst, b, h) do { _Pragma("unroll") for (int m = 0; m < 4; ++m) _Pragma("unroll") for (int k = 0; k < 2; ++k) dst[m][k] = *(const LAS bf16x8*)(lds + PG8_SA(b, h) + aoff + m * 2048 + k * 1024); } while (0)
#define PG8_LDB(dst, b, h) do { _Pragma("unroll") for (int n = 0; n < 2; ++n) _Pragma("unroll") for (int k = 0; k < 2; ++k) dst[n][k] = *(const LAS bf16x8*)(lds + PG8_SB(b, h) + boff + n * 2048 + k * 1024); } while (0)
#define PG8_MMA(ai, bj, At, Bt) do { __builtin_amdgcn_s_setprio(1); \
        if constexpr (FP8) { _Pragma("unroll") for (int m = 0; m < 4; ++m) _Pragma("unroll") for (int n = 0; n < 2; ++n) { \
            const u32x4 _b0 = __builtin_bit_cast(u32x4, Bt[n][0]), _b1 = __builtin_bit_cast(u32x4, Bt[n][1]), _a0 = __builtin_bit_cast(u32x4, At[m][0]), _a1 = __builtin_bit_cast(u32x4, At[m][1]); \
            const i32x8 _bb = {(int)_b0.x, (int)_b0.y, (int)_b0.z, (int)_b0.w, (int)_b1.x, (int)_b1.y, (int)_b1.z, (int)_b1.w}, _aa = {(int)_a0.x, (int)_a0.y, (int)_a0.z, (int)_a0.w, (int)_a1.x, (int)_a1.y, (int)_a1.z, (int)_a1.w}; \
            acc[ai][bj][m][n] = __builtin_amdgcn_mfma_scale_f32_16x16x128_f8f6f4(_bb, _aa, acc[ai][bj][m][n], 0, 0, 0, 0, 0, 0); } } \
        else { _Pragma("unroll") for (int m = 0; m < 4; ++m) _Pragma("unroll") for (int n = 0; n < 2; ++n) _Pragma("unroll") for (int k = 0; k < 2; ++k) \
            acc[ai][bj][m][n] = __builtin_amdgcn_mfma_f32_16x16x32_bf16(Bt[n][k], At[m][k], acc[ai][bj][m][n], 0, 0, 0); } \
        __builtin_amdgcn_s_setprio(0); } while (0)
#define PG8_WAIT_V(n) asm volatile("s_waitcnt vmcnt(" #n ")" ::: "memory")
#define PG8_WAIT_L(n) asm volatile("s_waitcnt lgkmcnt(" #n ")" ::: "memory")
#define PG8_BAR __builtin_amdgcn_s_barrier()
#define PG8_SCHED __builtin_amdgcn_sched_barrier(0)
    Unit cur, nxt; int ui = 0;
    if (!S.next(0, cur)) return;
    f32x4 acc[2][2][4][2];
#pragma unroll
    for (int a = 0; a < 2; ++a)
#pragma unroll
        for (int b = 0; b < 2; ++b)
#pragma unroll
            for (int m = 0; m < 4; ++m)
#pragma unroll
                for (int n = 0; n < 2; ++n) acc[a][b][m][n] = (f32x4){0.f, 0.f, 0.f, 0.f};
    bf16x8 At[4][2], B0[2][2], B1[2][2];
    unsigned voffA[2]; voffA[0] = (unsigned)(R0 * KB + C0 * 2); voffA[1] = voffA[0] + (unsigned)(64 * KB);
    unsigned oc00 = 0, oc01 = 0, oc10 = 0, oc11 = 0;
    LAS u32x4* park = (LAS u32x4*)(lds + STAGE_BYTES) + tid;
    unsigned cA = 0, nA = 0;
    if constexpr (Sched::GATHER) { S.aoff(cur, R0, C0, oc00, oc01, oc10, oc11); asm volatile("" : "+v"(oc00), "+v"(oc01), "+v"(oc10), "+v"(oc11)); }
    else cA = S.abase(cur);
#define PG8_STA(bufoff, ptr, h, kb) do { if constexpr (Sched::GATHER) { if ((h) == 0) PG8_STAGE_A(bufoff, oc00, oc01, kb); else PG8_STAGE_A(bufoff, oc10, oc11, kb); } \
        else PG8_STAGE_A(bufoff, voffA[0], voffA[1], (ptr) + (unsigned)(h) * hstep + (unsigned)(kb)); } while (0)
    unsigned cB = cur.B;
    PG8_STAGE(PG8_SB(0, 0), cB, voffB); PG8_STA(PG8_SA(0, 0), cA, 0, 0); PG8_STAGE(PG8_SB(0, 1), cB + hstep, voffB); PG8_STA(PG8_SA(0, 1), cA, 1, 0);
    if (wr == 1) PG8_BAR;
    PG8_WAIT_V(4); PG8_BAR;
    PG8_STAGE(PG8_SB(1, 0), cB + kstep, voffB); PG8_STA(PG8_SA(1, 0), cA, 0, kstep); PG8_STAGE(PG8_SB(1, 1), cB + hstep + kstep, voffB);
    PG8_WAIT_V(6); PG8_BAR;
    for (;;) {
        const bool has_next = S.next(ui + 1, nxt);
        if constexpr (Sched::GATHER) {
            unsigned on00 = oc00, on01 = oc01, on10 = oc10, on11 = oc11;
            if (has_next) S.aoff(nxt, R0, C0, on00, on01, on10, on11);
            *park = (u32x4){on00, on01, on10, on11};
        } else nA = has_next ? S.abase(nxt) : cA;
        const unsigned nB = has_next ? nxt.B : cB;
#pragma unroll 1
        for (int t = 0; t < nt; t += 2) {
            const bool last = (t == nt - 2);
            const unsigned k1 = (unsigned)(t + 1) * kstep;
            const unsigned k2 = last ? 0u : (unsigned)(t + 2) * kstep; const unsigned k3 = k2 + kstep;
            const unsigned a2 = last ? nA : cA;
            const unsigned b2 = last ? nB : cB + (unsigned)(t + 2) * kstep; const unsigned b3 = b2 + kstep;
            PG8_LDB(B0, 0, 0); PG8_SCHED; PG8_LDA(At, 0, 0); PG8_STA(PG8_SA(1, 1), cA, 1, k1);
            PG8_WAIT_L(8); PG8_BAR; PG8_WAIT_L(0); PG8_MMA(0, 0, At, B0); PG8_BAR; PG8_SCHED;
            if constexpr (Sched::GATHER) { if (last) { const u32x4 pk = *park; oc00 = pk.x; oc01 = pk.y; oc10 = pk.z; oc11 = pk.w; } }
            PG8_LDB(B1, 0, 1); PG8_STAGE(PG8_SB(0, 0), b2, voffB);
            PG8_BAR; PG8_WAIT_L(0); PG8_MMA(0, 1, At, B1); PG8_BAR;
            PG8_LDA(At, 0, 1); PG8_STA(PG8_SA(0, 0), a2, 0, k2);
            PG8_BAR; PG8_WAIT_L(0); PG8_MMA(1, 0, At, B0); PG8_BAR; PG8_SCHED;
            PG8_STAGE(PG8_SB(0, 1), b2 + hstep, voffB);
            PG8_WAIT_V(6); PG8_BAR; PG8_MMA(1, 1, At, B1); PG8_BAR;
            PG8_LDB(B0, 1, 0); PG8_SCHED; PG8_LDA(At, 1, 0); PG8_STA(PG8_SA(0, 1), a2, 1, k2);
            PG8_WAIT_L(8); PG8_BAR; PG8_WAIT_L(0); PG8_MMA(0, 0, At, B0); PG8_BAR; PG8_SCHED;
            PG8_LDB(B1, 1, 1); PG8_STAGE(PG8_SB(1, 0), b3, voffB);
            PG8_BAR; PG8_WAIT_L(0); PG8_MMA(0, 1, At, B1); PG8_BAR;
            PG8_LDA(At, 1, 1); PG8_STA(PG8_SA(1, 0), a2, 0, k3);
            PG8_BAR; PG8_WAIT_L(0); PG8_MMA(1, 0, At, B0); PG8_BAR; PG8_SCHED;
            PG8_STAGE(PG8_SB(1, 1), b3 + hstep, voffB);
            PG8_WAIT_V(6); PG8_BAR; PG8_MMA(1, 1, At, B1); PG8_BAR;
        }
        { const int _l = lane_id(); const int _fr = _l & 15, _fq = _l >> 4;
          E(acc, cur, wr, wc, _fr, _fq); }
        if (!has_next) break;
#pragma unroll
        for (int a = 0; a < 2; ++a)
#pragma unroll
            for (int b = 0; b < 2; ++b)
#pragma unroll
                for (int m = 0; m < 4; ++m)
#pragma unroll
                    for (int n = 0; n < 2; ++n) acc[a][b][m][n] = (f32x4){0.f, 0.f, 0.f, 0.f};
        cur = nxt; cB = nB; cA = nA; ++ui;
    }
    PG8_WAIT_V(0);
    if (wr == 0) PG8_BAR;
    PG8_BAR;
#undef PG8_SA
#undef PG8_SB
#undef PG8_STAGE
#undef PG8_STAGE_A
#undef PG8_STA
#undef PG8_LDA
#undef PG8_LDB
#undef PG8_MMA
#undef PG8_WAIT_V
#undef PG8_WAIT_L
#undef PG8_BAR
#undef PG8_SCHED
}

struct DenseSched {
    static constexpr bool GATHER = false;
    int nM, nN, G, c, KB;
    __device__ __forceinline__ unsigned abase(const Unit& u) const { return (unsigned)(u.pm * 256 * KB); }
    __device__ __forceinline__ bool next(int i, Unit& u) const {
        const long L = (long)i * G + c; if (L >= (long)nM * nN) return false;
        tile_map((int)L, nM, nN, u.pm, u.pn); u.B = (unsigned)(u.pn * 256 * KB); u.g = 0; return true;
    }
    __device__ __forceinline__ void aoff(const Unit& u, int R0, int C0, unsigned& o00, unsigned& o01, unsigned& o10, unsigned& o11) const {
        const unsigned base = (unsigned)((u.pm * 256 + R0) * KB + C0 * 2), r64 = (unsigned)(64 * KB);
        o00 = base; o01 = base + r64; o10 = base + 2u * r64; o11 = base + 3u * r64;
    }
};
struct InProjL1Sched {
    static constexpr bool GATHER = false;
    int G, c;
    __device__ __forceinline__ unsigned abase(const Unit& u) const { return (unsigned)(u.pm * 256 * D * 2); }
    __device__ __forceinline__ bool next(int i, Unit& u) const {
        const int L = i * G + c; if (L >= 3840 + 224) return false;
        if (L < 3840) tile_map(L, 256, 15, u.pm, u.pn);
        else { const int Lc = L - 3840; u.pm = 256 + Lc / 7; const int j = Lc % 7; u.pn = j < 6 ? 6 + j : 14; }
        u.B = (unsigned)(u.pn * 256 * D * 2); u.g = 0; return true;
    }
    __device__ __forceinline__ void aoff(const Unit& u, int R0, int C0, unsigned& o00, unsigned& o01, unsigned& o10, unsigned& o11) const {
        const unsigned base = (unsigned)((u.pm * 256 + R0) * D + C0) * 2u, r64 = (unsigned)(64 * D) * 2u;
        o00 = base; o01 = base + r64; o10 = base + 2u * r64; o11 = base + 3u * r64;
    }
};
struct MoeUpSched {
    static constexpr bool GATHER = true;
    int G, c; const int* rowtok; const volatile LAS int* tb;
    __device__ __forceinline__ unsigned abase(const Unit&) const { return 0u; }
    __device__ __forceinline__ bool next(int i, Unit& u) const {
        const int T = tb[8]; const int L = i * G + c; if (L >= T * 22) return false;
        tile_map(L, T, 22, u.pm, u.pn); int g = 0;
#pragma unroll
        for (int j = 1; j < 8; ++j) g += (u.pm >= tb[j]) ? 1 : 0;
        u.g = g; u.B = (unsigned)((g * 5632 + u.pn * 256) * D); return true;
    }
    __device__ __forceinline__ void aoff(const Unit& u, int R0, int C0, unsigned& o00, unsigned& o01, unsigned& o10, unsigned& o11) const {
        const int s0 = (u.pm - tb[u.g]) * 256 + R0, cnt = tb[16 + u.g]; const int* rt = rowtok + (size_t)u.g * RT_STRIDE;
        const int t00 = s0 < cnt ? rt[s0] : 0, t01 = s0 + 64 < cnt ? rt[s0 + 64] : 0, t10 = s0 + 128 < cnt ? rt[s0 + 128] : 0, t11 = s0 + 192 < cnt ? rt[s0 + 192] : 0;
        o00 = (unsigned)(t00 * D + C0 * 2); o01 = (unsigned)(t01 * D + C0 * 2); o10 = (unsigned)(t10 * D + C0 * 2); o11 = (unsigned)(t11 * D + C0 * 2);
    }
};
struct MoeDownSched {
    static constexpr bool GATHER = false;
    int G, c; const volatile LAS int* tb;
    __device__ __forceinline__ unsigned abase(const Unit& u) const { return (unsigned)(u.pm * 256 * DFF); }
    __device__ __forceinline__ bool next(int i, Unit& u) const {
        const int T = tb[8]; const int L = i * G + c; if (L >= T * 4) return false;
        tile_map(L, T, 4, u.pm, u.pn); int g = 0;
#pragma unroll
        for (int j = 1; j < 8; ++j) g += (u.pm >= tb[j]) ? 1 : 0;
        u.g = g; u.B = (unsigned)((g * D + u.pn * 256) * DFF); return true;
    }
    __device__ __forceinline__ void aoff(const Unit& u, int R0, int C0, unsigned& o00, unsigned& o01, unsigned& o10, unsigned& o11) const {
        const unsigned base = (unsigned)((u.pm * 256 + R0) * DFF + C0 * 2), r64 = (unsigned)(64 * DFF);
        o00 = base; o01 = base + r64; o10 = base + 2u * r64; o11 = base + 3u * r64;
    }
};

struct EpiProj {
    static constexpr bool PERM = true;
    bf16_t* P; float* GT; const float* bg; bool dry;
    __device__ __forceinline__ void operator()(const f32x4 (&acc)[2][2][4][2], const Unit& u, int wr, int wc, int fr, int fq) const {
        if (dry) {
#pragma unroll
            for (int ai = 0; ai < 2; ++ai)
#pragma unroll
                for (int bj = 0; bj < 2; ++bj)
#pragma unroll
                    for (int m = 0; m < 4; ++m) asm volatile("" :: "v"(acc[ai][bj][m][0]), "v"(acc[ai][bj][m][1]));
            return; }
        const int row0 = u.pm * BM + wr * 64 + fr;
        if (u.pn < 14) {
            const int col0 = u.pn * BM + wc * 32 + 8 * fq;
#pragma unroll
            for (int ai = 0; ai < 2; ++ai)
#pragma unroll
                for (int m = 0; m < 4; ++m) { bf16_t* rowp = P + (size_t)(row0 + ai * HALF + m * 16) * NPROJ + col0;
#pragma unroll
                    for (int bj = 0; bj < 2; ++bj) { const f32x4 v0 = acc[ai][bj][m][0], v1 = acc[ai][bj][m][1];
                        u32x4 w; w.x = cvt_pk_bf16(v0[0], v0[1]); w.y = cvt_pk_bf16(v0[2], v0[3]); w.z = cvt_pk_bf16(v1[0], v1[1]); w.w = cvt_pk_bf16(v1[2], v1[3]);
                        *(u32x4*)(rowp + bj * HALF) = w; } }
        } else if (wc == 0 && fq < 2) {
            const f32x4 b0 = *(const f32x4*)(bg + 8 * fq), b1 = *(const f32x4*)(bg + 8 * fq + 4);
#pragma unroll
            for (int ai = 0; ai < 2; ++ai)
#pragma unroll
                for (int m = 0; m < 4; ++m) { float* gp = GT + (size_t)(row0 + ai * HALF + m * 16) * 16 + 8 * fq;
                    *(f32x4*)gp = acc[ai][0][m][0] + b0; *(f32x4*)(gp + 4) = acc[ai][0][m][1] + b1; }
        }
    }
};
struct EpiResid {
    static constexpr bool PERM = false;
    const float* resL; const float* resC; float* outL; float* outC; const float* gate; float gscale;
    __device__ __forceinline__ void operator()(const f32x4 (&acc)[2][2][4][2], const Unit& u, int wr, int wc, int fr, int fq) const {
        const int rowg = u.pm * BM; const bool isc = rowg >= NL;
        const float* res = isc ? resC + (size_t)(rowg - NL) * D : resL + (size_t)rowg * D;
        float* out = isc ? outC + (size_t)(rowg - NL) * D : outL + (size_t)rowg * D;
        const int bidx = isc ? 32 : (rowg >> 11);
        const int col0 = u.pn * BM + wc * 32 + 4 * fq;
        const float* gv = gate + (size_t)bidx * 6144 + col0;
        f32x4 g[2][2];
#pragma unroll
        for (int bj = 0; bj < 2; ++bj)
#pragma unroll
            for (int n = 0; n < 2; ++n) g[bj][n] = *(const f32x4*)(gv + bj * HALF + n * 16) * gscale;
#pragma unroll
        for (int ai = 0; ai < 2; ++ai)
#pragma unroll
            for (int m = 0; m < 4; ++m) { const size_t off = (size_t)(ai * HALF + wr * 64 + m * 16 + fr) * D + col0;
#pragma unroll
                for (int bj = 0; bj < 2; ++bj)
#pragma unroll
                    for (int n = 0; n < 2; ++n) { const f32x4 r = *(const f32x4*)(res + off + bj * HALF + n * 16);
                        *(f32x4*)(out + off + bj * HALF + n * 16) = r + g[bj][n] * acc[ai][bj][m][n]; }
                asm volatile("" ::: "memory"); }
    }
};
__device__ __forceinline__ float clamp448(float x) { return fminf(fmaxf(x, -448.0f), 448.0f); }
struct EpiSwiglu {
    static constexpr bool PERM = true;
    unsigned char* ACT; float iscale, oscale;
    __device__ __forceinline__ void operator()(const f32x4 (&acc)[2][2][4][2], const Unit& u, int wr, int wc, int fr, int fq) const {
        const int row0 = u.pm * BM + wr * 64 + fr, col0 = u.pn * HALF + wc * 32 + 8 * fq;
#pragma unroll
        for (int ai = 0; ai < 2; ++ai)
#pragma unroll
            for (int m = 0; m < 4; ++m) { unsigned char* rowp = ACT + (size_t)(row0 + ai * HALF + m * 16) * DFF + col0;
                float o[8];
#pragma unroll
                for (int n = 0; n < 2; ++n)
#pragma unroll
                    for (int j = 0; j < 4; ++j) { const float a = acc[ai][0][m][n][j] * iscale, b = acc[ai][1][m][n][j] * iscale; o[n * 4 + j] = clamp448(a * b * __builtin_amdgcn_rcpf(1.0f + __expf(-a)) * oscale); }
                int w0 = 0, w1 = 0;
                w0 = __builtin_amdgcn_cvt_pk_fp8_f32(o[0], o[1], w0, false); w0 = __builtin_amdgcn_cvt_pk_fp8_f32(o[2], o[3], w0, true);
                w1 = __builtin_amdgcn_cvt_pk_fp8_f32(o[4], o[5], w1, false); w1 = __builtin_amdgcn_cvt_pk_fp8_f32(o[6], o[7], w1, true);
                *(u32x2*)rowp = (u32x2){(unsigned)w0, (unsigned)w1}; }
    }
};
struct EpiMoeDown {
    static constexpr bool PERM = false;
    float* H; const float* g2; const int* rowtok; const float* rowgate; const volatile LAS int* tb; float gscale;
    __device__ __forceinline__ void operator()(const f32x4 (&acc)[2][2][4][2], const Unit& u, int wr, int wc, int fr, int fq) const {
        const int s0 = (u.pm - tb[u.g]) * 256, cnt = tb[16 + u.g];
        const int* rt = rowtok + (size_t)u.g * RT_STRIDE; const float* rg = rowgate + (size_t)u.g * RT_STRIDE;
        const int col0 = u.pn * BM + wc * 32 + 4 * fq;
#pragma unroll
        for (int ai = 0; ai < 2; ++ai)
#pragma unroll
            for (int m = 0; m < 4; ++m) { const int slot = s0 + ai * HALF + wr * 64 + m * 16 + fr;
                if (slot < cnt) { const int tok = rt[slot]; const float gt = rg[slot] * gscale;
                    float* hp = H + (size_t)tok * D + col0; const float* gv = g2 + (size_t)(tok >> 11) * 6144 + col0;
#pragma unroll
                    for (int bj = 0; bj < 2; ++bj)
#pragma unroll
                        for (int n = 0; n < 2; ++n) { const f32x4 r = *(const f32x4*)(hp + bj * HALF + n * 16); const f32x4 gg = *(const f32x4*)(gv + bj * HALF + n * 16);
                            *(f32x4*)(hp + bj * HALF + n * 16) = r + (gg * gt) * acc[ai][bj][m][n]; } }
                asm volatile("" ::: "memory"); }
    }
};
}

struct Args { const float* in[21]; float* out; unsigned char* ws; int lo, hi; };
enum { I_X = 0, I_C, I_CTX, I_CCTX, I_N1G, I_N2G, I_WADA, I_BADA, I_WIN, I_CONVW, I_BG, I_MNG, I_WOUT, I_FW1, I_FW3, I_FW2, I_ROUTER, I_MW1, I_MW3, I_MW2, I_FNG };

struct Frame { LAS unsigned char* lds; int wid, G, wg;
    __device__ __forceinline__ int lane() const { return lane_id(); }
    __device__ __forceinline__ int tid() const { return wid * 64 + lane_id(); } };
typedef const __attribute__((address_space(4))) Args* KArgs;
#define KA() ({ KArgs _k = (KArgs)__builtin_amdgcn_kernarg_segment_ptr(); asm volatile("" : "+s"(_k)); _k; })

__device__ __forceinline__ int conv_row(int mode, int n, float& scale) {
    scale = 1.f;
    if (mode == 0) return n;
    if (mode == 1) { if (n >= 2048 && n < 2560) scale = 0.08838834764831845f; if (n < 3072) return n; if (n < 3088) return 3584 + (n - 3072); return n - 16; }
    return (n >> 7) * 256 + (n & 127) + (mode == 3 ? 128 : 0);
}
__device__ __forceinline__ void conv_tiles(const Frame& F, const float* src, bf16_t* dst, int K, int N, int mode, float fp8scale  , int& gbase) {
    LAS float* tile = (LAS float*)F.lds;
    const int tn = (N + 63) / 64, ntile = (K / 64) * tn, tid = F.tid();
    int t = (F.wg - gbase) % F.G; if (t < 0) t += F.G;
    for (; t < ntile; t += F.G) {
        const int k0 = (t / tn) * 64, n0 = (t % tn) * 64;
        { const int row = tid >> 4, c4 = (tid & 15) * 4;
#pragma unroll
          for (int j = 0; j < 2; ++j) { const int r = row + 32 * j; f32x4 v = (f32x4){0.f, 0.f, 0.f, 0.f};
              if (n0 + c4 < N) v = *(const f32x4*)(src + (size_t)(k0 + r) * N + n0 + c4);
              tile[r * 65 + c4 + 0] = v[0]; tile[r * 65 + c4 + 1] = v[1]; tile[r * 65 + c4 + 2] = v[2]; tile[r * 65 + c4 + 3] = v[3]; } }
        __syncthreads();
        { const int n = tid >> 3, kc = (tid & 7) * 8;
          if (n0 + n < N) { float sc; const int drow = conv_row(mode, n0 + n, sc); float v[8];
#pragma unroll
              for (int j = 0; j < 8; ++j) v[j] = tile[(kc + j) * 65 + n] * sc;
              if (fp8scale == 0.f) {
                  u32x4 w; w.x = cvt_pk_bf16(v[0], v[1]); w.y = cvt_pk_bf16(v[2], v[3]); w.z = cvt_pk_bf16(v[4], v[5]); w.w = cvt_pk_bf16(v[6], v[7]);
                  *(u32x4*)(dst + (size_t)drow * K + k0 + kc) = w;
              } else {
#pragma unroll
                  for (int j = 0; j < 8; ++j) v[j] = fminf(fmaxf(v[j] * fp8scale, -448.0f), 448.0f);
                  int w0 = 0, w1 = 0;
                  w0 = __builtin_amdgcn_cvt_pk_fp8_f32(v[0], v[1], w0, false); w0 = __builtin_amdgcn_cvt_pk_fp8_f32(v[2], v[3], w0, true);
                  w1 = __builtin_amdgcn_cvt_pk_fp8_f32(v[4], v[5], w1, false); w1 = __builtin_amdgcn_cvt_pk_fp8_f32(v[6], v[7], w1, true);
                  *(u32x2*)((unsigned char*)dst + (size_t)drow * K + k0 + kc) = (u32x2){(unsigned)w0, (unsigned)w1};
              } } }
        __syncthreads();
    }
    gbase = (gbase + ntile) % F.G;
}
__device__ void p0_prologue(const Frame& F) {
    const int tid = F.tid(); KArgs ka = KA(); unsigned char* const ws = ka->ws;
    if (F.wg < 192) {
        LAS float* s = (LAS float*)F.lds;
        for (int idx = tid; idx < 33 * 1024; idx += 512) { const int b = idx >> 10, k = idx & 1023; const float v = b < 32 ? ka->in[I_C][b * 1024 + k] : ka->in[I_CCTX][k]; s[idx] = v / (1.0f + __expf(-v)); }
        __syncthreads();
        const int layer = F.wg / 96, col0 = (F.wg % 96) * 64, col = tid & 63, g = tid >> 6;
        const float* W = ka->in[I_WADA] + (size_t)layer * 1024 * 6144 + col0 + col;
        float acc[33];
#pragma unroll
        for (int b = 0; b < 33; ++b) acc[b] = 0.f;
        for (int k4 = 0; k4 < 32; ++k4) { const int k = g * 128 + k4 * 4;
            const float w0 = W[(size_t)(k + 0) * 6144], w1 = W[(size_t)(k + 1) * 6144], w2 = W[(size_t)(k + 2) * 6144], w3 = W[(size_t)(k + 3) * 6144];
#pragma unroll
            for (int b = 0; b < 33; ++b) { const f32x4 s4 = *(const LAS f32x4*)(s + b * 1024 + k); acc[b] += s4[0] * w0 + s4[1] * w1 + s4[2] * w2 + s4[3] * w3; } }
        __syncthreads();
        LAS float* red = (LAS float*)F.lds;
#pragma unroll
        for (int b = 0; b < 33; ++b) red[(g * 33 + b) * 64 + col] = acc[b];
        __syncthreads();
        float* MOD = (float*)(ws + WS_MOD); const float* bada = ka->in[I_BADA];
        for (int idx = tid; idx < 33 * 64; idx += 512) { const int b = idx >> 6, cc = idx & 63; float sum = 0.f;
#pragma unroll
            for (int gg = 0; gg < 8; ++gg) sum += red[(gg * 33 + b) * 64 + cc];
            MOD[((size_t)layer * 33 + b) * 6144 + col0 + cc] = sum + bada[layer * 6144 + col0 + cc]; }
        __syncthreads();
    }
    { bf16_t* WIN = (bf16_t*)(ws + WS_WIN);
      for (int l = 0; l < 2; ++l) { u32x4* p = (u32x4*)(WIN + ((size_t)l * NPAD + PIN) * D); const int n16 = (NPAD - PIN) * D * 2 / 16;
          for (int i = F.wg * 512 + tid; i < n16; i += F.G * 512) p[i] = (u32x4){0u, 0u, 0u, 0u}; } }
    int gbase = 0;
    for (int j = 0; j < 31; ++j) {
        const float* src; bf16_t* dst; int K, N, mode; float f8 = 0.f;
        if (j < 2)       { src = ka->in[I_WIN] + (size_t)j * D * PIN; dst = (bf16_t*)(ws + WS_WIN) + (size_t)j * NPAD * D; K = D; N = PIN; mode = 1; }
        else if (j < 4)  { src = ka->in[I_WOUT] + (size_t)(j - 2) * D * D; dst = (bf16_t*)(ws + WS_WOUT) + (size_t)(j - 2) * D * D; K = D; N = D; mode = 0; }
        else if (j == 4) { src = ka->in[I_FW1]; dst = (bf16_t*)(ws + WS_WUP); K = D; N = DFF; mode = 2; f8 = S_W13; }
        else if (j == 5) { src = ka->in[I_FW3]; dst = (bf16_t*)(ws + WS_WUP); K = D; N = DFF; mode = 3; f8 = S_W13; }
        else if (j == 6) { src = ka->in[I_FW2]; dst = (bf16_t*)(ws + WS_WDN); K = DFF; N = D; mode = 0; f8 = S_W2; }
        else if (j < 15) { const int e = j - 7;  src = ka->in[I_MW1] + (size_t)e * D * DFF; dst = (bf16_t*)(ws + WS_MUP + (size_t)e * 2 * DFF * D); K = D; N = DFF; mode = 2; f8 = S_W13; }
        else if (j < 23) { const int e = j - 15; src = ka->in[I_MW3] + (size_t)e * D * DFF; dst = (bf16_t*)(ws + WS_MUP + (size_t)e * 2 * DFF * D); K = D; N = DFF; mode = 3; f8 = S_W13; }
        else             { const int e = j - 23; src = ka->in[I_MW2] + (size_t)e * DFF * D; dst = (bf16_t*)(ws + WS_MDN + (size_t)e * D * DFF); K = DFF; N = D; mode = 0; f8 = S_W2; }
        conv_tiles(F, src, dst, K, N, mode, f8, gbase);
    }
}

template <bool ROUTER, bool OUT8>
__device__ __forceinline__ void norm_phase(const Frame& F, const float* srcL, const float* srcC, int nrows, const float* gain, const float* mod  , int chunk_shift, bf16_t* U, const float* router) {
    const int lane = F.lane(), wid = F.wid, tid = F.tid();
    const int rpw = (nrows + F.G * 8 - 1) / (F.G * 8);
    const int rbase = (F.wg * 8 + wid) * rpw;
    LAS float* rl = (LAS float*)F.lds;
    LAS int* cntl = (LAS int*)(F.lds + 32768);
    LAS int* sel = (LAS int*)(F.lds + 32768 + 256);
    if (ROUTER) {
        for (int i = tid; i < 8192; i += 512) rl[i] = router[i];
        if (tid < 32) cntl[tid] = 0;
        __syncthreads();
    }
    f32x4 gn[4];
#pragma unroll
    for (int j = 0; j < 4; ++j) gn[j] = *(const f32x4*)(gain + j * 256 + lane * 4);
    for (int rr = 0; rr < rpw; ++rr) {
        const int r = rbase + rr; if (r >= nrows) break;
        const bool isc = r >= NL;
        const float* src = isc ? srcC + (size_t)(r - NL) * D : srcL + (size_t)r * D;
        const float* mv = mod + (size_t)(isc ? 32 : (r >> 11)) * 6144 + chunk_shift * 1024;
        f32x4 x[4]; float ss = 0.f;
#pragma unroll
        for (int j = 0; j < 4; ++j) { x[j] = *(const f32x4*)(src + j * 256 + lane * 4); ss += x[j][0] * x[j][0] + x[j][1] * x[j][1] + x[j][2] * x[j][2] + x[j][3] * x[j][3]; }
        ss = wave_sum(ss);
        const float rstd = rsqrtf(ss * (1.0f / 1024.0f) + EPS);
        float lg[8];
        if (ROUTER) {
#pragma unroll
            for (int e = 0; e < 8; ++e) lg[e] = 0.f;
        }
#pragma unroll
        for (int j = 0; j < 4; ++j) {
            const f32x4 sh = *(const f32x4*)(mv + j * 256 + lane * 4), sc = *(const f32x4*)(mv + 1024 + j * 256 + lane * 4);
            f32x4 u = (x[j] * rstd * gn[j]) * (sc + 1.0f) + sh;
            if (OUT8) { int w8 = 0; w8 = __builtin_amdgcn_cvt_pk_fp8_f32(fminf(fmaxf(u[0] * S_A, -448.f), 448.f), fminf(fmaxf(u[1] * S_A, -448.f), 448.f), w8, false);
                w8 = __builtin_amdgcn_cvt_pk_fp8_f32(fminf(fmaxf(u[2] * S_A, -448.f), 448.f), fminf(fmaxf(u[3] * S_A, -448.f), 448.f), w8, true);
                *(int*)((unsigned char*)U + (size_t)r * D + j * 256 + lane * 4) = w8; }
            else { u32x2 w; w.x = cvt_pk_bf16(u[0], u[1]); w.y = cvt_pk_bf16(u[2], u[3]);
                *(u32x2*)(U + (size_t)r * D + j * 256 + lane * 4) = w; }
            if (ROUTER) {
#pragma unroll
                for (int i = 0; i < 4; ++i) { const LAS f32x4* rp = (const LAS f32x4*)(rl + (j * 256 + lane * 4 + i) * 8); const f32x4 r0 = rp[0], r1 = rp[1];
                    lg[0] += u[i] * r0[0]; lg[1] += u[i] * r0[1]; lg[2] += u[i] * r0[2]; lg[3] += u[i] * r0[3];
                    lg[4] += u[i] * r1[0]; lg[5] += u[i] * r1[1]; lg[6] += u[i] * r1[2]; lg[7] += u[i] * r1[3]; }
            }
        }
        if (ROUTER) {
#pragma unroll
            for (int e = 0; e < 8; ++e) lg[e] = wave_sum(lg[e]);
            int e0 = 0; float v0 = lg[0];
#pragma unroll
            for (int e = 1; e < 8; ++e) if (lg[e] > v0) { v0 = lg[e]; e0 = e; }
            int e1 = -1; float v1 = -3.0e38f;
#pragma unroll
            for (int e = 0; e < 8; ++e) if (e != e0 && lg[e] > v1) { v1 = lg[e]; e1 = e; }
            if (lane == 0) {
                const float g0 = 1.0f / (1.0f + __expf(v1 - v0)), g1 = 1.0f - g0;
                const int r0 = atomicAdd((int*)(cntl + e0), 1), r1 = atomicAdd((int*)(cntl + 8 + e1), 1);
                LAS int* sp = sel + (wid * rpw + rr) * 6;
                sp[0] = e0 | (e1 << 8); sp[1] = r0; sp[2] = r1; sp[3] = __float_as_int(g0); sp[4] = __float_as_int(g1); sp[5] = r;
            }
        }
    }
    if (ROUTER) {
        __syncthreads();
        unsigned char* const ws = KA()->ws;
        if (tid < 16) { unsigned* gc = (unsigned*)(ws + WS_CTL + CTL_GCNT); cntl[16 + tid] = (int)__hip_atomic_fetch_add(gc + tid, (unsigned)cntl[tid], __ATOMIC_RELAXED, __HIP_MEMORY_SCOPE_AGENT); }
        __syncthreads();
        int* rowtok = (int*)(ws + WS_RTOK); float* rowgate = (float*)(ws + WS_RGATE);
        for (int i = tid; i < 8 * rpw; i += 512) {
            const int w = i / rpw, rr = i % rpw; const int r = (F.wg * 8 + w) * rpw + rr;
            if (r < nrows) { const LAS int* sp = sel + i * 6; const int e0 = sp[0] & 255, e1 = sp[0] >> 8;
                const int p0 = cntl[16 + e0] + sp[1], p1 = cntl[16 + 8 + e1] + sp[2];
                rowtok[(size_t)e0 * RT_STRIDE + p0] = sp[5]; rowgate[(size_t)e0 * RT_STRIDE + p0] = __int_as_float(sp[3]);
                rowtok[(size_t)(8 + e1) * RT_STRIDE + p1] = sp[5]; rowgate[(size_t)(8 + e1) * RT_STRIDE + p1] = __int_as_float(sp[4]); }
        }
        __syncthreads();
    }
}

__device__ __forceinline__ void unpack8(const u32x4 w, float (&v)[8]) { v[0] = bflo(w.x); v[1] = bfhi(w.x); v[2] = bflo(w.y); v[3] = bfhi(w.y); v[4] = bflo(w.z); v[5] = bfhi(w.z); v[6] = bflo(w.w); v[7] = bfhi(w.w); }
__device__ __forceinline__ u32x4 pack8(const float (&v)[8]) { u32x4 w; w.x = cvt_pk_bf16(v[0], v[1]); w.y = cvt_pk_bf16(v[2], v[3]); w.z = cvt_pk_bf16(v[4], v[5]); w.w = cvt_pk_bf16(v[6], v[7]); return w; }
__device__ __forceinline__ void mix_phase(const Frame& F, int nrows, const float* convw  , const float* gnorm  ) {
    const int lane = F.lane(); unsigned char* const ws = KA()->ws;
    const bf16_t* P = (const bf16_t*)(ws + WS_PROJ); const bf16_t* HL = (const bf16_t*)(ws + WS_HL); bf16_t* A2 = (bf16_t*)(ws + WS_U);
    const int rpw = (nrows + F.G * 8 - 1) / (F.G * 8); const int rbase = (F.wg * 8 + F.wid) * rpw;
    float w0[8], w1[8], w2[8], gnv[8];
#pragma unroll
    for (int j = 0; j < 8; ++j) { w0[j] = convw[lane * 8 + j]; w1[j] = convw[512 + lane * 8 + j]; w2[j] = convw[1024 + lane * 8 + j]; gnv[j] = gnorm[lane * 8 + j]; }
    for (int rr = 0; rr < rpw; ++rr) {
        const int r = rbase + rr; if (r >= nrows) break;
        bool hasL, hasR;
        if (r < NL) { const int cc = r & 63; hasL = cc != 0; hasR = cc != 63; } else { const int t = (r - NL) & 255; hasL = t != 0; hasR = t != 255; }
        const bf16_t* pr = P + (size_t)r * NPROJ + lane * 8;
        float gb[8], zc[8], zl[8], zr[8], t0[8], t1[8];
        unpack8(*(const u32x4*)pr, gb);
        unpack8(*(const u32x4*)(pr + 512), t0); unpack8(*(const u32x4*)(pr + 1024), t1);
#pragma unroll
        for (int j = 0; j < 8; ++j) zc[j] = t0[j] * t1[j];
        if (hasL) { unpack8(*(const u32x4*)(pr - NPROJ + 512), t0); unpack8(*(const u32x4*)(pr - NPROJ + 1024), t1);
#pragma unroll
            for (int j = 0; j < 8; ++j) zl[j] = t0[j] * t1[j]; }
        else {
#pragma unroll
            for (int j = 0; j < 8; ++j) zl[j] = 0.f; }
        if (hasR) { unpack8(*(const u32x4*)(pr + NPROJ + 512), t0); unpack8(*(const u32x4*)(pr + NPROJ + 1024), t1);
#pragma unroll
            for (int j = 0; j < 8; ++j) zr[j] = t0[j] * t1[j]; }
        else {
#pragma unroll
            for (int j = 0; j < 8; ++j) zr[j] = 0.f; }
        float y[8];
#pragma unroll
        for (int j = 0; j < 8; ++j) y[j] = gb[j] * (w0[j] * zl[j] + w1[j] * zc[j] + w2[j] * zr[j]);
        *(u32x4*)(A2 + (size_t)r * D + lane * 8) = pack8(y);
        float hf[8], hb[8], og[8];
        unpack8(*(const u32x4*)(HL + (size_t)r * 512 + lane * 8), hf); unpack8(*(const u32x4*)(HL + (size_t)(MT + r) * 512 + lane * 8), hb);
        unpack8(*(const u32x4*)(pr + 3072), og);
        float ss = 0.f;
#pragma unroll
        for (int j = 0; j < 8; ++j) { hf[j] += hb[j]; ss += hf[j] * hf[j]; }
        ss += __shfl_xor(ss, 1); ss += __shfl_xor(ss, 2); ss += __shfl_xor(ss, 4); ss += __shfl_xor(ss, 8);
        const float rstd = rsqrtf(ss * (1.0f / 128.0f) + EPS);
#pragma unroll
        for (int j = 0; j < 8; ++j) y[j] = hf[j] * rstd * gnv[j] * sigmoidf_(og[j]);
        *(u32x4*)(A2 + (size_t)r * D + 512 + lane * 8) = pack8(y);
    }
}

__device__ __forceinline__ void final_phase(const Frame& F) {
    const int lane = F.lane(); KArgs ka = KA(); const float* gain = ka->in[I_FNG]; float* const outp = ka->out;
    const int rpw = (NL + F.G * 8 - 1) / (F.G * 8); const int rbase = (F.wg * 8 + F.wid) * rpw;
    f32x4 gn[4];
#pragma unroll
    for (int j = 0; j < 4; ++j) gn[j] = *(const f32x4*)(gain + j * 256 + lane * 4);
    for (int rr = 0; rr < rpw; ++rr) {
        const int r = rbase + rr; if (r >= NL) break;
        float* p = outp + (size_t)r * D;
        f32x4 x[4]; float ss = 0.f;
#pragma unroll
        for (int j = 0; j < 4; ++j) { x[j] = *(const f32x4*)(p + j * 256 + lane * 4); ss += x[j][0] * x[j][0] + x[j][1] * x[j][1] + x[j][2] * x[j][2] + x[j][3] * x[j][3]; }
        ss = wave_sum(ss);
        const float rstd = rsqrtf(ss * (1.0f / 1024.0f) + EPS);
#pragma unroll
        for (int j = 0; j < 4; ++j) *(f32x4*)(p + j * 256 + lane * 4) = x[j] * rstd * gn[j];
    }
}

constexpr int ML_RB = 272;
constexpr int ML_Q = 0, ML_K = 34816, ML_V = 69632, ML_S = 104448, ML_VEC = 139264;
__device__ __forceinline__ bf16x8 tr_frag(const LAS unsigned char* base, int row0, int col0, int lane) {
    const int g = lane >> 4, q = (lane & 15) >> 2, p = lane & 3;
    const LAS unsigned char* a = base + (row0 + 8 * g + q) * ML_RB + (col0 + 4 * p) * 2;
    const s16x4 v0 = __builtin_amdgcn_ds_read_tr16_b64_v4i16((LAS s16x4*)a);
    const s16x4 v1 = __builtin_amdgcn_ds_read_tr16_b64_v4i16((LAS s16x4*)(a + 4 * ML_RB));
    return (bf16x8){v0[0], v0[1], v0[2], v0[3], v1[0], v1[1], v1[2], v1[3]};
}
__device__ void mlstm_phase(const Frame& F, bool ctx_out) {
    const int tid = F.tid(), lane = F.lane(), wid = F.wid, fr = lane & 15, fq = lane >> 4;
    LAS unsigned char* lds = F.lds;
    LAS float* ic = (LAS float*)(lds + ML_VEC); LAS float* fc = ic + 128; LAS float* av = ic + 256; LAS float* Mv = ic + 384; LAS float* bcv = ic + 512;
    LAS float* rden = ic + 640; LAS float* wintv = ic + 768; LAS float* nvec = ic + 896; LAS float* wkv = ic + 1024;
    unsigned char* const ws = KA()->ws;
    const bf16_t* P = (const bf16_t*)(ws + WS_PROJ); const float* GT = (const float*)(ws + WS_GATES); bf16_t* HL = (bf16_t*)(ws + WS_HL);
    for (int unit = F.wg; unit < 256; unit += F.G) {
        const int b = unit >> 3, hd = (unit >> 1) & 3, dir = unit & 1;
        f32x4 Cacc[8];
#pragma unroll
        for (int a = 0; a < 8; ++a) Cacc[a] = (f32x4){0.f, 0.f, 0.f, 0.f};
        float m = 0.f;
        if (tid < 128) nvec[tid] = 0.f;
        u32x4 st[12]; float gi = 0.f, gf = 0.f;
#define ML_ROW0(ci) ((ci) < 2 ? NL + b * 256 + (dir ? 1 - (ci) : (ci)) * 128 : b * 2048 + (dir ? 15 - ((ci) - 2) : ((ci) - 2)) * 128)
#define ML_LOAD(ci) do { const int _r0 = ML_ROW0(ci); _Pragma("unroll") for (int _p = 0; _p < 4; ++_p) { const int _id = tid + 512 * _p, _row = _id >> 4, _ch = _id & 15; \
            const bf16_t* _g = P + (size_t)(_r0 + _row) * NPROJ + 1536 + hd * 128 + _ch * 8; st[_p] = *(const u32x4*)_g; st[4 + _p] = *(const u32x4*)(_g + 512); st[8 + _p] = *(const u32x4*)(_g + 1024); } \
            if (tid < 128) { gi = GT[(size_t)(_r0 + tid) * 16 + (2 * dir) * 4 + hd]; gf = GT[(size_t)(_r0 + tid) * 16 + (2 * dir + 1) * 4 + hd]; } } while (0)
        ML_LOAD(0);
        for (int ci = 0; ci < 18; ++ci) {
            const int row0 = ML_ROW0(ci);
            const bool need_out = (ci >= 2) || ctx_out;
#pragma unroll
            for (int p = 0; p < 4; ++p) { const int id = tid + 512 * p, row = id >> 4, ch = id & 15; const int o = row * ML_RB + ch * 16;
                *(LAS u32x4*)(lds + ML_Q + o) = st[p]; *(LAS u32x4*)(lds + ML_K + o) = st[4 + p]; *(LAS u32x4*)(lds + ML_V + o) = st[8 + p]; }
            if (tid < 128) { ic[tid] = gi; fc[tid] = fminf(gf, 0.f) - log1pf(__expf(-fabsf(gf))); }
            if (ci + 1 < 18) ML_LOAD(ci + 1);
            __syncthreads();
            float bL, Mlast;
            { const int p0 = 2 * lane, p1 = p0 + 1, s0 = dir ? 127 - p0 : p0, s1 = dir ? 127 - p1 : p1;
              const float f0 = fc[s0], f1 = fc[s1], i0 = ic[s0], i1 = ic[s1];
              float incl = f0 + f1;
#pragma unroll
              for (int d = 1; d < 64; d <<= 1) { const float t = __shfl_up(incl, d); if (lane >= d) incl += t; }
              const float bc1 = incl, bc0 = incl - f1;
              const float a0 = i0 - bc0, a1 = i1 - bc1;
              float im = fmaxf(a0, a1);
#pragma unroll
              for (int d = 1; d < 64; d <<= 1) { const float t = __shfl_up(im, d); if (lane >= d) im = fmaxf(im, t); }
              float ex = __shfl_up(im, 1); if (lane == 0) ex = -3.0e38f;
              const float M0 = fmaxf(fmaxf(m, ex), a0), M1 = fmaxf(m, im);
              bL = __shfl(incl, 63); Mlast = __shfl(M1, 63);
              av[s0] = a0; av[s1] = a1; Mv[s0] = M0; Mv[s1] = M1; bcv[s0] = bc0; bcv[s1] = bc1;
              wkv[s0] = __expf(a0 - Mlast); wkv[s1] = __expf(a1 - Mlast); }
            if (need_out) {
                const int t = 16 * wid + fr; const float Mt = Mv[t];
                bf16x8 Qf[4];
#pragma unroll
                for (int ks = 0; ks < 4; ++ks) Qf[ks] = *(const LAS bf16x8*)(lds + ML_Q + t * ML_RB + (32 * ks + 8 * fq) * 2);
                float rowsum = 0.f;
#pragma unroll 1
                for (int j = 0; j < 8; ++j) {
                    f32x4 acc = (f32x4){0.f, 0.f, 0.f, 0.f};
#pragma unroll
                    for (int ks = 0; ks < 4; ++ks) { const bf16x8 Kf = *(const LAS bf16x8*)(lds + ML_K + (16 * j + fr) * ML_RB + (32 * ks + 8 * fq) * 2); acc = __builtin_amdgcn_mfma_f32_16x16x32_bf16(Kf, Qf[ks], acc, 0, 0, 0); }
                    const f32x4 a4 = *(const LAS f32x4*)(av + 16 * j + 4 * fq);
                    float v[4];
#pragma unroll
                    for (int r = 0; r < 4; ++r) { const int s = 16 * j + 4 * fq + r; const bool valid = dir ? (s >= t) : (s <= t); v[r] = valid ? acc[r] * __expf(a4[r] - Mt) : 0.f; rowsum += v[r]; }
                    u32x2 w; w.x = cvt_pk_bf16(v[0], v[1]); w.y = cvt_pk_bf16(v[2], v[3]);
                    *(LAS u32x2*)(lds + ML_S + t * ML_RB + (16 * j + 4 * fq) * 2) = w;
                }
                rowsum += __shfl_xor(rowsum, 16); rowsum += __shfl_xor(rowsum, 32);
                float qn = 0.f;
#pragma unroll
                for (int ks = 0; ks < 4; ++ks) { const f32x4 n0 = *(const LAS f32x4*)(nvec + 32 * ks + 8 * fq), n1 = *(const LAS f32x4*)(nvec + 32 * ks + 8 * fq + 4);
#pragma unroll
                    for (int jj = 0; jj < 4; ++jj) { qn += bf2f((unsigned short)Qf[ks][jj]) * n0[jj]; qn += bf2f((unsigned short)Qf[ks][4 + jj]) * n1[jj]; } }
                qn += __shfl_xor(qn, 16); qn += __shfl_xor(qn, 32);
                const float wi = __expf(m - Mt), den = rowsum + wi * qn, dn = fmaxf(fabsf(den), __expf(-(bcv[t] + Mt)));
                if (fq == 0) { rden[t] = 1.0f / dn; wintv[t] = wi; }
            }
            __syncthreads();
            bf16x8 Vf[4];
#pragma unroll
            for (int ks = 0; ks < 4; ++ks) Vf[ks] = tr_frag(lds + ML_V, 32 * ks, 16 * wid, lane);
            if (need_out) {
                bf16x8 Cf[4];
#pragma unroll
                for (int kp = 0; kp < 4; ++kp) { const f32x4 c0 = Cacc[2 * kp], c1 = Cacc[2 * kp + 1]; u32x4 w; w.x = cvt_pk_bf16(c0[0], c0[1]); w.y = cvt_pk_bf16(c0[2], c0[3]); w.z = cvt_pk_bf16(c1[0], c1[1]); w.w = cvt_pk_bf16(c1[2], c1[3]);
                    Cf[kp] = __builtin_bit_cast(bf16x8, w); }
#pragma unroll 1
                for (int i = 0; i < 8; ++i) {
                    f32x4 aS = (f32x4){0.f, 0.f, 0.f, 0.f}, aC = (f32x4){0.f, 0.f, 0.f, 0.f};
                    const int tt = 16 * i + fr;
#pragma unroll
                    for (int ks = 0; ks < 4; ++ks) { const bf16x8 Sf = *(const LAS bf16x8*)(lds + ML_S + tt * ML_RB + (32 * ks + 8 * fq) * 2); aS = __builtin_amdgcn_mfma_f32_16x16x32_bf16(Vf[ks], Sf, aS, 0, 0, 0); }
#pragma unroll
                    for (int kp = 0; kp < 4; ++kp) { const s16x4 q0 = *(const LAS s16x4*)(lds + ML_Q + tt * ML_RB + (32 * kp + 4 * fq) * 2), q1 = *(const LAS s16x4*)(lds + ML_Q + tt * ML_RB + (32 * kp + 16 + 4 * fq) * 2);
                        const bf16x8 Qp = (bf16x8){q0[0], q0[1], q0[2], q0[3], q1[0], q1[1], q1[2], q1[3]};
                        aC = __builtin_amdgcn_mfma_f32_16x16x32_bf16(Cf[kp], Qp, aC, 0, 0, 0); }
                    const float wi = wintv[tt], rd = rden[tt];
                    u32x2 w; w.x = cvt_pk_bf16((aS[0] + wi * aC[0]) * rd, (aS[1] + wi * aC[1]) * rd); w.y = cvt_pk_bf16((aS[2] + wi * aC[2]) * rd, (aS[3] + wi * aC[3]) * rd);
                    *(u32x2*)(HL + ((size_t)dir * MT + row0 + tt) * 512 + hd * 128 + 16 * wid + 4 * fq) = w;
                }
            }
            {
                const float dec = __expf(m - Mlast);
                bf16x8 Vw[4];
#pragma unroll
                for (int ks = 0; ks < 4; ++ks) { const f32x4 k0 = *(const LAS f32x4*)(wkv + 32 * ks + 8 * fq), k1 = *(const LAS f32x4*)(wkv + 32 * ks + 8 * fq + 4);
                    u32x4 w;
                    w.x = cvt_pk_bf16(bf2f((unsigned short)Vf[ks][0]) * k0[0], bf2f((unsigned short)Vf[ks][1]) * k0[1]); w.y = cvt_pk_bf16(bf2f((unsigned short)Vf[ks][2]) * k0[2], bf2f((unsigned short)Vf[ks][3]) * k0[3]);
                    w.z = cvt_pk_bf16(bf2f((unsigned short)Vf[ks][4]) * k1[0], bf2f((unsigned short)Vf[ks][5]) * k1[1]); w.w = cvt_pk_bf16(bf2f((unsigned short)Vf[ks][6]) * k1[2], bf2f((unsigned short)Vf[ks][7]) * k1[3]);
                    Vw[ks] = __builtin_bit_cast(bf16x8, w); }
#pragma unroll
                for (int a = 0; a < 8; ++a) { Cacc[a] = Cacc[a] * dec;
#pragma unroll
                    for (int ks = 0; ks < 4; ++ks) { const bf16x8 Kt = tr_frag(lds + ML_K, 32 * ks, 16 * a, lane); Cacc[a] = __builtin_amdgcn_mfma_f32_16x16x32_bf16(Kt, Vw[ks], Cacc[a], 0, 0, 0); } }
                if (tid < 128) { float an = dec * nvec[tid];
#pragma unroll 8
                    for (int s = 0; s < 128; ++s) an += wkv[s] * bf2f(*(const LAS unsigned short*)(lds + ML_K + s * ML_RB + tid * 2));
                    nvec[tid] = an; }
                m = bL + Mlast;
            }
            __syncthreads();
        }
#undef ML_ROW0
#undef ML_LOAD
    }
}

constexpr int NPH = 20;
constexpr int REP[NPH] = {1, 1, 1, 1, 1, 1, 1, 1, 1, 1, 1, 1, 1, 1, 1, 1, 1, 1, 1, 1};
#define REPEAT(k) for (int _r = 0; _r < REP[k]; ++_r)
#define GSCALE(k) ((_r == REP[k] - 1) ? 1.0f : 0.0f)
__global__ void __launch_bounds__(512, 2) mk_fwd(Args args_unused) {
    extern __shared__ __attribute__((aligned(16))) unsigned char smem[];
    Frame F;
    F.lds = (LAS unsigned char*)smem; F.wid = __builtin_amdgcn_readfirstlane((int)threadIdx.x >> 6); F.G = gridDim.x; F.wg = blockIdx.x;
    volatile LAS unsigned* misc = (volatile LAS unsigned*)(F.lds + MISC_OFF);
    if (F.tid() < 64) misc[F.tid()] = 0u;
    __syncthreads();
    int lo, hi;
    { KArgs ka = KA(); lo = ka->lo; hi = ka->hi; }
    XcdBarrier bar;
    { KArgs ka = KA(); bar.bar = (unsigned*)(ka->ws + WS_CTL); bar.x = 0; bar.st = misc; bar.wid = F.wid;
      if (hi - lo > 1) bar = xcd_barrier_post((unsigned*)(ka->ws + WS_CTL), misc, F.wid); }
#define IN(k) (lo <= (k) && (k) < hi)
#define SEAM(k) do { if (IN(k) && IN((k) + 1)) { KArgs _ka = KA(); bar.bar = (unsigned*)(_ka->ws + WS_CTL); xcd_barrier(bar); } } while (0)
    const volatile LAS int* tb = (const volatile LAS int*)(F.lds + MISC_OFF + 64);
    volatile LAS int* tbw = (volatile LAS int*)(F.lds + MISC_OFF + 64);

#ifdef PROBE_MFMA
    {
        f32x4 a0 = {0.f, 0.f, 0.f, 0.f}, a1 = a0, a2 = a0, a3 = a0; bf16x8 x = {1, 2, 3, 4, 5, 6, 7, 8}, y = {8, 7, 6, 5, 4, 3, 2, 1};
        asm volatile("" : "+v"(x), "+v"(y));
        for (int it = 0; it < 10000; ++it) {
            a0 = __builtin_amdgcn_mfma_f32_16x16x32_bf16(x, y, a0, 0, 0, 0); a1 = __builtin_amdgcn_mfma_f32_16x16x32_bf16(x, y, a1, 0, 0, 0);
            a2 = __builtin_amdgcn_mfma_f32_16x16x32_bf16(x, y, a2, 0, 0, 0); a3 = __builtin_amdgcn_mfma_f32_16x16x32_bf16(x, y, a3, 0, 0, 0); }
        asm volatile("" :: "v"(a0), "v"(a1), "v"(a2), "v"(a3));
    }
#endif
    if (IN(0)) REPEAT(0) { p0_prologue(F); }
    SEAM(0);
    if (IN(1)) REPEAT(1) { KArgs ka = KA(); unsigned char* ws = ka->ws;
        norm_phase<false, false>(F, ka->in[I_X], ka->in[I_CTX], MT, ka->in[I_N1G], (const float*)(ws + WS_MOD), 0, (bf16_t*)(ws + WS_U), nullptr); }
    SEAM(1);
    if (IN(2)) REPEAT(2) { KArgs ka = KA(); unsigned char* ws = ka->ws;
        pg8::DenseSched S{MT / 256, NPAD / 256, F.G, F.wg, 2 * D};
        pg8::EpiProj E{(bf16_t*)(ws + WS_PROJ), (float*)(ws + WS_GATES), ka->in[I_BG], GSCALE(2) == 0.0f};
        pg8::gemm_phase<false>(F.lds, F.wid, (const char*)(ws + WS_U), (const char*)(ws + WS_WIN), 2 * D, S, E); }
    SEAM(2);
    if (IN(3)) REPEAT(3) { mlstm_phase(F, true); }
    SEAM(3);
    if (IN(4)) REPEAT(4) { KArgs ka = KA(); mix_phase(F, MT, ka->in[I_CONVW], ka->in[I_MNG]); }
    SEAM(4);
    if (IN(5)) REPEAT(5) { KArgs ka = KA(); unsigned char* ws = ka->ws;
        pg8::DenseSched S{MT / 256, D / 256, F.G, F.wg, 2 * D};
        pg8::EpiResid E{ka->in[I_X], ka->in[I_CTX], ka->out, (float*)(ws + WS_HC), (const float*)(ws + WS_MOD) + 2 * 1024, 1.0f};
        pg8::gemm_phase<false>(F.lds, F.wid, (const char*)(ws + WS_U), (const char*)(ws + WS_WOUT), 2 * D, S, E); }
    SEAM(5);
    if (IN(6)) REPEAT(6) { KArgs ka = KA(); unsigned char* ws = ka->ws;
        norm_phase<false, true>(F, ka->out, (const float*)(ws + WS_HC), MT, ka->in[I_N2G], (const float*)(ws + WS_MOD), 3, (bf16_t*)(ws + WS_U), nullptr); }
    SEAM(6);
    if (IN(7)) REPEAT(7) { KArgs ka = KA(); unsigned char* ws = ka->ws;
        pg8::DenseSched S{MT / 256, 2 * DFF / 256, F.G, F.wg, D};
        pg8::EpiSwiglu E{(unsigned char*)(ws + WS_PROJ), 1.0f / (S_A * S_W13), S_H};
        pg8::gemm_phase<true>(F.lds, F.wid, (const char*)(ws + WS_U), (const char*)(ws + WS_WUP), D, S, E); }
    SEAM(7);
    if (IN(8)) REPEAT(8) { KArgs ka = KA(); unsigned char* ws = ka->ws;
        pg8::DenseSched S{MT / 256, D / 256, F.G, F.wg, DFF};
        pg8::EpiResid E{ka->out, (const float*)(ws + WS_HC), ka->out, (float*)(ws + WS_HC), (const float*)(ws + WS_MOD) + 5 * 1024, GSCALE(8) / (S_H * S_W2)};
        pg8::gemm_phase<true>(F.lds, F.wid, (const char*)(ws + WS_PROJ), (const char*)(ws + WS_WDN), DFF, S, E); }
    SEAM(8);
    if (IN(9)) REPEAT(9) { KArgs ka = KA(); unsigned char* ws = ka->ws;
        norm_phase<false, false>(F, ka->out, (const float*)(ws + WS_HC), MT, ka->in[I_N1G] + D, (const float*)(ws + WS_MOD) + 33 * 6144, 0, (bf16_t*)(ws + WS_U), nullptr); }
    SEAM(9);
    if (IN(10)) REPEAT(10) { KArgs ka = KA(); unsigned char* ws = ka->ws;
        pg8::InProjL1Sched S{F.G, F.wg};
        pg8::EpiProj E{(bf16_t*)(ws + WS_PROJ), (float*)(ws + WS_GATES), ka->in[I_BG] + 16, GSCALE(10) == 0.0f};
        pg8::gemm_phase<false>(F.lds, F.wid, (const char*)(ws + WS_U), (const char*)(ws + WS_WIN) + (size_t)NPAD * D * 2, 2 * D, S, E); }
    SEAM(10);
    if (IN(11)) REPEAT(11) { mlstm_phase(F, false); }
    SEAM(11);
    if (IN(12)) REPEAT(12) { KArgs ka = KA(); mix_phase(F, NL, ka->in[I_CONVW] + 3 * 512, ka->in[I_MNG] + 512); }
    SEAM(12);
    if (IN(13)) REPEAT(13) { KArgs ka = KA(); unsigned char* ws = ka->ws;
        pg8::DenseSched S{NL / 256, D / 256, F.G, F.wg, 2 * D};
        pg8::EpiResid E{ka->out, nullptr, ka->out, nullptr, (const float*)(ws + WS_MOD) + 33 * 6144 + 2 * 1024, GSCALE(13)};
        pg8::gemm_phase<false>(F.lds, F.wid, (const char*)(ws + WS_U), (const char*)(ws + WS_WOUT) + (size_t)D * D * 2, 2 * D, S, E); }
    SEAM(13);
    if (IN(14)) REPEAT(14) { KArgs ka = KA(); unsigned char* ws = ka->ws;
        norm_phase<true, true>(F, ka->out, nullptr, NL, ka->in[I_N2G] + D, (const float*)(ws + WS_MOD) + 33 * 6144, 3, (bf16_t*)(ws + WS_U), ka->in[I_ROUTER]); }
    SEAM(14);
    for (int k = 0; k < 2; ++k) {
        if (IN(15 + 2 * k) || IN(16 + 2 * k)) {
            __syncthreads();
            if (F.tid() == 0) { KArgs ka = KA(); const unsigned* gc = (const unsigned*)(ka->ws + WS_CTL + CTL_GCNT) + 8 * k; int t = 0;
                for (int g = 0; g < 8; ++g) { const int c = (int)__hip_atomic_load(gc + g, __ATOMIC_RELAXED, __HIP_MEMORY_SCOPE_AGENT); tbw[g] = t; tbw[16 + g] = c; t += (c + 255) >> 8; }
                tbw[8] = t; }
            __syncthreads();
        }
        if (IN(15 + 2 * k)) REPEAT(15) { KArgs ka = KA(); unsigned char* ws = ka->ws;
            pg8::MoeUpSched S{F.G, F.wg, (const int*)(ws + WS_RTOK) + (size_t)k * 8 * RT_STRIDE, tb};
            pg8::EpiSwiglu E{(unsigned char*)(ws + WS_PROJ), 1.0f / (S_A * S_W13), S_H};
            pg8::gemm_phase<true>(F.lds, F.wid, (const char*)(ws + WS_U), (const char*)(ws + WS_MUP), D, S, E); }
        SEAM(15 + 2 * k);
        if (IN(16 + 2 * k)) REPEAT(16) { KArgs ka = KA(); unsigned char* ws = ka->ws;
            pg8::MoeDownSched S{F.G, F.wg, tb};
            pg8::EpiMoeDown E{ka->out, (const float*)(ws + WS_MOD) + 33 * 6144 + 5 * 1024, (const int*)(ws + WS_RTOK) + (size_t)k * 8 * RT_STRIDE, (const float*)(ws + WS_RGATE) + (size_t)k * 8 * RT_STRIDE, tb, GSCALE(16) / (S_H * S_W2)};
            pg8::gemm_phase<true>(F.lds, F.wid, (const char*)(ws + WS_PROJ), (const char*)(ws + WS_MDN), DFF, S, E); }
        SEAM(16 + 2 * k);
    }
    if (IN(19)) REPEAT(19) { final_phase(F); }
#undef IN
#undef SEAM
}

extern "C" void kernel_launch(void* const* d_in, const int* in_sizes, int n_in, void* d_out, int out_size, void* d_ws, size_t ws_size, hipStream_t stream) {
    static int grid = 0;
    if (grid == 0) {
        if (n_in != 21 || ws_size < WS_END) { fprintf(stderr, "kernel_launch: expected 21 inputs and >= %zu bytes of workspace; got %d, %zu\n", (size_t)WS_END, n_in, ws_size); grid = -1; return; }
        int dev = 0, cus = 0, per_cu = 0;
        if (hipGetDevice(&dev) != hipSuccess || hipDeviceGetAttribute(&cus, hipDeviceAttributeMultiprocessorCount, dev) != hipSuccess) { grid = -1; return; }
        if (hipFuncSetAttribute((const void*)mk_fwd, hipFuncAttributeMaxDynamicSharedMemorySize, LDS_BYTES) != hipSuccess) { fprintf(stderr, "kernel_launch: hipFuncSetAttribute failed\n"); grid = -1; return; }
        if (hipOccupancyMaxActiveBlocksPerMultiprocessor(&per_cu, (const void*)mk_fwd, 512, LDS_BYTES) != hipSuccess || per_cu < 1) fprintf(stderr, "kernel_launch: occupancy query reports %d\n", per_cu);
        (void)hipGetLastError();
        grid = cus;
    }
    if (grid < 0) return;
    (void)hipMemsetAsync((char*)d_ws + WS_CTL, 0, CTL_BYTES, stream);
    Args a{};
    for (int i = 0; i < 21; ++i) a.in[i] = (const float*)d_in[i];
    a.out = (float*)d_out; a.ws = (unsigned char*)d_ws;
#if MK_PER_PHASE
    for (int p = 0; p < NPH; ++p) { a.lo = p; a.hi = p + 1; hipLaunchKernelGGL(mk_fwd, dim3(grid), dim3(512), LDS_BYTES, stream, a); }
#else
    a.lo = 0; a.hi = NPH; hipLaunchKernelGGL(mk_fwd, dim3(grid), dim3(512), LDS_BYTES, stream, a);
#endif
}
```

```cpp
#include <hip/hip_runtime.h>
#include <cstdio>
#include <cstdint>

#ifndef MK_PER_PHASE
#define MK_PER_PHASE 0
#endif

#define LAS __attribute__((address_space(3)))
typedef unsigned short bf16_t;
typedef short bf16x8 __attribute__((ext_vector_type(8)));
typedef short s16x4 __attribute__((ext_vector_type(4)));
typedef float f32x4 __attribute__((ext_vector_type(4)));
typedef unsigned u32x4 __attribute__((ext_vector_type(4)));
typedef unsigned u32x2 __attribute__((ext_vector_type(2)));

constexpr int D = 1024, NB = 32, SEQ = 2048, CTXL = 256;
constexpr int NL = NB * SEQ;
constexpr int NCX = NB * CTXL;
constexpr int MT = NL + NCX;
constexpr int PIN = 3600, NPROJ = 3584, NPAD = 3840;
constexpr int DFF = 2816, NE = 8;
constexpr float EPS = 1e-6f;
constexpr int RT_STRIDE = 65536;
constexpr float S_A = 16.0f, S_W13 = 256.0f, S_H = 8.0f, S_W2 = 256.0f;

constexpr size_t WS_CTL = 0;
constexpr size_t CTL_BYTES = 65536;
constexpr size_t CTL_GCNT = 16384;
constexpr size_t WS_MOD = 65536;
constexpr size_t WS_WIN = 2097152;
constexpr size_t WS_WOUT = WS_WIN + (size_t)2 * NPAD * D * 2;
constexpr size_t WS_WUP = WS_WOUT + (size_t)2 * D * D * 2;
constexpr size_t WS_WDN = WS_WUP + (size_t)2 * DFF * D * 2;
constexpr size_t WS_MUP = WS_WDN + (size_t)D * DFF * 2;
constexpr size_t WS_MDN = WS_MUP + (size_t)NE * 2 * DFF * D * 2;
constexpr size_t WS_HC = WS_MDN + (size_t)NE * D * DFF * 2;
constexpr size_t WS_U = WS_HC + (size_t)NCX * D * 4;
constexpr size_t WS_PROJ = WS_U + (size_t)MT * D * 2;
constexpr size_t WS_GATES = WS_PROJ + (size_t)MT * NPROJ * 2;
constexpr size_t WS_HL = WS_GATES + (size_t)MT * 16 * 4;
constexpr size_t WS_RTOK = WS_HL + (size_t)2 * MT * 512 * 2;
constexpr size_t WS_RGATE = WS_RTOK + (size_t)16 * RT_STRIDE * 4;
constexpr size_t WS_END = WS_RGATE + (size_t)16 * RT_STRIDE * 4;

constexpr int LDS_BYTES = 147456;
constexpr int MISC_OFF = 145408;

__device__ __forceinline__ unsigned cvt_pk_bf16(float lo, float hi) { unsigned r; asm volatile("v_cvt_pk_bf16_f32 %0, %1, %2" : "=v"(r) : "v"(lo), "v"(hi)); return r; }
__device__ __forceinline__ float bf2f(unsigned short b) { return __uint_as_float(((unsigned)b) << 16); }
__device__ __forceinline__ float bflo(unsigned w) { return __uint_as_float(w << 16); }
__device__ __forceinline__ float bfhi(unsigned w) { return __uint_as_float(w & 0xffff0000u); }
__device__ __forceinline__ float wave_sum(float v) {
#pragma unroll
    for (int o = 32; o >= 1; o >>= 1) v += __shfl_xor(v, o);
    return v;
}
__device__ __forceinline__ int lane_id() { int l; asm volatile("v_mbcnt_lo_u32_b32 %0, -1, 0\n\tv_mbcnt_hi_u32_b32 %0, -1, %0" : "=v"(l)); return l; }
__device__ __forceinline__ float sigmoidf_(float x) { return 1.0f / (1.0f + __expf(-x)); }

#define XB_TMO      128
#define XB_XCNT(j)  (256  + 64 * (j))
#define XB_XSUB(j)  (1280 + 64 * (j))
#define XB_XGEN(j)  (2304 + 64 * (j))
#define XB_TOP      3328
#define XB_TOPGEN   3392
#define XCD_BAR_WORDS 3456
#define XB_SPIN_CAP (1u << 18)

__device__ __forceinline__ unsigned xb_ld(unsigned* p)              { return __hip_atomic_load(p, __ATOMIC_RELAXED, __HIP_MEMORY_SCOPE_AGENT); }
__device__ __forceinline__ unsigned xb_add(unsigned* p, unsigned v) { return __hip_atomic_fetch_add(p, v, __ATOMIC_RELAXED, __HIP_MEMORY_SCOPE_AGENT); }
__device__ __forceinline__ unsigned xb_xcc_id() { return (unsigned)__builtin_amdgcn_s_getreg((3 << 11) | 20) & 0xFu; }
#define XB_SPIN(cond, bar) do { unsigned _sp = 0; while (cond) { __builtin_amdgcn_s_sleep(1); \
    if ((++_sp & 255u) == 0u) { if (xb_ld(&(bar)[XB_TMO])) break; if (_sp > XB_SPIN_CAP) { atomicAdd(&(bar)[XB_TMO], 1u); break; } } } } while (0)

struct XcdBarrier {
    unsigned* bar; unsigned x;
    volatile LAS unsigned* st;
    int wid;
};
#define XB_THREAD0(b) ((b).wid == 0 && lane_id() == 0)
__device__ __forceinline__ XcdBarrier xcd_barrier_post(unsigned* bar, volatile LAS unsigned* st, int wid) {
    XcdBarrier b; b.bar = bar; b.x = xb_xcc_id(); b.st = st; b.wid = wid;
    if (XB_THREAD0(b)) (void)xb_add(&bar[XB_XCNT(b.x)], 1u);
    return b;
}
__device__ __forceinline__ void xcd_barrier_complete(unsigned* bar, unsigned x, unsigned& nloc, unsigned& nx) {
    const unsigned G = gridDim.x * gridDim.y * gridDim.z;
    unsigned sum, cnt, mine, sp = 0u;
    for (;;) {
        sum = 0u; cnt = 0u; mine = 0u;
#pragma unroll
        for (unsigned j = 0; j < 16; ++j) { const unsigned c = xb_ld(&bar[XB_XCNT(j)]); sum += c; cnt += (c > 0u) ? 1u : 0u; mine = (j == x) ? c : mine; }
        if (sum == G) break;
        __builtin_amdgcn_s_sleep(1);
        if ((++sp & 255u) == 0u) { if (xb_ld(&bar[XB_TMO])) break; if (sp > XB_SPIN_CAP) { atomicAdd(&bar[XB_TMO], 1u); break; } }
    }
    nloc = mine > 0u ? mine : 1u; nx = cnt > 0u ? cnt : 1u;
}
__device__ __forceinline__ void xcd_barrier(const XcdBarrier& b) {
    asm volatile("s_waitcnt vmcnt(0)" ::: "memory");
    __syncthreads();
    if (XB_THREAD0(b)) {
        unsigned* bar = b.bar;
        __builtin_amdgcn_s_waitcnt(0);
        unsigned nloc = b.st[0], nx = b.st[1];
        if (nloc == 0u) { xcd_barrier_complete(bar, b.x, nloc, nx); b.st[0] = nloc; b.st[1] = nx; }
        const unsigned old = xb_add(&bar[XB_XSUB(b.x)], 1u);
        const unsigned gen = old / nloc;
        if (old + 1u == (gen + 1u) * nloc) {
            __builtin_amdgcn_fence(__ATOMIC_RELEASE, "agent");
            asm volatile("s_waitcnt vmcnt(0)" ::: "memory");
            const unsigned og = xb_add(&bar[XB_TOP], 1u);
            const unsigned tg = og / nx;
            if (og + 1u == (tg + 1u) * nx) xb_add(&bar[XB_TOPGEN], 1u);
            else XB_SPIN(xb_ld(&bar[XB_TOPGEN]) == tg, bar);
            __builtin_amdgcn_fence(__ATOMIC_ACQUIRE, "agent");
            xb_add(&bar[XB_XGEN(b.x)], 1u);
            asm volatile("s_waitcnt vmcnt(0)" ::: "memory");
        } else {
            XB_SPIN(xb_ld(&bar[XB_XGEN(b.x)]) == gen, bar);
            __builtin_amdgcn_fence(__ATOMIC_ACQUIRE, "agent");
            asm volatile("s_waitcnt vmcnt(0)" ::: "memory");
        }
    }
    __syncthreads();
}

namespace pg8 {
constexpr int BM = 256, BK = 64, HALF = 128, HTB = HALF * BK * 2, STAGE_BYTES = 8 * HTB, NXCD = 8, WGM = 8;
__device__ __forceinline__ int lds_byte(int r, int c) { const int st = (r >> 4) * 2 + (c >> 5), rr = r & 15, cc = c & 31, ob = rr * 64 + cc * 2; return st * 1024 + (ob ^ (((ob >> 9) & 1) << 5)); }
__device__ __forceinline__ void stage_rc(int b, int& R, int& C) { const int st = b / 1024, sb = b % 1024, swz = sb ^ (((sb >> 9) & 1) << 5); R = (st >> 1) * 16 + swz / 64; C = (st & 1) * 32 + (swz % 64) / 2; }
__device__ __forceinline__ int perm32(int rho) { const int n = rho >> 4, i = rho & 15; return 8 * (i >> 2) + 4 * n + (i & 3); }

struct Unit { int pm, pn; unsigned B; int g; };

__device__ __forceinline__ void tile_map(int L, int nM, int nN, int& pm, int& pn) {
    const int nwg = nM * nN; int wgid = L;
    { const int q = nwg / NXCD, r = nwg % NXCD, xcd = wgid % NXCD, off = wgid / NXCD; wgid = (xcd < r ? xcd * (q + 1) : r * (q + 1) + (xcd - r) * q) + off; }
    const int nig = WGM * nN, gid = wgid / nig, fm = gid * WGM, gsz = (nM - fm) < WGM ? (nM - fm) : WGM;
    pm = fm + ((wgid % nig) % gsz); pn = (wgid % nig) / gsz;
}

typedef int i32x8 __attribute__((ext_vector_type(8)));
template <bool FP8, class Epi, class Sched>
__device__ __forceinline__ void gemm_phase(LAS unsigned char* lds, const int wid, const char* Abase, const char* Bbase, const int KB, const Sched& S, const Epi& E) {
    const int lane = lane_id(), tid = wid * 64 + lane, wr = wid >> 2, wc = wid & 3, fr = lane & 15, fq = lane >> 4;
    const int nt = KB / 128;
    int R0, C0; stage_rc(tid * 16, R0, C0);
    unsigned voffB[2];
#pragma unroll
    for (int i = 0; i < 2; ++i) { const int R = R0 + 64 * i; const int Rb = Epi::PERM ? ((R & ~31) + perm32(R & 31)) : R; voffB[i] = (unsigned)(Rb * KB + C0 * 2); }
    const unsigned kstep = (unsigned)(BK * 2);
    const unsigned hstep = (unsigned)(HALF * KB);
    const __amdgpu_buffer_rsrc_t rsA = __builtin_amdgcn_make_buffer_rsrc((void*)Abase, (short)0, 0x7ffff000, 0x00020000);
    const __amdgpu_buffer_rsrc_t rsB = __builtin_amdgcn_make_buffer_rsrc((void*)Bbase, (short)0, 0x7ffff000, 0x00020000);
    const unsigned ldsw = (unsigned)wid * 1024u;
    const int aoff = lds_byte(wr * 64 + fr, fq * 8), boff = lds_byte(wc * 32 + fr, fq * 8);
#define PG8_SA(b, h) (((b) * 2 + (h)) * HTB)
#define PG8_SB(b, h) ((4 + (b) * 2 + (h)) * HTB)
#define PG8_STAGE(bufoff, soff, voff) do { _Pragma("unroll") for (int _i = 0; _i < 2; ++_i) \
        __builtin_amdgcn_raw_ptr_buffer_load_lds(rsB, (LAS unsigned*)(lds + (bufoff) + ldsw + _i * 8192), 16, (int)(voff)[_i], (int)(soff), 0, 0); } while (0)
#define PG8_STAGE_A(bufoff, o0, o1, soff) do { \
        __builtin_amdgcn_raw_ptr_buffer_load_lds(rsA, (LAS unsigned*)(lds + (bufoff) + ldsw), 16, (int)(o0), (int)(soff), 0, 0); \
        __builtin_amdgcn_raw_ptr_buffer_load_lds(rsA, (LAS unsigned*)(lds + (bufoff) + ldsw + 8192), 16, (int)(o1), (int)(soff), 0, 0); } while (0)
#define PG8_LDA(dst, b, h) do { _Pragma("unroll") for (int m = 0; m < 4; ++m) _Pragma("unroll") for (int k = 0; k < 2; ++k) dst[m][k] = *(const LAS bf16x8*)(lds + PG8_SA(b, h) + aoff + m * 2048 + k * 1024); } while (0)
#define PG8_LDB(dst, b, h) do { _Pragma("unroll") for (int n = 0; n < 2; ++n) _Pragma("unroll") for (int k = 0; k < 2; ++k) dst[n][k] = *(const LAS bf16x8*)(lds + PG8_SB(b, h) + boff + n * 2048 + k * 1024); } while (0)
#define PG8_MMA(ai, bj, At, Bt) do { __builtin_amdgcn_s_setprio(1); \
        if constexpr (FP8) { _Pragma("unroll") for (int m = 0; m < 4; ++m) _Pragma("unroll") for (int n = 0; n < 2; ++n) { \
            const u32x4 _b0 = __builtin_bit_cast(u32x4, Bt[n][0]), _b1 = __builtin_bit_cast(u32x4, Bt[n][1]), _a0 = __builtin_bit_cast(u32x4, At[m][0]), _a1 = __builtin_bit_cast(u32x4, At[m][1]); \
            const i32x8 _bb = {(int)_b0.x, (int)_b0.y, (int)_b0.z, (int)_b0.w, (int)_b1.x, (int)_b1.y, (int)_b1.z, (int)_b1.w}, _aa = {(int)_a0.x, (int)_a0.y, (int)_a0.z, (int)_a0.w, (int)_a1.x, (int)_a1.y, (int)_a1.z, (int)_a1.w}; \
            acc[ai][bj][m][n] = __builtin_amdgcn_mfma_scale_f32_16x16x128_f8f6f4(_bb, _aa, acc[ai][bj][m][n], 0, 0, 0, 0, 0, 0); } } \
        else { _Pragma("unroll") for (int m = 0; m < 4; ++m) _Pragma("unroll") for (int n = 0; n < 2; ++n) _Pragma("unroll") for (int k = 0; k < 2; ++k) \
            acc[ai][bj][m][n] = __builtin_amdgcn_mfma_f32_16x16x32_bf16(Bt[n][k], At[m][k], acc[ai][bj][m][n], 0, 0, 0); } \
        __builtin_amdgcn_s_setprio(0); } while (0)
#define PG8_WAIT_V(n) asm volatile("s_waitcnt vmcnt(" #n ")" ::: "memory")
#define PG8_WAIT_L(n) asm volatile("s_waitcnt lgkmcnt(" #n ")" ::: "memory")
#define PG8_BAR __builtin_amdgcn_s_barrier()
#define PG8_SCHED __builtin_amdgcn_sched_barrier(0)
    Unit cur, nxt; int ui = 0;
    if (!S.next(0, cur)) return;
    f32x4 acc[2][2][4][2];
#pragma unroll
    for (int a = 0; a < 2; ++a)
#pragma unroll
        for (int b = 0; b < 2; ++b)
#pragma unroll
            for (int m = 0; m < 4; ++m)
#pragma unroll
                for (int n = 0; n < 2; ++n) acc[a][b][m][n] = (f32x4){0.f, 0.f, 0.f, 0.f};
    bf16x8 At[4][2], B0[2][2], B1[2][2];
    unsigned voffA[2]; voffA[0] = (unsigned)(R0 * KB + C0 * 2); voffA[1] = voffA[0] + (unsigned)(64 * KB);
    unsigned oc00 = 0, oc01 = 0, oc10 = 0, oc11 = 0;
    LAS u32x4* park = (LAS u32x4*)(lds + STAGE_BYTES) + tid;
    unsigned cA = 0, nA = 0;
    if constexpr (Sched::GATHER) { S.aoff(cur, R0, C0, oc00, oc01, oc10, oc11); asm volatile("" : "+v"(oc00), "+v"(oc01), "+v"(oc10), "+v"(oc11)); }
    else cA = S.abase(cur);
#define PG8_STA(bufoff, ptr, h, kb) do { if constexpr (Sched::GATHER) { if ((h) == 0) PG8_STAGE_A(bufoff, oc00, oc01, kb); else PG8_STAGE_A(bufoff, oc10, oc11, kb); } \
        else PG8_STAGE_A(bufoff, voffA[0], voffA[1], (ptr) + (unsigned)(h) * hstep + (unsigned)(kb)); } while (0)
    unsigned cB = cur.B;
    PG8_STAGE(PG8_SB(0, 0), cB, voffB); PG8_STA(PG8_SA(0, 0), cA, 0, 0); PG8_STAGE(PG8_SB(0, 1), cB + hstep, voffB); PG8_STA(PG8_SA(0, 1), cA, 1, 0);
    if (wr == 1) PG8_BAR;
    PG8_WAIT_V(4); PG8_BAR;
    PG8_STAGE(PG8_SB(1, 0), cB + kstep, voffB); PG8_STA(PG8_SA(1, 0), cA, 0, kstep); PG8_STAGE(PG8_SB(1, 1), cB + hstep + kstep, voffB);
    PG8_WAIT_V(6); PG8_BAR;
    for (;;) {
        const bool has_next = S.next(ui + 1, nxt);
        if constexpr (Sched::GATHER) {
            unsigned on00 = oc00, on01 = oc01, on10 = oc10, on11 = oc11;
            if (has_next) S.aoff(nxt, R0, C0, on00, on01, on10, on11);
            *park = (u32x4){on00, on01, on10, on11};
        } else nA = has_next ? S.abase(nxt) : cA;
        const unsigned nB = has_next ? nxt.B : cB;
#pragma unroll 1
        for (int t = 0; t < nt; t += 2) {
            const bool last = (t == nt - 2);
            const unsigned k1 = (unsigned)(t + 1) * kstep;
            const unsigned k2 = last ? 0u : (unsigned)(t + 2) * kstep; const unsigned k3 = k2 + kstep;
            const unsigned a2 = last ? nA : cA;
            const unsigned b2 = last ? nB : cB + (unsigned)(t + 2) * kstep; const unsigned b3 = b2 + kstep;
            PG8_LDB(B0, 0, 0); PG8_SCHED; PG8_LDA(At, 0, 0); PG8_STA(PG8_SA(1, 1), cA, 1, k1);
            PG8_WAIT_L(8); PG8_BAR; PG8_WAIT_L(0); PG8_MMA(0, 0, At, B0); PG8_BAR; PG8_SCHED;
            if constexpr (Sched::GATHER) { if (last) { const u32x4 pk = *park; oc00 = pk.x; oc01 = pk.y; oc10 = pk.z; oc11 = pk.w; } }
            PG8_LDB(B1, 0, 1); PG8_STAGE(PG8_SB(0, 0), b2, voffB);
            PG8_BAR; PG8_WAIT_L(0); PG8_MMA(0, 1, At, B1); PG8_BAR;
            PG8_LDA(At, 0, 1); PG8_STA(PG8_SA(0, 0), a2, 0, k2);
            PG8_BAR; PG8_WAIT_L(0); PG8_MMA(1, 0, At, B0); PG8_BAR; PG8_SCHED;
            PG8_STAGE(PG8_SB(0, 1), b2 + hstep, voffB);
            PG8_WAIT_V(6); PG8_BAR; PG8_MMA(1, 1, At, B1); PG8_BAR;
            PG8_LDB(B0, 1, 0); PG8_SCHED; PG8_LDA(At, 1, 0); PG8_STA(PG8_SA(0, 1), a2, 1, k2);
            PG8_WAIT_L(8); PG8_BAR; PG8_WAIT_L(0); PG8_MMA(0, 0, At, B0); PG8_BAR; PG8_SCHED;
            PG8_LDB(B1, 1, 1); PG8_STAGE(PG8_SB(1, 0), b3, voffB);
            PG8_BAR; PG8_WAIT_L(0); PG8_MMA(0, 1, At, B1); PG8_BAR;
            PG8_LDA(At, 1, 1); PG8_STA(PG8_SA(1, 0), a2, 0, k3);
            PG8_BAR; PG8_WAIT_L(0); PG8_MMA(1, 0, At, B0); PG8_BAR; PG8_SCHED;
            PG8_STAGE(PG8_SB(1, 1), b3 + hstep, voffB);
            PG8_WAIT_V(6); PG8_BAR; PG8_MMA(1, 1, At, B1); PG8_BAR;
        }
        { const int _l = lane_id(); const int _fr = _l & 15, _fq = _l >> 4;
          E(acc, cur, wr, wc, _fr, _fq); }
        if (!has_next) break;
#pragma unroll
        for (int a = 0; a < 2; ++a)
#pragma unroll
            for (int b = 0; b < 2; ++b)
#pragma unroll
                for (int m = 0; m < 4; ++m)
#pragma unroll
                    for (int n = 0; n < 2; ++n) acc[a][b][m][n] = (f32x4){0.f, 0.f, 0.f, 0.f};
        cur = nxt; cB = nB; cA = nA; ++ui;
    }
    PG8_WAIT_V(0);
    if (wr == 0) PG8_BAR;
    PG8_BAR;
#undef PG8_SA
#undef PG8_SB
#undef PG8_STAGE
#undef PG8_STAGE_A
#undef PG8_STA
#undef PG8_LDA
#undef PG8_LDB
#undef PG8_MMA
#undef PG8_WAIT_V
#undef PG8_WAIT_L
#undef PG8_BAR
#undef PG8_SCHED
}

struct DenseSched {
    static constexpr bool GATHER = false;
    int nM, nN, G, c, KB;
    __device__ __forceinline__ unsigned abase(const Unit& u) const { return (unsigned)(u.pm * 256 * KB); }
    __device__ __forceinline__ bool next(int i, Unit& u) const {
        const long L = (long)i * G + c; if (L >= (long)nM * nN) return false;
        tile_map((int)L, nM, nN, u.pm, u.pn); u.B = (unsigned)(u.pn * 256 * KB); u.g = 0; return true;
    }
    __device__ __forceinline__ void aoff(const Unit& u, int R0, int C0, unsigned& o00, unsigned& o01, unsigned& o10, unsigned& o11) const {
        const unsigned base = (unsigned)((u.pm * 256 + R0) * KB + C0 * 2), r64 = (unsigned)(64 * KB);
        o00 = base; o01 = base + r64; o10 = base + 2u * r64; o11 = base + 3u * r64;
    }
};
struct InProjL1Sched {
    static constexpr bool GATHER = false;
    int G, c;
    __device__ __forceinline__ unsigned abase(const Unit& u) const { return (unsigned)(u.pm * 256 * D * 2); }
    __device__ __forceinline__ bool next(int i, Unit& u) const {
        const int L = i * G + c; if (L >= 3840 + 224) return false;
        if (L < 3840) tile_map(L, 256, 15, u.pm, u.pn);
        else { const int Lc = L - 3840; u.pm = 256 + Lc / 7; const int j = Lc % 7; u.pn = j < 6 ? 6 + j : 14; }
        u.B = (unsigned)(u.pn * 256 * D * 2); u.g = 0; return true;
    }
    __device__ __forceinline__ void aoff(const Unit& u, int R0, int C0, unsigned& o00, unsigned& o01, unsigned& o10, unsigned& o11) const {
        const unsigned base = (unsigned)((u.pm * 256 + R0) * D + C0) * 2u, r64 = (unsigned)(64 * D) * 2u;
        o00 = base; o01 = base + r64; o10 = base + 2u * r64; o11 = base + 3u * r64;
    }
};
struct MoeUpSched {
    static constexpr bool GATHER = true;
    int G, c; const int* rowtok; const volatile LAS int* tb;
    __device__ __forceinline__ unsigned abase(const Unit&) const { return 0u; }
    __device__ __forceinline__ bool next(int i, Unit& u) const {
        const int T = tb[8]; const int L = i * G + c; if (L >= T * 22) return false;
        tile_map(L, T, 22, u.pm, u.pn); int g = 0;
#pragma unroll
        for (int j = 1; j < 8; ++j) g += (u.pm >= tb[j]) ? 1 : 0;
        u.g = g; u.B = (unsigned)((g * 5632 + u.pn * 256) * D); return true;
    }
    __device__ __forceinline__ void aoff(const Unit& u, int R0, int C0, unsigned& o00, unsigned& o01, unsigned& o10, unsigned& o11) const {
        const int s0 = (u.pm - tb[u.g]) * 256 + R0, cnt = tb[16 + u.g]; const int* rt = rowtok + (size_t)u.g * RT_STRIDE;
        const int t00 = s0 < cnt ? rt[s0] : 0, t01 = s0 + 64 < cnt ? rt[s0 + 64] : 0, t10 = s0 + 128 < cnt ? rt[s0 + 128] : 0, t11 = s0 + 192 < cnt ? rt[s0 + 192] : 0;
        o00 = (unsigned)(t00 * D + C0 * 2); o01 = (unsigned)(t01 * D + C0 * 2); o10 = (unsigned)(t10 * D + C0 * 2); o11 = (unsigned)(t11 * D + C0 * 2);
    }
};
struct MoeDownSched {
    static constexpr bool GATHER = false;
    int G, c; const volatile LAS int* tb;
    __device__ __forceinline__ unsigned abase(const Unit& u) const { return (unsigned)(u.pm * 256 * DFF); }
    __device__ __forceinline__ bool next(int i, Unit& u) const {
        const int T = tb[8]; const int L = i * G + c; if (L >= T * 4) return false;
        tile_map(L, T, 4, u.pm, u.pn); int g = 0;
#pragma unroll
        for (int j = 1; j < 8; ++j) g += (u.pm >= tb[j]) ? 1 : 0;
        u.g = g; u.B = (unsigned)((g * D + u.pn * 256) * DFF); return true;
    }
    __device__ __forceinline__ void aoff(const Unit& u, int R0, int C0, unsigned& o00, unsigned& o01, unsigned& o10, unsigned& o11) const {
        const unsigned base = (unsigned)((u.pm * 256 + R0) * DFF + C0 * 2), r64 = (unsigned)(64 * DFF);
        o00 = base; o01 = base + r64; o10 = base + 2u * r64; o11 = base + 3u * r64;
    }
};

struct EpiProj {
    static constexpr bool PERM = true;
    bf16_t* P; float* GT; const float* bg; bool dry;
    __device__ __forceinline__ void operator()(const f32x4 (&acc)[2][2][4][2], const Unit& u, int wr, int wc, int fr, int fq) const {
        if (dry) {
#pragma unroll
            for (int ai = 0; ai < 2; ++ai)
#pragma unroll
                for (int bj = 0; bj < 2; ++bj)
#pragma unroll
                    for (int m = 0; m < 4; ++m) asm volatile("" :: "v"(acc[ai][bj][m][0]), "v"(acc[ai][bj][m][1]));
            return; }
        const int row0 = u.pm * BM + wr * 64 + fr;
        if (u.pn < 14) {
            const int col0 = u.pn * BM + wc * 32 + 8 * fq;
#pragma unroll
            for (int ai = 0; ai < 2; ++ai)
#pragma unroll
                for (int m = 0; m < 4; ++m) { bf16_t* rowp = P + (size_t)(row0 + ai * HALF + m * 16) * NPROJ + col0;
#pragma unroll
                    for (int bj = 0; bj < 2; ++bj) { const f32x4 v0 = acc[ai][bj][m][0], v1 = acc[ai][bj][m][1];
                        u32x4 w; w.x = cvt_pk_bf16(v0[0], v0[1]); w.y = cvt_pk_bf16(v0[2], v0[3]); w.z = cvt_pk_bf16(v1[0], v1[1]); w.w = cvt_pk_bf16(v1[2], v1[3]);
                        *(u32x4*)(rowp + bj * HALF) = w; } }
        } else if (wc == 0 && fq < 2) {
            const f32x4 b0 = *(const f32x4*)(bg + 8 * fq), b1 = *(const f32x4*)(bg + 8 * fq + 4);
#pragma unroll
            for (int ai = 0; ai < 2; ++ai)
#pragma unroll
                for (int m = 0; m < 4; ++m) { float* gp = GT + (size_t)(row0 + ai * HALF + m * 16) * 16 + 8 * fq;
                    *(f32x4*)gp = acc[ai][0][m][0] + b0; *(f32x4*)(gp + 4) = acc[ai][0][m][1] + b1; }
        }
    }
};
struct EpiResid {
    static constexpr bool PERM = false;
    const float* resL; const float* resC; float* outL; float* outC; const float* gate; float gscale;
    __device__ __forceinline__ void operator()(const f32x4 (&acc)[2][2][4][2], const Unit& u, int wr, int wc, int fr, int fq) const {
        const int rowg = u.pm * BM; const bool isc = rowg >= NL;
        const float* res = isc ? resC + (size_t)(rowg - NL) * D : resL + (size_t)rowg * D;
        float* out = isc ? outC + (size_t)(rowg - NL) * D : outL + (size_t)rowg * D;
        const int bidx = isc ? 32 : (rowg >> 11);
        const int col0 = u.pn * BM + wc * 32 + 4 * fq;
        const float* gv = gate + (size_t)bidx * 6144 + col0;
        f32x4 g[2][2];
#pragma unroll
        for (int bj = 0; bj < 2; ++bj)
#pragma unroll
            for (int n = 0; n < 2; ++n) g[bj][n] = *(const f32x4*)(gv + bj * HALF + n * 16) * gscale;
#pragma unroll
        for (int ai = 0; ai < 2; ++ai) {
            f32x4 r[4][2][2];
#pragma unroll
            for (int m = 0; m < 4; ++m) { const size_t off = (size_t)(ai * HALF + wr * 64 + m * 16 + fr) * D + col0;
#pragma unroll
                for (int bj = 0; bj < 2; ++bj)
#pragma unroll
                    for (int n = 0; n < 2; ++n) r[m][bj][n] = *(const f32x4*)(res + off + bj * HALF + n * 16); }
#pragma unroll
            for (int m = 0; m < 4; ++m) { const size_t off = (size_t)(ai * HALF + wr * 64 + m * 16 + fr) * D + col0;
#pragma unroll
                for (int bj = 0; bj < 2; ++bj)
#pragma unroll
                    for (int n = 0; n < 2; ++n) *(f32x4*)(out + off + bj * HALF + n * 16) = r[m][bj][n] + g[bj][n] * acc[ai][bj][m][n]; }
            asm volatile("" ::: "memory"); }
    }
};
__device__ __forceinline__ float clamp448(float x) { return fminf(fmaxf(x, -448.0f), 448.0f); }
struct EpiSwiglu {
    static constexpr bool PERM = true;
    unsigned char* ACT; float iscale, oscale;
    __device__ __forceinline__ void operator()(const f32x4 (&acc)[2][2][4][2], const Unit& u, int wr, int wc, int fr, int fq) const {
        const int row0 = u.pm * BM + wr * 64 + fr, col0 = u.pn * HALF + wc * 32 + 8 * fq;
#pragma unroll
        for (int ai = 0; ai < 2; ++ai)
#pragma unroll
            for (int m = 0; m < 4; ++m) { unsigned char* rowp = ACT + (size_t)(row0 + ai * HALF + m * 16) * DFF + col0;
                float o[8];
#pragma unroll
                for (int n = 0; n < 2; ++n)
#pragma unroll
                    for (int j = 0; j < 4; ++j) { const float a = acc[ai][0][m][n][j] * iscale, b = acc[ai][1][m][n][j] * iscale; o[n * 4 + j] = clamp448(a * b * __builtin_amdgcn_rcpf(1.0f + __expf(-a)) * oscale); }
                int w0 = 0, w1 = 0;
                w0 = __builtin_amdgcn_cvt_pk_fp8_f32(o[0], o[1], w0, false); w0 = __builtin_amdgcn_cvt_pk_fp8_f32(o[2], o[3], w0, true);
                w1 = __builtin_amdgcn_cvt_pk_fp8_f32(o[4], o[5], w1, false); w1 = __builtin_amdgcn_cvt_pk_fp8_f32(o[6], o[7], w1, true);
                *(u32x2*)rowp = (u32x2){(unsigned)w0, (unsigned)w1}; }
    }
};
struct EpiMoeDown {
    static constexpr bool PERM = false;
    float* H; const float* g2; const int* rowtok; const float* rowgate; const volatile LAS int* tb; float gscale;
    __device__ __forceinline__ void operator()(const f32x4 (&acc)[2][2][4][2], const Unit& u, int wr, int wc, int fr, int fq) const {
        const int s0 = (u.pm - tb[u.g]) * 256, cnt = tb[16 + u.g];
        const int* rt = rowtok + (size_t)u.g * RT_STRIDE; const float* rg = rowgate + (size_t)u.g * RT_STRIDE;
        const int col0 = u.pn * BM + wc * 32 + 4 * fq;
#pragma unroll
        for (int ai = 0; ai < 2; ++ai)
#pragma unroll
          for (int mp = 0; mp < 4; mp += 2) {
            f32x4 r[2][2][2], gg[2][2][2]; int tok[2]; float gt[2]; bool ok[2];
#pragma unroll
            for (int m = 0; m < 2; ++m) { const int slot = s0 + ai * HALF + wr * 64 + (mp + m) * 16 + fr; ok[m] = slot < cnt; tok[m] = ok[m] ? rt[slot] : 0; gt[m] = ok[m] ? rg[slot] * gscale : 0.f; }
#pragma unroll
            for (int m = 0; m < 2; ++m) { const float* hp = H + (size_t)tok[m] * D + col0; const float* gv = g2 + (size_t)(tok[m] >> 11) * 6144 + col0;
#pragma unroll
                for (int bj = 0; bj < 2; ++bj)
#pragma unroll
                    for (int n = 0; n < 2; ++n) { r[m][bj][n] = *(const f32x4*)(hp + bj * HALF + n * 16); gg[m][bj][n] = *(const f32x4*)(gv + bj * HALF + n * 16); } }
#pragma unroll
            for (int m = 0; m < 2; ++m) if (ok[m]) { float* hp = H + (size_t)tok[m] * D + col0;
#pragma unroll
                for (int bj = 0; bj < 2; ++bj)
#pragma unroll
                    for (int n = 0; n < 2; ++n) *(f32x4*)(hp + bj * HALF + n * 16) = r[m][bj][n] + (gg[m][bj][n] * gt[m]) * acc[ai][bj][mp + m][n]; }
            asm volatile("" ::: "memory"); }
    }
};
}

struct Args { const float* in[21]; float* out; unsigned char* ws; int lo, hi; };
enum { I_X = 0, I_C, I_CTX, I_CCTX, I_N1G, I_N2G, I_WADA, I_BADA, I_WIN, I_CONVW, I_BG, I_MNG, I_WOUT, I_FW1, I_FW3, I_FW2, I_ROUTER, I_MW1, I_MW3, I_MW2, I_FNG };

struct Frame { LAS unsigned char* lds; int wid, G, wg;
    __device__ __forceinline__ int lane() const { return lane_id(); }
    __device__ __forceinline__ int tid() const { return wid * 64 + lane_id(); } };
typedef const __attribute__((address_space(4))) Args* KArgs;
#define KA() ({ KArgs _k = (KArgs)__builtin_amdgcn_kernarg_segment_ptr(); asm volatile("" : "+s"(_k)); _k; })

__device__ __forceinline__ int conv_row(int mode, int n, float& scale) {
    scale = 1.f;
    if (mode == 0) return n;
    if (mode == 1) { if (n >= 2048 && n < 2560) scale = 0.08838834764831845f; if (n < 3072) return n; if (n < 3088) return 3584 + (n - 3072); return n - 16; }
    return (n >> 7) * 256 + (n & 127) + (mode == 3 ? 128 : 0);
}
__device__ __forceinline__ void conv_tiles(const Frame& F, const float* src, bf16_t* dst, int K, int N, int mode, float fp8scale  , int& gbase) {
    LAS float* tile = (LAS float*)F.lds;
    const int tn = (N + 63) / 64, ntile = (K / 64) * tn, tid = F.tid();
    int t = (F.wg - gbase) % F.G; if (t < 0) t += F.G;
    for (; t < ntile; t += F.G) {
        const int k0 = (t / tn) * 64, n0 = (t % tn) * 64;
        { const int row = tid >> 4, c4 = (tid & 15) * 4;
#pragma unroll
          for (int j = 0; j < 2; ++j) { const int r = row + 32 * j; f32x4 v = (f32x4){0.f, 0.f, 0.f, 0.f};
              if (n0 + c4 < N) v = *(const f32x4*)(src + (size_t)(k0 + r) * N + n0 + c4);
              tile[r * 65 + c4 + 0] = v[0]; tile[r * 65 + c4 + 1] = v[1]; tile[r * 65 + c4 + 2] = v[2]; tile[r * 65 + c4 + 3] = v[3]; } }
        __syncthreads();
        { const int n = tid >> 3, kc = (tid & 7) * 8;
          if (n0 + n < N) { float sc; const int drow = conv_row(mode, n0 + n, sc); float v[8];
#pragma unroll
              for (int j = 0; j < 8; ++j) v[j] = tile[(kc + j) * 65 + n] * sc;
              if (fp8scale == 0.f) {
                  u32x4 w; w.x = cvt_pk_bf16(v[0], v[1]); w.y = cvt_pk_bf16(v[2], v[3]); w.z = cvt_pk_bf16(v[4], v[5]); w.w = cvt_pk_bf16(v[6], v[7]);
                  *(u32x4*)(dst + (size_t)drow * K + k0 + kc) = w;
              } else {
#pragma unroll
                  for (int j = 0; j < 8; ++j) v[j] = fminf(fmaxf(v[j] * fp8scale, -448.0f), 448.0f);
                  int w0 = 0, w1 = 0;
                  w0 = __builtin_amdgcn_cvt_pk_fp8_f32(v[0], v[1], w0, false); w0 = __builtin_amdgcn_cvt_pk_fp8_f32(v[2], v[3], w0, true);
                  w1 = __builtin_amdgcn_cvt_pk_fp8_f32(v[4], v[5], w1, false); w1 = __builtin_amdgcn_cvt_pk_fp8_f32(v[6], v[7], w1, true);
                  *(u32x2*)((unsigned char*)dst + (size_t)drow * K + k0 + kc) = (u32x2){(unsigned)w0, (unsigned)w1};
              } } }
        __syncthreads();
    }
    gbase = (gbase + ntile) % F.G;
}
__device__ void p0_prologue(const Frame& F) {
    const int tid = F.tid(); KArgs ka = KA(); unsigned char* const ws = ka->ws;
    if (F.wg < 192) {
        LAS float* s = (LAS float*)F.lds;
        for (int idx = tid; idx < 33 * 1024; idx += 512) { const int b = idx >> 10, k = idx & 1023; const float v = b < 32 ? ka->in[I_C][b * 1024 + k] : ka->in[I_CCTX][k]; s[idx] = v / (1.0f + __expf(-v)); }
        __syncthreads();
        const int layer = F.wg / 96, col0 = (F.wg % 96) * 64, col = tid & 63, g = tid >> 6;
        const float* W = ka->in[I_WADA] + (size_t)layer * 1024 * 6144 + col0 + col;
        float acc[33];
#pragma unroll
        for (int b = 0; b < 33; ++b) acc[b] = 0.f;
        for (int k4 = 0; k4 < 32; ++k4) { const int k = g * 128 + k4 * 4;
            const float w0 = W[(size_t)(k + 0) * 6144], w1 = W[(size_t)(k + 1) * 6144], w2 = W[(size_t)(k + 2) * 6144], w3 = W[(size_t)(k + 3) * 6144];
#pragma unroll
            for (int b = 0; b < 33; ++b) { const f32x4 s4 = *(const LAS f32x4*)(s + b * 1024 + k); acc[b] += s4[0] * w0 + s4[1] * w1 + s4[2] * w2 + s4[3] * w3; } }
        __syncthreads();
        LAS float* red = (LAS float*)F.lds;
#pragma unroll
        for (int b = 0; b < 33; ++b) red[(g * 33 + b) * 64 + col] = acc[b];
        __syncthreads();
        float* MOD = (float*)(ws + WS_MOD); const float* bada = ka->in[I_BADA];
        for (int idx = tid; idx < 33 * 64; idx += 512) { const int b = idx >> 6, cc = idx & 63; float sum = 0.f;
#pragma unroll
            for (int gg = 0; gg < 8; ++gg) sum += red[(gg * 33 + b) * 64 + cc];
            MOD[((size_t)layer * 33 + b) * 6144 + col0 + cc] = sum + bada[layer * 6144 + col0 + cc]; }
        __syncthreads();
    }
    { bf16_t* WIN = (bf16_t*)(ws + WS_WIN);
      for (int l = 0; l < 2; ++l) { u32x4* p = (u32x4*)(WIN + ((size_t)l * NPAD + PIN) * D); const int n16 = (NPAD - PIN) * D * 2 / 16;
          for (int i = F.wg * 512 + tid; i < n16; i += F.G * 512) p[i] = (u32x4){0u, 0u, 0u, 0u}; } }
    int gbase = 0;
    for (int j = 0; j < 31; ++j) {
        const float* src; bf16_t* dst; int K, N, mode; float f8 = 0.f;
        if (j < 2)       { src = ka->in[I_WIN] + (size_t)j * D * PIN; dst = (bf16_t*)(ws + WS_WIN) + (size_t)j * NPAD * D; K = D; N = PIN; mode = 1; }
        else if (j < 4)  { src = ka->in[I_WOUT] + (size_t)(j - 2) * D * D; dst = (bf16_t*)(ws + WS_WOUT) + (size_t)(j - 2) * D * D; K = D; N = D; mode = 0; }
        else if (j == 4) { src = ka->in[I_FW1]; dst = (bf16_t*)(ws + WS_WUP); K = D; N = DFF; mode = 2; f8 = S_W13; }
        else if (j == 5) { src = ka->in[I_FW3]; dst = (bf16_t*)(ws + WS_WUP); K = D; N = DFF; mode = 3; f8 = S_W13; }
        else if (j == 6) { src = ka->in[I_FW2]; dst = (bf16_t*)(ws + WS_WDN); K = DFF; N = D; mode = 0; f8 = S_W2; }
        else if (j < 15) { const int e = j - 7;  src = ka->in[I_MW1] + (size_t)e * D * DFF; dst = (bf16_t*)(ws + WS_MUP + (size_t)e * 2 * DFF * D); K = D; N = DFF; mode = 2; f8 = S_W13; }
        else if (j < 23) { const int e = j - 15; src = ka->in[I_MW3] + (size_t)e * D * DFF; dst = (bf16_t*)(ws + WS_MUP + (size_t)e * 2 * DFF * D); K = D; N = DFF; mode = 3; f8 = S_W13; }
        else             { const int e = j - 23; src = ka->in[I_MW2] + (size_t)e * DFF * D; dst = (bf16_t*)(ws + WS_MDN + (size_t)e * D * DFF); K = DFF; N = D; mode = 0; f8 = S_W2; }
        conv_tiles(F, src, dst, K, N, mode, f8, gbase);
    }
}

template <bool ROUTER, bool OUT8>
__device__ __forceinline__ void norm_phase(const Frame& F, const float* srcL, const float* srcC, int nrows, const float* gain, const float* mod  , int chunk_shift, bf16_t* U, const float* router) {
    const int lane = F.lane(), wid = F.wid, tid = F.tid();
    const int rpw = (nrows + F.G * 8 - 1) / (F.G * 8);
    const int rbase = (F.wg * 8 + wid) * rpw;
    LAS float* rl = (LAS float*)F.lds;
    LAS int* cntl = (LAS int*)(F.lds + 32768);
    LAS int* sel = (LAS int*)(F.lds + 32768 + 256);
    if (ROUTER) {
        for (int i = tid; i < 8192; i += 512) rl[i] = router[i];
        if (tid < 32) cntl[tid] = 0;
        __syncthreads();
    }
    f32x4 gn[4];
#pragma unroll
    for (int j = 0; j < 4; ++j) gn[j] = *(const f32x4*)(gain + j * 256 + lane * 4);
    for (int rr = 0; rr < rpw; ++rr) {
        const int r = rbase + rr; if (r >= nrows) break;
        const bool isc = r >= NL;
        const float* src = isc ? srcC + (size_t)(r - NL) * D : srcL + (size_t)r * D;
        const float* mv = mod + (size_t)(isc ? 32 : (r >> 11)) * 6144 + chunk_shift * 1024;
        f32x4 x[4]; float ss = 0.f;
#pragma unroll
        for (int j = 0; j < 4; ++j) { x[j] = *(const f32x4*)(src + j * 256 + lane * 4); ss += x[j][0] * x[j][0] + x[j][1] * x[j][1] + x[j][2] * x[j][2] + x[j][3] * x[j][3]; }
        ss = wave_sum(ss);
        const float rstd = rsqrtf(ss * (1.0f / 1024.0f) + EPS);
        float lg[8];
        if (ROUTER) {
#pragma unroll
            for (int e = 0; e < 8; ++e) lg[e] = 0.f;
        }
#pragma unroll
        for (int j = 0; j < 4; ++j) {
            const f32x4 sh = *(const f32x4*)(mv + j * 256 + lane * 4), sc = *(const f32x4*)(mv + 1024 + j * 256 + lane * 4);
            f32x4 u = (x[j] * rstd * gn[j]) * (sc + 1.0f) + sh;
            if (OUT8) { int w8 = 0; w8 = __builtin_amdgcn_cvt_pk_fp8_f32(fminf(fmaxf(u[0] * S_A, -448.f), 448.f), fminf(fmaxf(u[1] * S_A, -448.f), 448.f), w8, false);
                w8 = __builtin_amdgcn_cvt_pk_fp8_f32(fminf(fmaxf(u[2] * S_A, -448.f), 448.f), fminf(fmaxf(u[3] * S_A, -448.f), 448.f), w8, true);
                *(int*)((unsigned char*)U + (size_t)r * D + j * 256 + lane * 4) = w8; }
            else { u32x2 w; w.x = cvt_pk_bf16(u[0], u[1]); w.y = cvt_pk_bf16(u[2], u[3]);
                *(u32x2*)(U + (size_t)r * D + j * 256 + lane * 4) = w; }
            if (ROUTER) {
#pragma unroll
                for (int i = 0; i < 4; ++i) { const LAS f32x4* rp = (const LAS f32x4*)(rl + (j * 256 + lane * 4 + i) * 8); const f32x4 r0 = rp[0], r1 = rp[1];
                    lg[0] += u[i] * r0[0]; lg[1] += u[i] * r0[1]; lg[2] += u[i] * r0[2]; lg[3] += u[i] * r0[3];
                    lg[4] += u[i] * r1[0]; lg[5] += u[i] * r1[1]; lg[6] += u[i] * r1[2]; lg[7] += u[i] * r1[3]; }
            }
        }
        if (ROUTER) {
#pragma unroll
            for (int e = 0; e < 8; ++e) lg[e] = wave_sum(lg[e]);
            int e0 = 0; float v0 = lg[0];
#pragma unroll
            for (int e = 1; e < 8; ++e) if (lg[e] > v0) { v0 = lg[e]; e0 = e; }
            int e1 = -1; float v1 = -3.0e38f;
#pragma unroll
            for (int e = 0; e < 8; ++e) if (e != e0 && lg[e] > v1) { v1 = lg[e]; e1 = e; }
            if (lane == 0) {
                const float g0 = 1.0f / (1.0f + __expf(v1 - v0)), g1 = 1.0f - g0;
                const int r0 = atomicAdd((int*)(cntl + e0), 1), r1 = atomicAdd((int*)(cntl + 8 + e1), 1);
                LAS int* sp = sel + (wid * rpw + rr) * 6;
                sp[0] = e0 | (e1 << 8); sp[1] = r0; sp[2] = r1; sp[3] = __float_as_int(g0); sp[4] = __float_as_int(g1); sp[5] = r;
            }
        }
    }
    if (ROUTER) {
        __syncthreads();
        unsigned char* const ws = KA()->ws;
        if (tid < 16) { unsigned* gc = (unsigned*)(ws + WS_CTL + CTL_GCNT); cntl[16 + tid] = (int)__hip_atomic_fetch_add(gc + tid, (unsigned)cntl[tid], __ATOMIC_RELAXED, __HIP_MEMORY_SCOPE_AGENT); }
        __syncthreads();
        int* rowtok = (int*)(ws + WS_RTOK); float* rowgate = (float*)(ws + WS_RGATE);
        for (int i = tid; i < 8 * rpw; i += 512) {
            const int w = i / rpw, rr = i % rpw; const int r = (F.wg * 8 + w) * rpw + rr;
            if (r < nrows) { const LAS int* sp = sel + i * 6; const int e0 = sp[0] & 255, e1 = sp[0] >> 8;
                const int p0 = cntl[16 + e0] + sp[1], p1 = cntl[16 + 8 + e1] + sp[2];
                rowtok[(size_t)e0 * RT_STRIDE + p0] = sp[5]; rowgate[(size_t)e0 * RT_STRIDE + p0] = __int_as_float(sp[3]);
                rowtok[(size_t)(8 + e1) * RT_STRIDE + p1] = sp[5]; rowgate[(size_t)(8 + e1) * RT_STRIDE + p1] = __int_as_float(sp[4]); }
        }
        __syncthreads();
    }
}

__device__ __forceinline__ void unpack8(const u32x4 w, float (&v)[8]) { v[0] = bflo(w.x); v[1] = bfhi(w.x); v[2] = bflo(w.y); v[3] = bfhi(w.y); v[4] = bflo(w.z); v[5] = bfhi(w.z); v[6] = bflo(w.w); v[7] = bfhi(w.w); }
__device__ __forceinline__ u32x4 pack8(const float (&v)[8]) { u32x4 w; w.x = cvt_pk_bf16(v[0], v[1]); w.y = cvt_pk_bf16(v[2], v[3]); w.z = cvt_pk_bf16(v[4], v[5]); w.w = cvt_pk_bf16(v[6], v[7]); return w; }
__device__ __forceinline__ void mix_phase(const Frame& F, int nrows, const float* convw  , const float* gnorm  ) {
    const int lane = F.lane(); unsigned char* const ws = KA()->ws;
    const bf16_t* P = (const bf16_t*)(ws + WS_PROJ); const bf16_t* HL = (const bf16_t*)(ws + WS_HL); bf16_t* A2 = (bf16_t*)(ws + WS_U);
    const int rpw = (nrows + F.G * 8 - 1) / (F.G * 8); const int rbase = (F.wg * 8 + F.wid) * rpw;
    float w0[8], w1[8], w2[8], gnv[8];
#pragma unroll
    for (int j = 0; j < 8; ++j) { w0[j] = convw[lane * 8 + j]; w1[j] = convw[512 + lane * 8 + j]; w2[j] = convw[1024 + lane * 8 + j]; gnv[j] = gnorm[lane * 8 + j]; }
    for (int rr = 0; rr < rpw; ++rr) {
        const int r = rbase + rr; if (r >= nrows) break;
        bool hasL, hasR;
        if (r < NL) { const int cc = r & 63; hasL = cc != 0; hasR = cc != 63; } else { const int t = (r - NL) & 255; hasL = t != 0; hasR = t != 255; }
        const bf16_t* pr = P + (size_t)r * NPROJ + lane * 8;
        float gb[8], zc[8], zl[8], zr[8], t0[8], t1[8];
        unpack8(*(const u32x4*)pr, gb);
        unpack8(*(const u32x4*)(pr + 512), t0); unpack8(*(const u32x4*)(pr + 1024), t1);
#pragma unroll
        for (int j = 0; j < 8; ++j) zc[j] = t0[j] * t1[j];
        if (hasL) { unpack8(*(const u32x4*)(pr - NPROJ + 512), t0); unpack8(*(const u32x4*)(pr - NPROJ + 1024), t1);
#pragma unroll
            for (int j = 0; j < 8; ++j) zl[j] = t0[j] * t1[j]; }
        else {
#pragma unroll
            for (int j = 0; j < 8; ++j) zl[j] = 0.f; }
        if (hasR) { unpack8(*(const u32x4*)(pr + NPROJ + 512), t0); unpack8(*(const u32x4*)(pr + NPROJ + 1024), t1);
#pragma unroll
            for (int j = 0; j < 8; ++j) zr[j] = t0[j] * t1[j]; }
        else {
#pragma unroll
            for (int j = 0; j < 8; ++j) zr[j] = 0.f; }
        float y[8];
#pragma unroll
        for (int j = 0; j < 8; ++j) y[j] = gb[j] * (w0[j] * zl[j] + w1[j] * zc[j] + w2[j] * zr[j]);
        *(u32x4*)(A2 + (size_t)r * D + lane * 8) = pack8(y);
        float hf[8], hb[8], og[8];
        unpack8(*(const u32x4*)(HL + (size_t)r * 512 + lane * 8), hf); unpack8(*(const u32x4*)(HL + (size_t)(MT + r) * 512 + lane * 8), hb);
        unpack8(*(const u32x4*)(pr + 3072), og);
        float ss = 0.f;
#pragma unroll
        for (int j = 0; j < 8; ++j) { hf[j] += hb[j]; ss += hf[j] * hf[j]; }
        ss += __shfl_xor(ss, 1); ss += __shfl_xor(ss, 2); ss += __shfl_xor(ss, 4); ss += __shfl_xor(ss, 8);
        const float rstd = rsqrtf(ss * (1.0f / 128.0f) + EPS);
#pragma unroll
        for (int j = 0; j < 8; ++j) y[j] = hf[j] * rstd * gnv[j] * sigmoidf_(og[j]);
        *(u32x4*)(A2 + (size_t)r * D + 512 + lane * 8) = pack8(y);
    }
}

__device__ __forceinline__ void final_phase(const Frame& F) {
    const int lane = F.lane(); KArgs ka = KA(); const float* gain = ka->in[I_FNG]; float* const outp = ka->out;
    const int rpw = (NL + F.G * 8 - 1) / (F.G * 8); const int rbase = (F.wg * 8 + F.wid) * rpw;
    f32x4 gn[4];
#pragma unroll
    for (int j = 0; j < 4; ++j) gn[j] = *(const f32x4*)(gain + j * 256 + lane * 4);
    for (int rr = 0; rr < rpw; ++rr) {
        const int r = rbase + rr; if (r >= NL) break;
        float* p = outp + (size_t)r * D;
        f32x4 x[4]; float ss = 0.f;
#pragma unroll
        for (int j = 0; j < 4; ++j) { x[j] = *(const f32x4*)(p + j * 256 + lane * 4); ss += x[j][0] * x[j][0] + x[j][1] * x[j][1] + x[j][2] * x[j][2] + x[j][3] * x[j][3]; }
        ss = wave_sum(ss);
        const float rstd = rsqrtf(ss * (1.0f / 1024.0f) + EPS);
#pragma unroll
        for (int j = 0; j < 4; ++j) *(f32x4*)(p + j * 256 + lane * 4) = x[j] * rstd * gn[j];
    }
}

constexpr int ML_RB = 272;
constexpr int ML_Q = 0, ML_K = 34816, ML_V = 69632, ML_S = 104448, ML_VEC = 139264;
__device__ __forceinline__ bf16x8 tr_frag(const LAS unsigned char* base, int row0, int col0, int lane) {
    const int g = lane >> 4, q = (lane & 15) >> 2, p = lane & 3;
    const LAS unsigned char* a = base + (row0 + 8 * g + q) * ML_RB + (col0 + 4 * p) * 2;
    const s16x4 v0 = __builtin_amdgcn_ds_read_tr16_b64_v4i16((LAS s16x4*)a);
    const s16x4 v1 = __builtin_amdgcn_ds_read_tr16_b64_v4i16((LAS s16x4*)(a + 4 * ML_RB));
    return (bf16x8){v0[0], v0[1], v0[2], v0[3], v1[0], v1[1], v1[2], v1[3]};
}
__device__ void mlstm_phase(const Frame& F, bool ctx_out) {
    const int tid = F.tid(), lane = F.lane(), wid = F.wid, fr = lane & 15, fq = lane >> 4;
    LAS unsigned char* lds = F.lds;
    LAS float* ic = (LAS float*)(lds + ML_VEC); LAS float* fc = ic + 128; LAS float* av = ic + 256; LAS float* Mv = ic + 384; LAS float* bcv = ic + 512;
    LAS float* rden = ic + 640; LAS float* wintv = ic + 768; LAS float* nvec = ic + 896; LAS float* wkv = ic + 1024;
    unsigned char* const ws = KA()->ws;
    const bf16_t* P = (const bf16_t*)(ws + WS_PROJ); const float* GT = (const float*)(ws + WS_GATES); bf16_t* HL = (bf16_t*)(ws + WS_HL);
    for (int unit = F.wg; unit < 256; unit += F.G) {
        const int b = unit >> 3, hd = (unit >> 1) & 3, dir = unit & 1;
        f32x4 Cacc[8];
#pragma unroll
        for (int a = 0; a < 8; ++a) Cacc[a] = (f32x4){0.f, 0.f, 0.f, 0.f};
        float m = 0.f;
        if (tid < 128) nvec[tid] = 0.f;
        u32x4 st[12]; float gi = 0.f, gf = 0.f;
#define ML_ROW0(ci) ((ci) < 2 ? NL + b * 256 + (dir ? 1 - (ci) : (ci)) * 128 : b * 2048 + (dir ? 15 - ((ci) - 2) : ((ci) - 2)) * 128)
#define ML_LOAD(ci) do { const int _r0 = ML_ROW0(ci); _Pragma("unroll") for (int _p = 0; _p < 4; ++_p) { const int _id = tid + 512 * _p, _row = _id >> 4, _ch = _id & 15; \
            const bf16_t* _g = P + (size_t)(_r0 + _row) * NPROJ + 1536 + hd * 128 + _ch * 8; st[_p] = *(const u32x4*)_g; st[4 + _p] = *(const u32x4*)(_g + 512); st[8 + _p] = *(const u32x4*)(_g + 1024); } \
            if (tid < 128) { gi = GT[(size_t)(_r0 + tid) * 16 + (2 * dir) * 4 + hd]; gf = GT[(size_t)(_r0 + tid) * 16 + (2 * dir + 1) * 4 + hd]; } } while (0)
        ML_LOAD(0);
        for (int ci = 0; ci < 18; ++ci) {
            const int row0 = ML_ROW0(ci);
            const bool need_out = (ci >= 2) || ctx_out;
#pragma unroll
            for (int p = 0; p < 4; ++p) { const int id = tid + 512 * p, row = id >> 4, ch = id & 15; const int o = row * ML_RB + ch * 16;
                *(LAS u32x4*)(lds + ML_Q + o) = st[p]; *(LAS u32x4*)(lds + ML_K + o) = st[4 + p]; *(LAS u32x4*)(lds + ML_V + o) = st[8 + p]; }
            if (tid < 128) { ic[tid] = gi; fc[tid] = fminf(gf, 0.f) - log1pf(__expf(-fabsf(gf))); }
            if (ci + 1 < 18) ML_LOAD(ci + 1);
            __syncthreads();
            float bL, Mlast;
            { const int p0 = 2 * lane, p1 = p0 + 1, s0 = dir ? 127 - p0 : p0, s1 = dir ? 127 - p1 : p1;
              const float f0 = fc[s0], f1 = fc[s1], i0 = ic[s0], i1 = ic[s1];
              float incl = f0 + f1;
#pragma unroll
              for (int d = 1; d < 64; d <<= 1) { const float t = __shfl_up(incl, d); if (lane >= d) incl += t; }
              const float bc1 = incl, bc0 = incl - f1;
              const float a0 = i0 - bc0, a1 = i1 - bc1;
              float im = fmaxf(a0, a1);
#pragma unroll
              for (int d = 1; d < 64; d <<= 1) { const float t = __shfl_up(im, d); if (lane >= d) im = fmaxf(im, t); }
              float ex = __shfl_up(im, 1); if (lane == 0) ex = -3.0e38f;
              const float M0 = fmaxf(fmaxf(m, ex), a0), M1 = fmaxf(m, im);
              bL = __shfl(incl, 63); Mlast = __shfl(M1, 63);
              av[s0] = a0; av[s1] = a1; Mv[s0] = M0; Mv[s1] = M1; bcv[s0] = bc0; bcv[s1] = bc1;
              wkv[s0] = __expf(a0 - Mlast); wkv[s1] = __expf(a1 - Mlast); }
            if (need_out) {
                const int t = 16 * wid + fr; const float Mt = Mv[t];
                bf16x8 Qf[4];
#pragma unroll
                for (int ks = 0; ks < 4; ++ks) Qf[ks] = *(const LAS bf16x8*)(lds + ML_Q + t * ML_RB + (32 * ks + 8 * fq) * 2);
                float rowsum = 0.f;
#pragma unroll 1
                for (int j = 0; j < 8; ++j) {
                    f32x4 acc = (f32x4){0.f, 0.f, 0.f, 0.f};
#pragma unroll
                    for (int ks = 0; ks < 4; ++ks) { const bf16x8 Kf = *(const LAS bf16x8*)(lds + ML_K + (16 * j + fr) * ML_RB + (32 * ks + 8 * fq) * 2); acc = __builtin_amdgcn_mfma_f32_16x16x32_bf16(Kf, Qf[ks], acc, 0, 0, 0); }
                    const f32x4 a4 = *(const LAS f32x4*)(av + 16 * j + 4 * fq);
                    float v[4];
#pragma unroll
                    for (int r = 0; r < 4; ++r) { const int s = 16 * j + 4 * fq + r; const bool valid = dir ? (s >= t) : (s <= t); v[r] = valid ? acc[r] * __expf(a4[r] - Mt) : 0.f; rowsum += v[r]; }
                    u32x2 w; w.x = cvt_pk_bf16(v[0], v[1]); w.y = cvt_pk_bf16(v[2], v[3]);
                    *(LAS u32x2*)(lds + ML_S + t * ML_RB + (16 * j + 4 * fq) * 2) = w;
                }
                rowsum += __shfl_xor(rowsum, 16); rowsum += __shfl_xor(rowsum, 32);
                float qn = 0.f;
#pragma unroll
                for (int ks = 0; ks < 4; ++ks) { const f32x4 n0 = *(const LAS f32x4*)(nvec + 32 * ks + 8 * fq), n1 = *(const LAS f32x4*)(nvec + 32 * ks + 8 * fq + 4);
#pragma unroll
                    for (int jj = 0; jj < 4; ++jj) { qn += bf2f((unsigned short)Qf[ks][jj]) * n0[jj]; qn += bf2f((unsigned short)Qf[ks][4 + jj]) * n1[jj]; } }
                qn += __shfl_xor(qn, 16); qn += __shfl_xor(qn, 32);
                const float wi = __expf(m - Mt), den = rowsum + wi * qn, dn = fmaxf(fabsf(den), __expf(-(bcv[t] + Mt)));
                if (fq == 0) { rden[t] = 1.0f / dn; wintv[t] = wi; }
            }
            __syncthreads();
            bf16x8 Vf[4];
#pragma unroll
            for (int ks = 0; ks < 4; ++ks) Vf[ks] = tr_frag(lds + ML_V, 32 * ks, 16 * wid, lane);
            if (need_out) {
                bf16x8 Cf[4];
#pragma unroll
                for (int kp = 0; kp < 4; ++kp) { const f32x4 c0 = Cacc[2 * kp], c1 = Cacc[2 * kp + 1]; u32x4 w; w.x = cvt_pk_bf16(c0[0], c0[1]); w.y = cvt_pk_bf16(c0[2], c0[3]); w.z = cvt_pk_bf16(c1[0], c1[1]); w.w = cvt_pk_bf16(c1[2], c1[3]);
                    Cf[kp] = __builtin_bit_cast(bf16x8, w); }
#pragma unroll 1
                for (int i = 0; i < 8; ++i) {
                    f32x4 aS = (f32x4){0.f, 0.f, 0.f, 0.f}, aC = (f32x4){0.f, 0.f, 0.f, 0.f};
                    const int tt = 16 * i + fr;
#pragma unroll
                    for (int ks = 0; ks < 4; ++ks) { const bf16x8 Sf = *(const LAS bf16x8*)(lds + ML_S + tt * ML_RB + (32 * ks + 8 * fq) * 2); aS = __builtin_amdgcn_mfma_f32_16x16x32_bf16(Vf[ks], Sf, aS, 0, 0, 0); }
#pragma unroll
                    for (int kp = 0; kp < 4; ++kp) { const s16x4 q0 = *(const LAS s16x4*)(lds + ML_Q + tt * ML_RB + (32 * kp + 4 * fq) * 2), q1 = *(const LAS s16x4*)(lds + ML_Q + tt * ML_RB + (32 * kp + 16 + 4 * fq) * 2);
                        const bf16x8 Qp = (bf16x8){q0[0], q0[1], q0[2], q0[3], q1[0], q1[1], q1[2], q1[3]};
                        aC = __builtin_amdgcn_mfma_f32_16x16x32_bf16(Cf[kp], Qp, aC, 0, 0, 0); }
                    const float wi = wintv[tt], rd = rden[tt];
                    u32x2 w; w.x = cvt_pk_bf16((aS[0] + wi * aC[0]) * rd, (aS[1] + wi * aC[1]) * rd); w.y = cvt_pk_bf16((aS[2] + wi * aC[2]) * rd, (aS[3] + wi * aC[3]) * rd);
                    *(u32x2*)(HL + ((size_t)dir * MT + row0 + tt) * 512 + hd * 128 + 16 * wid + 4 * fq) = w;
                }
            }
            {
                const float dec = __expf(m - Mlast);
                bf16x8 Vw[4];
#pragma unroll
                for (int ks = 0; ks < 4; ++ks) { const f32x4 k0 = *(const LAS f32x4*)(wkv + 32 * ks + 8 * fq), k1 = *(const LAS f32x4*)(wkv + 32 * ks + 8 * fq + 4);
                    u32x4 w;
                    w.x = cvt_pk_bf16(bf2f((unsigned short)Vf[ks][0]) * k0[0], bf2f((unsigned short)Vf[ks][1]) * k0[1]); w.y = cvt_pk_bf16(bf2f((unsigned short)Vf[ks][2]) * k0[2], bf2f((unsigned short)Vf[ks][3]) * k0[3]);
                    w.z = cvt_pk_bf16(bf2f((unsigned short)Vf[ks][4]) * k1[0], bf2f((unsigned short)Vf[ks][5]) * k1[1]); w.w = cvt_pk_bf16(bf2f((unsigned short)Vf[ks][6]) * k1[2], bf2f((unsigned short)Vf[ks][7]) * k1[3]);
                    Vw[ks] = __builtin_bit_cast(bf16x8, w); }
#pragma unroll
                for (int a = 0; a < 8; ++a) { Cacc[a] = Cacc[a] * dec;
#pragma unroll
                    for (int ks = 0; ks < 4; ++ks) { const bf16x8 Kt = tr_frag(lds + ML_K, 32 * ks, 16 * a, lane); Cacc[a] = __builtin_amdgcn_mfma_f32_16x16x32_bf16(Kt, Vw[ks], Cacc[a], 0, 0, 0); } }
                if (tid < 128) { float an = dec * nvec[tid];
#pragma unroll 8
                    for (int s = 0; s < 128; ++s) an += wkv[s] * bf2f(*(const LAS unsigned short*)(lds + ML_K + s * ML_RB + tid * 2));
                    nvec[tid] = an; }
                m = bL + Mlast;
            }
            __syncthreads();
        }
#undef ML_ROW0
#undef ML_LOAD
    }
}

constexpr int NPH = 20;
constexpr int REP[NPH] = {1, 1, 1, 1, 1, 1, 1, 1, 1, 1, 1, 1, 1, 1, 1, 1, 1, 1, 1, 1};
#define REPEAT(k) for (int _r = 0; _r < REP[k]; ++_r)
#define GSCALE(k) ((_r == REP[k] - 1) ? 1.0f : 0.0f)
__global__ void __launch_bounds__(512, 2) mk_fwd(Args args_unused) {
    extern __shared__ __attribute__((aligned(16))) unsigned char smem[];
    Frame F;
    F.lds = (LAS unsigned char*)smem; F.wid = __builtin_amdgcn_readfirstlane((int)threadIdx.x >> 6); F.G = gridDim.x; F.wg = blockIdx.x;
    volatile LAS unsigned* misc = (volatile LAS unsigned*)(F.lds + MISC_OFF);
    if (F.tid() < 64) misc[F.tid()] = 0u;
    __syncthreads();
    int lo, hi;
    { KArgs ka = KA(); lo = ka->lo; hi = ka->hi; }
    XcdBarrier bar;
    { KArgs ka = KA(); bar.bar = (unsigned*)(ka->ws + WS_CTL); bar.x = 0; bar.st = misc; bar.wid = F.wid;
      if (hi - lo > 1) bar = xcd_barrier_post((unsigned*)(ka->ws + WS_CTL), misc, F.wid); }
#define IN(k) (lo <= (k) && (k) < hi)
#define SEAM(k) do { if (IN(k) && IN((k) + 1)) { KArgs _ka = KA(); bar.bar = (unsigned*)(_ka->ws + WS_CTL); xcd_barrier(bar); } } while (0)
    const volatile LAS int* tb = (const volatile LAS int*)(F.lds + MISC_OFF + 64);
    volatile LAS int* tbw = (volatile LAS int*)(F.lds + MISC_OFF + 64);

#ifdef PROBE_MFMA
    {
        f32x4 a0 = {0.f, 0.f, 0.f, 0.f}, a1 = a0, a2 = a0, a3 = a0; bf16x8 x = {1, 2, 3, 4, 5, 6, 7, 8}, y = {8, 7, 6, 5, 4, 3, 2, 1};
        asm volatile("" : "+v"(x), "+v"(y));
        for (int it = 0; it < 10000; ++it) {
            a0 = __builtin_amdgcn_mfma_f32_16x16x32_bf16(x, y, a0, 0, 0, 0); a1 = __builtin_amdgcn_mfma_f32_16x16x32_bf16(x, y, a1, 0, 0, 0);
            a2 = __builtin_amdgcn_mfma_f32_16x16x32_bf16(x, y, a2, 0, 0, 0); a3 = __builtin_amdgcn_mfma_f32_16x16x32_bf16(x, y, a3, 0, 0, 0); }
        asm volatile("" :: "v"(a0), "v"(a1), "v"(a2), "v"(a3));
    }
#endif
    if (IN(0)) REPEAT(0) { p0_prologue(F); }
    SEAM(0);
    if (IN(1)) REPEAT(1) { KArgs ka = KA(); unsigned char* ws = ka->ws;
        norm_phase<false, false>(F, ka->in[I_X], ka->in[I_CTX], MT, ka->in[I_N1G], (const float*)(ws + WS_MOD), 0, (bf16_t*)(ws + WS_U), nullptr); }
    SEAM(1);
    if (IN(2)) REPEAT(2) { KArgs ka = KA(); unsigned char* ws = ka->ws;
        pg8::DenseSched S{MT / 256, NPAD / 256, F.G, F.wg, 2 * D};
        pg8::EpiProj E{(bf16_t*)(ws + WS_PROJ), (float*)(ws + WS_GATES), ka->in[I_BG], GSCALE(2) == 0.0f};
        pg8::gemm_phase<false>(F.lds, F.wid, (const char*)(ws + WS_U), (const char*)(ws + WS_WIN), 2 * D, S, E); }
    SEAM(2);
    if (IN(3)) REPEAT(3) { mlstm_phase(F, true); }
    SEAM(3);
    if (IN(4)) REPEAT(4) { KArgs ka = KA(); mix_phase(F, MT, ka->in[I_CONVW], ka->in[I_MNG]); }
    SEAM(4);
    if (IN(5)) REPEAT(5) { KArgs ka = KA(); unsigned char* ws = ka->ws;
        pg8::DenseSched S{MT / 256, D / 256, F.G, F.wg, 2 * D};
        pg8::EpiResid E{ka->in[I_X], ka->in[I_CTX], ka->out, (float*)(ws + WS_HC), (const float*)(ws + WS_MOD) + 2 * 1024, 1.0f};
        pg8::gemm_phase<false>(F.lds, F.wid, (const char*)(ws + WS_U), (const char*)(ws + WS_WOUT), 2 * D, S, E); }
    SEAM(5);
    if (IN(6)) REPEAT(6) { KArgs ka = KA(); unsigned char* ws = ka->ws;
        norm_phase<false, true>(F, ka->out, (const float*)(ws + WS_HC), MT, ka->in[I_N2G], (const float*)(ws + WS_MOD), 3, (bf16_t*)(ws + WS_U), nullptr); }
    SEAM(6);
    if (IN(7)) REPEAT(7) { KArgs ka = KA(); unsigned char* ws = ka->ws;
        pg8::DenseSched S{MT / 256, 2 * DFF / 256, F.G, F.wg, D};
        pg8::EpiSwiglu E{(unsigned char*)(ws + WS_PROJ), 1.0f / (S_A * S_W13), S_H};
        pg8::gemm_phase<true>(F.lds, F.wid, (const char*)(ws + WS_U), (const char*)(ws + WS_WUP), D, S, E); }
    SEAM(7);
    if (IN(8)) REPEAT(8) { KArgs ka = KA(); unsigned char* ws = ka->ws;
        pg8::DenseSched S{MT / 256, D / 256, F.G, F.wg, DFF};
        pg8::EpiResid E{ka->out, (const float*)(ws + WS_HC), ka->out, (float*)(ws + WS_HC), (const float*)(ws + WS_MOD) + 5 * 1024, GSCALE(8) / (S_H * S_W2)};
        pg8::gemm_phase<true>(F.lds, F.wid, (const char*)(ws + WS_PROJ), (const char*)(ws + WS_WDN), DFF, S, E); }
    SEAM(8);
    if (IN(9)) REPEAT(9) { KArgs ka = KA(); unsigned char* ws = ka->ws;
        norm_phase<false, false>(F, ka->out, (const float*)(ws + WS_HC), MT, ka->in[I_N1G] + D, (const float*)(ws + WS_MOD) + 33 * 6144, 0, (bf16_t*)(ws + WS_U), nullptr); }
    SEAM(9);
    if (IN(10)) REPEAT(10) { KArgs ka = KA(); unsigned char* ws = ka->ws;
        pg8::InProjL1Sched S{F.G, F.wg};
        pg8::EpiProj E{(bf16_t*)(ws + WS_PROJ), (float*)(ws + WS_GATES), ka->in[I_BG] + 16, GSCALE(10) == 0.0f};
        pg8::gemm_phase<false>(F.lds, F.wid, (const char*)(ws + WS_U), (const char*)(ws + WS_WIN) + (size_t)NPAD * D * 2, 2 * D, S, E); }
    SEAM(10);
    if (IN(11)) REPEAT(11) { mlstm_phase(F, false); }
    SEAM(11);
    if (IN(12)) REPEAT(12) { KArgs ka = KA(); mix_phase(F, NL, ka->in[I_CONVW] + 3 * 512, ka->in[I_MNG] + 512); }
    SEAM(12);
    if (IN(13)) REPEAT(13) { KArgs ka = KA(); unsigned char* ws = ka->ws;
        pg8::DenseSched S{NL / 256, D / 256, F.G, F.wg, 2 * D};
        pg8::EpiResid E{ka->out, nullptr, ka->out, nullptr, (const float*)(ws + WS_MOD) + 33 * 6144 + 2 * 1024, GSCALE(13)};
        pg8::gemm_phase<false>(F.lds, F.wid, (const char*)(ws + WS_U), (const char*)(ws + WS_WOUT) + (size_t)D * D * 2, 2 * D, S, E); }
    SEAM(13);
    if (IN(14)) REPEAT(14) { KArgs ka = KA(); unsigned char* ws = ka->ws;
        norm_phase<true, true>(F, ka->out, nullptr, NL, ka->in[I_N2G] + D, (const float*)(ws + WS_MOD) + 33 * 6144, 3, (bf16_t*)(ws + WS_U), ka->in[I_ROUTER]); }
    SEAM(14);
    for (int k = 0; k < 2; ++k) {
        if (IN(15 + 2 * k) || IN(16 + 2 * k)) {
            __syncthreads();
            if (F.tid() == 0) { KArgs ka = KA(); const unsigned* gc = (const unsigned*)(ka->ws + WS_CTL + CTL_GCNT) + 8 * k; int t = 0;
                for (int g = 0; g < 8; ++g) { const int c = (int)__hip_atomic_load(gc + g, __ATOMIC_RELAXED, __HIP_MEMORY_SCOPE_AGENT); tbw[g] = t; tbw[16 + g] = c; t += (c + 255) >> 8; }
                tbw[8] = t; }
            __syncthreads();
        }
        if (IN(15 + 2 * k)) REPEAT(15) { KArgs ka = KA(); unsigned char* ws = ka->ws;
            pg8::MoeUpSched S{F.G, F.wg, (const int*)(ws + WS_RTOK) + (size_t)k * 8 * RT_STRIDE, tb};
            pg8::EpiSwiglu E{(unsigned char*)(ws + WS_PROJ), 1.0f / (S_A * S_W13), S_H};
            pg8::gemm_phase<true>(F.lds, F.wid, (const char*)(ws + WS_U), (const char*)(ws + WS_MUP), D, S, E); }
        SEAM(15 + 2 * k);
        if (IN(16 + 2 * k)) REPEAT(16) { KArgs ka = KA(); unsigned char* ws = ka->ws;
            pg8::MoeDownSched S{F.G, F.wg, tb};
            pg8::EpiMoeDown E{ka->out, (const float*)(ws + WS_MOD) + 33 * 6144 + 5 * 1024, (const int*)(ws + WS_RTOK) + (size_t)k * 8 * RT_STRIDE, (const float*)(ws + WS_RGATE) + (size_t)k * 8 * RT_STRIDE, tb, GSCALE(16) / (S_H * S_W2)};
            pg8::gemm_phase<true>(F.lds, F.wid, (const char*)(ws + WS_PROJ), (const char*)(ws + WS_MDN), DFF, S, E); }
        SEAM(16 + 2 * k);
    }
    if (IN(19)) REPEAT(19) { final_phase(F); }
#undef IN
#undef SEAM
}

extern "C" void kernel_launch(void* const* d_in, const int* in_sizes, int n_in, void* d_out, int out_size, void* d_ws, size_t ws_size, hipStream_t stream) {
    static int grid = 0;
    if (grid == 0) {
        if (n_in != 21 || ws_size < WS_END) { fprintf(stderr, "kernel_launch: expected 21 inputs and >= %zu bytes of workspace; got %d, %zu\n", (size_t)WS_END, n_in, ws_size); grid = -1; return; }
        int dev = 0, cus = 0, per_cu = 0;
        if (hipGetDevice(&dev) != hipSuccess || hipDeviceGetAttribute(&cus, hipDeviceAttributeMultiprocessorCount, dev) != hipSuccess) { grid = -1; return; }
        if (hipFuncSetAttribute((const void*)mk_fwd, hipFuncAttributeMaxDynamicSharedMemorySize, LDS_BYTES) != hipSuccess) { fprintf(stderr, "kernel_launch: hipFuncSetAttribute failed\n"); grid = -1; return; }
        if (hipOccupancyMaxActiveBlocksPerMultiprocessor(&per_cu, (const void*)mk_fwd, 512, LDS_BYTES) != hipSuccess || per_cu < 1) fprintf(stderr, "kernel_launch: occupancy query reports %d\n", per_cu);
        (void)hipGetLastError();
        grid = cus;
    }
    if (grid < 0) return;
    (void)hipMemsetAsync((char*)d_ws + WS_CTL, 0, CTL_BYTES, stream);
    Args a{};
    for (int i = 0; i < 21; ++i) a.in[i] = (const float*)d_in[i];
    a.out = (float*)d_out; a.ws = (unsigned char*)d_ws;
#if MK_PER_PHASE
    for (int p = 0; p < NPH; ++p) { a.lo = p; a.hi = p + 1; hipLaunchKernelGGL(mk_fwd, dim3(grid), dim3(512), LDS_BYTES, stream, a); }
#else
    a.lo = 0; a.hi = NPH; hipLaunchKernelGGL(mk_fwd, dim3(grid), dim3(512), LDS_BYTES, stream, a);
#endif
}
```

```cpp
#include <hip/hip_runtime.h>
#include <cstdio>
#include <cstdint>

#ifndef MK_PER_PHASE
#define MK_PER_PHASE 0
#endif

#define LAS __attribute__((address_space(3)))
typedef unsigned short bf16_t;
typedef short bf16x8 __attribute__((ext_vector_type(8)));
typedef short s16x4 __attribute__((ext_vector_type(4)));
typedef float f32x4 __attribute__((ext_vector_type(4)));
typedef unsigned u32x4 __attribute__((ext_vector_type(4)));
typedef unsigned u32x2 __attribute__((ext_vector_type(2)));

constexpr int D = 1024, NB = 32, SEQ = 2048, CTXL = 256;
constexpr int NL = NB * SEQ;
constexpr int NCX = NB * CTXL;
constexpr int MT = NL + NCX;
constexpr int PIN = 3600, NPROJ = 3584, NPAD = 3840;
constexpr int DFF = 2816, NE = 8;
constexpr float EPS = 1e-6f;
constexpr int RT_STRIDE = 65536;
constexpr float S_A = 16.0f, S_W13 = 256.0f, S_H = 8.0f, S_W2 = 256.0f;

constexpr size_t WS_CTL = 0;
constexpr size_t CTL_BYTES = 65536;
constexpr size_t CTL_GCNT = 16384;
constexpr size_t WS_MOD = 65536;
constexpr size_t WS_WIN = 2097152;
constexpr size_t WS_WOUT = WS_WIN + (size_t)2 * NPAD * D * 2;
constexpr size_t WS_WUP = WS_WOUT + (size_t)2 * D * D * 2;
constexpr size_t WS_WDN = WS_WUP + (size_t)2 * DFF * D * 2;
constexpr size_t WS_MUP = WS_WDN + (size_t)D * DFF * 2;
constexpr size_t WS_MDN = WS_MUP + (size_t)NE * 2 * DFF * D * 2;
constexpr size_t WS_HC = WS_MDN + (size_t)NE * D * DFF * 2;
constexpr size_t WS_U = WS_HC + (size_t)NCX * D * 4;
constexpr size_t WS_PROJ = WS_U + (size_t)MT * D * 2;
constexpr size_t WS_GATES = WS_PROJ + (size_t)MT * NPROJ * 2;
constexpr size_t WS_HL = WS_GATES + (size_t)MT * 16 * 4;
constexpr size_t WS_HB = WS_HL;
constexpr size_t WS_RTOK = WS_HL + (size_t)2 * MT * 512 * 2;
constexpr size_t WS_RGATE = WS_RTOK + (size_t)16 * RT_STRIDE * 4;
constexpr size_t WS_END = WS_RGATE + (size_t)16 * RT_STRIDE * 4;

constexpr int LDS_BYTES = 147456;
constexpr int MISC_OFF = 145408;

__device__ __forceinline__ unsigned cvt_pk_bf16(float lo, float hi) { unsigned r; asm volatile("v_cvt_pk_bf16_f32 %0, %1, %2" : "=v"(r) : "v"(lo), "v"(hi)); return r; }
__device__ __forceinline__ float bf2f(unsigned short b) { return __uint_as_float(((unsigned)b) << 16); }
__device__ __forceinline__ float bflo(unsigned w) { return __uint_as_float(w << 16); }
__device__ __forceinline__ float bfhi(unsigned w) { return __uint_as_float(w & 0xffff0000u); }
__device__ __forceinline__ float wave_sum(float v) {
#pragma unroll
    for (int o = 32; o >= 1; o >>= 1) v += __shfl_xor(v, o);
    return v;
}
__device__ __forceinline__ int lane_id() { int l; asm volatile("v_mbcnt_lo_u32_b32 %0, -1, 0\n\tv_mbcnt_hi_u32_b32 %0, -1, %0" : "=v"(l)); return l; }
__device__ __forceinline__ float sigmoidf_(float x) { return 1.0f / (1.0f + __expf(-x)); }

#define XB_TMO      128
#define XB_XCNT(j)  (256  + 64 * (j))
#define XB_XSUB(j)  (1280 + 64 * (j))
#define XB_XGEN(j)  (2304 + 64 * (j))
#define XB_TOP      3328
#define XB_TOPGEN   3392
#define XCD_BAR_WORDS 3456
#define XB_SPIN_CAP (1u << 18)

__device__ __forceinline__ unsigned xb_ld(unsigned* p)              { return __hip_atomic_load(p, __ATOMIC_RELAXED, __HIP_MEMORY_SCOPE_AGENT); }
__device__ __forceinline__ unsigned xb_add(unsigned* p, unsigned v) { return __hip_atomic_fetch_add(p, v, __ATOMIC_RELAXED, __HIP_MEMORY_SCOPE_AGENT); }
__device__ __forceinline__ unsigned xb_xcc_id() { return (unsigned)__builtin_amdgcn_s_getreg((3 << 11) | 20) & 0xFu; }
#define XB_SPIN(cond, bar) do { unsigned _sp = 0; while (cond) { __builtin_amdgcn_s_sleep(1); \
    if ((++_sp & 255u) == 0u) { if (xb_ld(&(bar)[XB_TMO])) break; if (_sp > XB_SPIN_CAP) { atomicAdd(&(bar)[XB_TMO], 1u); break; } } } } while (0)

struct XcdBarrier {
    unsigned* bar; unsigned x;
    volatile LAS unsigned* st;
    int wid;
};
#define XB_THREAD0(b) ((b).wid == 0 && lane_id() == 0)
__device__ __forceinline__ XcdBarrier xcd_barrier_post(unsigned* bar, volatile LAS unsigned* st, int wid) {
    XcdBarrier b; b.bar = bar; b.x = xb_xcc_id(); b.st = st; b.wid = wid;
    if (XB_THREAD0(b)) (void)xb_add(&bar[XB_XCNT(b.x)], 1u);
    return b;
}
__device__ __forceinline__ void xcd_barrier_complete(unsigned* bar, unsigned x, unsigned& nloc, unsigned& nx) {
    const unsigned G = gridDim.x * gridDim.y * gridDim.z;
    unsigned sum, cnt, mine, sp = 0u;
    for (;;) {
        sum = 0u; cnt = 0u; mine = 0u;
#pragma unroll
        for (unsigned j = 0; j < 16; ++j) { const unsigned c = xb_ld(&bar[XB_XCNT(j)]); sum += c; cnt += (c > 0u) ? 1u : 0u; mine = (j == x) ? c : mine; }
        if (sum == G) break;
        __builtin_amdgcn_s_sleep(1);
        if ((++sp & 255u) == 0u) { if (xb_ld(&bar[XB_TMO])) break; if (sp > XB_SPIN_CAP) { atomicAdd(&bar[XB_TMO], 1u); break; } }
    }
    nloc = mine > 0u ? mine : 1u; nx = cnt > 0u ? cnt : 1u;
}
__device__ __forceinline__ void xcd_barrier(const XcdBarrier& b) {
    asm volatile("s_waitcnt vmcnt(0)" ::: "memory");
    __syncthreads();
    if (XB_THREAD0(b)) {
        unsigned* bar = b.bar;
        __builtin_amdgcn_s_waitcnt(0);
        unsigned nloc = b.st[0], nx = b.st[1];
        if (nloc == 0u) { xcd_barrier_complete(bar, b.x, nloc, nx); b.st[0] = nloc; b.st[1] = nx; }
        const unsigned old = xb_add(&bar[XB_XSUB(b.x)], 1u);
        const unsigned gen = old / nloc;
        if (old + 1u == (gen + 1u) * nloc) {
            __builtin_amdgcn_fence(__ATOMIC_RELEASE, "agent");
            asm volatile("s_waitcnt vmcnt(0)" ::: "memory");
            const unsigned og = xb_add(&bar[XB_TOP], 1u);
            const unsigned tg = og / nx;
            if (og + 1u == (tg + 1u) * nx) xb_add(&bar[XB_TOPGEN], 1u);
            else XB_SPIN(xb_ld(&bar[XB_TOPGEN]) == tg, bar);
            __builtin_amdgcn_fence(__ATOMIC_ACQUIRE, "agent");
            xb_add(&bar[XB_XGEN(b.x)], 1u);
            asm volatile("s_waitcnt vmcnt(0)" ::: "memory");
        } else {
            XB_SPIN(xb_ld(&bar[XB_XGEN(b.x)]) == gen, bar);
            __builtin_amdgcn_fence(__ATOMIC_ACQUIRE, "agent");
            asm volatile("s_waitcnt vmcnt(0)" ::: "memory");
        }
    }
    __syncthreads();
}

namespace pg8 {
constexpr int BM = 256, BK = 64, HALF = 128, HTB = HALF * BK * 2, STAGE_BYTES = 8 * HTB, NXCD = 8, WGM = 8;
__device__ __forceinline__ int lds_byte(int r, int c) { const int st = (r >> 4) * 2 + (c >> 5), rr = r & 15, cc = c & 31, ob = rr * 64 + cc * 2; return st * 1024 + (ob ^ (((ob >> 9) & 1) << 5)); }
__device__ __forceinline__ void stage_rc(int b, int& R, int& C) { const int st = b / 1024, sb = b % 1024, swz = sb ^ (((sb >> 9) & 1) << 5); R = (st >> 1) * 16 + swz / 64; C = (st & 1) * 32 + (swz % 64) / 2; }
__device__ __forceinline__ int perm32(int rho) { const int n = rho >> 4, i = rho & 15; return 8 * (i >> 2) + 4 * n + (i & 3); }

struct Unit { int pm, pn; unsigned B; int g; };

__device__ __forceinline__ void tile_map(int L, int nM, int nN, int& pm, int& pn) {
    const int nwg = nM * nN; int wgid = L;
    { const int q = nwg / NXCD, r = nwg % NXCD, xcd = wgid % NXCD, off = wgid / NXCD; wgid = (xcd < r ? xcd * (q + 1) : r * (q + 1) + (xcd - r) * q) + off; }
    const int nig = WGM * nN, gid = wgid / nig, fm = gid * WGM, gsz = (nM - fm) < WGM ? (nM - fm) : WGM;
    pm = fm + ((wgid % nig) % gsz); pn = (wgid % nig) / gsz;
}

typedef int i32x8 __attribute__((ext_vector_type(8)));
template <bool FP8, class Epi, class Sched>
__device__ __forceinline__ void gemm_phase(LAS unsigned char* lds, const int wid, const char* Abase, const char* Bbase, const int KB, const Sched& S, const Epi& E) {
    const int lane = lane_id(), tid = wid * 64 + lane, wr = wid >> 2, wc = wid & 3, fr = lane & 15, fq = lane >> 4;
    const int nt = KB / 128;
    int R0, C0; stage_rc(tid * 16, R0, C0);
    unsigned voffB[2];
#pragma unroll
    for (int i = 0; i < 2; ++i) { const int R = R0 + 64 * i; const int Rb = Epi::PERM ? ((R & ~31) + perm32(R & 31)) : R; voffB[i] = (unsigned)(Rb * KB + C0 * 2); }
    const unsigned kstep = (unsigned)(BK * 2);
    const unsigned hstep = (unsigned)(HALF * KB);
    const __amdgpu_buffer_rsrc_t rsA = __builtin_amdgcn_make_buffer_rsrc((void*)Abase, (short)0, 0x7ffff000, 0x00020000);
    const __amdgpu_buffer_rsrc_t rsB = __builtin_amdgcn_make_buffer_rsrc((void*)Bbase, (short)0, 0x7ffff000, 0x00020000);
    const unsigned ldsw = (unsigned)wid * 1024u;
    const int aoff = lds_byte(wr * 64 + fr, fq * 8), boff = lds_byte(wc * 32 + fr, fq * 8);
#define PG8_SA(b, h) (((b) * 2 + (h)) * HTB)
#define PG8_SB(b, h) ((4 + (b) * 2 + (h)) * HTB)
#define PG8_STAGE(bufoff, soff, voff) do { _Pragma("unroll") for (int _i = 0; _i < 2; ++_i) \
        __builtin_amdgcn_raw_ptr_buffer_load_lds(rsB, (LAS unsigned*)(lds + (bufoff) + ldsw + _i * 8192), 16, (int)(voff)[_i], (int)(soff), 0, 0); } while (0)
#define PG8_STAGE_A(bufoff, o0, o1, soff) do { \
        __builtin_amdgcn_raw_ptr_buffer_load_lds(rsA, (LAS unsigned*)(lds + (bufoff) + ldsw), 16, (int)(o0), (int)(soff), 0, 0); \
        __builtin_amdgcn_raw_ptr_buffer_load_lds(rsA, (LAS unsigned*)(lds + (bufoff) + ldsw + 8192), 16, (int)(o1), (int)(soff), 0, 0); } while (0)
#define PG8_LDA(dst, b, h) do { _Pragma("unroll") for (int m = 0; m < 4; ++m) _Pragma("unroll") for (int k = 0; k < 2; ++k) dst[m][k] = *(const LAS bf16x8*)(lds + PG8_SA(b, h) + aoff + m * 2048 + k * 1024); } while (0)
#define PG8_LDB(dst, b, h) do { _Pragma("unroll") for (int n = 0; n < 2; ++n) _Pragma("unroll") for (int k = 0; k < 2; ++k) dst[n][k] = *(const LAS bf16x8*)(lds + PG8_SB(b, h) + boff + n * 2048 + k * 1024); } while (0)
#define PG8_MMA(ai, bj, At, Bt) do { __builtin_amdgcn_s_setprio(1); \
        if constexpr (FP8) { _Pragma("unroll") for (int m = 0; m < 4; ++m) _Pragma("unroll") for (int n = 0; n < 2; ++n) { \
            const u32x4 _b0 = __builtin_bit_cast(u32x4, Bt[n][0]), _b1 = __builtin_bit_cast(u32x4, Bt[n][1]), _a0 = __builtin_bit_cast(u32x4, At[m][0]), _a1 = __builtin_bit_cast(u32x4, At[m][1]); \
            const i32x8 _bb = {(int)_b0.x, (int)_b0.y, (int)_b0.z, (int)_b0.w, (int)_b1.x, (int)_b1.y, (int)_b1.z, (int)_b1.w}, _aa = {(int)_a0.x, (int)_a0.y, (int)_a0.z, (int)_a0.w, (int)_a1.x, (int)_a1.y, (int)_a1.z, (int)_a1.w}; \
            acc[ai][bj][m][n] = __builtin_amdgcn_mfma_scale_f32_16x16x128_f8f6f4(_bb, _aa, acc[ai][bj][m][n], 0, 0, 0, 0, 0, 0); } } \
        else { _Pragma("unroll") for (int m = 0; m < 4; ++m) _Pragma("unroll") for (int n = 0; n < 2; ++n) _Pragma("unroll") for (int k = 0; k < 2; ++k) \
            acc[ai][bj][m][n] = __builtin_amdgcn_mfma_f32_16x16x32_bf16(Bt[n][k], At[m][k], acc[ai][bj][m][n], 0, 0, 0); } \
        __builtin_amdgcn_s_setprio(0); } while (0)
#define PG8_WAIT_V(n) asm volatile("s_waitcnt vmcnt(" #n ")" ::: "memory")
#define PG8_WAIT_L(n) asm volatile("s_waitcnt lgkmcnt(" #n ")" ::: "memory")
#define PG8_BAR __builtin_amdgcn_s_barrier()
#define PG8_SCHED __builtin_amdgcn_sched_barrier(0)
    Unit cur, nxt; int ui = 0;
    if (!S.next(0, cur)) return;
    f32x4 acc[2][2][4][2];
#pragma unroll
    for (int a = 0; a < 2; ++a)
#pragma unroll
        for (int b = 0; b < 2; ++b)
#pragma unroll
            for (int m = 0; m < 4; ++m)
#pragma unroll
                for (int n = 0; n < 2; ++n) acc[a][b][m][n] = (f32x4){0.f, 0.f, 0.f, 0.f};
    bf16x8 At[4][2], B0[2][2], B1[2][2];
    unsigned voffA[2]; voffA[0] = (unsigned)(R0 * KB + C0 * 2); voffA[1] = voffA[0] + (unsigned)(64 * KB);
    unsigned oc00 = 0, oc01 = 0, oc10 = 0, oc11 = 0;
    LAS u32x4* park = (LAS u32x4*)(lds + STAGE_BYTES) + tid;
    unsigned cA = 0, nA = 0;
    if constexpr (Sched::GATHER) { S.aoff(cur, R0, C0, oc00, oc01, oc10, oc11); asm volatile("" : "+v"(oc00), "+v"(oc01), "+v"(oc10), "+v"(oc11)); }
    else cA = S.abase(cur);
#define PG8_STA(bufoff, ptr, h, kb) do { if constexpr (Sched::GATHER) { if ((h) == 0) PG8_STAGE_A(bufoff, oc00, oc01, kb); else PG8_STAGE_A(bufoff, oc10, oc11, kb); } \
        else PG8_STAGE_A(bufoff, voffA[0], voffA[1], (ptr) + (unsigned)(h) * hstep + (unsigned)(kb)); } while (0)
    unsigned cB = cur.B;
    PG8_STAGE(PG8_SB(0, 0), cB, voffB); PG8_STA(PG8_SA(0, 0), cA, 0, 0); PG8_STAGE(PG8_SB(0, 1), cB + hstep, voffB); PG8_STA(PG8_SA(0, 1), cA, 1, 0);
    if (wr == 1) PG8_BAR;
    PG8_WAIT_V(4); PG8_BAR;
    PG8_STAGE(PG8_SB(1, 0), cB + kstep, voffB); PG8_STA(PG8_SA(1, 0), cA, 0, kstep); PG8_STAGE(PG8_SB(1, 1), cB + hstep + kstep, voffB);
    PG8_WAIT_V(6); PG8_BAR;
    for (;;) {
        const bool has_next = S.next(ui + 1, nxt);
        if constexpr (Sched::GATHER) {
            unsigned on00 = oc00, on01 = oc01, on10 = oc10, on11 = oc11;
            if (has_next) S.aoff(nxt, R0, C0, on00, on01, on10, on11);
            *park = (u32x4){on00, on01, on10, on11};
        } else nA = has_next ? S.abase(nxt) : cA;
        const unsigned nB = has_next ? nxt.B : cB;
#pragma unroll 1
        for (int t = 0; t < nt; t += 2) {
            const bool last = (t == nt - 2);
            const unsigned k1 = (unsigned)(t + 1) * kstep;
            const unsigned k2 = last ? 0u : (unsigned)(t + 2) * kstep; const unsigned k3 = k2 + kstep;
            const unsigned a2 = last ? nA : cA;
            const unsigned b2 = last ? nB : cB + (unsigned)(t + 2) * kstep; const unsigned b3 = b2 + kstep;
            PG8_LDB(B0, 0, 0); PG8_SCHED; PG8_LDA(At, 0, 0); PG8_STA(PG8_SA(1, 1), cA, 1, k1);
            PG8_WAIT_L(8); PG8_BAR; PG8_WAIT_L(0); PG8_MMA(0, 0, At, B0); PG8_BAR; PG8_SCHED;
            if constexpr (Sched::GATHER) { if (last) { const u32x4 pk = *park; oc00 = pk.x; oc01 = pk.y; oc10 = pk.z; oc11 = pk.w; } }
            PG8_LDB(B1, 0, 1); PG8_STAGE(PG8_SB(0, 0), b2, voffB);
            PG8_BAR; PG8_WAIT_L(0); PG8_MMA(0, 1, At, B1); PG8_BAR;
            PG8_LDA(At, 0, 1); PG8_STA(PG8_SA(0, 0), a2, 0, k2);
            PG8_BAR; PG8_WAIT_L(0); PG8_MMA(1, 0, At, B0); PG8_BAR; PG8_SCHED;
            PG8_STAGE(PG8_SB(0, 1), b2 + hstep, voffB);
            PG8_WAIT_V(6); PG8_BAR; PG8_MMA(1, 1, At, B1); PG8_BAR;
            PG8_LDB(B0, 1, 0); PG8_SCHED; PG8_LDA(At, 1, 0); PG8_STA(PG8_SA(0, 1), a2, 1, k2);
            PG8_WAIT_L(8); PG8_BAR; PG8_WAIT_L(0); PG8_MMA(0, 0, At, B0); PG8_BAR; PG8_SCHED;
            PG8_LDB(B1, 1, 1); PG8_STAGE(PG8_SB(1, 0), b3, voffB);
            PG8_BAR; PG8_WAIT_L(0); PG8_MMA(0, 1, At, B1); PG8_BAR;
            PG8_LDA(At, 1, 1); PG8_STA(PG8_SA(1, 0), a2, 0, k3);
            PG8_BAR; PG8_WAIT_L(0); PG8_MMA(1, 0, At, B0); PG8_BAR; PG8_SCHED;
            PG8_STAGE(PG8_SB(1, 1), b3 + hstep, voffB);
            PG8_WAIT_V(6); PG8_BAR; PG8_MMA(1, 1, At, B1); PG8_BAR;
        }
        { const int _l = lane_id(); const int _fr = _l & 15, _fq = _l >> 4;
          E(acc, cur, wr, wc, _fr, _fq); }
        if (!has_next) break;
#pragma unroll
        for (int a = 0; a < 2; ++a)
#pragma unroll
            for (int b = 0; b < 2; ++b)
#pragma unroll
                for (int m = 0; m < 4; ++m)
#pragma unroll
                    for (int n = 0; n < 2; ++n) acc[a][b][m][n] = (f32x4){0.f, 0.f, 0.f, 0.f};
        cur = nxt; cB = nB; cA = nA; ++ui;
    }
    PG8_WAIT_V(0);
    if (wr == 0) PG8_BAR;
    PG8_BAR;
#undef PG8_SA
#undef PG8_SB
#undef PG8_STAGE
#undef PG8_STAGE_A
#undef PG8_STA
#undef PG8_LDA
#undef PG8_LDB
#undef PG8_MMA
#undef PG8_WAIT_V
#undef PG8_WAIT_L
#undef PG8_BAR
#undef PG8_SCHED
}

struct DenseSched {
    static constexpr bool GATHER = false;
    int nM, nN, G, c, KB;
    __device__ __forceinline__ unsigned abase(const Unit& u) const { return (unsigned)(u.pm * 256 * KB); }
    __device__ __forceinline__ bool next(int i, Unit& u) const {
        const long L = (long)i * G + c; if (L >= (long)nM * nN) return false;
        tile_map((int)L, nM, nN, u.pm, u.pn); u.B = (unsigned)(u.pn * 256 * KB); u.g = 0; return true;
    }
    __device__ __forceinline__ void aoff(const Unit& u, int R0, int C0, unsigned& o00, unsigned& o01, unsigned& o10, unsigned& o11) const {
        const unsigned base = (unsigned)((u.pm * 256 + R0) * KB + C0 * 2), r64 = (unsigned)(64 * KB);
        o00 = base; o01 = base + r64; o10 = base + 2u * r64; o11 = base + 3u * r64;
    }
};
struct InProjL1Sched {
    static constexpr bool GATHER = false;
    int G, c;
    __device__ __forceinline__ unsigned abase(const Unit& u) const { return (unsigned)(u.pm * 256 * D * 2); }
    __device__ __forceinline__ bool next(int i, Unit& u) const {
        const int L = i * G + c; if (L >= 3840 + 224) return false;
        if (L < 3840) tile_map(L, 256, 15, u.pm, u.pn);
        else { const int Lc = L - 3840; u.pm = 256 + Lc / 7; const int j = Lc % 7; u.pn = j < 6 ? 6 + j : 14; }
        u.B = (unsigned)(u.pn * 256 * D * 2); u.g = 0; return true;
    }
    __device__ __forceinline__ void aoff(const Unit& u, int R0, int C0, unsigned& o00, unsigned& o01, unsigned& o10, unsigned& o11) const {
        const unsigned base = (unsigned)((u.pm * 256 + R0) * D + C0) * 2u, r64 = (unsigned)(64 * D) * 2u;
        o00 = base; o01 = base + r64; o10 = base + 2u * r64; o11 = base + 3u * r64;
    }
};
struct MoeUpSched {
    static constexpr bool GATHER = true;
    int G, c; const int* rowtok; const volatile LAS int* tb;
    __device__ __forceinline__ unsigned abase(const Unit&) const { return 0u; }
    __device__ __forceinline__ bool next(int i, Unit& u) const {
        const int T = tb[8]; const int L = i * G + c; if (L >= T * 22) return false;
        tile_map(L, T, 22, u.pm, u.pn); int g = 0;
#pragma unroll
        for (int j = 1; j < 8; ++j) g += (u.pm >= tb[j]) ? 1 : 0;
        u.g = g; u.B = (unsigned)((g * 5632 + u.pn * 256) * D); return true;
    }
    __device__ __forceinline__ void aoff(const Unit& u, int R0, int C0, unsigned& o00, unsigned& o01, unsigned& o10, unsigned& o11) const {
        const int s0 = (u.pm - tb[u.g]) * 256 + R0, cnt = tb[16 + u.g]; const int* rt = rowtok + (size_t)u.g * RT_STRIDE;
        const int t00 = s0 < cnt ? rt[s0] : 0, t01 = s0 + 64 < cnt ? rt[s0 + 64] : 0, t10 = s0 + 128 < cnt ? rt[s0 + 128] : 0, t11 = s0 + 192 < cnt ? rt[s0 + 192] : 0;
        o00 = (unsigned)(t00 * D + C0 * 2); o01 = (unsigned)(t01 * D + C0 * 2); o10 = (unsigned)(t10 * D + C0 * 2); o11 = (unsigned)(t11 * D + C0 * 2);
    }
};
struct MoeDownSched {
    static constexpr bool GATHER = false;
    int G, c; const volatile LAS int* tb;
    __device__ __forceinline__ unsigned abase(const Unit& u) const { return (unsigned)(u.pm * 256 * DFF); }
    __device__ __forceinline__ bool next(int i, Unit& u) const {
        const int T = tb[8]; const int L = i * G + c; if (L >= T * 4) return false;
        tile_map(L, T, 4, u.pm, u.pn); int g = 0;
#pragma unroll
        for (int j = 1; j < 8; ++j) g += (u.pm >= tb[j]) ? 1 : 0;
        u.g = g; u.B = (unsigned)((g * D + u.pn * 256) * DFF); return true;
    }
    __device__ __forceinline__ void aoff(const Unit& u, int R0, int C0, unsigned& o00, unsigned& o01, unsigned& o10, unsigned& o11) const {
        const unsigned base = (unsigned)((u.pm * 256 + R0) * DFF + C0 * 2), r64 = (unsigned)(64 * DFF);
        o00 = base; o01 = base + r64; o10 = base + 2u * r64; o11 = base + 3u * r64;
    }
};

struct EpiProj {
    static constexpr bool PERM = true;
    bf16_t* P; float* GT; const float* bg; bool dry;
    __device__ __forceinline__ void operator()(const f32x4 (&acc)[2][2][4][2], const Unit& u, int wr, int wc, int fr, int fq) const {
        if (dry) {
#pragma unroll
            for (int ai = 0; ai < 2; ++ai)
#pragma unroll
                for (int bj = 0; bj < 2; ++bj)
#pragma unroll
                    for (int m = 0; m < 4; ++m) asm volatile("" :: "v"(acc[ai][bj][m][0]), "v"(acc[ai][bj][m][1]));
            return; }
        const int row0 = u.pm * BM + wr * 64 + fr;
        if (u.pn < 14) {
            const int col0 = u.pn * BM + wc * 32 + 8 * fq;
#pragma unroll
            for (int ai = 0; ai < 2; ++ai)
#pragma unroll
                for (int m = 0; m < 4; ++m) { bf16_t* rowp = P + (size_t)(row0 + ai * HALF + m * 16) * NPROJ + col0;
#pragma unroll
                    for (int bj = 0; bj < 2; ++bj) { const f32x4 v0 = acc[ai][bj][m][0], v1 = acc[ai][bj][m][1];
                        u32x4 w; w.x = cvt_pk_bf16(v0[0], v0[1]); w.y = cvt_pk_bf16(v0[2], v0[3]); w.z = cvt_pk_bf16(v1[0], v1[1]); w.w = cvt_pk_bf16(v1[2], v1[3]);
                        *(u32x4*)(rowp + bj * HALF) = w; } }
        } else if (wc == 0 && fq < 2) {
            const f32x4 b0 = *(const f32x4*)(bg + 8 * fq), b1 = *(const f32x4*)(bg + 8 * fq + 4);
#pragma unroll
            for (int ai = 0; ai < 2; ++ai)
#pragma unroll
                for (int m = 0; m < 4; ++m) { float* gp = GT + (size_t)(row0 + ai * HALF + m * 16) * 16 + 8 * fq;
                    *(f32x4*)gp = acc[ai][0][m][0] + b0; *(f32x4*)(gp + 4) = acc[ai][0][m][1] + b1; }
        }
    }
};
template <bool SRC32>
struct EpiResid {
    static constexpr bool PERM = true;
    const float* resL; const float* resC; bf16_t* HB; const float* gate; float gscale;
    __device__ __forceinline__ void operator()(const f32x4 (&acc)[2][2][4][2], const Unit& u, int wr, int wc, int fr, int fq) const {
        const int rowg = u.pm * BM; const bool isc = rowg >= NL;
        const int bidx = isc ? 32 : (rowg >> 11);
        const int col0 = u.pn * BM + wc * 32 + 8 * fq;
        const float* gv = gate + (size_t)bidx * 6144 + col0;
        bf16_t* out = HB + (size_t)rowg * D + col0;
        const float* res32 = SRC32 ? (isc ? resC + (size_t)(rowg - NL) * D : resL + (size_t)rowg * D) + col0 : nullptr;
        f32x4 g[2][2];
#pragma unroll
        for (int bj = 0; bj < 2; ++bj)
#pragma unroll
            for (int n = 0; n < 2; ++n) g[bj][n] = *(const f32x4*)(gv + bj * HALF + n * 4) * gscale;
#pragma unroll
        for (int ai = 0; ai < 2; ++ai) {
            if constexpr (SRC32) {
                f32x4 r[4][2][2];
#pragma unroll
                for (int m = 0; m < 4; ++m) { const size_t off = (size_t)(ai * HALF + wr * 64 + m * 16 + fr) * D;
#pragma unroll
                    for (int bj = 0; bj < 2; ++bj)
#pragma unroll
                        for (int n = 0; n < 2; ++n) r[m][bj][n] = *(const f32x4*)(res32 + off + bj * HALF + n * 4); }
#pragma unroll
                for (int m = 0; m < 4; ++m) { const size_t off = (size_t)(ai * HALF + wr * 64 + m * 16 + fr) * D;
#pragma unroll
                    for (int bj = 0; bj < 2; ++bj) { const f32x4 o0 = r[m][bj][0] + g[bj][0] * acc[ai][bj][m][0], o1 = r[m][bj][1] + g[bj][1] * acc[ai][bj][m][1];
                        u32x4 w; w.x = cvt_pk_bf16(o0[0], o0[1]); w.y = cvt_pk_bf16(o0[2], o0[3]); w.z = cvt_pk_bf16(o1[0], o1[1]); w.w = cvt_pk_bf16(o1[2], o1[3]);
                        *(u32x4*)(out + off + bj * HALF) = w; } }
            } else {
                u32x4 r[4][2];
#pragma unroll
                for (int m = 0; m < 4; ++m) { const size_t off = (size_t)(ai * HALF + wr * 64 + m * 16 + fr) * D;
#pragma unroll
                    for (int bj = 0; bj < 2; ++bj) r[m][bj] = *(const u32x4*)(out + off + bj * HALF); }
#pragma unroll
                for (int m = 0; m < 4; ++m) { const size_t off = (size_t)(ai * HALF + wr * 64 + m * 16 + fr) * D;
#pragma unroll
                    for (int bj = 0; bj < 2; ++bj) { const u32x4 rr = r[m][bj]; const f32x4 a0 = g[bj][0] * acc[ai][bj][m][0], a1 = g[bj][1] * acc[ai][bj][m][1];
                        u32x4 w; w.x = cvt_pk_bf16(bflo(rr.x) + a0[0], bfhi(rr.x) + a0[1]); w.y = cvt_pk_bf16(bflo(rr.y) + a0[2], bfhi(rr.y) + a0[3]);
                        w.z = cvt_pk_bf16(bflo(rr.z) + a1[0], bfhi(rr.z) + a1[1]); w.w = cvt_pk_bf16(bflo(rr.w) + a1[2], bfhi(rr.w) + a1[3]);
                        *(u32x4*)(out + off + bj * HALF) = w; } }
            }
            asm volatile("" ::: "memory"); }
    }
};
__device__ __forceinline__ float clamp448(float x) { return fminf(fmaxf(x, -448.0f), 448.0f); }
struct EpiSwiglu {
    static constexpr bool PERM = true;
    unsigned char* ACT; float iscale, oscale;
    __device__ __forceinline__ void operator()(const f32x4 (&acc)[2][2][4][2], const Unit& u, int wr, int wc, int fr, int fq) const {
        const int row0 = u.pm * BM + wr * 64 + fr, col0 = u.pn * HALF + wc * 32 + 8 * fq;
#pragma unroll
        for (int ai = 0; ai < 2; ++ai)
#pragma unroll
            for (int m = 0; m < 4; ++m) { unsigned char* rowp = ACT + (size_t)(row0 + ai * HALF + m * 16) * DFF + col0;
                float o[8];
#pragma unroll
                for (int n = 0; n < 2; ++n)
#pragma unroll
                    for (int j = 0; j < 4; ++j) { const float a = acc[ai][0][m][n][j] * iscale, b = acc[ai][1][m][n][j] * iscale; o[n * 4 + j] = clamp448(a * b * __builtin_amdgcn_rcpf(1.0f + __expf(-a)) * oscale); }
                int w0 = 0, w1 = 0;
                w0 = __builtin_amdgcn_cvt_pk_fp8_f32(o[0], o[1], w0, false); w0 = __builtin_amdgcn_cvt_pk_fp8_f32(o[2], o[3], w0, true);
                w1 = __builtin_amdgcn_cvt_pk_fp8_f32(o[4], o[5], w1, false); w1 = __builtin_amdgcn_cvt_pk_fp8_f32(o[6], o[7], w1, true);
                *(u32x2*)rowp = (u32x2){(unsigned)w0, (unsigned)w1}; }
    }
};
struct EpiMoeDown {
    static constexpr bool PERM = true;
    bf16_t* H; const float* g2; const int* rowtok; const float* rowgate; const volatile LAS int* tb; float gscale;
    __device__ __forceinline__ void operator()(const f32x4 (&acc)[2][2][4][2], const Unit& u, int wr, int wc, int fr, int fq) const {
        const int s0 = (u.pm - tb[u.g]) * 256, cnt = tb[16 + u.g];
        const int* rt = rowtok + (size_t)u.g * RT_STRIDE; const float* rg = rowgate + (size_t)u.g * RT_STRIDE;
        const int col0 = u.pn * BM + wc * 32 + 8 * fq;
#pragma unroll
        for (int ai = 0; ai < 2; ++ai)
#pragma unroll
          for (int mp = 0; mp < 4; mp += 2) {
            u32x4 r[2][2]; f32x4 gg[2][2][2]; int tok[2]; float gt[2]; bool ok[2];
#pragma unroll
            for (int m = 0; m < 2; ++m) { const int slot = s0 + ai * HALF + wr * 64 + (mp + m) * 16 + fr; ok[m] = slot < cnt; tok[m] = ok[m] ? rt[slot] : 0; gt[m] = ok[m] ? rg[slot] * gscale : 0.f; }
#pragma unroll
            for (int m = 0; m < 2; ++m) { const bf16_t* hp = H + (size_t)tok[m] * D + col0; const float* gv = g2 + (size_t)(tok[m] >> 11) * 6144 + col0;
#pragma unroll
                for (int bj = 0; bj < 2; ++bj) { r[m][bj] = *(const u32x4*)(hp + bj * HALF); gg[m][bj][0] = *(const f32x4*)(gv + bj * HALF); gg[m][bj][1] = *(const f32x4*)(gv + bj * HALF + 4); } }
#pragma unroll
            for (int m = 0; m < 2; ++m) if (ok[m]) { bf16_t* hp = H + (size_t)tok[m] * D + col0;
#pragma unroll
                for (int bj = 0; bj < 2; ++bj) { const u32x4 rr = r[m][bj]; const f32x4 a0 = (gg[m][bj][0] * gt[m]) * acc[ai][bj][mp + m][0], a1 = (gg[m][bj][1] * gt[m]) * acc[ai][bj][mp + m][1];
                    u32x4 w; w.x = cvt_pk_bf16(bflo(rr.x) + a0[0], bfhi(rr.x) + a0[1]); w.y = cvt_pk_bf16(bflo(rr.y) + a0[2], bfhi(rr.y) + a0[3]);
                    w.z = cvt_pk_bf16(bflo(rr.z) + a1[0], bfhi(rr.z) + a1[1]); w.w = cvt_pk_bf16(bflo(rr.w) + a1[2], bfhi(rr.w) + a1[3]);
                    *(u32x4*)(hp + bj * HALF) = w; } }
            asm volatile("" ::: "memory"); }
    }
};
}

struct Args { const float* in[21]; float* out; unsigned char* ws; int lo, hi; };
enum { I_X = 0, I_C, I_CTX, I_CCTX, I_N1G, I_N2G, I_WADA, I_BADA, I_WIN, I_CONVW, I_BG, I_MNG, I_WOUT, I_FW1, I_FW3, I_FW2, I_ROUTER, I_MW1, I_MW3, I_MW2, I_FNG };

struct Frame { LAS unsigned char* lds; int wid, G, wg;
    __device__ __forceinline__ int lane() const { return lane_id(); }
    __device__ __forceinline__ int tid() const { return wid * 64 + lane_id(); } };
typedef const __attribute__((address_space(4))) Args* KArgs;
#define KA() ({ KArgs _k = (KArgs)__builtin_amdgcn_kernarg_segment_ptr(); asm volatile("" : "+s"(_k)); _k; })

__device__ __forceinline__ int conv_row(int mode, int n, float& scale) {
    scale = 1.f;
    if (mode == 0) return n;
    if (mode == 1) { if (n >= 2048 && n < 2560) scale = 0.08838834764831845f; if (n < 3072) return n; if (n < 3088) return 3584 + (n - 3072); return n - 16; }
    return (n >> 7) * 256 + (n & 127) + (mode == 3 ? 128 : 0);
}
__device__ __forceinline__ void conv_tiles(const Frame& F, const float* src, bf16_t* dst, int K, int N, int mode, float fp8scale  , int& gbase) {
    LAS float* tile = (LAS float*)F.lds;
    const int tn = (N + 63) / 64, ntile = (K / 64) * tn, tid = F.tid();
    int t = (F.wg - gbase) % F.G; if (t < 0) t += F.G;
    for (; t < ntile; t += F.G) {
        const int k0 = (t / tn) * 64, n0 = (t % tn) * 64;
        { const int row = tid >> 4, c4 = (tid & 15) * 4;
#pragma unroll
          for (int j = 0; j < 2; ++j) { const int r = row + 32 * j; f32x4 v = (f32x4){0.f, 0.f, 0.f, 0.f};
              if (n0 + c4 < N) v = *(const f32x4*)(src + (size_t)(k0 + r) * N + n0 + c4);
              tile[r * 65 + c4 + 0] = v[0]; tile[r * 65 + c4 + 1] = v[1]; tile[r * 65 + c4 + 2] = v[2]; tile[r * 65 + c4 + 3] = v[3]; } }
        __syncthreads();
        { const int n = tid >> 3, kc = (tid & 7) * 8;
          if (n0 + n < N) { float sc; const int drow = conv_row(mode, n0 + n, sc); float v[8];
#pragma unroll
              for (int j = 0; j < 8; ++j) v[j] = tile[(kc + j) * 65 + n] * sc;
              if (fp8scale == 0.f) {
                  u32x4 w; w.x = cvt_pk_bf16(v[0], v[1]); w.y = cvt_pk_bf16(v[2], v[3]); w.z = cvt_pk_bf16(v[4], v[5]); w.w = cvt_pk_bf16(v[6], v[7]);
                  *(u32x4*)(dst + (size_t)drow * K + k0 + kc) = w;
              } else {
#pragma unroll
                  for (int j = 0; j < 8; ++j) v[j] = fminf(fmaxf(v[j] * fp8scale, -448.0f), 448.0f);
                  int w0 = 0, w1 = 0;
                  w0 = __builtin_amdgcn_cvt_pk_fp8_f32(v[0], v[1], w0, false); w0 = __builtin_amdgcn_cvt_pk_fp8_f32(v[2], v[3], w0, true);
                  w1 = __builtin_amdgcn_cvt_pk_fp8_f32(v[4], v[5], w1, false); w1 = __builtin_amdgcn_cvt_pk_fp8_f32(v[6], v[7], w1, true);
                  *(u32x2*)((unsigned char*)dst + (size_t)drow * K + k0 + kc) = (u32x2){(unsigned)w0, (unsigned)w1};
              } } }
        __syncthreads();
    }
    gbase = (gbase + ntile) % F.G;
}
__device__ void p0_prologue(const Frame& F) {
    const int tid = F.tid(); KArgs ka = KA(); unsigned char* const ws = ka->ws;
    if (F.wg < 192) {
        LAS float* s = (LAS float*)F.lds;
        for (int idx = tid; idx < 33 * 1024; idx += 512) { const int b = idx >> 10, k = idx & 1023; const float v = b < 32 ? ka->in[I_C][b * 1024 + k] : ka->in[I_CCTX][k]; s[idx] = v / (1.0f + __expf(-v)); }
        __syncthreads();
        const int layer = F.wg / 96, col0 = (F.wg % 96) * 64, col = tid & 63, g = tid >> 6;
        const float* W = ka->in[I_WADA] + (size_t)layer * 1024 * 6144 + col0 + col;
        float acc[33];
#pragma unroll
        for (int b = 0; b < 33; ++b) acc[b] = 0.f;
        for (int k4 = 0; k4 < 32; ++k4) { const int k = g * 128 + k4 * 4;
            const float w0 = W[(size_t)(k + 0) * 6144], w1 = W[(size_t)(k + 1) * 6144], w2 = W[(size_t)(k + 2) * 6144], w3 = W[(size_t)(k + 3) * 6144];
#pragma unroll
            for (int b = 0; b < 33; ++b) { const f32x4 s4 = *(const LAS f32x4*)(s + b * 1024 + k); acc[b] += s4[0] * w0 + s4[1] * w1 + s4[2] * w2 + s4[3] * w3; } }
        __syncthreads();
        LAS float* red = (LAS float*)F.lds;
#pragma unroll
        for (int b = 0; b < 33; ++b) red[(g * 33 + b) * 64 + col] = acc[b];
        __syncthreads();
        float* MOD = (float*)(ws + WS_MOD); const float* bada = ka->in[I_BADA];
        for (int idx = tid; idx < 33 * 64; idx += 512) { const int b = idx >> 6, cc = idx & 63; float sum = 0.f;
#pragma unroll
            for (int gg = 0; gg < 8; ++gg) sum += red[(gg * 33 + b) * 64 + cc];
            MOD[((size_t)layer * 33 + b) * 6144 + col0 + cc] = sum + bada[layer * 6144 + col0 + cc]; }
        __syncthreads();
    }
    { bf16_t* WIN = (bf16_t*)(ws + WS_WIN);
      for (int l = 0; l < 2; ++l) { u32x4* p = (u32x4*)(WIN + ((size_t)l * NPAD + PIN) * D); const int n16 = (NPAD - PIN) * D * 2 / 16;
          for (int i = F.wg * 512 + tid; i < n16; i += F.G * 512) p[i] = (u32x4){0u, 0u, 0u, 0u}; } }
    int gbase = 0;
    for (int j = 0; j < 31; ++j) {
        const float* src; bf16_t* dst; int K, N, mode; float f8 = 0.f;
        if (j < 2)       { src = ka->in[I_WIN] + (size_t)j * D * PIN; dst = (bf16_t*)(ws + WS_WIN) + (size_t)j * NPAD * D; K = D; N = PIN; mode = 1; }
        else if (j < 4)  { src = ka->in[I_WOUT] + (size_t)(j - 2) * D * D; dst = (bf16_t*)(ws + WS_WOUT) + (size_t)(j - 2) * D * D; K = D; N = D; mode = 0; }
        else if (j == 4) { src = ka->in[I_FW1]; dst = (bf16_t*)(ws + WS_WUP); K = D; N = DFF; mode = 2; f8 = S_W13; }
        else if (j == 5) { src = ka->in[I_FW3]; dst = (bf16_t*)(ws + WS_WUP); K = D; N = DFF; mode = 3; f8 = S_W13; }
        else if (j == 6) { src = ka->in[I_FW2]; dst = (bf16_t*)(ws + WS_WDN); K = DFF; N = D; mode = 0; f8 = S_W2; }
        else if (j < 15) { const int e = j - 7;  src = ka->in[I_MW1] + (size_t)e * D * DFF; dst = (bf16_t*)(ws + WS_MUP + (size_t)e * 2 * DFF * D); K = D; N = DFF; mode = 2; f8 = S_W13; }
        else if (j < 23) { const int e = j - 15; src = ka->in[I_MW3] + (size_t)e * D * DFF; dst = (bf16_t*)(ws + WS_MUP + (size_t)e * 2 * DFF * D); K = D; N = DFF; mode = 3; f8 = S_W13; }
        else             { const int e = j - 23; src = ka->in[I_MW2] + (size_t)e * DFF * D; dst = (bf16_t*)(ws + WS_MDN + (size_t)e * D * DFF); K = DFF; N = D; mode = 0; f8 = S_W2; }
        conv_tiles(F, src, dst, K, N, mode, f8, gbase);
    }
}

template <bool ROUTER, bool OUT8, bool SRC16>
__device__ __forceinline__ void norm_phase(const Frame& F, const float* srcL, const float* srcC  , int nrows, const float* gain, const float* mod  , int chunk_shift, bf16_t* U, const float* router) {
    const int lane = F.lane(), wid = F.wid, tid = F.tid();
    const int rpw = (nrows + F.G * 8 - 1) / (F.G * 8);
    const int rbase = (F.wg * 8 + wid) * rpw;
    LAS float* rl = (LAS float*)F.lds;
    LAS int* cntl = (LAS int*)(F.lds + 32768);
    LAS int* sel = (LAS int*)(F.lds + 32768 + 256);
    if (ROUTER) {
        for (int i = tid; i < 8192; i += 512) rl[i] = router[i];
        if (tid < 32) cntl[tid] = 0;
        __syncthreads();
    }
    f32x4 gn[4];
#pragma unroll
    for (int j = 0; j < 4; ++j) gn[j] = *(const f32x4*)(gain + j * 256 + lane * 4);
    for (int rr = 0; rr < rpw; ++rr) {
        const int r = rbase + rr; if (r >= nrows) break;
        const bool isc = r >= NL;
        const float* src = isc ? srcC + (size_t)(r - NL) * D : srcL + (size_t)r * D;
        const float* mv = mod + (size_t)(isc ? 32 : (r >> 11)) * 6144 + chunk_shift * 1024;
        f32x4 x[4]; float ss = 0.f;
#pragma unroll
        for (int j = 0; j < 4; ++j) {
            if constexpr (SRC16) { const u32x2 w = *(const u32x2*)((const bf16_t*)srcL + (size_t)r * D + j * 256 + lane * 4); x[j] = (f32x4){bflo(w.x), bfhi(w.x), bflo(w.y), bfhi(w.y)}; }
            else x[j] = *(const f32x4*)(src + j * 256 + lane * 4);
            ss += x[j][0] * x[j][0] + x[j][1] * x[j][1] + x[j][2] * x[j][2] + x[j][3] * x[j][3]; }
        ss = wave_sum(ss);
        const float rstd = rsqrtf(ss * (1.0f / 1024.0f) + EPS);
        float lg[8];
        if (ROUTER) {
#pragma unroll
            for (int e = 0; e < 8; ++e) lg[e] = 0.f;
        }
#pragma unroll
        for (int j = 0; j < 4; ++j) {
            const f32x4 sh = *(const f32x4*)(mv + j * 256 + lane * 4), sc = *(const f32x4*)(mv + 1024 + j * 256 + lane * 4);
            f32x4 u = (x[j] * rstd * gn[j]) * (sc + 1.0f) + sh;
            if (OUT8) { int w8 = 0; w8 = __builtin_amdgcn_cvt_pk_fp8_f32(fminf(fmaxf(u[0] * S_A, -448.f), 448.f), fminf(fmaxf(u[1] * S_A, -448.f), 448.f), w8, false);
                w8 = __builtin_amdgcn_cvt_pk_fp8_f32(fminf(fmaxf(u[2] * S_A, -448.f), 448.f), fminf(fmaxf(u[3] * S_A, -448.f), 448.f), w8, true);
                *(int*)((unsigned char*)U + (size_t)r * D + j * 256 + lane * 4) = w8; }
            else { u32x2 w; w.x = cvt_pk_bf16(u[0], u[1]); w.y = cvt_pk_bf16(u[2], u[3]);
                *(u32x2*)(U + (size_t)r * D + j * 256 + lane * 4) = w; }
            if (ROUTER) {
#pragma unroll
                for (int i = 0; i < 4; ++i) { const LAS f32x4* rp = (const LAS f32x4*)(rl + (j * 256 + lane * 4 + i) * 8); const f32x4 r0 = rp[0], r1 = rp[1];
                    lg[0] += u[i] * r0[0]; lg[1] += u[i] * r0[1]; lg[2] += u[i] * r0[2]; lg[3] += u[i] * r0[3];
                    lg[4] += u[i] * r1[0]; lg[5] += u[i] * r1[1]; lg[6] += u[i] * r1[2]; lg[7] += u[i] * r1[3]; }
            }
        }
        if (ROUTER) {
#pragma unroll
            for (int e = 0; e < 8; ++e) lg[e] = wave_sum(lg[e]);
            int e0 = 0; float v0 = lg[0];
#pragma unroll
            for (int e = 1; e < 8; ++e) if (lg[e] > v0) { v0 = lg[e]; e0 = e; }
            int e1 = -1; float v1 = -3.0e38f;
#pragma unroll
            for (int e = 0; e < 8; ++e) if (e != e0 && lg[e] > v1) { v1 = lg[e]; e1 = e; }
            if (lane == 0) {
                const float g0 = 1.0f / (1.0f + __expf(v1 - v0)), g1 = 1.0f - g0;
                const int r0 = atomicAdd((int*)(cntl + e0), 1), r1 = atomicAdd((int*)(cntl + 8 + e1), 1);
                LAS int* sp = sel + (wid * rpw + rr) * 6;
                sp[0] = e0 | (e1 << 8); sp[1] = r0; sp[2] = r1; sp[3] = __float_as_int(g0); sp[4] = __float_as_int(g1); sp[5] = r;
            }
        }
    }
    if (ROUTER) {
        __syncthreads();
        unsigned char* const ws = KA()->ws;
        if (tid < 16) { unsigned* gc = (unsigned*)(ws + WS_CTL + CTL_GCNT); cntl[16 + tid] = (int)__hip_atomic_fetch_add(gc + tid, (unsigned)cntl[tid], __ATOMIC_RELAXED, __HIP_MEMORY_SCOPE_AGENT); }
        __syncthreads();
        int* rowtok = (int*)(ws + WS_RTOK); float* rowgate = (float*)(ws + WS_RGATE);
        for (int i = tid; i < 8 * rpw; i += 512) {
            const int w = i / rpw, rr = i % rpw; const int r = (F.wg * 8 + w) * rpw + rr;
            if (r < nrows) { const LAS int* sp = sel + i * 6; const int e0 = sp[0] & 255, e1 = sp[0] >> 8;
                const int p0 = cntl[16 + e0] + sp[1], p1 = cntl[16 + 8 + e1] + sp[2];
                rowtok[(size_t)e0 * RT_STRIDE + p0] = sp[5]; rowgate[(size_t)e0 * RT_STRIDE + p0] = __int_as_float(sp[3]);
                rowtok[(size_t)(8 + e1) * RT_STRIDE + p1] = sp[5]; rowgate[(size_t)(8 + e1) * RT_STRIDE + p1] = __int_as_float(sp[4]); }
        }
        __syncthreads();
    }
}

__device__ __forceinline__ void unpack8(const u32x4 w, float (&v)[8]) { v[0] = bflo(w.x); v[1] = bfhi(w.x); v[2] = bflo(w.y); v[3] = bfhi(w.y); v[4] = bflo(w.z); v[5] = bfhi(w.z); v[6] = bflo(w.w); v[7] = bfhi(w.w); }
__device__ __forceinline__ u32x4 pack8(const float (&v)[8]) { u32x4 w; w.x = cvt_pk_bf16(v[0], v[1]); w.y = cvt_pk_bf16(v[2], v[3]); w.z = cvt_pk_bf16(v[4], v[5]); w.w = cvt_pk_bf16(v[6], v[7]); return w; }
__device__ __forceinline__ void mix_phase(const Frame& F, int nrows, const float* convw  , const float* gnorm  ) {
    const int lane = F.lane(); unsigned char* const ws = KA()->ws;
    const bf16_t* P = (const bf16_t*)(ws + WS_PROJ); const bf16_t* HL = (const bf16_t*)KA()->out; bf16_t* A2 = (bf16_t*)(ws + WS_U);
    const int rpw = (nrows + F.G * 8 - 1) / (F.G * 8); const int rbase = (F.wg * 8 + F.wid) * rpw;
    float w0[8], w1[8], w2[8], gnv[8];
#pragma unroll
    for (int j = 0; j < 8; ++j) { w0[j] = convw[lane * 8 + j]; w1[j] = convw[512 + lane * 8 + j]; w2[j] = convw[1024 + lane * 8 + j]; gnv[j] = gnorm[lane * 8 + j]; }
    for (int rr = 0; rr < rpw; ++rr) {
        const int r = rbase + rr; if (r >= nrows) break;
        bool hasL, hasR;
        if (r < NL) { const int cc = r & 63; hasL = cc != 0; hasR = cc != 63; } else { const int t = (r - NL) & 255; hasL = t != 0; hasR = t != 255; }
        const bf16_t* pr = P + (size_t)r * NPROJ + lane * 8;
        float gb[8], zc[8], zl[8], zr[8], t0[8], t1[8];
        unpack8(*(const u32x4*)pr, gb);
        unpack8(*(const u32x4*)(pr + 512), t0); unpack8(*(const u32x4*)(pr + 1024), t1);
#pragma unroll
        for (int j = 0; j < 8; ++j) zc[j] = t0[j] * t1[j];
        if (hasL) { unpack8(*(const u32x4*)(pr - NPROJ + 512), t0); unpack8(*(const u32x4*)(pr - NPROJ + 1024), t1);
#pragma unroll
            for (int j = 0; j < 8; ++j) zl[j] = t0[j] * t1[j]; }
        else {
#pragma unroll
            for (int j = 0; j < 8; ++j) zl[j] = 0.f; }
        if (hasR) { unpack8(*(const u32x4*)(pr + NPROJ + 512), t0); unpack8(*(const u32x4*)(pr + NPROJ + 1024), t1);
#pragma unroll
            for (int j = 0; j < 8; ++j) zr[j] = t0[j] * t1[j]; }
        else {
#pragma unroll
            for (int j = 0; j < 8; ++j) zr[j] = 0.f; }
        float y[8];
#pragma unroll
        for (int j = 0; j < 8; ++j) y[j] = gb[j] * (w0[j] * zl[j] + w1[j] * zc[j] + w2[j] * zr[j]);
        *(u32x4*)(A2 + (size_t)r * D + lane * 8) = pack8(y);
        float hf[8], hb[8], og[8];
        unpack8(*(const u32x4*)(HL + (size_t)r * 512 + lane * 8), hf); unpack8(*(const u32x4*)(HL + (size_t)(MT + r) * 512 + lane * 8), hb);
        unpack8(*(const u32x4*)(pr + 3072), og);
        float ss = 0.f;
#pragma unroll
        for (int j = 0; j < 8; ++j) { hf[j] += hb[j]; ss += hf[j] * hf[j]; }
        ss += __shfl_xor(ss, 1); ss += __shfl_xor(ss, 2); ss += __shfl_xor(ss, 4); ss += __shfl_xor(ss, 8);
        const float rstd = rsqrtf(ss * (1.0f / 128.0f) + EPS);
#pragma unroll
        for (int j = 0; j < 8; ++j) y[j] = hf[j] * rstd * gnv[j] * sigmoidf_(og[j]);
        *(u32x4*)(A2 + (size_t)r * D + 512 + lane * 8) = pack8(y);
    }
}

__device__ __forceinline__ void final_phase(const Frame& F) {
    const int lane = F.lane(); KArgs ka = KA(); const float* gain = ka->in[I_FNG]; float* const outp = ka->out; const bf16_t* HB = (const bf16_t*)(ka->ws + WS_HB);
    const int rpw = (NL + F.G * 8 - 1) / (F.G * 8); const int rbase = (F.wg * 8 + F.wid) * rpw;
    f32x4 gn[4];
#pragma unroll
    for (int j = 0; j < 4; ++j) gn[j] = *(const f32x4*)(gain + j * 256 + lane * 4);
    for (int rr = 0; rr < rpw; ++rr) {
        const int r = rbase + rr; if (r >= NL) break;
        f32x4 x[4]; float ss = 0.f;
#pragma unroll
        for (int j = 0; j < 4; ++j) { const u32x2 w = *(const u32x2*)(HB + (size_t)r * D + j * 256 + lane * 4); x[j] = (f32x4){bflo(w.x), bfhi(w.x), bflo(w.y), bfhi(w.y)};
            ss += x[j][0] * x[j][0] + x[j][1] * x[j][1] + x[j][2] * x[j][2] + x[j][3] * x[j][3]; }
        ss = wave_sum(ss);
        const float rstd = rsqrtf(ss * (1.0f / 1024.0f) + EPS);
        float* p = outp + (size_t)r * D;
#pragma unroll
        for (int j = 0; j < 4; ++j) *(f32x4*)(p + j * 256 + lane * 4) = x[j] * rstd * gn[j];
    }
}

constexpr int ML_RB = 272;
constexpr int ML_Q = 0, ML_K = 34816, ML_V = 69632, ML_S = 104448, ML_VEC = 139264;
__device__ __forceinline__ bf16x8 tr_frag(const LAS unsigned char* base, int row0, int col0, int lane) {
    const int g = lane >> 4, q = (lane & 15) >> 2, p = lane & 3;
    const LAS unsigned char* a = base + (row0 + 8 * g + q) * ML_RB + (col0 + 4 * p) * 2;
    const s16x4 v0 = __builtin_amdgcn_ds_read_tr16_b64_v4i16((LAS s16x4*)a);
    const s16x4 v1 = __builtin_amdgcn_ds_read_tr16_b64_v4i16((LAS s16x4*)(a + 4 * ML_RB));
    return (bf16x8){v0[0], v0[1], v0[2], v0[3], v1[0], v1[1], v1[2], v1[3]};
}
__device__ void mlstm_phase(const Frame& F, bool ctx_out) {
    const int tid = F.tid(), lane = F.lane(), wid = F.wid, fr = lane & 15, fq = lane >> 4;
    LAS unsigned char* lds = F.lds;
    LAS float* ic = (LAS float*)(lds + ML_VEC); LAS float* fc = ic + 128; LAS float* av = ic + 256; LAS float* Mv = ic + 384; LAS float* bcv = ic + 512;
    LAS float* rden = ic + 640; LAS float* wintv = ic + 768; LAS float* nvec = ic + 896; LAS float* wkv = ic + 1024;
    unsigned char* const ws = KA()->ws;
    const bf16_t* P = (const bf16_t*)(ws + WS_PROJ); const float* GT = (const float*)(ws + WS_GATES); bf16_t* HL = (bf16_t*)KA()->out;
    for (int unit = F.wg; unit < 256; unit += F.G) {
        const int b = unit >> 3, hd = (unit >> 1) & 3, dir = unit & 1;
        f32x4 Cacc[8];
#pragma unroll
        for (int a = 0; a < 8; ++a) Cacc[a] = (f32x4){0.f, 0.f, 0.f, 0.f};
        float m = 0.f;
        if (tid < 128) nvec[tid] = 0.f;
        u32x4 st[12]; float gi = 0.f, gf = 0.f;
#define ML_ROW0(ci) ((ci) < 2 ? NL + b * 256 + (dir ? 1 - (ci) : (ci)) * 128 : b * 2048 + (dir ? 15 - ((ci) - 2) : ((ci) - 2)) * 128)
#define ML_LOAD(ci) do { const int _r0 = ML_ROW0(ci); _Pragma("unroll") for (int _p = 0; _p < 4; ++_p) { const int _id = tid + 512 * _p, _row = _id >> 4, _ch = _id & 15; \
            const bf16_t* _g = P + (size_t)(_r0 + _row) * NPROJ + 1536 + hd * 128 + _ch * 8; st[_p] = *(const u32x4*)_g; st[4 + _p] = *(const u32x4*)(_g + 512); st[8 + _p] = *(const u32x4*)(_g + 1024); } \
            if (tid < 128) { gi = GT[(size_t)(_r0 + tid) * 16 + (2 * dir) * 4 + hd]; gf = GT[(size_t)(_r0 + tid) * 16 + (2 * dir + 1) * 4 + hd]; } } while (0)
        ML_LOAD(0);
        for (int ci = 0; ci < 18; ++ci) {
            const int row0 = ML_ROW0(ci);
            const bool need_out = (ci >= 2) || ctx_out;
#pragma unroll
            for (int p = 0; p < 4; ++p) { const int id = tid + 512 * p, row = id >> 4, ch = id & 15; const int o = row * ML_RB + ch * 16;
                *(LAS u32x4*)(lds + ML_Q + o) = st[p]; *(LAS u32x4*)(lds + ML_K + o) = st[4 + p]; *(LAS u32x4*)(lds + ML_V + o) = st[8 + p]; }
            if (tid < 128) { ic[tid] = gi; fc[tid] = fminf(gf, 0.f) - log1pf(__expf(-fabsf(gf))); }
            if (ci + 1 < 18) ML_LOAD(ci + 1);
            __syncthreads();
            float bL, Mlast;
            { const int p0 = 2 * lane, p1 = p0 + 1, s0 = dir ? 127 - p0 : p0, s1 = dir ? 127 - p1 : p1;
              const float f0 = fc[s0], f1 = fc[s1], i0 = ic[s0], i1 = ic[s1];
              float incl = f0 + f1;
#pragma unroll
              for (int d = 1; d < 64; d <<= 1) { const float t = __shfl_up(incl, d); if (lane >= d) incl += t; }
              const float bc1 = incl, bc0 = incl - f1;
              const float a0 = i0 - bc0, a1 = i1 - bc1;
              float im = fmaxf(a0, a1);
#pragma unroll
              for (int d = 1; d < 64; d <<= 1) { const float t = __shfl_up(im, d); if (lane >= d) im = fmaxf(im, t); }
              float ex = __shfl_up(im, 1); if (lane == 0) ex = -3.0e38f;
              const float M0 = fmaxf(fmaxf(m, ex), a0), M1 = fmaxf(m, im);
              bL = __shfl(incl, 63); Mlast = __shfl(M1, 63);
              av[s0] = a0; av[s1] = a1; Mv[s0] = M0; Mv[s1] = M1; bcv[s0] = bc0; bcv[s1] = bc1;
              wkv[s0] = __expf(a0 - Mlast); wkv[s1] = __expf(a1 - Mlast); }
            if (need_out) {
                const int t = 16 * wid + fr; const float Mt = Mv[t];
                bf16x8 Qf[4];
#pragma unroll
                for (int ks = 0; ks < 4; ++ks) Qf[ks] = *(const LAS bf16x8*)(lds + ML_Q + t * ML_RB + (32 * ks + 8 * fq) * 2);
                float rowsum = 0.f;
#pragma unroll 1
                for (int j = 0; j < 8; ++j) {
                    f32x4 acc = (f32x4){0.f, 0.f, 0.f, 0.f};
#pragma unroll
                    for (int ks = 0; ks < 4; ++ks) { const bf16x8 Kf = *(const LAS bf16x8*)(lds + ML_K + (16 * j + fr) * ML_RB + (32 * ks + 8 * fq) * 2); acc = __builtin_amdgcn_mfma_f32_16x16x32_bf16(Kf, Qf[ks], acc, 0, 0, 0); }
                    const f32x4 a4 = *(const LAS f32x4*)(av + 16 * j + 4 * fq);
                    float v[4];
#pragma unroll
                    for (int r = 0; r < 4; ++r) { const int s = 16 * j + 4 * fq + r; const bool valid = dir ? (s >= t) : (s <= t); v[r] = valid ? acc[r] * __expf(a4[r] - Mt) : 0.f; rowsum += v[r]; }
                    u32x2 w; w.x = cvt_pk_bf16(v[0], v[1]); w.y = cvt_pk_bf16(v[2], v[3]);
                    *(LAS u32x2*)(lds + ML_S + t * ML_RB + (16 * j + 4 * fq) * 2) = w;
                }
                rowsum += __shfl_xor(rowsum, 16); rowsum += __shfl_xor(rowsum, 32);
                float qn = 0.f;
#pragma unroll
                for (int ks = 0; ks < 4; ++ks) { const f32x4 n0 = *(const LAS f32x4*)(nvec + 32 * ks + 8 * fq), n1 = *(const LAS f32x4*)(nvec + 32 * ks + 8 * fq + 4);
#pragma unroll
                    for (int jj = 0; jj < 4; ++jj) { qn += bf2f((unsigned short)Qf[ks][jj]) * n0[jj]; qn += bf2f((unsigned short)Qf[ks][4 + jj]) * n1[jj]; } }
                qn += __shfl_xor(qn, 16); qn += __shfl_xor(qn, 32);
                const float wi = __expf(m - Mt), den = rowsum + wi * qn, dn = fmaxf(fabsf(den), __expf(-(bcv[t] + Mt)));
                if (fq == 0) { rden[t] = 1.0f / dn; wintv[t] = wi; }
            }
            __syncthreads();
            bf16x8 Vf[4];
#pragma unroll
            for (int ks = 0; ks < 4; ++ks) Vf[ks] = tr_frag(lds + ML_V, 32 * ks, 16 * wid, lane);
            if (need_out) {
                bf16x8 Cf[4];
#pragma unroll
                for (int kp = 0; kp < 4; ++kp) { const f32x4 c0 = Cacc[2 * kp], c1 = Cacc[2 * kp + 1]; u32x4 w; w.x = cvt_pk_bf16(c0[0], c0[1]); w.y = cvt_pk_bf16(c0[2], c0[3]); w.z = cvt_pk_bf16(c1[0], c1[1]); w.w = cvt_pk_bf16(c1[2], c1[3]);
                    Cf[kp] = __builtin_bit_cast(bf16x8, w); }
#pragma unroll 1
                for (int i = 0; i < 8; ++i) {
                    f32x4 aS = (f32x4){0.f, 0.f, 0.f, 0.f}, aC = (f32x4){0.f, 0.f, 0.f, 0.f};
                    const int tt = 16 * i + fr;
#pragma unroll
                    for (int ks = 0; ks < 4; ++ks) { const bf16x8 Sf = *(const LAS bf16x8*)(lds + ML_S + tt * ML_RB + (32 * ks + 8 * fq) * 2); aS = __builtin_amdgcn_mfma_f32_16x16x32_bf16(Vf[ks], Sf, aS, 0, 0, 0); }
#pragma unroll
                    for (int kp = 0; kp < 4; ++kp) { const s16x4 q0 = *(const LAS s16x4*)(lds + ML_Q + tt * ML_RB + (32 * kp + 4 * fq) * 2), q1 = *(const LAS s16x4*)(lds + ML_Q + tt * ML_RB + (32 * kp + 16 + 4 * fq) * 2);
                        const bf16x8 Qp = (bf16x8){q0[0], q0[1], q0[2], q0[3], q1[0], q1[1], q1[2], q1[3]};
                        aC = __builtin_amdgcn_mfma_f32_16x16x32_bf16(Cf[kp], Qp, aC, 0, 0, 0); }
                    const float wi = wintv[tt], rd = rden[tt];
                    u32x2 w; w.x = cvt_pk_bf16((aS[0] + wi * aC[0]) * rd, (aS[1] + wi * aC[1]) * rd); w.y = cvt_pk_bf16((aS[2] + wi * aC[2]) * rd, (aS[3] + wi * aC[3]) * rd);
                    *(u32x2*)(HL + ((size_t)dir * MT + row0 + tt) * 512 + hd * 128 + 16 * wid + 4 * fq) = w;
                }
            }
            {
                const float dec = __expf(m - Mlast);
                bf16x8 Vw[4];
#pragma unroll
                for (int ks = 0; ks < 4; ++ks) { const f32x4 k0 = *(const LAS f32x4*)(wkv + 32 * ks + 8 * fq), k1 = *(const LAS f32x4*)(wkv + 32 * ks + 8 * fq + 4);
                    u32x4 w;
                    w.x = cvt_pk_bf16(bf2f((unsigned short)Vf[ks][0]) * k0[0], bf2f((unsigned short)Vf[ks][1]) * k0[1]); w.y = cvt_pk_bf16(bf2f((unsigned short)Vf[ks][2]) * k0[2], bf2f((unsigned short)Vf[ks][3]) * k0[3]);
                    w.z = cvt_pk_bf16(bf2f((unsigned short)Vf[ks][4]) * k1[0], bf2f((unsigned short)Vf[ks][5]) * k1[1]); w.w = cvt_pk_bf16(bf2f((unsigned short)Vf[ks][6]) * k1[2], bf2f((unsigned short)Vf[ks][7]) * k1[3]);
                    Vw[ks] = __builtin_bit_cast(bf16x8, w); }
#pragma unroll
                for (int a = 0; a < 8; ++a) { Cacc[a] = Cacc[a] * dec;
#pragma unroll
                    for (int ks = 0; ks < 4; ++ks) { const bf16x8 Kt = tr_frag(lds + ML_K, 32 * ks, 16 * a, lane); Cacc[a] = __builtin_amdgcn_mfma_f32_16x16x32_bf16(Kt, Vw[ks], Cacc[a], 0, 0, 0); } }
                if (tid < 128) { float an = dec * nvec[tid];
#pragma unroll 8
                    for (int s = 0; s < 128; ++s) an += wkv[s] * bf2f(*(const LAS unsigned short*)(lds + ML_K + s * ML_RB + tid * 2));
                    nvec[tid] = an; }
                m = bL + Mlast;
            }
            __syncthreads();
        }
#undef ML_ROW0
#undef ML_LOAD
    }
}

constexpr int NPH = 20;
constexpr int REP[NPH] = {1, 1, 1, 1, 1, 1, 1, 1, 1, 1, 1, 1, 1, 1, 1, 1, 1, 1, 1, 1};
#define REPEAT(k) for (int _r = 0; _r < REP[k]; ++_r)
#define GSCALE(k) ((_r == REP[k] - 1) ? 1.0f : 0.0f)
__global__ void __launch_bounds__(512, 2) mk_fwd(Args args_unused) {
    extern __shared__ __attribute__((aligned(16))) unsigned char smem[];
    Frame F;
    F.lds = (LAS unsigned char*)smem; F.wid = __builtin_amdgcn_readfirstlane((int)threadIdx.x >> 6); F.G = gridDim.x; F.wg = blockIdx.x;
    volatile LAS unsigned* misc = (volatile LAS unsigned*)(F.lds + MISC_OFF);
    if (F.tid() < 64) misc[F.tid()] = 0u;
    __syncthreads();
    int lo, hi;
    { KArgs ka = KA(); lo = ka->lo; hi = ka->hi; }
    XcdBarrier bar;
    { KArgs ka = KA(); bar.bar = (unsigned*)(ka->ws + WS_CTL); bar.x = 0; bar.st = misc; bar.wid = F.wid;
      if (hi - lo > 1) bar = xcd_barrier_post((unsigned*)(ka->ws + WS_CTL), misc, F.wid); }
#define IN(k) (lo <= (k) && (k) < hi)
#define SEAM(k) do { if (IN(k) && IN((k) + 1)) { KArgs _ka = KA(); bar.bar = (unsigned*)(_ka->ws + WS_CTL); xcd_barrier(bar); } } while (0)
    const volatile LAS int* tb = (const volatile LAS int*)(F.lds + MISC_OFF + 64);
    volatile LAS int* tbw = (volatile LAS int*)(F.lds + MISC_OFF + 64);

#ifdef PROBE_MFMA
    {
        f32x4 a0 = {0.f, 0.f, 0.f, 0.f}, a1 = a0, a2 = a0, a3 = a0; bf16x8 x = {1, 2, 3, 4, 5, 6, 7, 8}, y = {8, 7, 6, 5, 4, 3, 2, 1};
        asm volatile("" : "+v"(x), "+v"(y));
        for (int it = 0; it < 10000; ++it) {
            a0 = __builtin_amdgcn_mfma_f32_16x16x32_bf16(x, y, a0, 0, 0, 0); a1 = __builtin_amdgcn_mfma_f32_16x16x32_bf16(x, y, a1, 0, 0, 0);
            a2 = __builtin_amdgcn_mfma_f32_16x16x32_bf16(x, y, a2, 0, 0, 0); a3 = __builtin_amdgcn_mfma_f32_16x16x32_bf16(x, y, a3, 0, 0, 0); }
        asm volatile("" :: "v"(a0), "v"(a1), "v"(a2), "v"(a3));
    }
#endif
    if (IN(0)) REPEAT(0) { p0_prologue(F); }
    SEAM(0);
    if (IN(1)) REPEAT(1) { KArgs ka = KA(); unsigned char* ws = ka->ws;
        norm_phase<false, false, false>(F, ka->in[I_X], ka->in[I_CTX], MT, ka->in[I_N1G], (const float*)(ws + WS_MOD), 0, (bf16_t*)(ws + WS_U), nullptr); }
    SEAM(1);
    if (IN(2)) REPEAT(2) { KArgs ka = KA(); unsigned char* ws = ka->ws;
        pg8::DenseSched S{MT / 256, NPAD / 256, F.G, F.wg, 2 * D};
        pg8::EpiProj E{(bf16_t*)(ws + WS_PROJ), (float*)(ws + WS_GATES), ka->in[I_BG], GSCALE(2) == 0.0f};
        pg8::gemm_phase<false>(F.lds, F.wid, (const char*)(ws + WS_U), (const char*)(ws + WS_WIN), 2 * D, S, E); }
    SEAM(2);
    if (IN(3)) REPEAT(3) { mlstm_phase(F, true); }
    SEAM(3);
    if (IN(4)) REPEAT(4) { KArgs ka = KA(); mix_phase(F, MT, ka->in[I_CONVW], ka->in[I_MNG]); }
    SEAM(4);
    if (IN(5)) REPEAT(5) { KArgs ka = KA(); unsigned char* ws = ka->ws;
        pg8::DenseSched S{MT / 256, D / 256, F.G, F.wg, 2 * D};
        pg8::EpiResid<true> E{ka->in[I_X], ka->in[I_CTX], (bf16_t*)(ws + WS_HB), (const float*)(ws + WS_MOD) + 2 * 1024, 1.0f};
        pg8::gemm_phase<false>(F.lds, F.wid, (const char*)(ws + WS_U), (const char*)(ws + WS_WOUT), 2 * D, S, E); }
    SEAM(5);
    if (IN(6)) REPEAT(6) { KArgs ka = KA(); unsigned char* ws = ka->ws;
        norm_phase<false, true, true>(F, (const float*)(ws + WS_HB), nullptr, MT, ka->in[I_N2G], (const float*)(ws + WS_MOD), 3, (bf16_t*)(ws + WS_U), nullptr); }
    SEAM(6);
    if (IN(7)) REPEAT(7) { KArgs ka = KA(); unsigned char* ws = ka->ws;
        pg8::DenseSched S{MT / 256, 2 * DFF / 256, F.G, F.wg, D};
        pg8::EpiSwiglu E{(unsigned char*)(ws + WS_PROJ), 1.0f / (S_A * S_W13), S_H};
        pg8::gemm_phase<true>(F.lds, F.wid, (const char*)(ws + WS_U), (const char*)(ws + WS_WUP), D, S, E); }
    SEAM(7);
    if (IN(8)) REPEAT(8) { KArgs ka = KA(); unsigned char* ws = ka->ws;
        pg8::DenseSched S{MT / 256, D / 256, F.G, F.wg, DFF};
        pg8::EpiResid<false> E{nullptr, nullptr, (bf16_t*)(ws + WS_HB), (const float*)(ws + WS_MOD) + 5 * 1024, GSCALE(8) / (S_H * S_W2)};
        pg8::gemm_phase<true>(F.lds, F.wid, (const char*)(ws + WS_PROJ), (const char*)(ws + WS_WDN), DFF, S, E); }
    SEAM(8);
    if (IN(9)) REPEAT(9) { KArgs ka = KA(); unsigned char* ws = ka->ws;
        norm_phase<false, false, true>(F, (const float*)(ws + WS_HB), nullptr, MT, ka->in[I_N1G] + D, (const float*)(ws + WS_MOD) + 33 * 6144, 0, (bf16_t*)(ws + WS_U), nullptr); }
    SEAM(9);
    if (IN(10)) REPEAT(10) { KArgs ka = KA(); unsigned char* ws = ka->ws;
        pg8::InProjL1Sched S{F.G, F.wg};
        pg8::EpiProj E{(bf16_t*)(ws + WS_PROJ), (float*)(ws + WS_GATES), ka->in[I_BG] + 16, GSCALE(10) == 0.0f};
        pg8::gemm_phase<false>(F.lds, F.wid, (const char*)(ws + WS_U), (const char*)(ws + WS_WIN) + (size_t)NPAD * D * 2, 2 * D, S, E); }
    SEAM(10);
    if (IN(11)) REPEAT(11) { mlstm_phase(F, false); }
    SEAM(11);
    if (IN(12)) REPEAT(12) { KArgs ka = KA(); mix_phase(F, NL, ka->in[I_CONVW] + 3 * 512, ka->in[I_MNG] + 512); }
    SEAM(12);
    if (IN(13)) REPEAT(13) { KArgs ka = KA(); unsigned char* ws = ka->ws;
        pg8::DenseSched S{NL / 256, D / 256, F.G, F.wg, 2 * D};
        pg8::EpiResid<false> E{nullptr, nullptr, (bf16_t*)(ws + WS_HB), (const float*)(ws + WS_MOD) + 33 * 6144 + 2 * 1024, GSCALE(13)};
        pg8::gemm_phase<false>(F.lds, F.wid, (const char*)(ws + WS_U), (const char*)(ws + WS_WOUT) + (size_t)D * D * 2, 2 * D, S, E); }
    SEAM(13);
    if (IN(14)) REPEAT(14) { KArgs ka = KA(); unsigned char* ws = ka->ws;
        norm_phase<true, true, true>(F, (const float*)(ws + WS_HB), nullptr, NL, ka->in[I_N2G] + D, (const float*)(ws + WS_MOD) + 33 * 6144, 3, (bf16_t*)(ws + WS_U), ka->in[I_ROUTER]); }
    SEAM(14);
    for (int k = 0; k < 2; ++k) {
        if (IN(15 + 2 * k) || IN(16 + 2 * k)) {
            __syncthreads();
            if (F.tid() == 0) { KArgs ka = KA(); const unsigned* gc = (const unsigned*)(ka->ws + WS_CTL + CTL_GCNT) + 8 * k; int t = 0;
                for (int g = 0; g < 8; ++g) { const int c = (int)__hip_atomic_load(gc + g, __ATOMIC_RELAXED, __HIP_MEMORY_SCOPE_AGENT); tbw[g] = t; tbw[16 + g] = c; t += (c + 255) >> 8; }
                tbw[8] = t; }
            __syncthreads();
        }
        if (IN(15 + 2 * k)) REPEAT(15) { KArgs ka = KA(); unsigned char* ws = ka->ws;
            pg8::MoeUpSched S{F.G, F.wg, (const int*)(ws + WS_RTOK) + (size_t)k * 8 * RT_STRIDE, tb};
            pg8::EpiSwiglu E{(unsigned char*)(ws + WS_PROJ), 1.0f / (S_A * S_W13), S_H};
            pg8::gemm_phase<true>(F.lds, F.wid, (const char*)(ws + WS_U), (const char*)(ws + WS_MUP), D, S, E); }
        SEAM(15 + 2 * k);
        if (IN(16 + 2 * k)) REPEAT(16) { KArgs ka = KA(); unsigned char* ws = ka->ws;
            pg8::MoeDownSched S{F.G, F.wg, tb};
            pg8::EpiMoeDown E{(bf16_t*)(ws + WS_HB), (const float*)(ws + WS_MOD) + 33 * 6144 + 5 * 1024, (const int*)(ws + WS_RTOK) + (size_t)k * 8 * RT_STRIDE, (const float*)(ws + WS_RGATE) + (size_t)k * 8 * RT_STRIDE, tb, GSCALE(16) / (S_H * S_W2)};
            pg8::gemm_phase<true>(F.lds, F.wid, (const char*)(ws + WS_PROJ), (const char*)(ws + WS_MDN), DFF, S, E); }
        SEAM(16 + 2 * k);
    }
    if (IN(19)) REPEAT(19) { final_phase(F); }
#undef IN
#undef SEAM
}

extern "C" void kernel_launch(void* const* d_in, const int* in_sizes, int n_in, void* d_out, int out_size, void* d_ws, size_t ws_size, hipStream_t stream) {
    static int grid = 0;
    if (grid == 0) {
        if (n_in != 21 || ws_size < WS_END) { fprintf(stderr, "kernel_launch: expected 21 inputs and >= %zu bytes of workspace; got %d, %zu\n", (size_t)WS_END, n_in, ws_size); grid = -1; return; }
        int dev = 0, cus = 0, per_cu = 0;
        if (hipGetDevice(&dev) != hipSuccess || hipDeviceGetAttribute(&cus, hipDeviceAttributeMultiprocessorCount, dev) != hipSuccess) { grid = -1; return; }
        if (hipFuncSetAttribute((const void*)mk_fwd, hipFuncAttributeMaxDynamicSharedMemorySize, LDS_BYTES) != hipSuccess) { fprintf(stderr, "kernel_launch: hipFuncSetAttribute failed\n"); grid = -1; return; }
        if (hipOccupancyMaxActiveBlocksPerMultiprocessor(&per_cu, (const void*)mk_fwd, 512, LDS_BYTES) != hipSuccess || per_cu < 1) fprintf(stderr, "kernel_launch: occupancy query reports %d\n", per_cu);
        (void)hipGetLastError();
        grid = cus;
    }
    if (grid < 0) return;
    (void)hipMemsetAsync((char*)d_ws + WS_CTL, 0, CTL_BYTES, stream);
    Args a{};
    for (int i = 0; i < 21; ++i) a.in[i] = (const float*)d_in[i];
    a.out = (float*)d_out; a.ws = (unsigned char*)d_ws;
#if MK_PER_PHASE
    for (int p = 0; p < NPH; ++p) { a.lo = p; a.hi = p + 1; hipLaunchKernelGGL(mk_fwd, dim3(grid), dim3(512), LDS_BYTES, stream, a); }
#else
    a.lo = 0; a.hi = NPH; hipLaunchKernelGGL(mk_fwd, dim3(grid), dim3(512), LDS_BYTES, stream, a);
#endif
}
```

```cpp
#include <hip/hip_runtime.h>
#include <cstdio>
#include <cstdint>
#include <type_traits>

#ifndef MK_PER_PHASE
#define MK_PER_PHASE 0
#endif

#define LAS __attribute__((address_space(3)))
typedef unsigned short bf16_t;
typedef short bf16x8 __attribute__((ext_vector_type(8)));
typedef short s16x4 __attribute__((ext_vector_type(4)));
typedef float f32x4 __attribute__((ext_vector_type(4)));
typedef float f32x2 __attribute__((ext_vector_type(2)));
typedef unsigned u32x4 __attribute__((ext_vector_type(4)));
typedef unsigned u32x2 __attribute__((ext_vector_type(2)));

constexpr int D = 1024, NB = 32, SEQ = 2048, CTXL = 256;
constexpr int NL = NB * SEQ;
constexpr int NCX = NB * CTXL;
constexpr int MT = NL + NCX;
constexpr int PIN = 3600, NPROJ = 3584, NPAD = 3840;
constexpr int NPO = 3072;
constexpr int DFF = 2816, NE = 8;
constexpr float EPS = 1e-6f;
constexpr int PROBE_P0SKIP = 0;
constexpr int PROBE_MLSKIP = 0;
constexpr bool PROBE_DRY = false;
constexpr int RT_STRIDE = 65536;
constexpr float S_A = 16.0f, S_W13 = 256.0f, S_H = 8.0f, S_W2 = 256.0f, S_Y = 32.0f;

constexpr size_t WS_CTL = 0;
constexpr size_t CTL_BYTES = 65536;
constexpr size_t CTL_GCNT = 16384;
constexpr size_t WS_MOD = 65536;
constexpr size_t WS_WIN = 2097152;
constexpr size_t WS_WOUT = WS_WIN + (size_t)2 * NPAD * D * 2;
constexpr size_t WS_WUP = WS_WOUT + (size_t)2 * D * D * 2;
constexpr size_t WS_WDN = WS_WUP + (size_t)2 * DFF * D * 2;
constexpr size_t WS_MUP = WS_WDN + (size_t)D * DFF * 2;
constexpr size_t WS_MDN = WS_MUP + (size_t)NE * 2 * DFF * D * 2;
constexpr size_t WS_HC = WS_MDN + (size_t)NE * D * DFF * 2;
constexpr size_t WS_U = WS_HC + (size_t)NCX * D * 4;
constexpr size_t WS_PROJ = WS_U + (size_t)MT * D * 2;
constexpr size_t WS_GATES = WS_PROJ + (size_t)MT * NPROJ * 2;
constexpr size_t WS_HL = WS_GATES + (size_t)MT * 16 * 4;
constexpr size_t WS_HB = WS_HL;
constexpr size_t WS_Y1 = WS_PROJ + (size_t)368 * 1048576;
static_assert(WS_Y1 + (size_t)NL * D * 2 <= WS_GATES && (size_t)528 * 256 * DFF <= (size_t)368 * 1048576, "Y1 placement");
constexpr size_t WS_RTOK = WS_HL + (size_t)2 * MT * 512 * 2;
constexpr size_t WS_RGATE = WS_RTOK + (size_t)16 * RT_STRIDE * 4;
constexpr size_t WS_END = WS_RGATE + (size_t)16 * RT_STRIDE * 4;

constexpr int LDS_BYTES = 163840;
constexpr int MISC_OFF = 161792;

__device__ __forceinline__ unsigned cvt_pk_bf16(float lo, float hi) { unsigned r; asm volatile("v_cvt_pk_bf16_f32 %0, %1, %2" : "=v"(r) : "v"(lo), "v"(hi)); return r; }
__device__ __forceinline__ float bf2f(unsigned short b) { return __uint_as_float(((unsigned)b) << 16); }
__device__ __forceinline__ float bflo(unsigned w) { return __uint_as_float(w << 16); }
__device__ __forceinline__ float bfhi(unsigned w) { return __uint_as_float(w & 0xffff0000u); }
__device__ __forceinline__ float wave_sum(float v) {
#pragma unroll
    for (int o = 32; o >= 1; o >>= 1) v += __shfl_xor(v, o);
    return v;
}
__device__ __forceinline__ int lane_id() { int l; asm volatile("v_mbcnt_lo_u32_b32 %0, -1, 0\n\tv_mbcnt_hi_u32_b32 %0, -1, %0" : "=v"(l)); return l; }
template <int CTRL, int RM> __device__ __forceinline__ float dppf(float ident, float v) {
    return __builtin_bit_cast(float, __builtin_amdgcn_update_dpp(__builtin_bit_cast(int, ident), __builtin_bit_cast(int, v), CTRL, RM, 0xf, false)); }
__device__ __forceinline__ float wave_scan_add(float v) {
    v += dppf<0x111, 0xf>(0.f, v); v += dppf<0x112, 0xf>(0.f, v); v += dppf<0x114, 0xf>(0.f, v); v += dppf<0x118, 0xf>(0.f, v);
    v += dppf<0x142, 0xa>(0.f, v); v += dppf<0x143, 0xc>(0.f, v); return v; }
__device__ __forceinline__ float wave_scan_max(float v) {
    v = fmaxf(v, dppf<0x111, 0xf>(-3.0e38f, v)); v = fmaxf(v, dppf<0x112, 0xf>(-3.0e38f, v)); v = fmaxf(v, dppf<0x114, 0xf>(-3.0e38f, v)); v = fmaxf(v, dppf<0x118, 0xf>(-3.0e38f, v));
    v = fmaxf(v, dppf<0x142, 0xa>(-3.0e38f, v)); v = fmaxf(v, dppf<0x143, 0xc>(-3.0e38f, v)); return v; }
__device__ __forceinline__ float sigmoidf_(float x) { return 1.0f / (1.0f + __expf(-x)); }

#define XB_TMO      128
#define XB_XCNT(j)  (256  + 64 * (j))
#define XB_XSUB(j)  (1280 + 64 * (j))
#define XB_XGEN(j)  (2304 + 64 * (j))
#define XB_TOP      3328
#define XB_TOPGEN   3392
#define XCD_BAR_WORDS 3456
#define XB_SPIN_CAP (1u << 18)

__device__ __forceinline__ unsigned xb_ld(unsigned* p)              { return __hip_atomic_load(p, __ATOMIC_RELAXED, __HIP_MEMORY_SCOPE_AGENT); }
__device__ __forceinline__ unsigned xb_add(unsigned* p, unsigned v) { return __hip_atomic_fetch_add(p, v, __ATOMIC_RELAXED, __HIP_MEMORY_SCOPE_AGENT); }
__device__ __forceinline__ unsigned xb_xcc_id() { return (unsigned)__builtin_amdgcn_s_getreg((3 << 11) | 20) & 0xFu; }
#define XB_SPIN(cond, bar) do { unsigned _sp = 0; while (cond) { __builtin_amdgcn_s_sleep(1); \
    if ((++_sp & 255u) == 0u) { if (xb_ld(&(bar)[XB_TMO])) break; if (_sp > XB_SPIN_CAP) { atomicAdd(&(bar)[XB_TMO], 1u); break; } } } } while (0)

struct XcdBarrier {
    unsigned* bar; unsigned x;
    volatile LAS unsigned* st;
    int wid;
};
#define XB_THREAD0(b) ((b).wid == 0 && lane_id() == 0)
__device__ __forceinline__ XcdBarrier xcd_barrier_post(unsigned* bar, volatile LAS unsigned* st, int wid) {
    XcdBarrier b; b.bar = bar; b.x = xb_xcc_id(); b.st = st; b.wid = wid;
    if (XB_THREAD0(b)) (void)xb_add(&bar[XB_XCNT(b.x)], 1u);
    return b;
}
__device__ __forceinline__ void xcd_barrier_complete(unsigned* bar, unsigned x, unsigned& nloc, unsigned& nx) {
    const unsigned G = gridDim.x * gridDim.y * gridDim.z;
    unsigned sum, cnt, mine, sp = 0u;
    for (;;) {
        sum = 0u; cnt = 0u; mine = 0u;
#pragma unroll
        for (unsigned j = 0; j < 16; ++j) { const unsigned c = xb_ld(&bar[XB_XCNT(j)]); sum += c; cnt += (c > 0u) ? 1u : 0u; mine = (j == x) ? c : mine; }
        if (sum == G) break;
        __builtin_amdgcn_s_sleep(1);
        if ((++sp & 255u) == 0u) { if (xb_ld(&bar[XB_TMO])) break; if (sp > XB_SPIN_CAP) { atomicAdd(&bar[XB_TMO], 1u); break; } }
    }
    nloc = mine > 0u ? mine : 1u; nx = cnt > 0u ? cnt : 1u;
}
__device__ __forceinline__ void xcd_barrier(const XcdBarrier& b) {
    asm volatile("s_waitcnt vmcnt(0)" ::: "memory");
    __syncthreads();
    if (XB_THREAD0(b)) {
        unsigned* bar = b.bar;
        __builtin_amdgcn_s_waitcnt(0);
        unsigned nloc = b.st[0], nx = b.st[1];
        if (nloc == 0u) { xcd_barrier_complete(bar, b.x, nloc, nx); b.st[0] = nloc; b.st[1] = nx; }
        const unsigned old = xb_add(&bar[XB_XSUB(b.x)], 1u);
        const unsigned gen = old / nloc;
        if (old + 1u == (gen + 1u) * nloc) {
            __builtin_amdgcn_fence(__ATOMIC_RELEASE, "agent");
            asm volatile("s_waitcnt vmcnt(0)" ::: "memory");
            const unsigned og = xb_add(&bar[XB_TOP], 1u);
            const unsigned tg = og / nx;
            if (og + 1u == (tg + 1u) * nx) xb_add(&bar[XB_TOPGEN], 1u);
            else XB_SPIN(xb_ld(&bar[XB_TOPGEN]) == tg, bar);
            __builtin_amdgcn_fence(__ATOMIC_ACQUIRE, "agent");
            xb_add(&bar[XB_XGEN(b.x)], 1u);
            asm volatile("s_waitcnt vmcnt(0)" ::: "memory");
        } else {
            XB_SPIN(xb_ld(&bar[XB_XGEN(b.x)]) == gen, bar);
            __builtin_amdgcn_fence(__ATOMIC_ACQUIRE, "agent");
            asm volatile("s_waitcnt vmcnt(0)" ::: "memory");
        }
    }
    __syncthreads();
}

namespace pg8 {
constexpr int BM = 256, BK = 64, HALF = 128, HTB = HALF * BK * 2, STAGE_BYTES = 8 * HTB, NXCD = 8, WGM = 4;
__device__ __forceinline__ int lds_byte(int r, int c) { const int st = (r >> 4) * 2 + (c >> 5), rr = r & 15, cc = c & 31, ob = rr * 64 + cc * 2; return st * 1024 + (ob ^ (((ob >> 9) & 1) << 5)); }
__device__ __forceinline__ void stage_rc(int b, int& R, int& C) { const int st = b / 1024, sb = b % 1024, swz = sb ^ (((sb >> 9) & 1) << 5); R = (st >> 1) * 16 + swz / 64; C = (st & 1) * 32 + (swz % 64) / 2; }
__device__ __forceinline__ int perm32(int rho) { const int n = rho >> 4, i = rho & 15; return 8 * (i >> 2) + 4 * n + (i & 3); }

struct Unit { int pm, pn; unsigned B; int g; int par; };

__device__ __forceinline__ void tile_map(int L, int nM, int nN, int& pm, int& pn, const int WGM = pg8::WGM) {
    const int nwg = nM * nN; int wgid = L;
    { const int q = nwg / NXCD, r = nwg % NXCD, xcd = wgid % NXCD, off = wgid / NXCD; wgid = (xcd < r ? xcd * (q + 1) : r * (q + 1) + (xcd - r) * q) + off; }
    const int nig = WGM * nN, gid = wgid / nig, fm = gid * WGM, gsz = (nM - fm) < WGM ? (nM - fm) : WGM;
    pm = fm + ((wgid % nig) % gsz); pn = (wgid % nig) / gsz;
}

typedef int i32x8 __attribute__((ext_vector_type(8)));
template <bool FP8, class Epi, class Sched>
__device__ __forceinline__ void gemm_phase(LAS unsigned char* lds, const int wid, const char* Abase, const char* Bbase, const int KB, const Sched& S, const Epi& E, const int skew_ticks  ) {
    const int lane = lane_id(), tid = wid * 64 + lane, wr = wid >> 2, wc = wid & 3, fr = lane & 15, fq = lane >> 4;
    const int nt = KB / 128;
    int R0, C0; stage_rc(tid * 16, R0, C0);
    unsigned voffB[2];
#pragma unroll
    for (int i = 0; i < 2; ++i) { const int R = R0 + 64 * i; const int Rb = Epi::PERM ? (Epi::WIDE ? ((R >> 5) * 64 + perm32(R & 31)) : ((R & ~31) + perm32(R & 31))) : R; voffB[i] = (unsigned)(Rb * KB + C0 * 2); }
    const unsigned kstep = (unsigned)(BK * 2);
    const unsigned hstep = (unsigned)(HALF * KB);
    const unsigned hstepB = Epi::WIDE ? (unsigned)(32 * KB) : hstep;
    const __amdgpu_buffer_rsrc_t rsA = __builtin_amdgcn_make_buffer_rsrc((void*)Abase, (short)0, 0x7ffff000, 0x00020000);
    const __amdgpu_buffer_rsrc_t rsB = __builtin_amdgcn_make_buffer_rsrc((void*)Bbase, (short)0, 0x7ffff000, 0x00020000);
    const unsigned ldsw = (unsigned)wid * 1024u;
    const int aoff = lds_byte(wr * 64 + fr, fq * 8), boff = lds_byte(wc * 32 + fr, fq * 8);
#define PG8_SA(b, h) (((b) * 2 + (h)) * HTB)
#define PG8_SB(b, h) ((4 + (b) * 2 + (h)) * HTB)
#define PG8_STAGE(bufoff, soff, voff) do { _Pragma("unroll") for (int _i = 0; _i < 2; ++_i) \
        __builtin_amdgcn_raw_ptr_buffer_load_lds(rsB, (LAS unsigned*)(lds + (bufoff) + ldsw + _i * 8192), 16, (int)(voff)[_i], (int)(soff), 0, 0); } while (0)
#define PG8_STAGE_A(bufoff, o0, o1, soff) do { \
        __builtin_amdgcn_raw_ptr_buffer_load_lds(rsA, (LAS unsigned*)(lds + (bufoff) + ldsw), 16, (int)(o0), (int)(soff), 0, 0); \
        __builtin_amdgcn_raw_ptr_buffer_load_lds(rsA, (LAS unsigned*)(lds + (bufoff) + ldsw + 8192), 16, (int)(o1), (int)(soff), 0, 0); } while (0)
#define PG8_LDA(dst, b, h) do { _Pragma("unroll") for (int m = 0; m < 4; ++m) _Pragma("unroll") for (int k = 0; k < 2; ++k) dst[m][k] = *(const LAS bf16x8*)(lds + PG8_SA(b, h) + aoff + m * 2048 + k * 1024); } while (0)
#define PG8_LDB(dst, b, h) do { _Pragma("unroll") for (int n = 0; n < 2; ++n) _Pragma("unroll") for (int k = 0; k < 2; ++k) dst[n][k] = *(const LAS bf16x8*)(lds + PG8_SB(b, h) + boff + n * 2048 + k * 1024); } while (0)
#define PG8_MMA(ai, bj, At, Bt) do { __builtin_amdgcn_s_setprio(1); \
        if constexpr (FP8) { _Pragma("unroll") for (int m = 0; m < 4; ++m) _Pragma("unroll") for (int n = 0; n < 2; ++n) { \
            const u32x4 _b0 = __builtin_bit_cast(u32x4, Bt[n][0]), _b1 = __builtin_bit_cast(u32x4, Bt[n][1]), _a0 = __builtin_bit_cast(u32x4, At[m][0]), _a1 = __builtin_bit_cast(u32x4, At[m][1]); \
            const i32x8 _bb = {(int)_b0.x, (int)_b0.y, (int)_b0.z, (int)_b0.w, (int)_b1.x, (int)_b1.y, (int)_b1.z, (int)_b1.w}, _aa = {(int)_a0.x, (int)_a0.y, (int)_a0.z, (int)_a0.w, (int)_a1.x, (int)_a1.y, (int)_a1.z, (int)_a1.w}; \
            acc[ai][bj][m][n] = __builtin_amdgcn_mfma_scale_f32_16x16x128_f8f6f4(_bb, _aa, acc[ai][bj][m][n], 0, 0, 0, 0, 0, 0); } } \
        else { _Pragma("unroll") for (int m = 0; m < 4; ++m) _Pragma("unroll") for (int n = 0; n < 2; ++n) _Pragma("unroll") for (int k = 0; k < 2; ++k) \
            acc[ai][bj][m][n] = __builtin_amdgcn_mfma_f32_16x16x32_bf16(Bt[n][k], At[m][k], acc[ai][bj][m][n], 0, 0, 0); } \
        __builtin_amdgcn_s_setprio(0); } while (0)
#define PG8_WAIT_V(n) asm volatile("s_waitcnt vmcnt(" #n ")" ::: "memory")
#define PG8_WAIT_L(n) asm volatile("s_waitcnt lgkmcnt(" #n ")" ::: "memory")
#define PG8_BAR __builtin_amdgcn_s_barrier()
#define PG8_SCHED __builtin_amdgcn_sched_barrier(0)
    Unit cur, nxt; int ui = 0;
    if (!S.next(0, cur)) return;
    if (skew_ticks > 0) { const unsigned long long t0 = __builtin_amdgcn_s_memrealtime(); while (__builtin_amdgcn_s_memrealtime() - t0 < (unsigned long long)skew_ticks) __builtin_amdgcn_s_sleep(8); }
    f32x4 acc[2][2][4][2];
#pragma unroll
    for (int a = 0; a < 2; ++a)
#pragma unroll
        for (int b = 0; b < 2; ++b)
#pragma unroll
            for (int m = 0; m < 4; ++m)
#pragma unroll
                for (int n = 0; n < 2; ++n) acc[a][b][m][n] = (f32x4){0.f, 0.f, 0.f, 0.f};
    bf16x8 At[4][2], B0[2][2], B1[2][2];
    unsigned voffA[2]; voffA[0] = (unsigned)(R0 * KB + C0 * 2); voffA[1] = voffA[0] + (unsigned)(64 * KB);
    unsigned oc00 = 0, oc01 = 0, oc10 = 0, oc11 = 0;
    int nvr = -1;
    __amdgpu_buffer_rsrc_t rsT = rsA;
    if constexpr (Sched::GATHER) rsT = __builtin_amdgcn_make_buffer_rsrc((void*)S.tok_base(), (short)0, 16 * RT_STRIDE * 4, 0x00020000);
    unsigned cA = 0, nA = 0;
    if constexpr (Sched::GATHER) { S.aoff(cur, R0, C0, oc00, oc01, oc10, oc11); asm volatile("" : "+v"(oc00), "+v"(oc01), "+v"(oc10), "+v"(oc11)); }
    else cA = S.abase(cur);
    cur.par = 0;
    if constexpr (Sched::UNIT_DMA) { if (wid == 0) S.unit_dma(cur, lds + STAGE_BYTES, lane); }
#define PG8_STA(bufoff, ptr, h, kb) do { if constexpr (Sched::GATHER) { if ((h) == 0) PG8_STAGE_A(bufoff, oc00, oc01, kb); else PG8_STAGE_A(bufoff, oc10, oc11, kb); } \
        else PG8_STAGE_A(bufoff, voffA[0], voffA[1], (ptr) + (unsigned)(h) * hstep + (unsigned)(kb)); } while (0)
    unsigned cB = cur.B;
    PG8_STAGE(PG8_SB(0, 0), cB, voffB); PG8_STA(PG8_SA(0, 0), cA, 0, 0); PG8_STAGE(PG8_SB(0, 1), cB + hstepB, voffB); PG8_STA(PG8_SA(0, 1), cA, 1, 0);
    if (wr == 1) PG8_BAR;
    PG8_WAIT_V(4); PG8_BAR;
    PG8_STAGE(PG8_SB(1, 0), cB + kstep, voffB); PG8_STA(PG8_SA(1, 0), cA, 0, kstep); PG8_STAGE(PG8_SB(1, 1), cB + hstepB + kstep, voffB);
    PG8_WAIT_V(6); PG8_BAR;
    for (;;) {
        const bool has_next = S.next(ui + 1, nxt); nxt.par = (ui + 1) & 1;
        if constexpr (Sched::GATHER) {
            nvr = has_next ? S.valid_rows(nxt) : -1;
            if (has_next && wid == 0) __builtin_amdgcn_raw_ptr_buffer_load_lds(rsT, (LAS unsigned*)(lds + STAGE_BYTES), 16, lane * 16, (int)S.tokoff(nxt), 0, 0);
        } else nA = has_next ? S.abase(nxt) : cA;
        const unsigned nB = has_next ? nxt.B : cB;
#pragma unroll 1
        for (int t = 0; t < nt; t += 2) {
            const bool last = (t == nt - 2);
            const unsigned k1 = (unsigned)(t + 1) * kstep;
            const unsigned k2 = last ? 0u : (unsigned)(t + 2) * kstep; const unsigned k3 = k2 + kstep;
            const unsigned a2 = last ? nA : cA;
            const unsigned b2 = last ? nB : cB + (unsigned)(t + 2) * kstep; const unsigned b3 = b2 + kstep;
            PG8_LDB(B0, 0, 0); PG8_SCHED; PG8_LDA(At, 0, 0); PG8_STA(PG8_SA(1, 1), cA, 1, k1);
            PG8_WAIT_L(8); PG8_BAR; PG8_WAIT_L(0); PG8_MMA(0, 0, At, B0); PG8_BAR; PG8_SCHED;
            if constexpr (Sched::UNIT_DMA) { if (t == 0 && has_next && wid == 0) S.unit_dma(nxt, lds + STAGE_BYTES, lane); }
            if constexpr (Sched::GATHER) { if (last && nvr >= 0) { const LAS int* lt = (const LAS int*)(lds + STAGE_BYTES);
                const int t00 = R0 < nvr ? lt[R0] : 0, t01 = R0 + 64 < nvr ? lt[R0 + 64] : 0, t10 = R0 + 128 < nvr ? lt[R0 + 128] : 0, t11 = R0 + 192 < nvr ? lt[R0 + 192] : 0;
                oc00 = (unsigned)(t00 * KB + C0 * 2); oc01 = (unsigned)(t01 * KB + C0 * 2); oc10 = (unsigned)(t10 * KB + C0 * 2); oc11 = (unsigned)(t11 * KB + C0 * 2); } }
            PG8_LDB(B1, 0, 1); PG8_STAGE(PG8_SB(0, 0), b2, voffB);
            PG8_BAR; PG8_WAIT_L(0); PG8_MMA(0, 1, At, B1); PG8_BAR;
            PG8_LDA(At, 0, 1); PG8_STA(PG8_SA(0, 0), a2, 0, k2);
            PG8_BAR; PG8_WAIT_L(0); PG8_MMA(1, 0, At, B0); PG8_BAR; PG8_SCHED;
            PG8_STAGE(PG8_SB(0, 1), b2 + hstepB, voffB);
            PG8_WAIT_V(6); PG8_BAR; PG8_MMA(1, 1, At, B1); PG8_BAR;
            PG8_LDB(B0, 1, 0); PG8_SCHED; PG8_LDA(At, 1, 0); PG8_STA(PG8_SA(0, 1), a2, 1, k2);
            PG8_WAIT_L(8); PG8_BAR; PG8_WAIT_L(0); PG8_MMA(0, 0, At, B0); PG8_BAR; PG8_SCHED;
            PG8_LDB(B1, 1, 1); PG8_STAGE(PG8_SB(1, 0), b3, voffB);
            PG8_BAR; PG8_WAIT_L(0); PG8_MMA(0, 1, At, B1); PG8_BAR;
            PG8_LDA(At, 1, 1); PG8_STA(PG8_SA(1, 0), a2, 0, k3);
            PG8_BAR; PG8_WAIT_L(0); PG8_MMA(1, 0, At, B0); PG8_BAR; PG8_SCHED;
            PG8_STAGE(PG8_SB(1, 1), b3 + hstepB, voffB);
            PG8_WAIT_V(6); PG8_BAR; PG8_MMA(1, 1, At, B1); PG8_BAR;
        }
        { const int _l = lane_id(); const int _fr = _l & 15, _fq = _l >> 4;
          E(acc, cur, wr, wc, _fr, _fq); }
        if (!has_next) break;
#pragma unroll
        for (int a = 0; a < 2; ++a)
#pragma unroll
            for (int b = 0; b < 2; ++b)
#pragma unroll
                for (int m = 0; m < 4; ++m)
#pragma unroll
                    for (int n = 0; n < 2; ++n) acc[a][b][m][n] = (f32x4){0.f, 0.f, 0.f, 0.f};
        cur = nxt; cB = nB; cA = nA; ++ui;
    }
    PG8_WAIT_V(0);
    if (wr == 0) PG8_BAR;
    PG8_BAR;
#undef PG8_SA
#undef PG8_SB
#undef PG8_STAGE
#undef PG8_STAGE_A
#undef PG8_STA
#undef PG8_LDA
#undef PG8_LDB
#undef PG8_MMA
#undef PG8_WAIT_V
#undef PG8_WAIT_L
#undef PG8_BAR
#undef PG8_SCHED
}

struct DenseSched {
    static constexpr bool GATHER = false, UNIT_DMA = false;
    int nM, nN, G, c, KB, wgm;
    __device__ __forceinline__ unsigned abase(const Unit& u) const { return (unsigned)(u.pm * 256 * KB); }
    __device__ __forceinline__ bool next(int i, Unit& u) const {
        const long L = (long)i * G + c; if (L >= (long)nM * nN) return false;
        tile_map((int)L, nM, nN, u.pm, u.pn, wgm); u.B = (unsigned)(u.pn * 256 * KB); u.g = 0; return true;
    }
    __device__ __forceinline__ void aoff(const Unit& u, int R0, int C0, unsigned& o00, unsigned& o01, unsigned& o10, unsigned& o11) const {
        const unsigned base = (unsigned)((u.pm * 256 + R0) * KB + C0 * 2), r64 = (unsigned)(64 * KB);
        o00 = base; o01 = base + r64; o10 = base + 2u * r64; o11 = base + 3u * r64;
    }
};
struct InProjL1Sched {
    static constexpr bool GATHER = false, UNIT_DMA = false;
    int G, c;
    __device__ __forceinline__ unsigned abase(const Unit& u) const { return (unsigned)(u.pm * 256 * D * 2); }
    __device__ __forceinline__ bool next(int i, Unit& u) const {
        const int L = i * G + c; if (L >= 3584 + 192) return false;
        if (L < 3584) tile_map(L, 256, 14, u.pm, u.pn);
        else { const int Lc = L - 3584; u.pm = 256 + Lc / 6; u.pn = 6 + Lc % 6; }
        u.B = (unsigned)(u.pn * 256 * D * 2); u.g = 0; return true;
    }
    __device__ __forceinline__ void aoff(const Unit& u, int R0, int C0, unsigned& o00, unsigned& o01, unsigned& o10, unsigned& o11) const {
        const unsigned base = (unsigned)((u.pm * 256 + R0) * D + C0) * 2u, r64 = (unsigned)(64 * D) * 2u;
        o00 = base; o01 = base + r64; o10 = base + 2u * r64; o11 = base + 3u * r64;
    }
};
struct MoeUpSched {
    static constexpr bool GATHER = true, UNIT_DMA = false;
    int G, c; const int* rowtok; const volatile LAS int* tb;
    __device__ __forceinline__ unsigned abase(const Unit&) const { return 0u; }
    __device__ __forceinline__ bool next(int i, Unit& u) const {
        const int T = tb[16]; const int L = i * G + c; if (L >= T * 22) return false;
        tile_map(L, T, 22, u.pm, u.pn, 8); int g = 0;
#pragma unroll
        for (int j = 1; j < 16; ++j) g += (u.pm >= tb[j]) ? 1 : 0;
        u.g = g; u.B = (unsigned)(((g & 7) * 5632 + u.pn * 256) * D); return true;
    }
    __device__ __forceinline__ const int* tok_base() const { return rowtok; }
    __device__ __forceinline__ unsigned tokoff(const Unit& u) const { return (unsigned)((u.g * RT_STRIDE + (u.pm - tb[u.g]) * 256) * 4); }
    __device__ __forceinline__ int valid_rows(const Unit& u) const { return tb[32 + u.g] - (u.pm - tb[u.g]) * 256; }
    __device__ __forceinline__ void aoff(const Unit& u, int R0, int C0, unsigned& o00, unsigned& o01, unsigned& o10, unsigned& o11) const {
        const int s0 = (u.pm - tb[u.g]) * 256 + R0, cnt = tb[32 + u.g]; const int* rt = rowtok + (size_t)u.g * RT_STRIDE;
        const int t00 = s0 < cnt ? rt[s0] : 0, t01 = s0 + 64 < cnt ? rt[s0 + 64] : 0, t10 = s0 + 128 < cnt ? rt[s0 + 128] : 0, t11 = s0 + 192 < cnt ? rt[s0 + 192] : 0;
        o00 = (unsigned)(t00 * D + C0 * 2); o01 = (unsigned)(t01 * D + C0 * 2); o10 = (unsigned)(t10 * D + C0 * 2); o11 = (unsigned)(t11 * D + C0 * 2);
    }
};
struct MoeDownSched {
    static constexpr bool GATHER = false, UNIT_DMA = true;
    int G, c; const volatile LAS int* tb; const int* rowtok; const float* rowgate;
    __device__ __forceinline__ unsigned abase(const Unit& u) const { return (unsigned)(u.pm * 256 * DFF); }
    __device__ __forceinline__ void unit_dma(const Unit& u, LAS unsigned char* side, int lane) const {
        const __amdgpu_buffer_rsrc_t rt = __builtin_amdgcn_make_buffer_rsrc((void*)rowtok, (short)0, 16 * RT_STRIDE * 4, 0x00020000);
        const __amdgpu_buffer_rsrc_t rg = __builtin_amdgcn_make_buffer_rsrc((void*)rowgate, (short)0, 16 * RT_STRIDE * 4, 0x00020000);
        const int off = (u.g * RT_STRIDE + (u.pm - tb[u.g]) * 256) * 4;
        __builtin_amdgcn_raw_ptr_buffer_load_lds(rt, (LAS unsigned*)(side + u.par * 2048), 16, lane * 16, off, 0, 0);
        __builtin_amdgcn_raw_ptr_buffer_load_lds(rg, (LAS unsigned*)(side + u.par * 2048 + 1024), 16, lane * 16, off, 0, 0);
    }
    __device__ __forceinline__ bool next(int i, Unit& u) const {
        const int T = tb[16]; const int L = i * G + c; if (L >= T * 4) return false;
        tile_map(L, T, 4, u.pm, u.pn); int g = 0;
#pragma unroll
        for (int j = 1; j < 16; ++j) g += (u.pm >= tb[j]) ? 1 : 0;
        u.g = g; u.B = (unsigned)(((g & 7) * D + u.pn * 256) * DFF); return true;
    }
};

struct EpiProj {
    static constexpr bool PERM = true, WIDE = true;
    bf16_t* P; bool dry;
    __device__ __forceinline__ void operator()(const f32x4 (&acc)[2][2][4][2], const Unit& u, int wr, int wc, int fr, int fq) const {
        if (dry) {
#pragma unroll
            for (int ai = 0; ai < 2; ++ai)
#pragma unroll
                for (int bj = 0; bj < 2; ++bj)
#pragma unroll
                    for (int m = 0; m < 4; ++m) asm volatile("" :: "v"(acc[ai][bj][m][0]), "v"(acc[ai][bj][m][1]));
            return; }
        const int row0 = u.pm * BM + wr * 64 + fr;
        if (u.pn >= 2 && u.pn < 6) {
            const int col0 = 512 + (u.pn - 2) * HALF + wc * 32 + 8 * fq;
#pragma unroll
            for (int ai = 0; ai < 2; ++ai)
#pragma unroll
                for (int m = 0; m < 4; ++m) { const f32x4 z0 = acc[ai][0][m][0] * acc[ai][1][m][0], z1 = acc[ai][0][m][1] * acc[ai][1][m][1];
                    u32x4 w; w.x = cvt_pk_bf16(z0[0], z0[1]); w.y = cvt_pk_bf16(z0[2], z0[3]); w.z = cvt_pk_bf16(z1[0], z1[1]); w.w = cvt_pk_bf16(z1[2], z1[3]);
                    *(u32x4*)(P + (size_t)(row0 + ai * HALF + m * 16) * NPO + col0) = w; }
            return; }
        const int colb = (u.pn < 2 ? u.pn * BM : u.pn * BM - 512) + wc * 64 + (fr < 8 ? 0 : 32) + 8 * fq; const bool lo = fr < 8;
#pragma unroll
        for (int ai = 0; ai < 2; ++ai)
#pragma unroll
            for (int m = 0; m < 4; ++m) { u32x4 a, b;
                { const f32x4 v0 = acc[ai][0][m][0], v1 = acc[ai][0][m][1]; a.x = cvt_pk_bf16(v0[0], v0[1]); a.y = cvt_pk_bf16(v0[2], v0[3]); a.z = cvt_pk_bf16(v1[0], v1[1]); a.w = cvt_pk_bf16(v1[2], v1[3]); }
                { const f32x4 v0 = acc[ai][1][m][0], v1 = acc[ai][1][m][1]; b.x = cvt_pk_bf16(v0[0], v0[1]); b.y = cvt_pk_bf16(v0[2], v0[3]); b.z = cvt_pk_bf16(v1[0], v1[1]); b.w = cvt_pk_bf16(v1[2], v1[3]); }
                u32x4 x = lo ? b : a, y;
                y.x = (unsigned)__builtin_amdgcn_update_dpp(0, (int)x.x, 0x128, 0xf, 0xf, false); y.y = (unsigned)__builtin_amdgcn_update_dpp(0, (int)x.y, 0x128, 0xf, 0xf, false);
                y.z = (unsigned)__builtin_amdgcn_update_dpp(0, (int)x.z, 0x128, 0xf, 0xf, false); y.w = (unsigned)__builtin_amdgcn_update_dpp(0, (int)x.w, 0x128, 0xf, 0xf, false);
                const u32x4 first = lo ? a : y, second = lo ? y : b;
                bf16_t* rowp = P + (size_t)(u.pm * BM + wr * 64 + ai * HALF + m * 16 + (fr & 7)) * NPO + colb;
                *(u32x4*)rowp = first; *(u32x4*)(rowp + (size_t)8 * NPO) = second; }
    }
};
struct EpiResid {
    static constexpr bool PERM = true, WIDE = true;
    bf16_t* HB; const float* gate; float gscale;
    __device__ __forceinline__ void operator()(const f32x4 (&acc)[2][2][4][2], const Unit& u, int wr, int wc, int fr, int fq) const {
        if (PROBE_DRY && gscale == 0.f) {
#pragma unroll
            for (int ai = 0; ai < 2; ++ai)
#pragma unroll
                for (int bj = 0; bj < 2; ++bj)
#pragma unroll
                    for (int m = 0; m < 4; ++m) asm volatile("" :: "v"(acc[ai][bj][m][0]), "v"(acc[ai][bj][m][1]));
            return; }
        const int rowg = u.pm * BM; const bool isc = rowg >= NL;
        const int bidx = isc ? 32 : (rowg >> 11);
        const bool lo = fr < 8;
        const int colw = u.pn * BM + wc * 64 + 8 * fq;
        const float* gv = gate + (size_t)bidx * 6144 + colw;
        bf16_t* out = HB + (size_t)(rowg + wr * 64 + (fr & 7)) * D + colw + (lo ? 0 : 32);
        u32x4 r[2][4][2];
#pragma unroll
        for (int ai = 0; ai < 2; ++ai)
#pragma unroll
            for (int m = 0; m < 4; ++m)
#pragma unroll
                for (int h = 0; h < 2; ++h) r[ai][m][h] = *(const u32x4*)(out + (size_t)(ai * HALF + m * 16 + 8 * h) * D);
        f32x4 g[2][2];
#pragma unroll
        for (int bj = 0; bj < 2; ++bj)
#pragma unroll
            for (int n = 0; n < 2; ++n) g[bj][n] = *(const f32x4*)(gv + bj * 32 + n * 4) * gscale;
#pragma unroll
        for (int ai = 0; ai < 2; ++ai)
#pragma unroll
            for (int m = 0; m < 4; ++m) {
                const f32x4 a0 = g[0][0] * acc[ai][0][m][0], a1 = g[0][1] * acc[ai][0][m][1], b0 = g[1][0] * acc[ai][1][m][0], b1 = g[1][1] * acc[ai][1][m][1];
                float x[8], y[8];
#pragma unroll
                for (int i = 0; i < 4; ++i) { x[i] = lo ? b0[i] : a0[i]; x[4 + i] = lo ? b1[i] : a1[i]; }
#pragma unroll
                for (int i = 0; i < 8; ++i) y[i] = __builtin_bit_cast(float, __builtin_amdgcn_update_dpp(0, __builtin_bit_cast(int, x[i]), 0x128, 0xf, 0xf, false));
                float f[8], s2[8];
#pragma unroll
                for (int i = 0; i < 4; ++i) { f[i] = lo ? a0[i] : y[i]; f[4 + i] = lo ? a1[i] : y[4 + i]; s2[i] = lo ? y[i] : b0[i]; s2[4 + i] = lo ? y[4 + i] : b1[i]; }
#pragma unroll
                for (int h = 0; h < 2; ++h) { const u32x4 rr = r[ai][m][h]; const float* v = h ? s2 : f;
                    u32x4 w; w.x = cvt_pk_bf16(bflo(rr.x) + v[0], bfhi(rr.x) + v[1]); w.y = cvt_pk_bf16(bflo(rr.y) + v[2], bfhi(rr.y) + v[3]);
                    w.z = cvt_pk_bf16(bflo(rr.z) + v[4], bfhi(rr.z) + v[5]); w.w = cvt_pk_bf16(bflo(rr.w) + v[6], bfhi(rr.w) + v[7]);
                    *(u32x4*)(out + (size_t)(ai * HALF + m * 16 + 8 * h) * D) = w; } }
    }
};
__device__ __forceinline__ float clamp448(float x) { return fminf(fmaxf(x, -448.0f), 448.0f); }
struct EpiSwiglu {
    static constexpr bool PERM = true, WIDE = false;
    unsigned char* ACT; float iscale, oscale;
    __device__ __forceinline__ void operator()(const f32x4 (&acc)[2][2][4][2], const Unit& u, int wr, int wc, int fr, int fq) const {
        if (PROBE_DRY && oscale == 0.f) {
#pragma unroll
            for (int ai = 0; ai < 2; ++ai)
#pragma unroll
                for (int bj = 0; bj < 2; ++bj)
#pragma unroll
                    for (int m = 0; m < 4; ++m) asm volatile("" :: "v"(acc[ai][bj][m][0]), "v"(acc[ai][bj][m][1]));
            return; }
        const int row0 = u.pm * BM + wr * 64 + fr, col0 = u.pn * HALF + wc * 32 + 8 * fq;
        const float c1 = -1.4426950408889634f * iscale, kk = oscale == 0.f ? 1.0e30f : 1.0f / (iscale * iscale * oscale);
#pragma unroll
        for (int ai = 0; ai < 2; ++ai)
#pragma unroll
            for (int m = 0; m < 4; ++m) { unsigned char* rowp = ACT + (size_t)(row0 + ai * HALF + m * 16) * DFF + col0;
                float o[8];
#pragma unroll
                for (int n = 0; n < 2; ++n)
#pragma unroll
                    for (int h2 = 0; h2 < 2; ++h2) {
                        const f32x2 a = {acc[ai][0][m][n][2 * h2], acc[ai][0][m][n][2 * h2 + 1]}, b = {acc[ai][1][m][n][2 * h2], acc[ai][1][m][n][2 * h2 + 1]};
                        const f32x2 t = a * c1; f32x2 e; e.x = __builtin_amdgcn_exp2f(t.x); e.y = __builtin_amdgcn_exp2f(t.y);
                        const f32x2 d = e * kk + kk; f32x2 r; r.x = __builtin_amdgcn_rcpf(d.x); r.y = __builtin_amdgcn_rcpf(d.y);
                        const f32x2 p = (a * b) * r;
                        o[n * 4 + 2 * h2] = __builtin_amdgcn_fmed3f(p.x, -448.0f, 448.0f); o[n * 4 + 2 * h2 + 1] = __builtin_amdgcn_fmed3f(p.y, -448.0f, 448.0f); }
                int w0 = 0, w1 = 0;
                w0 = __builtin_amdgcn_cvt_pk_fp8_f32(o[0], o[1], w0, false); w0 = __builtin_amdgcn_cvt_pk_fp8_f32(o[2], o[3], w0, true);
                w1 = __builtin_amdgcn_cvt_pk_fp8_f32(o[4], o[5], w1, false); w1 = __builtin_amdgcn_cvt_pk_fp8_f32(o[6], o[7], w1, true);
                *(u32x2*)rowp = (u32x2){(unsigned)w0, (unsigned)w1}; }
    }
};
struct EpiMoeDown {
    static constexpr bool PERM = true, WIDE = false;
    unsigned char* Y0; unsigned char* Y1; const LAS unsigned char* side; const volatile LAS int* tb; float gscale;
    __device__ __forceinline__ void operator()(const f32x4 (&acc)[2][2][4][2], const Unit& u, int wr, int wc, int fr, int fq) const {
        const int nv = tb[32 + u.g] - (u.pm - tb[u.g]) * 256;
        const LAS int* lt = (const LAS int*)(side + u.par * 2048); const LAS float* lg = (const LAS float*)(side + u.par * 2048 + 1024);
        unsigned char* Y = u.g < 8 ? Y0 : Y1;
        const int col0 = u.pn * BM + wc * 32 + 8 * fq;
        int tok[2][4]; float gt[2][4]; bool ok[2][4];
#pragma unroll
        for (int ai = 0; ai < 2; ++ai)
#pragma unroll
            for (int m = 0; m < 4; ++m) { const int rl = ai * HALF + wr * 64 + m * 16 + fr; ok[ai][m] = rl < nv; const int tk = lt[rl]; const float gg = lg[rl]; tok[ai][m] = ok[ai][m] ? tk : 0; gt[ai][m] = ok[ai][m] ? gg * gscale : 0.f; }
#pragma unroll
        for (int ai = 0; ai < 2; ++ai)
#pragma unroll
            for (int m = 0; m < 4; ++m) if (ok[ai][m]) { unsigned char* yp = Y + (size_t)tok[ai][m] * D + col0; const float gg = gt[ai][m];
#pragma unroll
                for (int bj = 0; bj < 2; ++bj) { const f32x4 a0 = acc[ai][bj][m][0] * gg, a1 = acc[ai][bj][m][1] * gg; int w0 = 0, w1 = 0;
                    w0 = __builtin_amdgcn_cvt_pk_fp8_f32(clamp448(a0[0]), clamp448(a0[1]), w0, false); w0 = __builtin_amdgcn_cvt_pk_fp8_f32(clamp448(a0[2]), clamp448(a0[3]), w0, true);
                    w1 = __builtin_amdgcn_cvt_pk_fp8_f32(clamp448(a1[0]), clamp448(a1[1]), w1, false); w1 = __builtin_amdgcn_cvt_pk_fp8_f32(clamp448(a1[2]), clamp448(a1[3]), w1, true);
                    *(u32x2*)(yp + bj * HALF) = (u32x2){(unsigned)w0, (unsigned)w1}; } }
    }
};
}

struct Args { const float* in[21]; float* out; unsigned char* ws; int lo, hi; };
enum { I_X = 0, I_C, I_CTX, I_CCTX, I_N1G, I_N2G, I_WADA, I_BADA, I_WIN, I_CONVW, I_BG, I_MNG, I_WOUT, I_FW1, I_FW3, I_FW2, I_ROUTER, I_MW1, I_MW3, I_MW2, I_FNG };

struct Frame { LAS unsigned char* lds; int wid, G, wg;
    __device__ __forceinline__ int lane() const { return lane_id(); }
    __device__ __forceinline__ int tid() const { return wid * 64 + lane_id(); } };
typedef const __attribute__((address_space(4))) Args* KArgs;
#define KA() ({ KArgs _k = (KArgs)__builtin_amdgcn_kernarg_segment_ptr(); asm volatile("" : "+s"(_k)); _k; })

__device__ __forceinline__ int conv_row(int mode, int n, float& scale) {
    scale = 1.f;
    if (mode == 0) return n;
    if (mode == 1) { if (n >= 2048 && n < 2560) scale = 0.08838834764831845f;
        if (n >= 512 && n < 1024) { const int j = n - 512; return (2 + (j >> 7)) * 256 + ((j & 127) >> 5) * 64 + (j & 31); }
        if (n >= 1024 && n < 1536) { const int j = n - 1024; return (2 + (j >> 7)) * 256 + ((j & 127) >> 5) * 64 + 32 + (j & 31); }
        if (n < 3072) return n; if (n < 3088) return 3584 + (n - 3072); return n - 16; }
    return (n >> 7) * 256 + (n & 127) + (mode == 3 ? 128 : 0);
}
__device__ __forceinline__ void conv_tiles(const Frame& F, const float* src, bf16_t* dst, int K, int N, int mode, float fp8scale  , int& gbase) {
    const int lane = F.lane();
    LAS float* tile = (LAS float*)(F.lds + F.wid * (64 * 65 * 4 + 64));
    const int GW = F.G * 8, gw = F.wg * 8 + F.wid;
    const int tn = (N + 63) / 64, ntile = (K / 64) * tn;
    int t = (gw - gbase) % GW; if (t < 0) t += GW;
    const int row = lane >> 4, c4 = (lane & 15) * 4;
    for (; t < ntile; t += GW) {
        const int k0 = (t / tn) * 64, n0 = (t % tn) * 64;
        f32x4 v[16];
#pragma unroll
        for (int i = 0; i < 16; ++i) { v[i] = (f32x4){0.f, 0.f, 0.f, 0.f}; if (n0 + c4 < N) v[i] = *(const f32x4*)(src + (size_t)(k0 + row + 4 * i) * N + n0 + c4); }
#pragma unroll
        for (int i = 0; i < 16; ++i) { LAS float* p = tile + (row + 4 * i) * 65 + c4; p[0] = v[i][0]; p[1] = v[i][1]; p[2] = v[i][2]; p[3] = v[i][3]; }
        asm volatile("s_waitcnt lgkmcnt(0)" ::: "memory");
#pragma unroll
        for (int p = 0; p < 8; ++p) { const int n = (lane >> 3) + 8 * p, kc = (lane & 7) * 8;
            if (n0 + n < N) { float sc; const int drow = conv_row(mode, n0 + n, sc); float x[8];
#pragma unroll
                for (int j = 0; j < 8; ++j) x[j] = tile[(kc + j) * 65 + n] * sc;
                if (fp8scale == 0.f) {
                    u32x4 w; w.x = cvt_pk_bf16(x[0], x[1]); w.y = cvt_pk_bf16(x[2], x[3]); w.z = cvt_pk_bf16(x[4], x[5]); w.w = cvt_pk_bf16(x[6], x[7]);
                    *(u32x4*)(dst + (size_t)drow * K + k0 + kc) = w;
                } else {
#pragma unroll
                    for (int j = 0; j < 8; ++j) x[j] = fminf(fmaxf(x[j] * fp8scale, -448.0f), 448.0f);
                    int w0 = 0, w1 = 0;
                    w0 = __builtin_amdgcn_cvt_pk_fp8_f32(x[0], x[1], w0, false); w0 = __builtin_amdgcn_cvt_pk_fp8_f32(x[2], x[3], w0, true);
                    w1 = __builtin_amdgcn_cvt_pk_fp8_f32(x[4], x[5], w1, false); w1 = __builtin_amdgcn_cvt_pk_fp8_f32(x[6], x[7], w1, true);
                    *(u32x2*)((unsigned char*)dst + (size_t)drow * K + k0 + kc) = (u32x2){(unsigned)w0, (unsigned)w1};
                } } }
        asm volatile("s_waitcnt lgkmcnt(0)" ::: "memory");
    }
    gbase = (gbase + ntile) % GW;
}
constexpr int P0_JOBS = 19;
__device__ __forceinline__ void conv_job(const Frame& F, int j, int& gbase) {
    KArgs ka = KA(); unsigned char* const ws = ka->ws;
    const float* src; bf16_t* dst; int K, N, mode; float f8 = 0.f;
    if (j < 2)       { src = ka->in[I_WIN] + (size_t)j * D * PIN; dst = (bf16_t*)(ws + WS_WIN) + (size_t)j * NPAD * D; K = D; N = PIN; mode = 1; }
    else if (j < 4)  { src = ka->in[I_WOUT] + (size_t)(j - 2) * D * D; dst = (bf16_t*)(ws + WS_WOUT) + (size_t)(j - 2) * D * D; K = D; N = D; mode = 0; }
    else if (j == 4) { src = ka->in[I_FW1]; dst = (bf16_t*)(ws + WS_WUP); K = D; N = DFF; mode = 2; f8 = S_W13; }
    else if (j == 5) { src = ka->in[I_FW3]; dst = (bf16_t*)(ws + WS_WUP); K = D; N = DFF; mode = 3; f8 = S_W13; }
    else if (j == 6) { src = ka->in[I_FW2]; dst = (bf16_t*)(ws + WS_WDN); K = DFF; N = D; mode = 0; f8 = S_W2; }
    else if (j < 15) { const int e = j - 7;  src = ka->in[I_MW1] + (size_t)e * D * DFF; dst = (bf16_t*)(ws + WS_MUP + (size_t)e * 2 * DFF * D); K = D; N = DFF; mode = 2; f8 = S_W13; }
    else if (j < 23) { const int e = j - 15; src = ka->in[I_MW3] + (size_t)e * D * DFF; dst = (bf16_t*)(ws + WS_MUP + (size_t)e * 2 * DFF * D); K = D; N = DFF; mode = 3; f8 = S_W13; }
    else             { const int e = j - 23; src = ka->in[I_MW2] + (size_t)e * DFF * D; dst = (bf16_t*)(ws + WS_MDN + (size_t)e * D * DFF); K = DFF; N = D; mode = 0; f8 = S_W2; }
    conv_tiles(F, src, dst, K, N, mode, f8, gbase);
}
__device__ __forceinline__ void p0_prologue(const Frame& F, int skip  ) {
    const int tid = F.tid(); KArgs ka = KA(); unsigned char* const ws = ka->ws;
    if (F.wg < 192 && !(skip & 1)) {
        constexpr int SP = 2080;
        for (int idx = tid; idx < 48 * 512; idx += 512) { const int b = idx >> 9, k2 = (idx & 511) * 2; float v0 = 0.f, v1 = 0.f;
            if (b < 33) { const float* cp = b < 32 ? ka->in[I_C] + b * 1024 : ka->in[I_CCTX]; v0 = cp[k2]; v1 = cp[k2 + 1]; v0 = v0 / (1.0f + __expf(-v0)); v1 = v1 / (1.0f + __expf(-v1)); }
            *(LAS unsigned*)(F.lds + b * SP + k2 * 2) = cvt_pk_bf16(v0, v1); }
        __syncthreads();
        const int layer = F.wg / 96, col0 = (F.wg % 96) * 64, g = F.wid;
        const int gl = F.lane(), gfr = gl & 15, gfq = gl >> 4;
        const float* Wu = ka->in[I_WADA] + (size_t)layer * 1024 * 6144 + col0 + (size_t)(g * 128) * 6144;
        const unsigned loff = (unsigned)(gfr + 8 * gfq * 6144);
        float wv[4][4][8];
#pragma unroll
        for (int ks = 0; ks < 4; ++ks)
#pragma unroll
            for (int nt = 0; nt < 4; ++nt)
#pragma unroll
                for (int j = 0; j < 8; ++j) wv[ks][nt][j] = (Wu + (size_t)(32 * ks + j) * 6144 + 16 * nt)[loff];
        f32x4 acc[4][3];
#pragma unroll
        for (int nt = 0; nt < 4; ++nt)
#pragma unroll
            for (int bt = 0; bt < 3; ++bt) acc[nt][bt] = (f32x4){0.f, 0.f, 0.f, 0.f};
#pragma unroll
        for (int ks = 0; ks < 4; ++ks) {
            bf16x8 Bf[3];
#pragma unroll
            for (int bt = 0; bt < 3; ++bt) Bf[bt] = *(const LAS bf16x8*)(F.lds + (16 * bt + gfr) * SP + (g * 128 + 32 * ks + 8 * gfq) * 2);
#pragma unroll
            for (int nt = 0; nt < 4; ++nt) {
                u32x4 aw; aw.x = cvt_pk_bf16(wv[ks][nt][0], wv[ks][nt][1]); aw.y = cvt_pk_bf16(wv[ks][nt][2], wv[ks][nt][3]); aw.z = cvt_pk_bf16(wv[ks][nt][4], wv[ks][nt][5]); aw.w = cvt_pk_bf16(wv[ks][nt][6], wv[ks][nt][7]);
                const bf16x8 Af = __builtin_bit_cast(bf16x8, aw);
#pragma unroll
                for (int bt = 0; bt < 3; ++bt) acc[nt][bt] = __builtin_amdgcn_mfma_f32_16x16x32_bf16(Af, Bf[bt], acc[nt][bt], 0, 0, 0);
            }
        }
        __syncthreads();
        LAS float* red = (LAS float*)F.lds;
#pragma unroll
        for (int nt = 0; nt < 4; ++nt)
#pragma unroll
            for (int bt = 0; bt < 3; ++bt) { const int b = 16 * bt + gfr;
                if (b < 33) {
#pragma unroll
                    for (int r = 0; r < 4; ++r) red[(g * 33 + b) * 64 + 16 * nt + 4 * gfq + r] = acc[nt][bt][r]; } }
        __syncthreads();
        float* MOD = (float*)(ws + WS_MOD); const float* bada = ka->in[I_BADA];
        for (int idx = tid; idx < 33 * 64; idx += 512) { const int b = idx >> 6, cc = idx & 63; float sum = 0.f;
#pragma unroll
            for (int gg = 0; gg < 8; ++gg) sum += red[(gg * 33 + b) * 64 + cc];
            MOD[((size_t)layer * 33 + b) * 6144 + col0 + cc] = sum + bada[layer * 6144 + col0 + cc]; }
        __syncthreads();
    }
    { bf16_t* WIN = (bf16_t*)(ws + WS_WIN);
      for (int l = 0; l < 2; ++l) { u32x4* p = (u32x4*)(WIN + ((size_t)l * NPAD + PIN) * D); const int n16 = (NPAD - PIN) * D * 2 / 16;
          for (int i = F.wg * 512 + tid; i < n16; i += F.G * 512) p[i] = (u32x4){0u, 0u, 0u, 0u}; } }
    int gbase = 0;
    for (int j = 0; j < ((skip & 2) ? 0 : P0_JOBS); ++j) conv_job(F, j, gbase);
}
__device__ __forceinline__ void tail_convert(const Frame& F, int ntiles, int j0, int j1) {
    const int rem = ntiles % F.G; if (F.wg < rem) return;
    Frame F2 = F; F2.G = F.G - rem; F2.wg = F.wg - rem;
    int gbase = 0;
    for (int j = j0; j < j1; ++j) conv_job(F2, j, gbase);
}

template <bool ROUTER, bool OUT8, bool SRC16, bool GATES>
__device__ __forceinline__ void norm_phase(const Frame& F, const float* srcL, const float* srcC  , int nrows, const float* gain, const float* mod  , int chunk_shift, bf16_t* U, const float* router,
                                           const bf16_t* Wg = nullptr, const float* bgate = nullptr, float* GT = nullptr, bf16_t* HBcopy = nullptr  ) {
    const int lane = F.lane(), wid = F.wid, tid = F.tid();
    constexpr int WG_RB = 2080;
    if constexpr (GATES) {
        for (int i = tid; i < 16 * 128; i += 512) { const int n = i >> 7, ch = i & 127; *(LAS u32x4*)(F.lds + n * WG_RB + ch * 16) = *(const u32x4*)(Wg + (size_t)n * D + ch * 8); }
        __syncthreads();
    }
    const int rpw = (nrows + F.G * 8 - 1) / (F.G * 8);
    const int rbase = (F.wg * 8 + wid) * rpw;
    LAS float* rl = (LAS float*)F.lds;
    LAS int* cntl = (LAS int*)(F.lds + 32768);
    LAS int* sel = (LAS int*)(F.lds + 32768 + 256);
    f32x4 rw[ROUTER ? 16 : 1][2];
    if (ROUTER) {
#pragma unroll
        for (int j = 0; j < 4; ++j)
#pragma unroll
            for (int i = 0; i < 4; ++i) { const float* rp = router + (size_t)(j * 256 + lane * 4 + i) * 8; rw[j * 4 + i][0] = *(const f32x4*)rp; rw[j * 4 + i][1] = *(const f32x4*)(rp + 4); }
        if (tid < 32) cntl[tid] = 0;
        __syncthreads();
    }
    f32x4 gn[4];
#pragma unroll
    for (int j = 0; j < 4; ++j) gn[j] = *(const f32x4*)(gain + j * 256 + lane * 4);
    typedef typename std::conditional<SRC16, u32x2, f32x4>::type raw_t;
    constexpr int NB4 = 4;
#define NP_LOAD(dst, row) do { const int _r = (row); _Pragma("unroll") for (int _j = 0; _j < 4; ++_j) { \
        if constexpr (SRC16) dst[_j] = *(const raw_t*)((const bf16_t*)srcL + (size_t)_r * D + _j * 256 + lane * 4); \
        else dst[_j] = *(const raw_t*)((_r >= NL ? srcC + (size_t)(_r - NL) * D : srcL + (size_t)_r * D) + _j * 256 + lane * 4); } } while (0)
    int cur_b = -1; f32x4 shv[4], scv[4];
#pragma unroll
    for (int j = 0; j < 4; ++j) { shv[j] = (f32x4){0.f, 0.f, 0.f, 0.f}; scv[j] = shv[j]; }
    for (int rr0 = 0; rr0 < rpw; rr0 += NB4) {
      if (rbase + rr0 >= nrows) break;
      { const int r = rbase + rr0; const int bidx = (r >= NL) ? 32 : (r >> 11);
        if (bidx != cur_b) { cur_b = bidx; const float* mv = mod + (size_t)bidx * 6144 + chunk_shift * 1024;
#pragma unroll
            for (int j = 0; j < 4; ++j) { shv[j] = *(const f32x4*)(mv + j * 256 + lane * 4); scv[j] = *(const f32x4*)(mv + 1024 + j * 256 + lane * 4) + 1.0f; }
#pragma unroll
            for (int j = 0; j < 4; ++j) asm volatile("" : "+v"(shv[j]), "+v"(scv[j])); } }
      raw_t bt[NB4][4];
#pragma unroll
      for (int q = 0; q < NB4; ++q) { int rl = rbase + rr0 + q; rl = rl < nrows ? rl : nrows - 1; NP_LOAD(bt[q], rl); }
#pragma unroll
      for (int q = 0; q < NB4; ++q) {
        const int rr = rr0 + q; const int r = rbase + rr; if (rr >= rpw || r >= nrows) continue;
        raw_t cr[4];
#pragma unroll
        for (int j = 0; j < 4; ++j) cr[j] = bt[q][j];
        f32x4 x[4]; float ss = 0.f;
#pragma unroll
        for (int j = 0; j < 4; ++j) {
            if constexpr (SRC16) { const u32x2 w = cr[j]; x[j] = (f32x4){bflo(w.x), bfhi(w.x), bflo(w.y), bfhi(w.y)}; }
            else { x[j] = cr[j];
                if (HBcopy) { u32x2 w; w.x = cvt_pk_bf16(x[j][0], x[j][1]); w.y = cvt_pk_bf16(x[j][2], x[j][3]); *(u32x2*)(HBcopy + (size_t)r * D + j * 256 + lane * 4) = w; } }
            ss += x[j][0] * x[j][0] + x[j][1] * x[j][1] + x[j][2] * x[j][2] + x[j][3] * x[j][3]; }
        ss = wave_sum(ss);
        const float rstd = rsqrtf(ss * (1.0f / 1024.0f) + EPS);
        float lg[8];
        if (ROUTER) {
#pragma unroll
            for (int e = 0; e < 8; ++e) lg[e] = 0.f;
        }
#pragma unroll
        for (int j = 0; j < 4; ++j) {
            f32x4 u = (x[j] * rstd * gn[j]) * scv[j] + shv[j];
            if (OUT8) { int w8 = 0; w8 = __builtin_amdgcn_cvt_pk_fp8_f32(fminf(fmaxf(u[0] * S_A, -448.f), 448.f), fminf(fmaxf(u[1] * S_A, -448.f), 448.f), w8, false);
                w8 = __builtin_amdgcn_cvt_pk_fp8_f32(fminf(fmaxf(u[2] * S_A, -448.f), 448.f), fminf(fmaxf(u[3] * S_A, -448.f), 448.f), w8, true);
                *(int*)((unsigned char*)U + (size_t)r * D + j * 256 + lane * 4) = w8; }
            else { u32x2 w; w.x = cvt_pk_bf16(u[0], u[1]); w.y = cvt_pk_bf16(u[2], u[3]);
                *(u32x2*)(U + (size_t)r * D + j * 256 + lane * 4) = w; }
            if (ROUTER) {
#pragma unroll
                for (int i = 0; i < 4; ++i) { const f32x4 r0 = rw[ROUTER ? j * 4 + i : 0][0], r1 = rw[ROUTER ? j * 4 + i : 0][1];
                    lg[0] += u[i] * r0[0]; lg[1] += u[i] * r0[1]; lg[2] += u[i] * r0[2]; lg[3] += u[i] * r0[3];
                    lg[4] += u[i] * r1[0]; lg[5] += u[i] * r1[1]; lg[6] += u[i] * r1[2]; lg[7] += u[i] * r1[3]; }
            }
        }
        if (ROUTER) {
            { const bool h5 = (lane & 32) != 0, h4 = (lane & 16) != 0, h3 = (lane & 8) != 0;
              float a4[4], a2[2], a1;
#pragma unroll
              for (int q = 0; q < 4; ++q) { const float keep = h5 ? lg[4 + q] : lg[q], send = h5 ? lg[q] : lg[4 + q]; a4[q] = keep + __shfl_xor(send, 32); }
#pragma unroll
              for (int q = 0; q < 2; ++q) { const float keep = h4 ? a4[2 + q] : a4[q], send = h4 ? a4[q] : a4[2 + q]; a2[q] = keep + __shfl_xor(send, 16); }
              { const float keep = h3 ? a2[1] : a2[0], send = h3 ? a2[0] : a2[1]; a1 = keep + __shfl_xor(send, 8); }
              a1 += __shfl_xor(a1, 4); a1 += __shfl_xor(a1, 2); a1 += __shfl_xor(a1, 1);
#pragma unroll
              for (int e = 0; e < 8; ++e) lg[e] = __shfl(a1, ((e >> 2) & 1) * 32 + ((e >> 1) & 1) * 16 + (e & 1) * 8); }
            int e0 = 0; float v0 = lg[0];
#pragma unroll
            for (int e = 1; e < 8; ++e) if (lg[e] > v0) { v0 = lg[e]; e0 = e; }
            int e1 = -1; float v1 = -3.0e38f;
#pragma unroll
            for (int e = 0; e < 8; ++e) if (e != e0 && lg[e] > v1) { v1 = lg[e]; e1 = e; }
            if (lane == 0) {
                const float g0 = 1.0f / (1.0f + __expf(v1 - v0)), g1 = 1.0f - g0;
                const int r0 = atomicAdd((int*)(cntl + e0), 1), r1 = atomicAdd((int*)(cntl + 8 + e1), 1);
                LAS int* sp = sel + (wid * rpw + rr) * 6;
                sp[0] = e0 | (e1 << 8); sp[1] = r0; sp[2] = r1; sp[3] = __float_as_int(g0); sp[4] = __float_as_int(g1); sp[5] = r;
            }
        }
      }
    }
    if constexpr (GATES) {
        asm volatile("s_waitcnt vmcnt(0)" ::: "memory");
        const int fr = lane & 15, fq = lane >> 4;
        int nr = nrows - rbase; nr = nr < 0 ? 0 : (nr > rpw ? rpw : nr);
        const f32x4 bias = *(const f32x4*)(bgate + 4 * fq);
        for (int g0 = 0; g0 < nr; g0 += 16) {
            int rl = g0 + fr; if (rl > nr - 1) rl = nr - 1;
            const bf16_t* up = U + (size_t)(rbase + rl) * D + 8 * fq;
            f32x4 a0 = (f32x4){0.f, 0.f, 0.f, 0.f}, a1 = a0;
#pragma unroll
            for (int ks = 0; ks < 32; ks += 2) {
                const bf16x8 u0 = *(const bf16x8*)(up + 32 * ks), u1 = *(const bf16x8*)(up + 32 * ks + 32);
                const bf16x8 w0 = *(const LAS bf16x8*)(F.lds + fr * WG_RB + (32 * ks + 8 * fq) * 2), w1 = *(const LAS bf16x8*)(F.lds + fr * WG_RB + (32 * ks + 32 + 8 * fq) * 2);
                a0 = __builtin_amdgcn_mfma_f32_16x16x32_bf16(w0, u0, a0, 0, 0, 0); a1 = __builtin_amdgcn_mfma_f32_16x16x32_bf16(w1, u1, a1, 0, 0, 0);
            }
            if (g0 + fr < nr) *(f32x4*)(GT + (size_t)(rbase + g0 + fr) * 16 + 4 * fq) = a0 + a1 + bias;
        }
    }
    if (ROUTER) {
        __syncthreads();
        unsigned char* const ws = KA()->ws;
        if (tid < 16) { unsigned* gc = (unsigned*)(ws + WS_CTL + CTL_GCNT); cntl[16 + tid] = (int)__hip_atomic_fetch_add(gc + tid, (unsigned)cntl[tid], __ATOMIC_RELAXED, __HIP_MEMORY_SCOPE_AGENT); }
        __syncthreads();
        int* rowtok = (int*)(ws + WS_RTOK); float* rowgate = (float*)(ws + WS_RGATE);
        for (int i = tid; i < 8 * rpw; i += 512) {
            const int w = i / rpw, rr = i % rpw; const int r = (F.wg * 8 + w) * rpw + rr;
            if (r < nrows) { const LAS int* sp = sel + i * 6; const int e0 = sp[0] & 255, e1 = sp[0] >> 8;
                const int p0 = cntl[16 + e0] + sp[1], p1 = cntl[16 + 8 + e1] + sp[2];
                rowtok[(size_t)e0 * RT_STRIDE + p0] = sp[5]; rowgate[(size_t)e0 * RT_STRIDE + p0] = __int_as_float(sp[3]);
                rowtok[(size_t)(8 + e1) * RT_STRIDE + p1] = sp[5]; rowgate[(size_t)(8 + e1) * RT_STRIDE + p1] = __int_as_float(sp[4]); }
        }
        __syncthreads();
    }
}

#undef NP_LOAD
__device__ __forceinline__ void unpack8(const u32x4 w, float (&v)[8]) { v[0] = bflo(w.x); v[1] = bfhi(w.x); v[2] = bflo(w.y); v[3] = bfhi(w.y); v[4] = bflo(w.z); v[5] = bfhi(w.z); v[6] = bflo(w.w); v[7] = bfhi(w.w); }
__device__ __forceinline__ u32x4 pack8(const float (&v)[8]) { u32x4 w; w.x = cvt_pk_bf16(v[0], v[1]); w.y = cvt_pk_bf16(v[2], v[3]); w.z = cvt_pk_bf16(v[4], v[5]); w.w = cvt_pk_bf16(v[6], v[7]); return w; }
__device__ __forceinline__ void mix_phase(const Frame& F, int nrows, const float* gnorm  ) {
    const int lane = F.lane(); unsigned char* const ws = KA()->ws;
    const bf16_t* P = (const bf16_t*)(ws + WS_PROJ); const bf16_t* HL = (const bf16_t*)KA()->out; bf16_t* A2 = (bf16_t*)(ws + WS_U);
    const int rpw = (nrows + F.G * 8 - 1) / (F.G * 8); const int rbase = (F.wg * 8 + F.wid) * rpw;
    if (rbase >= nrows) return;
    float gnv[8];
#pragma unroll
    for (int j = 0; j < 8; ++j) gnv[j] = gnorm[lane * 8 + j];
    u32x4 n_hf, n_hb, n_og;
#define MX_LOAD(r) do { n_og = *(const u32x4*)(P + (size_t)(r) * NPO + 2560 + lane * 8); n_hf = *(const u32x4*)(HL + (size_t)(r) * 512 + lane * 8); n_hb = *(const u32x4*)(HL + (size_t)(MT + (r)) * 512 + lane * 8); } while (0)
    MX_LOAD(rbase);
    for (int rr = 0; rr < rpw; ++rr) {
        const int r = rbase + rr; if (r >= nrows) break;
        const u32x4 c_hf = n_hf, c_hb = n_hb, c_og = n_og;
        if (rr + 1 < rpw && r + 1 < nrows) MX_LOAD(r + 1);
        float hf[8], hb[8], og[8], y[8];
        unpack8(c_hf, hf); unpack8(c_hb, hb); unpack8(c_og, og);
        float ss = 0.f;
#pragma unroll
        for (int j = 0; j < 8; ++j) { hf[j] += hb[j]; ss += hf[j] * hf[j]; }
        ss += __shfl_xor(ss, 1); ss += __shfl_xor(ss, 2); ss += __shfl_xor(ss, 4); ss += __shfl_xor(ss, 8);
        const float rstd = rsqrtf(ss * (1.0f / 128.0f) + EPS);
#pragma unroll
        for (int j = 0; j < 8; ++j) y[j] = hf[j] * rstd * gnv[j] * sigmoidf_(og[j]);
        *(u32x4*)(A2 + (size_t)r * D + 512 + lane * 8) = pack8(y);
    }
#undef MX_LOAD
}

__device__ __forceinline__ void final_phase(const Frame& F) {
    const int lane = F.lane(); KArgs ka = KA(); const float* gain = ka->in[I_FNG]; float* const outp = ka->out;
    const bf16_t* HB = (const bf16_t*)(ka->ws + WS_HB); const unsigned char* Y0 = (const unsigned char*)(ka->ws + WS_U); const unsigned char* Y1 = (const unsigned char*)(ka->ws + WS_Y1);
    const float* g2 = (const float*)(ka->ws + WS_MOD) + 33 * 6144 + 5 * 1024;
    const int rpw = (NL + F.G * 8 - 1) / (F.G * 8); const int rbase = (F.wg * 8 + F.wid) * rpw;
    f32x4 gn[4], gv[4];
#pragma unroll
    for (int j = 0; j < 4; ++j) { gn[j] = *(const f32x4*)(gain + j * 256 + lane * 4); gv[j] = (f32x4){0.f, 0.f, 0.f, 0.f}; }
    int cur_b = -1;
    u32x2 nx[4]; int ny[4], nz[4];
#define FP_LOAD(row) do { _Pragma("unroll") for (int _j = 0; _j < 4; ++_j) { nx[_j] = *(const u32x2*)(HB + (size_t)(row) * D + _j * 256 + lane * 4); \
        ny[_j] = *(const int*)(Y0 + (size_t)(row) * D + _j * 256 + lane * 4); nz[_j] = *(const int*)(Y1 + (size_t)(row) * D + _j * 256 + lane * 4); } } while (0)
    if (rbase < NL) FP_LOAD(rbase);
    for (int rr = 0; rr < rpw; ++rr) {
        const int r = rbase + rr; if (r >= NL) break;
        u32x2 cr[4]; int cy[4], cz[4];
#pragma unroll
        for (int j = 0; j < 4; ++j) { cr[j] = nx[j]; cy[j] = ny[j]; cz[j] = nz[j]; }
        if (rr + 1 < rpw && r + 1 < NL) FP_LOAD(r + 1);
        const int bidx = r >> 11;
        if (bidx != cur_b) { cur_b = bidx;
#pragma unroll
            for (int j = 0; j < 4; ++j) gv[j] = *(const f32x4*)(g2 + (size_t)bidx * 6144 + j * 256 + lane * 4) * (1.0f / S_Y); }
        f32x4 x[4]; float ss = 0.f;
#pragma unroll
        for (int j = 0; j < 4; ++j) { const u32x2 w = cr[j];
            const f32x2 y0 = __builtin_amdgcn_cvt_pk_f32_fp8(cy[j], false), y1 = __builtin_amdgcn_cvt_pk_f32_fp8(cy[j], true), z0 = __builtin_amdgcn_cvt_pk_f32_fp8(cz[j], false), z1 = __builtin_amdgcn_cvt_pk_f32_fp8(cz[j], true);
            x[j] = (f32x4){bflo(w.x), bfhi(w.x), bflo(w.y), bfhi(w.y)} + gv[j] * (f32x4){y0.x + z0.x, y0.y + z0.y, y1.x + z1.x, y1.y + z1.y};
            ss += x[j][0] * x[j][0] + x[j][1] * x[j][1] + x[j][2] * x[j][2] + x[j][3] * x[j][3]; }
        ss = wave_sum(ss);
        const float rstd = rsqrtf(ss * (1.0f / 1024.0f) + EPS);
        float* p = outp + (size_t)r * D;
#pragma unroll
        for (int j = 0; j < 4; ++j) *(f32x4*)(p + j * 256 + lane * 4) = x[j] * rstd * gn[j];
    }
#undef FP_LOAD
}

constexpr int ML_RB = 288;
constexpr int ML_RBC = 256;
constexpr int ML_Q = 0, ML_K = 36864, ML_V = 73728, ML_CT = 110592, ML_VEC = 145408, ML_CW = 151552;
__device__ __forceinline__ bf16x8 tr_frag2(const LAS unsigned char* base, int rowA, int rowB, int col0, int lane) {
    const int g = lane >> 4, q = (lane & 15) >> 2, p = lane & 3;
    const s16x4 v0 = __builtin_amdgcn_ds_read_tr16_b64_v4i16((LAS s16x4*)(base + (rowA + 4 * g + q) * ML_RB + (col0 + 4 * p) * 2));
    const s16x4 v1 = __builtin_amdgcn_ds_read_tr16_b64_v4i16((LAS s16x4*)(base + (rowB + 4 * g + q) * ML_RB + (col0 + 4 * p) * 2));
    return (bf16x8){v0[0], v0[1], v0[2], v0[3], v1[0], v1[1], v1[2], v1[3]};
}
__device__ __forceinline__ bf16x8 tr_frag(const LAS unsigned char* base, int row0, int col0, int lane) {
    const int g = lane >> 4, q = (lane & 15) >> 2, p = lane & 3;
    const LAS unsigned char* a = base + (row0 + 8 * g + q) * ML_RB + (col0 + 4 * p) * 2;
    const s16x4 v0 = __builtin_amdgcn_ds_read_tr16_b64_v4i16((LAS s16x4*)a);
    const s16x4 v1 = __builtin_amdgcn_ds_read_tr16_b64_v4i16((LAS s16x4*)(a + 4 * ML_RB));
    return (bf16x8){v0[0], v0[1], v0[2], v0[3], v1[0], v1[1], v1[2], v1[3]};
}
__device__ __forceinline__ void mlstm_phase(const Frame& F, bool ctx_out, int skip  ,
                                             int conv_rows  , const float* convw  ) {
    const int lane = F.lane(), wid = F.wid, tid = wid * 64 + lane, fr = lane & 15, fq = lane >> 4;
    LAS unsigned char* lds = F.lds;
    LAS float* ic = (LAS float*)(lds + ML_VEC); LAS float* fc = ic + 128; LAS float* av = ic + 256; LAS float* Mv = ic + 384; LAS float* bcv = ic + 512;
    LAS float* nvec = ic + 640; LAS float* wkv = ic + 768; LAS float* npart = ic + 896;
    LAS float* eav = ic + 1408;
    LAS float* cw = (LAS float*)(lds + ML_CW);
    for (int i = tid; i < 1536; i += 512) cw[i] = convw[i];
    unsigned char* const ws = KA()->ws;
    const bf16_t* P = (const bf16_t*)(ws + WS_PROJ); const float* GT = (const float*)(ws + WS_GATES); bf16_t* HL = (bf16_t*)KA()->out;
    bf16_t* A2 = (bf16_t*)(ws + WS_U);
    const int crpw = (conv_rows + F.G * 8 - 1) / (F.G * 8), crb = (F.wg * 8 + wid) * crpw; int cri = 0;
    int cnr = conv_rows - crb; cnr = cnr < 0 ? 0 : (cnr > crpw ? crpw : cnr);
#define MC_HASL(r) ((r) < NL ? (((r) & 63) != 0) : ((((r) - NL) & 255) != 0))
#define MC_HASR(r) ((r) < NL ? (((r) & 63) != 63) : ((((r) - NL) & 255) != 255))
    float zl[8], zc[8];
#pragma unroll
    for (int j = 0; j < 8; ++j) { zl[j] = 0.f; zc[j] = 0.f; }
    if (cnr > 0) { const bf16_t* pr = P + (size_t)crb * NPO + lane * 8;
        unpack8(*(const u32x4*)(pr + 512), zc);
        if (MC_HASL(crb)) unpack8(*(const u32x4*)(pr - NPO + 512), zl); }
    for (int unit = F.wg; unit < 256; unit += F.G) {
        const int b = unit >> 3, hd = (unit >> 1) & 3, dir = unit & 1;
        f32x4 Cacc[8];
#pragma unroll
        for (int a = 0; a < 8; ++a) Cacc[a] = (f32x4){0.f, 0.f, 0.f, 0.f};
        float m = 0.f, dec_prev = 0.f;
        if (tid < 128) nvec[tid] = 0.f;
        if (tid < 512) npart[tid] = 0.f;
        u32x4 st[12]; float gi = 0.f, gf = 0.f;
#define ML_ROW0(ci) ((ci) < 2 ? NL + b * 256 + (dir ? 1 - (ci) : (ci)) * 128 : b * 2048 + (dir ? 15 - ((ci) - 2) : ((ci) - 2)) * 128)
#define ML_LOAD(ci) do { const int _r0 = ML_ROW0(ci); _Pragma("unroll") for (int _p = 0; _p < 4; ++_p) { const int _id = tid + 512 * _p, _row = _id >> 4, _ch = _id & 15; \
            const bf16_t* _g = P + (size_t)(_r0 + _row) * NPO + 1024 + hd * 128 + _ch * 8; st[_p] = *(const u32x4*)_g; st[4 + _p] = *(const u32x4*)(_g + 512); st[8 + _p] = *(const u32x4*)(_g + 1024); } \
            if (tid < 128) { gi = GT[(size_t)(_r0 + tid) * 16 + (2 * dir) * 4 + hd]; gf = GT[(size_t)(_r0 + tid) * 16 + (2 * dir + 1) * 4 + hd]; } } while (0)
#define ML_BAR() do { asm volatile("s_waitcnt lgkmcnt(0)" ::: "memory"); __builtin_amdgcn_s_barrier(); asm volatile("" ::: "memory"); } while (0)
        ML_LOAD(0);
        __syncthreads();
        for (int ci = 0; ci < 18; ++ci) {
            const int row0 = ML_ROW0(ci);
            const bool need_out = ((ci >= 2) || ctx_out) && !(skip & 1);
            int lane_c = lane; asm volatile("" : "+v"(lane_c));
            const int lane = lane_c, fr = lane & 15, fq = lane >> 4, tid = wid * 64 + lane;
#pragma unroll
            for (int p = 0; p < 4; ++p) { const int id = tid + 512 * p, row = id >> 4, ch = id & 15; const int o = row * ML_RB + ch * 16;
                *(LAS u32x4*)(lds + ML_Q + o) = st[p]; *(LAS u32x4*)(lds + ML_K + o) = st[4 + p]; *(LAS u32x4*)(lds + ML_V + o) = st[8 + p]; }
#pragma unroll
            for (int a = 0; a < 8; ++a) { u32x2 w; w.x = cvt_pk_bf16(Cacc[a][0], Cacc[a][1]); w.y = cvt_pk_bf16(Cacc[a][2], Cacc[a][3]);
                *(LAS u32x2*)(lds + ML_CT + (16 * wid + fr) * ML_RBC + (((2 * a + (fq >> 1)) ^ fr) << 4) + (fq & 1) * 8) = w; }
            if (tid < 128) { ic[tid] = gi; fc[tid] = fminf(gf, 0.f) - __logf(1.0f + __expf(-fabsf(gf)));
                nvec[tid] = dec_prev * nvec[tid] + ((npart[tid] + npart[128 + tid]) + (npart[256 + tid] + npart[384 + tid])); }
            if (ci + 1 < 18 && !(skip & 4)) ML_LOAD(ci + 1);
            ML_BAR();
            float bL, Mlast, amax;
            { const int p0 = 2 * lane, p1 = p0 + 1, s0 = dir ? 127 - p0 : p0, s1 = dir ? 127 - p1 : p1;
              const float f0 = fc[s0], f1 = fc[s1], i0 = ic[s0], i1 = ic[s1];
              const float incl = wave_scan_add(f0 + f1);
              const float bc1 = incl, bc0 = incl - f1;
              const float a0 = i0 - bc0, a1 = i1 - bc1;
              const float im = wave_scan_max(fmaxf(a0, a1));
              float ex = __shfl_up(im, 1); if (lane == 0) ex = -3.0e38f;
              const float M0 = fmaxf(fmaxf(m, ex), a0), M1 = fmaxf(m, im);
              bL = __shfl(incl, 63); Mlast = __shfl(M1, 63); amax = __shfl(im, 63);
              av[s0] = a0; av[s1] = a1; Mv[s0] = M0; Mv[s1] = M1; bcv[s0] = bc0; bcv[s1] = bc1;
              wkv[s0] = __expf(a0 - Mlast); wkv[s1] = __expf(a1 - Mlast);
              eav[s0] = __expf(a0 - amax); eav[s1] = __expf(a1 - amax); }
            if (need_out) {
                int tq = __builtin_amdgcn_readfirstlane(wid < 4 ? 2 * wid : 15 - 2 * wid); asm volatile("" : "+s"(tq));
                const int t = 16 * tq + fr; const float Mt = Mv[t];
                bf16x8 Qf[4];
#pragma unroll
                for (int ks = 0; ks < 4; ++ks) Qf[ks] = *(const LAS bf16x8*)(lds + ML_Q + t * ML_RB + (32 * ks + 8 * fq) * 2);
                float rowsum = 0.f; u32x2 Sp[8];
#pragma unroll
                for (int j = 0; j < 8; ++j) {
                    Sp[j] = (u32x2){0u, 0u};
                    const bool act = dir ? (j >= tq) : (j <= tq);
                    if (act) {
                        f32x4 acc = (f32x4){0.f, 0.f, 0.f, 0.f};
#pragma unroll
                        for (int ks = 0; ks < 4; ++ks) { const bf16x8 Kf = *(const LAS bf16x8*)(lds + ML_K + (16 * j + fr) * ML_RB + (32 * ks + 8 * fq) * 2); acc = __builtin_amdgcn_mfma_f32_16x16x32_bf16(Kf, Qf[ks], acc, 0, 0, 0); }
                        const f32x4 e4 = *(const LAS f32x4*)(eav + 16 * j + 4 * fq);
                        float v[4];
#pragma unroll
                        for (int r = 0; r < 4; ++r) v[r] = acc[r] * e4[r];
                        if (j == tq) {
#pragma unroll
                            for (int r = 0; r < 4; ++r) { const bool valid = dir ? (4 * fq + r >= fr) : (4 * fq + r <= fr); v[r] = valid ? v[r] : 0.f; } }
                        rowsum += (v[0] + v[1]) + (v[2] + v[3]);
                        Sp[j].x = cvt_pk_bf16(v[0], v[1]); Sp[j].y = cvt_pk_bf16(v[2], v[3]);
                    }
                }
                rowsum += __shfl_xor(rowsum, 16); rowsum += __shfl_xor(rowsum, 32);
                float qn = 0.f;
#pragma unroll
                for (int ks = 0; ks < 4; ++ks) { const f32x4 n0 = *(const LAS f32x4*)(nvec + 32 * ks + 8 * fq), n1 = *(const LAS f32x4*)(nvec + 32 * ks + 8 * fq + 4);
#pragma unroll
                    for (int jj = 0; jj < 4; ++jj) { qn += bf2f((unsigned short)Qf[ks][jj]) * n0[jj]; qn += bf2f((unsigned short)Qf[ks][4 + jj]) * n1[jj]; } }
                qn += __shfl_xor(qn, 16); qn += __shfl_xor(qn, 32);
                const float em = __expf(amax - Mt), wi = __expf(m - Mt), den = em * rowsum + wi * qn, rd = 1.0f / fmaxf(fabsf(den), __expf(-(bcv[t] + Mt)));
                const float ems = em * rd, wis = wi * rd;
                bf16x8 Sf[4];
#pragma unroll
                for (int ks = 0; ks < 4; ++ks) { const u32x4 w = (u32x4){Sp[2 * ks].x, Sp[2 * ks].y, Sp[2 * ks + 1].x, Sp[2 * ks + 1].y}; Sf[ks] = __builtin_bit_cast(bf16x8, w); }
                LAS unsigned char* const obuf = lds + ML_Q + 16 * tq * ML_RB;
#pragma unroll 2
                for (int d = 0; d < 8; ++d) {
                    f32x4 aS = (f32x4){0.f, 0.f, 0.f, 0.f}, aC = (f32x4){0.f, 0.f, 0.f, 0.f};
#pragma unroll
                    for (int ks = 0; ks < 4; ++ks) { const bool act = dir ? (2 * ks + 1 >= tq) : (2 * ks <= tq);
                        if (act) { const bf16x8 Vt = tr_frag2(lds + ML_V, 32 * ks, 32 * ks + 16, 16 * d, lane); aS = __builtin_amdgcn_mfma_f32_16x16x32_bf16(Vt, Sf[ks], aS, 0, 0, 0); } }
#pragma unroll
                    for (int kp = 0; kp < 4; ++kp) { const bf16x8 Cf = *(const LAS bf16x8*)(lds + ML_CT + (16 * d + fr) * ML_RBC + (((4 * kp + fq) ^ fr) << 4)); aC = __builtin_amdgcn_mfma_f32_16x16x32_bf16(Cf, Qf[kp], aC, 0, 0, 0); }
                    u32x2 w; w.x = cvt_pk_bf16(ems * aS[0] + wis * aC[0], ems * aS[1] + wis * aC[1]); w.y = cvt_pk_bf16(ems * aS[2] + wis * aC[2], ems * aS[3] + wis * aC[3]);
                    *(LAS u32x2*)(obuf + fr * 272 + (16 * d + 4 * fq) * 2) = w;
                }
#pragma unroll
                for (int i = 0; i < 4; ++i) { const int orow = (lane >> 4) + 4 * i; const u32x4 v = *(const LAS u32x4*)(obuf + orow * 272 + (lane & 15) * 16);
                    *(u32x4*)(HL + ((size_t)dir * MT + row0 + 16 * tq + orow) * 512 + hd * 128 + (lane & 15) * 8) = v; }
            }
            u32x4 c_gb[2], c_gc[2]; int c_n = 0;
            {
                c_n = cnr - cri; c_n = c_n > 2 ? 2 : (c_n < 0 ? 0 : c_n); if (skip & 8) c_n = 0;
#pragma unroll
                for (int q = 0; q < 2; ++q) if (q < c_n) { const bf16_t* pr = P + (size_t)(crb + cri + q) * NPO + lane * 8; c_gb[q] = *(const u32x4*)pr; c_gc[q] = *(const u32x4*)(pr + NPO + 512); }
                asm volatile("" ::: "memory");
                const float dec = __expf(m - Mlast);
                bf16x8 Vw[4], Wk[4];
#pragma unroll
                for (int ks = 0; ks < 4; ++ks) { const bf16x8 Vf = tr_frag2(lds + ML_V, 32 * ks, 32 * ks + 16, 16 * wid, lane);
                    const f32x4 k0 = *(const LAS f32x4*)(wkv + 32 * ks + 4 * fq), k1 = *(const LAS f32x4*)(wkv + 32 * ks + 16 + 4 * fq);
                    u32x4 w;
                    w.x = cvt_pk_bf16(bf2f((unsigned short)Vf[0]) * k0[0], bf2f((unsigned short)Vf[1]) * k0[1]); w.y = cvt_pk_bf16(bf2f((unsigned short)Vf[2]) * k0[2], bf2f((unsigned short)Vf[3]) * k0[3]);
                    w.z = cvt_pk_bf16(bf2f((unsigned short)Vf[4]) * k1[0], bf2f((unsigned short)Vf[5]) * k1[1]); w.w = cvt_pk_bf16(bf2f((unsigned short)Vf[6]) * k1[2], bf2f((unsigned short)Vf[7]) * k1[3]);
                    Vw[ks] = __builtin_bit_cast(bf16x8, w);
                    u32x4 wq = (u32x4){0u, 0u, 0u, 0u};
                    if (fr == 0) { wq.x = cvt_pk_bf16(k0[0], k0[1]); wq.y = cvt_pk_bf16(k0[2], k0[3]); wq.z = cvt_pk_bf16(k1[0], k1[1]); wq.w = cvt_pk_bf16(k1[2], k1[3]); }
                    Wk[ks] = __builtin_bit_cast(bf16x8, wq); }
                f32x4 nacc = (f32x4){0.f, 0.f, 0.f, 0.f};
                if (!(skip & 2)) {
#pragma unroll
                for (int a = 0; a < 8; ++a) { Cacc[a] = Cacc[a] * dec;
#pragma unroll
                    for (int ks = 0; ks < 4; ++ks) { const bf16x8 Kt = tr_frag2(lds + ML_K, 32 * ks, 32 * ks + 16, 16 * a, lane); Cacc[a] = __builtin_amdgcn_mfma_f32_16x16x32_bf16(Kt, Vw[ks], Cacc[a], 0, 0, 0);
                        if (a == wid) nacc = __builtin_amdgcn_mfma_f32_16x16x32_bf16(Kt, Wk[ks], nacc, 0, 0, 0); } } }
                if (fr == 0) *(LAS f32x4*)(npart + 16 * wid + 4 * fq) = nacc;
                dec_prev = dec;
                m = bL + Mlast;
            }
#pragma unroll
            for (int q = 0; q < 2; ++q) if (q < c_n) { const int r = crb + cri + q;
                float gb[8], zr[8], y[8];
                unpack8(c_gb[q], gb); unpack8(c_gc[q], zr);
                const f32x4 wa0 = *(const LAS f32x4*)(cw + lane * 8), wa1 = *(const LAS f32x4*)(cw + lane * 8 + 4), wb0 = *(const LAS f32x4*)(cw + 512 + lane * 8), wb1 = *(const LAS f32x4*)(cw + 512 + lane * 8 + 4),
                            wc0 = *(const LAS f32x4*)(cw + 1024 + lane * 8), wc1 = *(const LAS f32x4*)(cw + 1024 + lane * 8 + 4);
                const bool hasR = MC_HASR(r);
#pragma unroll
                for (int j = 0; j < 8; ++j) {
                    const float w0 = j < 4 ? wa0[j & 3] : wa1[j & 3], w1 = j < 4 ? wb0[j & 3] : wb1[j & 3], w2 = j < 4 ? wc0[j & 3] : wc1[j & 3];
                    y[j] = gb[j] * (w0 * zl[j] + w1 * zc[j] + (hasR ? w2 * zr[j] : 0.f)); }
                *(u32x4*)(A2 + (size_t)r * D + lane * 8) = pack8(y);
#pragma unroll
                for (int j = 0; j < 8; ++j) { zl[j] = hasR ? zc[j] : 0.f; zc[j] = zr[j]; } }
            cri += c_n;
            ML_BAR();
        }
#undef ML_ROW0
#undef ML_LOAD
#undef ML_BAR
#undef MC_HASL
#undef MC_HASR
    }
}

constexpr int NPH = 20;
constexpr int REP[NPH] = {1, 1, 1, 1, 1, 1, 1, 1, 1, 1, 1, 1, 1, 1, 1, 1, 1, 1, 1, 1};
#define REPEAT(k) for (int _r = 0; _r < REP[k]; ++_r)
#define GSCALE(k) ((_r == REP[k] - 1) ? 1.0f : 0.0f)
__global__ void __launch_bounds__(512, 2) mk_fwd(Args args_unused) {
    extern __shared__ __attribute__((aligned(16))) unsigned char smem[];
    Frame F;
    F.lds = (LAS unsigned char*)smem; F.wid = __builtin_amdgcn_readfirstlane((int)threadIdx.x >> 6); F.G = gridDim.x; F.wg = blockIdx.x;
    volatile LAS unsigned* misc = (volatile LAS unsigned*)(F.lds + MISC_OFF);
    if (F.tid() < 64) misc[F.tid()] = 0u;
    __syncthreads();
    int lo, hi;
    { KArgs ka = KA(); lo = ka->lo; hi = ka->hi; }
    XcdBarrier bar;
    { KArgs ka = KA(); bar.bar = (unsigned*)(ka->ws + WS_CTL); bar.x = 0; bar.st = misc; bar.wid = F.wid;
      if (hi - lo > 1) bar = xcd_barrier_post((unsigned*)(ka->ws + WS_CTL), misc, F.wid); }
#define IN(k) (lo <= (k) && (k) < hi)
#define SEAM(k) do { if (IN(k) && IN((k) + 1)) { KArgs _ka = KA(); bar.bar = (unsigned*)(_ka->ws + WS_CTL); xcd_barrier(bar); } } while (0)
    const volatile LAS int* tb = (const volatile LAS int*)(F.lds + MISC_OFF + 64);
    volatile LAS int* tbw = (volatile LAS int*)(F.lds + MISC_OFF + 64);

#ifdef PROBE_MFMA
    {
        f32x4 a0 = {0.f, 0.f, 0.f, 0.f}, a1 = a0, a2 = a0, a3 = a0; bf16x8 x = {1, 2, 3, 4, 5, 6, 7, 8}, y = {8, 7, 6, 5, 4, 3, 2, 1};
        asm volatile("" : "+v"(x), "+v"(y));
        for (int it = 0; it < 10000; ++it) {
            a0 = __builtin_amdgcn_mfma_f32_16x16x32_bf16(x, y, a0, 0, 0, 0); a1 = __builtin_amdgcn_mfma_f32_16x16x32_bf16(x, y, a1, 0, 0, 0);
            a2 = __builtin_amdgcn_mfma_f32_16x16x32_bf16(x, y, a2, 0, 0, 0); a3 = __builtin_amdgcn_mfma_f32_16x16x32_bf16(x, y, a3, 0, 0, 0); }
        asm volatile("" :: "v"(a0), "v"(a1), "v"(a2), "v"(a3));
    }
#endif
    if (IN(0)) REPEAT(0) { p0_prologue(F, _r < REP[0] - 1 ? PROBE_P0SKIP : 0); }
    SEAM(0);
    if (IN(1)) REPEAT(1) { KArgs ka = KA(); unsigned char* ws = ka->ws;
        norm_phase<false, false, false, true>(F, ka->in[I_X], ka->in[I_CTX], MT, ka->in[I_N1G], (const float*)(ws + WS_MOD), 0, (bf16_t*)(ws + WS_U), nullptr,
            (const bf16_t*)(ws + WS_WIN) + (size_t)NPROJ * D, ka->in[I_BG], (float*)(ws + WS_GATES), (bf16_t*)(ws + WS_HB)); }
    SEAM(1);
    if (IN(2)) REPEAT(2) { KArgs ka = KA(); unsigned char* ws = ka->ws;
        pg8::DenseSched S{MT / 256, NPROJ / 256, F.G, F.wg, 2 * D, 4};
        pg8::EpiProj E{(bf16_t*)(ws + WS_PROJ), GSCALE(2) == 0.0f};
        pg8::gemm_phase<false>(F.lds, F.wid, (const char*)(ws + WS_U), (const char*)(ws + WS_WIN), 2 * D, S, E, 0);
        tail_convert(F, (MT / 256) * (NPROJ / 256), 30, 31); }
    SEAM(2);
    if (IN(3)) REPEAT(3) { mlstm_phase(F, true, _r < REP[3] - 1 ? PROBE_MLSKIP : 0, MT, KA()->in[I_CONVW]); }
    SEAM(3);
    if (IN(4)) REPEAT(4) { KArgs ka = KA(); mix_phase(F, MT, ka->in[I_MNG]); }
    SEAM(4);
    if (IN(5)) REPEAT(5) { KArgs ka = KA(); unsigned char* ws = ka->ws;
        pg8::DenseSched S{MT / 256, D / 256, F.G, F.wg, 2 * D, 4};
        pg8::EpiResid E{(bf16_t*)(ws + WS_HB), (const float*)(ws + WS_MOD) + 2 * 1024, 1.0f};
        pg8::gemm_phase<false>(F.lds, F.wid, (const char*)(ws + WS_U), (const char*)(ws + WS_WOUT), 2 * D, S, E, 0);
        tail_convert(F, (MT / 256) * (D / 256), 27, 30); }
    SEAM(5);
    if (IN(6)) REPEAT(6) { KArgs ka = KA(); unsigned char* ws = ka->ws;
        norm_phase<false, true, true, false>(F, (const float*)(ws + WS_HB), nullptr, MT, ka->in[I_N2G], (const float*)(ws + WS_MOD), 3, (bf16_t*)(ws + WS_U), nullptr); }
    SEAM(6);
    if (IN(7)) REPEAT(7) { KArgs ka = KA(); unsigned char* ws = ka->ws;
        pg8::DenseSched S{MT / 256, 2 * DFF / 256, F.G, F.wg, D, 8};
        pg8::EpiSwiglu E{(unsigned char*)(ws + WS_PROJ), 1.0f / (S_A * S_W13), S_H * GSCALE(7)};
        pg8::gemm_phase<true>(F.lds, F.wid, (const char*)(ws + WS_U), (const char*)(ws + WS_WUP), D, S, E, 0);
        tail_convert(F, (MT / 256) * (2 * DFF / 256), 26, 27); }
    SEAM(7);
    if (IN(8)) REPEAT(8) { KArgs ka = KA(); unsigned char* ws = ka->ws;
        pg8::DenseSched S{MT / 256, D / 256, F.G, F.wg, DFF, 4};
        pg8::EpiResid E{(bf16_t*)(ws + WS_HB), (const float*)(ws + WS_MOD) + 5 * 1024, GSCALE(8) / (S_H * S_W2)};
        pg8::gemm_phase<true>(F.lds, F.wid, (const char*)(ws + WS_PROJ), (const char*)(ws + WS_WDN), DFF, S, E, 0);
        tail_convert(F, (MT / 256) * (D / 256), 20, 26); }
    SEAM(8);
    if (IN(9)) REPEAT(9) { KArgs ka = KA(); unsigned char* ws = ka->ws;
        norm_phase<false, false, true, true>(F, (const float*)(ws + WS_HB), nullptr, MT, ka->in[I_N1G] + D, (const float*)(ws + WS_MOD) + 33 * 6144, 0, (bf16_t*)(ws + WS_U), nullptr,
            (const bf16_t*)(ws + WS_WIN) + (size_t)(NPAD + NPROJ) * D, ka->in[I_BG] + 16, (float*)(ws + WS_GATES)); }
    SEAM(9);
    if (IN(10)) REPEAT(10) { KArgs ka = KA(); unsigned char* ws = ka->ws;
        pg8::InProjL1Sched S{F.G, F.wg};
        pg8::EpiProj E{(bf16_t*)(ws + WS_PROJ), GSCALE(10) == 0.0f};
        pg8::gemm_phase<false>(F.lds, F.wid, (const char*)(ws + WS_U), (const char*)(ws + WS_WIN) + (size_t)NPAD * D * 2, 2 * D, S, E, 0);
        tail_convert(F, 3584 + 192, 19, 20); }
    SEAM(10);
    if (IN(11)) REPEAT(11) { mlstm_phase(F, false, _r < REP[11] - 1 ? PROBE_MLSKIP : 0, NL, KA()->in[I_CONVW] + 3 * 512); }
    SEAM(11);
    if (IN(12)) REPEAT(12) { KArgs ka = KA(); mix_phase(F, NL, ka->in[I_MNG] + 512); }
    SEAM(12);
    if (IN(13)) REPEAT(13) { KArgs ka = KA(); unsigned char* ws = ka->ws;
        pg8::DenseSched S{NL / 256, D / 256, F.G, F.wg, 2 * D, 4};
        pg8::EpiResid E{(bf16_t*)(ws + WS_HB), (const float*)(ws + WS_MOD) + 33 * 6144 + 2 * 1024, GSCALE(13)};
        pg8::gemm_phase<false>(F.lds, F.wid, (const char*)(ws + WS_U), (const char*)(ws + WS_WOUT) + (size_t)D * D * 2, 2 * D, S, E, 0); }
    SEAM(13);
    if (IN(14)) REPEAT(14) { KArgs ka = KA(); unsigned char* ws = ka->ws;
        norm_phase<true, true, true, false>(F, (const float*)(ws + WS_HB), nullptr, NL, ka->in[I_N2G] + D, (const float*)(ws + WS_MOD) + 33 * 6144, 3, (bf16_t*)(ws + WS_U), ka->in[I_ROUTER]); }
    SEAM(14);
    if (IN(15) || IN(16)) {
        __syncthreads();
        { const int tidl = F.tid();
          if (tidl < 64) {
            KArgs ka = KA(); const unsigned* gc = (const unsigned*)(ka->ws + WS_CTL + CTL_GCNT);
            const int c = tidl < 16 ? (int)__hip_atomic_load(gc + tidl, __ATOMIC_RELAXED, __HIP_MEMORY_SCOPE_AGENT) : 0;
            const int nt_ = (c + 255) >> 8; int incl = nt_;
#pragma unroll
            for (int d = 1; d < 16; d <<= 1) { const int t = __shfl_up(incl, d); if (tidl >= d) incl += t; }
            if (tidl < 16) { tbw[tidl] = incl - nt_; tbw[32 + tidl] = c; }
            if (tidl == 15) tbw[16] = incl; } }
        __syncthreads();
    }
    if (IN(15)) REPEAT(15) { KArgs ka = KA(); unsigned char* ws = ka->ws;
        pg8::MoeUpSched S{F.G, F.wg, (const int*)(ws + WS_RTOK), tb};
        pg8::EpiSwiglu E{(unsigned char*)(ws + WS_PROJ), 1.0f / (S_A * S_W13), S_H};
        pg8::gemm_phase<true>(F.lds, F.wid, (const char*)(ws + WS_U), (const char*)(ws + WS_MUP), D, S, E, 0); }
    SEAM(15);
    if (IN(16)) { KArgs ka = KA(); unsigned char* ws = ka->ws;
        pg8::MoeDownSched S{F.G, F.wg, tb, (const int*)(ws + WS_RTOK), (const float*)(ws + WS_RGATE)};
        pg8::EpiMoeDown E{(unsigned char*)(ws + WS_U), (unsigned char*)(ws + WS_Y1), F.lds + pg8::STAGE_BYTES, tb, S_Y / (S_H * S_W2)};
        pg8::gemm_phase<true>(F.lds, F.wid, (const char*)(ws + WS_PROJ), (const char*)(ws + WS_MDN), DFF, S, E, 0); }
    SEAM(16);
    if (IN(19)) REPEAT(19) { final_phase(F); }
#undef IN
#undef SEAM
}

extern "C" void kernel_launch(void* const* d_in, const int* in_sizes, int n_in, void* d_out, int out_size, void* d_ws, size_t ws_size, hipStream_t stream) {
    static int grid = 0;
    if (grid == 0) {
        if (n_in != 21 || ws_size < WS_END) { fprintf(stderr, "kernel_launch: expected 21 inputs and >= %zu bytes of workspace; got %d, %zu\n", (size_t)WS_END, n_in, ws_size); grid = -1; return; }
        int dev = 0, cus = 0, per_cu = 0;
        if (hipGetDevice(&dev) != hipSuccess || hipDeviceGetAttribute(&cus, hipDeviceAttributeMultiprocessorCount, dev) != hipSuccess) { grid = -1; return; }
        if (hipFuncSetAttribute((const void*)mk_fwd, hipFuncAttributeMaxDynamicSharedMemorySize, LDS_BYTES) != hipSuccess) { fprintf(stderr, "kernel_launch: hipFuncSetAttribute failed\n"); grid = -1; return; }
        if (hipOccupancyMaxActiveBlocksPerMultiprocessor(&per_cu, (const void*)mk_fwd, 512, LDS_BYTES) != hipSuccess || per_cu < 1) fprintf(stderr, "kernel_launch: occupancy query reports %d\n", per_cu);
        (void)hipGetLastError();
        grid = cus;
    }
    if (grid < 0) return;
    (void)hipMemsetAsync((char*)d_ws + WS_CTL, 0, CTL_BYTES, stream);
    Args a{};
    for (int i = 0; i < 21; ++i) a.in[i] = (const float*)d_in[i];
    a.out = (float*)d_out; a.ws = (unsigned char*)d_ws;
#if MK_PER_PHASE
    for (int p = 0; p < NPH; ++p) { a.lo = p; a.hi = p + 1; hipLaunchKernelGGL(mk_fwd, dim3(grid), dim3(512), LDS_BYTES, stream, a); }
#else
    a.lo = 0; a.hi = NPH; hipLaunchKernelGGL(mk_fwd, dim3(grid), dim3(512), LDS_BYTES, stream, a);
#endif
}
```

```cpp
#include <hip/hip_runtime.h>
#include <cstdio>
#include <cstdint>
#include <type_traits>

#ifndef MK_PER_PHASE
#define MK_PER_PHASE 0
#endif

#define LAS __attribute__((address_space(3)))
typedef unsigned short bf16_t;
typedef short bf16x8 __attribute__((ext_vector_type(8)));
typedef short s16x4 __attribute__((ext_vector_type(4)));
typedef float f32x4 __attribute__((ext_vector_type(4)));
typedef float f32x2 __attribute__((ext_vector_type(2)));
typedef unsigned u32x4 __attribute__((ext_vector_type(4)));
typedef unsigned u32x2 __attribute__((ext_vector_type(2)));

constexpr int D = 1024, NB = 32, SEQ = 2048, CTXL = 256;
constexpr int NL = NB * SEQ;
constexpr int NCX = NB * CTXL;
constexpr int MT = NL + NCX;
constexpr int PIN = 3600, NPROJ = 3584, NPAD = 3840;
constexpr int NPO = 3072;
constexpr int DFF = 2816, NE = 8;
constexpr float EPS = 1e-6f;
constexpr int PROBE_P0SKIP = 0;
constexpr int PROBE_MLSKIP = 0;
constexpr bool PROBE_DRY = false;
constexpr int RT_STRIDE = 65536;
constexpr float S_A = 16.0f, S_W13 = 256.0f, S_H = 8.0f, S_W2 = 256.0f, S_Y = 32.0f;

constexpr size_t WS_CTL = 0;
constexpr size_t CTL_BYTES = 65536;
constexpr size_t CTL_GCNT = 16384;
constexpr size_t WS_MOD = 65536;
constexpr size_t WS_WIN = 2097152;
constexpr size_t WS_WOUT = WS_WIN + (size_t)2 * NPAD * D * 2;
constexpr size_t WS_WUP = WS_WOUT + (size_t)2 * D * D * 2;
constexpr size_t WS_WDN = WS_WUP + (size_t)2 * DFF * D * 2;
constexpr size_t WS_MUP = WS_WDN + (size_t)D * DFF * 2;
constexpr size_t WS_MDN = WS_MUP + (size_t)NE * 2 * DFF * D * 2;
constexpr size_t WS_HC = WS_MDN + (size_t)NE * D * DFF * 2;
constexpr size_t WS_U = WS_HC + (size_t)NCX * D * 4;
constexpr size_t WS_PROJ = WS_U + (size_t)MT * D * 2;
constexpr size_t WS_GATES = WS_PROJ + (size_t)MT * NPROJ * 2;
constexpr size_t WS_HL = WS_GATES + (size_t)MT * 16 * 4;
constexpr size_t WS_HB = WS_HL;
constexpr size_t WS_Y1 = WS_PROJ + (size_t)368 * 1048576;
static_assert(WS_Y1 + (size_t)NL * D * 2 <= WS_GATES && (size_t)528 * 256 * DFF <= (size_t)368 * 1048576, "Y1 placement");
constexpr size_t WS_RTOK = WS_HL + (size_t)2 * MT * 512 * 2;
constexpr size_t WS_RGATE = WS_RTOK + (size_t)16 * RT_STRIDE * 4;
constexpr size_t WS_END = WS_RGATE + (size_t)16 * RT_STRIDE * 4;

constexpr int LDS_BYTES = 163840;
constexpr int MISC_OFF = 161792;

__device__ __forceinline__ unsigned cvt_pk_bf16(float lo, float hi) { unsigned r; asm volatile("v_cvt_pk_bf16_f32 %0, %1, %2" : "=v"(r) : "v"(lo), "v"(hi)); return r; }
__device__ __forceinline__ float bf2f(unsigned short b) { return __uint_as_float(((unsigned)b) << 16); }
__device__ __forceinline__ float bflo(unsigned w) { return __uint_as_float(w << 16); }
__device__ __forceinline__ float bfhi(unsigned w) { return __uint_as_float(w & 0xffff0000u); }
__device__ __forceinline__ float wave_sum(float v) {
#pragma unroll
    for (int o = 32; o >= 1; o >>= 1) v += __shfl_xor(v, o);
    return v;
}
__device__ __forceinline__ int lane_id() { int l; asm volatile("v_mbcnt_lo_u32_b32 %0, -1, 0\n\tv_mbcnt_hi_u32_b32 %0, -1, %0" : "=v"(l)); return l; }
template <int CTRL, int RM> __device__ __forceinline__ float dppf(float ident, float v) {
    return __builtin_bit_cast(float, __builtin_amdgcn_update_dpp(__builtin_bit_cast(int, ident), __builtin_bit_cast(int, v), CTRL, RM, 0xf, false)); }
__device__ __forceinline__ float wave_scan_add(float v) {
    v += dppf<0x111, 0xf>(0.f, v); v += dppf<0x112, 0xf>(0.f, v); v += dppf<0x114, 0xf>(0.f, v); v += dppf<0x118, 0xf>(0.f, v);
    v += dppf<0x142, 0xa>(0.f, v); v += dppf<0x143, 0xc>(0.f, v); return v; }
__device__ __forceinline__ float wave_scan_max(float v) {
    v = fmaxf(v, dppf<0x111, 0xf>(-3.0e38f, v)); v = fmaxf(v, dppf<0x112, 0xf>(-3.0e38f, v)); v = fmaxf(v, dppf<0x114, 0xf>(-3.0e38f, v)); v = fmaxf(v, dppf<0x118, 0xf>(-3.0e38f, v));
    v = fmaxf(v, dppf<0x142, 0xa>(-3.0e38f, v)); v = fmaxf(v, dppf<0x143, 0xc>(-3.0e38f, v)); return v; }
__device__ __forceinline__ float sigmoidf_(float x) { return 1.0f / (1.0f + __expf(-x)); }

#define XB_TMO      128
#define XB_XCNT(j)  (256  + 64 * (j))
#define XB_XSUB(j)  (1280 + 64 * (j))
#define XB_XGEN(j)  (2304 + 64 * (j))
#define XB_TOP      3328
#define XB_TOPGEN   3392
#define XCD_BAR_WORDS 3456
#define XB_SPIN_CAP (1u << 18)

__device__ __forceinline__ unsigned xb_ld(unsigned* p)              { return __hip_atomic_load(p, __ATOMIC_RELAXED, __HIP_MEMORY_SCOPE_AGENT); }
__device__ __forceinline__ unsigned xb_add(unsigned* p, unsigned v) { return __hip_atomic_fetch_add(p, v, __ATOMIC_RELAXED, __HIP_MEMORY_SCOPE_AGENT); }
__device__ __forceinline__ unsigned xb_xcc_id() { return (unsigned)__builtin_amdgcn_s_getreg((3 << 11) | 20) & 0xFu; }
#define XB_SPIN(cond, bar) do { unsigned _sp = 0; while (cond) { __builtin_amdgcn_s_sleep(1); \
    if ((++_sp & 255u) == 0u) { if (xb_ld(&(bar)[XB_TMO])) break; if (_sp > XB_SPIN_CAP) { atomicAdd(&(bar)[XB_TMO], 1u); break; } } } } while (0)

struct XcdBarrier {
    unsigned* bar; unsigned x;
    volatile LAS unsigned* st;
    int wid;
};
#define XB_THREAD0(b) ((b).wid == 0 && lane_id() == 0)
__device__ __forceinline__ XcdBarrier xcd_barrier_post(unsigned* bar, volatile LAS unsigned* st, int wid) {
    XcdBarrier b; b.bar = bar; b.x = xb_xcc_id(); b.st = st; b.wid = wid;
    if (XB_THREAD0(b)) (void)xb_add(&bar[XB_XCNT(b.x)], 1u);
    return b;
}
__device__ __forceinline__ void xcd_barrier_complete(unsigned* bar, unsigned x, unsigned& nloc, unsigned& nx) {
    const unsigned G = gridDim.x * gridDim.y * gridDim.z;
    unsigned sum, cnt, mine, sp = 0u;
    for (;;) {
        sum = 0u; cnt = 0u; mine = 0u;
#pragma unroll
        for (unsigned j = 0; j < 16; ++j) { const unsigned c = xb_ld(&bar[XB_XCNT(j)]); sum += c; cnt += (c > 0u) ? 1u : 0u; mine = (j == x) ? c : mine; }
        if (sum == G) break;
        __builtin_amdgcn_s_sleep(1);
        if ((++sp & 255u) == 0u) { if (xb_ld(&bar[XB_TMO])) break; if (sp > XB_SPIN_CAP) { atomicAdd(&bar[XB_TMO], 1u); break; } }
    }
    nloc = mine > 0u ? mine : 1u; nx = cnt > 0u ? cnt : 1u;
}
__device__ __forceinline__ void xcd_barrier(const XcdBarrier& b) {
    asm volatile("s_waitcnt vmcnt(0)" ::: "memory");
    __syncthreads();
    if (XB_THREAD0(b)) {
        unsigned* bar = b.bar;
        __builtin_amdgcn_s_waitcnt(0);
        unsigned nloc = b.st[0], nx = b.st[1];
        if (nloc == 0u) { xcd_barrier_complete(bar, b.x, nloc, nx); b.st[0] = nloc; b.st[1] = nx; }
        const unsigned old = xb_add(&bar[XB_XSUB(b.x)], 1u);
        const unsigned gen = old / nloc;
        if (old + 1u == (gen + 1u) * nloc) {
            __builtin_amdgcn_fence(__ATOMIC_RELEASE, "agent");
            asm volatile("s_waitcnt vmcnt(0)" ::: "memory");
            const unsigned og = xb_add(&bar[XB_TOP], 1u);
            const unsigned tg = og / nx;
            if (og + 1u == (tg + 1u) * nx) xb_add(&bar[XB_TOPGEN], 1u);
            else XB_SPIN(xb_ld(&bar[XB_TOPGEN]) == tg, bar);
            __builtin_amdgcn_fence(__ATOMIC_ACQUIRE, "agent");
            xb_add(&bar[XB_XGEN(b.x)], 1u);
            asm volatile("s_waitcnt vmcnt(0)" ::: "memory");
        } else {
            XB_SPIN(xb_ld(&bar[XB_XGEN(b.x)]) == gen, bar);
            __builtin_amdgcn_fence(__ATOMIC_ACQUIRE, "agent");
            asm volatile("s_waitcnt vmcnt(0)" ::: "memory");
        }
    }
    __syncthreads();
}

namespace pg8 {
constexpr int BM = 256, BK = 64, HALF = 128, HTB = HALF * BK * 2, STAGE_BYTES = 8 * HTB, NXCD = 8, WGM = 4;
__device__ __forceinline__ int lds_byte(int r, int c) { const int st = (r >> 4) * 2 + (c >> 5), rr = r & 15, cc = c & 31, ob = rr * 64 + cc * 2; return st * 1024 + (ob ^ (((ob >> 9) & 1) << 5)); }
__device__ __forceinline__ void stage_rc(int b, int& R, int& C) { const int st = b / 1024, sb = b % 1024, swz = sb ^ (((sb >> 9) & 1) << 5); R = (st >> 1) * 16 + swz / 64; C = (st & 1) * 32 + (swz % 64) / 2; }
__device__ __forceinline__ int perm32(int rho) { const int n = rho >> 4, i = rho & 15; return 8 * (i >> 2) + 4 * n + (i & 3); }

struct Unit { int pm, pn; unsigned B; int g; int par; };

__device__ __forceinline__ void tile_map(int L, int nM, int nN, int& pm, int& pn, const int WGM = pg8::WGM) {
    const int nwg = nM * nN; int wgid = L;
    { const int q = nwg / NXCD, r = nwg % NXCD, xcd = wgid % NXCD, off = wgid / NXCD; wgid = (xcd < r ? xcd * (q + 1) : r * (q + 1) + (xcd - r) * q) + off; }
    const int nig = WGM * nN, gid = wgid / nig, fm = gid * WGM, gsz = (nM - fm) < WGM ? (nM - fm) : WGM;
    pm = fm + ((wgid % nig) % gsz); pn = (wgid % nig) / gsz;
}

typedef int i32x8 __attribute__((ext_vector_type(8)));
template <bool FP8, class Epi, class Sched>
__device__ __forceinline__ void gemm_phase(LAS unsigned char* lds, const int wid, const char* Abase, const char* Bbase, const int KB, const Sched& S, const Epi& E, const int skew_ticks  ) {
    const int lane = lane_id(), tid = wid * 64 + lane, wr = wid >> 2, wc = wid & 3, fr = lane & 15, fq = lane >> 4;
    const int nt = KB / 128;
    int R0, C0; stage_rc(tid * 16, R0, C0);
    unsigned voffB[2];
#pragma unroll
    for (int i = 0; i < 2; ++i) { const int R = R0 + 64 * i; const int Rb = Epi::PERM ? (Epi::WIDE ? ((R >> 5) * 64 + perm32(R & 31)) : ((R & ~31) + perm32(R & 31))) : R; voffB[i] = (unsigned)(Rb * KB + C0 * 2); }
    const unsigned kstep = (unsigned)(BK * 2);
    const unsigned hstep = (unsigned)(HALF * KB);
    const unsigned hstepB = Epi::WIDE ? (unsigned)(32 * KB) : hstep;
    const __amdgpu_buffer_rsrc_t rsA = __builtin_amdgcn_make_buffer_rsrc((void*)Abase, (short)0, 0x7ffff000, 0x00020000);
    const __amdgpu_buffer_rsrc_t rsB = __builtin_amdgcn_make_buffer_rsrc((void*)Bbase, (short)0, 0x7ffff000, 0x00020000);
    const unsigned ldsw = (unsigned)wid * 1024u;
    const int aoff = lds_byte(wr * 64 + fr, fq * 8), boff = lds_byte(wc * 32 + fr, fq * 8);
#define PG8_SA(b, h) (((b) * 2 + (h)) * HTB)
#define PG8_SB(b, h) ((4 + (b) * 2 + (h)) * HTB)
#define PG8_STAGE(bufoff, soff, voff) do { _Pragma("unroll") for (int _i = 0; _i < 2; ++_i) \
        __builtin_amdgcn_raw_ptr_buffer_load_lds(rsB, (LAS unsigned*)(lds + (bufoff) + ldsw + _i * 8192), 16, (int)(voff)[_i], (int)(soff), 0, 0); } while (0)
#define PG8_STAGE_A(bufoff, o0, o1, soff) do { \
        __builtin_amdgcn_raw_ptr_buffer_load_lds(rsA, (LAS unsigned*)(lds + (bufoff) + ldsw), 16, (int)(o0), (int)(soff), 0, 0); \
        __builtin_amdgcn_raw_ptr_buffer_load_lds(rsA, (LAS unsigned*)(lds + (bufoff) + ldsw + 8192), 16, (int)(o1), (int)(soff), 0, 0); } while (0)
#define PG8_LDA(dst, b, h) do { _Pragma("unroll") for (int m = 0; m < 4; ++m) _Pragma("unroll") for (int k = 0; k < 2; ++k) dst[m][k] = *(const LAS bf16x8*)(lds + PG8_SA(b, h) + aoff + m * 2048 + k * 1024); } while (0)
#define PG8_LDB(dst, b, h) do { _Pragma("unroll") for (int n = 0; n < 2; ++n) _Pragma("unroll") for (int k = 0; k < 2; ++k) dst[n][k] = *(const LAS bf16x8*)(lds + PG8_SB(b, h) + boff + n * 2048 + k * 1024); } while (0)
#define PG8_MMA(ai, bj, At, Bt) do { __builtin_amdgcn_s_setprio(1); \
        if constexpr (FP8) { _Pragma("unroll") for (int m = 0; m < 4; ++m) _Pragma("unroll") for (int n = 0; n < 2; ++n) { \
            const u32x4 _b0 = __builtin_bit_cast(u32x4, Bt[n][0]), _b1 = __builtin_bit_cast(u32x4, Bt[n][1]), _a0 = __builtin_bit_cast(u32x4, At[m][0]), _a1 = __builtin_bit_cast(u32x4, At[m][1]); \
            const i32x8 _bb = {(int)_b0.x, (int)_b0.y, (int)_b0.z, (int)_b0.w, (int)_b1.x, (int)_b1.y, (int)_b1.z, (int)_b1.w}, _aa = {(int)_a0.x, (int)_a0.y, (int)_a0.z, (int)_a0.w, (int)_a1.x, (int)_a1.y, (int)_a1.z, (int)_a1.w}; \
            acc[ai][bj][m][n] = __builtin_amdgcn_mfma_scale_f32_16x16x128_f8f6f4(_bb, _aa, acc[ai][bj][m][n], 0, 0, 0, 0, 0, 0); } } \
        else { _Pragma("unroll") for (int m = 0; m < 4; ++m) _Pragma("unroll") for (int n = 0; n < 2; ++n) _Pragma("unroll") for (int k = 0; k < 2; ++k) \
            acc[ai][bj][m][n] = __builtin_amdgcn_mfma_f32_16x16x32_bf16(Bt[n][k], At[m][k], acc[ai][bj][m][n], 0, 0, 0); } \
        __builtin_amdgcn_s_setprio(0); } while (0)
#define PG8_WAIT_V(n) asm volatile("s_waitcnt vmcnt(" #n ")" ::: "memory")
#define PG8_WAIT_L(n) asm volatile("s_waitcnt lgkmcnt(" #n ")" ::: "memory")
#define PG8_BAR __builtin_amdgcn_s_barrier()
#define PG8_SCHED __builtin_amdgcn_sched_barrier(0)
    Unit cur, nxt; int ui = 0;
    if (!S.next(0, cur)) return;
    if (skew_ticks > 0) { const unsigned long long t0 = __builtin_amdgcn_s_memrealtime(); while (__builtin_amdgcn_s_memrealtime() - t0 < (unsigned long long)skew_ticks) __builtin_amdgcn_s_sleep(8); }
    f32x4 acc[2][2][4][2];
#pragma unroll
    for (int a = 0; a < 2; ++a)
#pragma unroll
        for (int b = 0; b < 2; ++b)
#pragma unroll
            for (int m = 0; m < 4; ++m)
#pragma unroll
                for (int n = 0; n < 2; ++n) acc[a][b][m][n] = (f32x4){0.f, 0.f, 0.f, 0.f};
    bf16x8 At[4][2], B0[2][2], B1[2][2];
    unsigned voffA[2]; voffA[0] = (unsigned)(R0 * KB + C0 * 2); voffA[1] = voffA[0] + (unsigned)(64 * KB);
    unsigned oc00 = 0, oc01 = 0, oc10 = 0, oc11 = 0;
    int nvr = -1;
    __amdgpu_buffer_rsrc_t rsT = rsA;
    if constexpr (Sched::GATHER) rsT = __builtin_amdgcn_make_buffer_rsrc((void*)S.tok_base(), (short)0, 16 * RT_STRIDE * 4, 0x00020000);
    unsigned cA = 0, nA = 0;
    if constexpr (Sched::GATHER) { S.aoff(cur, R0, C0, oc00, oc01, oc10, oc11); asm volatile("" : "+v"(oc00), "+v"(oc01), "+v"(oc10), "+v"(oc11)); }
    else cA = S.abase(cur);
    cur.par = 0;
    if constexpr (Sched::UNIT_DMA) { if (wid == 0) S.unit_dma(cur, lds + STAGE_BYTES, lane); }
#define PG8_STA(bufoff, ptr, h, kb) do { if constexpr (Sched::GATHER) { if ((h) == 0) PG8_STAGE_A(bufoff, oc00, oc01, kb); else PG8_STAGE_A(bufoff, oc10, oc11, kb); } \
        else PG8_STAGE_A(bufoff, voffA[0], voffA[1], (ptr) + (unsigned)(h) * hstep + (unsigned)(kb)); } while (0)
    unsigned cB = cur.B;
    PG8_STAGE(PG8_SB(0, 0), cB, voffB); PG8_STA(PG8_SA(0, 0), cA, 0, 0); PG8_STAGE(PG8_SB(0, 1), cB + hstepB, voffB); PG8_STA(PG8_SA(0, 1), cA, 1, 0);
    if (wr == 1) PG8_BAR;
    PG8_WAIT_V(4); PG8_BAR;
    PG8_STAGE(PG8_SB(1, 0), cB + kstep, voffB); PG8_STA(PG8_SA(1, 0), cA, 0, kstep); PG8_STAGE(PG8_SB(1, 1), cB + hstepB + kstep, voffB);
    PG8_WAIT_V(6); PG8_BAR;
    for (;;) {
        const bool has_next = S.next(ui + 1, nxt); nxt.par = (ui + 1) & 1;
        if constexpr (Sched::GATHER) {
            nvr = has_next ? S.valid_rows(nxt) : -1;
            if (has_next && wid == 0) __builtin_amdgcn_raw_ptr_buffer_load_lds(rsT, (LAS unsigned*)(lds + STAGE_BYTES), 16, lane * 16, (int)S.tokoff(nxt), 0, 0);
        } else nA = has_next ? S.abase(nxt) : cA;
        const unsigned nB = has_next ? nxt.B : cB;
#pragma unroll 1
        for (int t = 0; t < nt; t += 2) {
            const bool last = (t == nt - 2);
            const unsigned k1 = (unsigned)(t + 1) * kstep;
            const unsigned k2 = last ? 0u : (unsigned)(t + 2) * kstep; const unsigned k3 = k2 + kstep;
            const unsigned a2 = last ? nA : cA;
            const unsigned b2 = last ? nB : cB + (unsigned)(t + 2) * kstep; const unsigned b3 = b2 + kstep;
            PG8_LDB(B0, 0, 0); PG8_SCHED; PG8_LDA(At, 0, 0); PG8_STA(PG8_SA(1, 1), cA, 1, k1);
            PG8_WAIT_L(8); PG8_BAR; PG8_WAIT_L(0); PG8_MMA(0, 0, At, B0); PG8_BAR; PG8_SCHED;
            if constexpr (Sched::UNIT_DMA) { if (t == 0 && has_next && wid == 0) S.unit_dma(nxt, lds + STAGE_BYTES, lane); }
            if constexpr (Sched::GATHER) { if (last && nvr >= 0) { const LAS int* lt = (const LAS int*)(lds + STAGE_BYTES);
                const int t00 = R0 < nvr ? lt[R0] : 0, t01 = R0 + 64 < nvr ? lt[R0 + 64] : 0, t10 = R0 + 128 < nvr ? lt[R0 + 128] : 0, t11 = R0 + 192 < nvr ? lt[R0 + 192] : 0;
                oc00 = (unsigned)(t00 * KB + C0 * 2); oc01 = (unsigned)(t01 * KB + C0 * 2); oc10 = (unsigned)(t10 * KB + C0 * 2); oc11 = (unsigned)(t11 * KB + C0 * 2); } }
            PG8_LDB(B1, 0, 1); PG8_STAGE(PG8_SB(0, 0), b2, voffB);
            PG8_BAR; PG8_WAIT_L(0); PG8_MMA(0, 1, At, B1); PG8_BAR;
            PG8_LDA(At, 0, 1); PG8_STA(PG8_SA(0, 0), a2, 0, k2);
            PG8_BAR; PG8_WAIT_L(0); PG8_MMA(1, 0, At, B0); PG8_BAR; PG8_SCHED;
            PG8_STAGE(PG8_SB(0, 1), b2 + hstepB, voffB);
            PG8_WAIT_V(6); PG8_BAR; PG8_MMA(1, 1, At, B1); PG8_BAR;
            PG8_LDB(B0, 1, 0); PG8_SCHED; PG8_LDA(At, 1, 0); PG8_STA(PG8_SA(0, 1), a2, 1, k2);
            PG8_WAIT_L(8); PG8_BAR; PG8_WAIT_L(0); PG8_MMA(0, 0, At, B0); PG8_BAR; PG8_SCHED;
            PG8_LDB(B1, 1, 1); PG8_STAGE(PG8_SB(1, 0), b3, voffB);
            PG8_BAR; PG8_WAIT_L(0); PG8_MMA(0, 1, At, B1); PG8_BAR;
            PG8_LDA(At, 1, 1); PG8_STA(PG8_SA(1, 0), a2, 0, k3);
            PG8_BAR; PG8_WAIT_L(0); PG8_MMA(1, 0, At, B0); PG8_BAR; PG8_SCHED;
            PG8_STAGE(PG8_SB(1, 1), b3 + hstepB, voffB);
            PG8_WAIT_V(6); PG8_BAR; PG8_MMA(1, 1, At, B1); PG8_BAR;
        }
        { const int _l = lane_id(); const int _fr = _l & 15, _fq = _l >> 4;
          E(acc, cur, wr, wc, _fr, _fq); }
        if (!has_next) break;
#pragma unroll
        for (int a = 0; a < 2; ++a)
#pragma unroll
            for (int b = 0; b < 2; ++b)
#pragma unroll
                for (int m = 0; m < 4; ++m)
#pragma unroll
                    for (int n = 0; n < 2; ++n) acc[a][b][m][n] = (f32x4){0.f, 0.f, 0.f, 0.f};
        cur = nxt; cB = nB; cA = nA; ++ui;
    }
    PG8_WAIT_V(0);
    if (wr == 0) PG8_BAR;
    PG8_BAR;
#undef PG8_SA
#undef PG8_SB
#undef PG8_STAGE
#undef PG8_STAGE_A
#undef PG8_STA
#undef PG8_LDA
#undef PG8_LDB
#undef PG8_MMA
#undef PG8_WAIT_V
#undef PG8_WAIT_L
#undef PG8_BAR
#undef PG8_SCHED
}

struct DenseSched {
    static constexpr bool GATHER = false, UNIT_DMA = false;
    int nM, nN, G, c, KB, wgm;
    __device__ __forceinline__ unsigned abase(const Unit& u) const { return (unsigned)(u.pm * 256 * KB); }
    __device__ __forceinline__ bool next(int i, Unit& u) const {
        const long L = (long)i * G + c; if (L >= (long)nM * nN) return false;
        tile_map((int)L, nM, nN, u.pm, u.pn, wgm); u.B = (unsigned)(u.pn * 256 * KB); u.g = 0; return true;
    }
    __device__ __forceinline__ void aoff(const Unit& u, int R0, int C0, unsigned& o00, unsigned& o01, unsigned& o10, unsigned& o11) const {
        const unsigned base = (unsigned)((u.pm * 256 + R0) * KB + C0 * 2), r64 = (unsigned)(64 * KB);
        o00 = base; o01 = base + r64; o10 = base + 2u * r64; o11 = base + 3u * r64;
    }
};
struct InProjL1Sched {
    static constexpr bool GATHER = false, UNIT_DMA = false;
    int G, c;
    __device__ __forceinline__ unsigned abase(const Unit& u) const { return (unsigned)(u.pm * 256 * D * 2); }
    __device__ __forceinline__ bool next(int i, Unit& u) const {
        const int L = i * G + c; if (L >= 3584 + 192) return false;
        if (L < 3584) tile_map(L, 256, 14, u.pm, u.pn);
        else { const int Lc = L - 3584; u.pm = 256 + Lc / 6; u.pn = 6 + Lc % 6; }
        u.B = (unsigned)(u.pn * 256 * D * 2); u.g = 0; return true;
    }
    __device__ __forceinline__ void aoff(const Unit& u, int R0, int C0, unsigned& o00, unsigned& o01, unsigned& o10, unsigned& o11) const {
        const unsigned base = (unsigned)((u.pm * 256 + R0) * D + C0) * 2u, r64 = (unsigned)(64 * D) * 2u;
        o00 = base; o01 = base + r64; o10 = base + 2u * r64; o11 = base + 3u * r64;
    }
};
struct MoeUpSched {
    static constexpr bool GATHER = true, UNIT_DMA = false;
    int G, c; const int* rowtok; const volatile LAS int* tb;
    __device__ __forceinline__ unsigned abase(const Unit&) const { return 0u; }
    __device__ __forceinline__ bool next(int i, Unit& u) const {
        const int T = tb[16]; const int L = i * G + c; if (L >= T * 22) return false;
        tile_map(L, T, 22, u.pm, u.pn, 8); int g = 0;
#pragma unroll
        for (int j = 1; j < 16; ++j) g += (u.pm >= tb[j]) ? 1 : 0;
        u.g = g; u.B = (unsigned)(((g & 7) * 5632 + u.pn * 256) * D); return true;
    }
    __device__ __forceinline__ const int* tok_base() const { return rowtok; }
    __device__ __forceinline__ unsigned tokoff(const Unit& u) const { return (unsigned)((u.g * RT_STRIDE + (u.pm - tb[u.g]) * 256) * 4); }
    __device__ __forceinline__ int valid_rows(const Unit& u) const { return tb[32 + u.g] - (u.pm - tb[u.g]) * 256; }
    __device__ __forceinline__ void aoff(const Unit& u, int R0, int C0, unsigned& o00, unsigned& o01, unsigned& o10, unsigned& o11) const {
        const int s0 = (u.pm - tb[u.g]) * 256 + R0, cnt = tb[32 + u.g]; const int* rt = rowtok + (size_t)u.g * RT_STRIDE;
        const int t00 = s0 < cnt ? rt[s0] : 0, t01 = s0 + 64 < cnt ? rt[s0 + 64] : 0, t10 = s0 + 128 < cnt ? rt[s0 + 128] : 0, t11 = s0 + 192 < cnt ? rt[s0 + 192] : 0;
        o00 = (unsigned)(t00 * D + C0 * 2); o01 = (unsigned)(t01 * D + C0 * 2); o10 = (unsigned)(t10 * D + C0 * 2); o11 = (unsigned)(t11 * D + C0 * 2);
    }
};
struct MoeDownSched {
    static constexpr bool GATHER = false, UNIT_DMA = true;
    int G, c; const volatile LAS int* tb; const int* rowtok; const float* rowgate;
    __device__ __forceinline__ unsigned abase(const Unit& u) const { return (unsigned)(u.pm * 256 * DFF); }
    __device__ __forceinline__ void unit_dma(const Unit& u, LAS unsigned char* side, int lane) const {
        const __amdgpu_buffer_rsrc_t rt = __builtin_amdgcn_make_buffer_rsrc((void*)rowtok, (short)0, 16 * RT_STRIDE * 4, 0x00020000);
        const __amdgpu_buffer_rsrc_t rg = __builtin_amdgcn_make_buffer_rsrc((void*)rowgate, (short)0, 16 * RT_STRIDE * 4, 0x00020000);
        const int off = (u.g * RT_STRIDE + (u.pm - tb[u.g]) * 256) * 4;
        __builtin_amdgcn_raw_ptr_buffer_load_lds(rt, (LAS unsigned*)(side + u.par * 2048), 16, lane * 16, off, 0, 0);
        __builtin_amdgcn_raw_ptr_buffer_load_lds(rg, (LAS unsigned*)(side + u.par * 2048 + 1024), 16, lane * 16, off, 0, 0);
    }
    __device__ __forceinline__ bool next(int i, Unit& u) const {
        const int T = tb[16]; const int L = i * G + c; if (L >= T * 4) return false;
        tile_map(L, T, 4, u.pm, u.pn); int g = 0;
#pragma unroll
        for (int j = 1; j < 16; ++j) g += (u.pm >= tb[j]) ? 1 : 0;
        u.g = g; u.B = (unsigned)(((g & 7) * D + u.pn * 256) * DFF); return true;
    }
};

struct EpiProj {
    static constexpr bool PERM = true, WIDE = true;
    bf16_t* P; bool dry;
    __device__ __forceinline__ void operator()(const f32x4 (&acc)[2][2][4][2], const Unit& u, int wr, int wc, int fr, int fq) const {
        if (dry) {
#pragma unroll
            for (int ai = 0; ai < 2; ++ai)
#pragma unroll
                for (int bj = 0; bj < 2; ++bj)
#pragma unroll
                    for (int m = 0; m < 4; ++m) asm volatile("" :: "v"(acc[ai][bj][m][0]), "v"(acc[ai][bj][m][1]));
            return; }
        const int row0 = u.pm * BM + wr * 64 + fr;
        if (u.pn >= 2 && u.pn < 6) {
            const int col0 = 512 + (u.pn - 2) * HALF + wc * 32 + 8 * fq;
#pragma unroll
            for (int ai = 0; ai < 2; ++ai)
#pragma unroll
                for (int m = 0; m < 4; ++m) { const f32x4 z0 = acc[ai][0][m][0] * acc[ai][1][m][0], z1 = acc[ai][0][m][1] * acc[ai][1][m][1];
                    u32x4 w; w.x = cvt_pk_bf16(z0[0], z0[1]); w.y = cvt_pk_bf16(z0[2], z0[3]); w.z = cvt_pk_bf16(z1[0], z1[1]); w.w = cvt_pk_bf16(z1[2], z1[3]);
                    *(u32x4*)(P + (size_t)(row0 + ai * HALF + m * 16) * NPO + col0) = w; }
            return; }
        const int colb = (u.pn < 2 ? u.pn * BM : u.pn * BM - 512) + wc * 64 + (fr < 8 ? 0 : 32) + 8 * fq; const bool lo = fr < 8;
#pragma unroll
        for (int ai = 0; ai < 2; ++ai)
#pragma unroll
            for (int m = 0; m < 4; ++m) { u32x4 a, b;
                { const f32x4 v0 = acc[ai][0][m][0], v1 = acc[ai][0][m][1]; a.x = cvt_pk_bf16(v0[0], v0[1]); a.y = cvt_pk_bf16(v0[2], v0[3]); a.z = cvt_pk_bf16(v1[0], v1[1]); a.w = cvt_pk_bf16(v1[2], v1[3]); }
                { const f32x4 v0 = acc[ai][1][m][0], v1 = acc[ai][1][m][1]; b.x = cvt_pk_bf16(v0[0], v0[1]); b.y = cvt_pk_bf16(v0[2], v0[3]); b.z = cvt_pk_bf16(v1[0], v1[1]); b.w = cvt_pk_bf16(v1[2], v1[3]); }
                u32x4 x = lo ? b : a, y;
                y.x = (unsigned)__builtin_amdgcn_update_dpp(0, (int)x.x, 0x128, 0xf, 0xf, false); y.y = (unsigned)__builtin_amdgcn_update_dpp(0, (int)x.y, 0x128, 0xf, 0xf, false);
                y.z = (unsigned)__builtin_amdgcn_update_dpp(0, (int)x.z, 0x128, 0xf, 0xf, false); y.w = (unsigned)__builtin_amdgcn_update_dpp(0, (int)x.w, 0x128, 0xf, 0xf, false);
                const u32x4 first = lo ? a : y, second = lo ? y : b;
                bf16_t* rowp = P + (size_t)(u.pm * BM + wr * 64 + ai * HALF + m * 16 + (fr & 7)) * NPO + colb;
                *(u32x4*)rowp = first; *(u32x4*)(rowp + (size_t)8 * NPO) = second; }
    }
};
struct EpiResid {
    static constexpr bool PERM = true, WIDE = true;
    bf16_t* HB; const float* gate; float gscale;
    __device__ __forceinline__ void operator()(const f32x4 (&acc)[2][2][4][2], const Unit& u, int wr, int wc, int fr, int fq) const {
        if (PROBE_DRY && gscale == 0.f) {
#pragma unroll
            for (int ai = 0; ai < 2; ++ai)
#pragma unroll
                for (int bj = 0; bj < 2; ++bj)
#pragma unroll
                    for (int m = 0; m < 4; ++m) asm volatile("" :: "v"(acc[ai][bj][m][0]), "v"(acc[ai][bj][m][1]));
            return; }
        const int rowg = u.pm * BM; const bool isc = rowg >= NL;
        const int bidx = isc ? 32 : (rowg >> 11);
        const bool lo = fr < 8;
        const int colw = u.pn * BM + wc * 64 + 8 * fq;
        const float* gv = gate + (size_t)bidx * 6144 + colw;
        bf16_t* out = HB + (size_t)(rowg + wr * 64 + (fr & 7)) * D + colw + (lo ? 0 : 32);
        u32x4 r[2][4][2];
#pragma unroll
        for (int ai = 0; ai < 2; ++ai)
#pragma unroll
            for (int m = 0; m < 4; ++m)
#pragma unroll
                for (int h = 0; h < 2; ++h) r[ai][m][h] = *(const u32x4*)(out + (size_t)(ai * HALF + m * 16 + 8 * h) * D);
        f32x4 g[2][2];
#pragma unroll
        for (int bj = 0; bj < 2; ++bj)
#pragma unroll
            for (int n = 0; n < 2; ++n) g[bj][n] = *(const f32x4*)(gv + bj * 32 + n * 4) * gscale;
#pragma unroll
        for (int ai = 0; ai < 2; ++ai)
#pragma unroll
            for (int m = 0; m < 4; ++m) {
                const f32x4 a0 = g[0][0] * acc[ai][0][m][0], a1 = g[0][1] * acc[ai][0][m][1], b0 = g[1][0] * acc[ai][1][m][0], b1 = g[1][1] * acc[ai][1][m][1];
                float x[8], y[8];
#pragma unroll
                for (int i = 0; i < 4; ++i) { x[i] = lo ? b0[i] : a0[i]; x[4 + i] = lo ? b1[i] : a1[i]; }
#pragma unroll
                for (int i = 0; i < 8; ++i) y[i] = __builtin_bit_cast(float, __builtin_amdgcn_update_dpp(0, __builtin_bit_cast(int, x[i]), 0x128, 0xf, 0xf, false));
                float f[8], s2[8];
#pragma unroll
                for (int i = 0; i < 4; ++i) { f[i] = lo ? a0[i] : y[i]; f[4 + i] = lo ? a1[i] : y[4 + i]; s2[i] = lo ? y[i] : b0[i]; s2[4 + i] = lo ? y[4 + i] : b1[i]; }
#pragma unroll
                for (int h = 0; h < 2; ++h) { const u32x4 rr = r[ai][m][h]; const float* v = h ? s2 : f;
                    u32x4 w; w.x = cvt_pk_bf16(bflo(rr.x) + v[0], bfhi(rr.x) + v[1]); w.y = cvt_pk_bf16(bflo(rr.y) + v[2], bfhi(rr.y) + v[3]);
                    w.z = cvt_pk_bf16(bflo(rr.z) + v[4], bfhi(rr.z) + v[5]); w.w = cvt_pk_bf16(bflo(rr.w) + v[6], bfhi(rr.w) + v[7]);
                    *(u32x4*)(out + (size_t)(ai * HALF + m * 16 + 8 * h) * D) = w; } }
    }
};
__device__ __forceinline__ float clamp448(float x) { return fminf(fmaxf(x, -448.0f), 448.0f); }
struct EpiSwiglu {
    static constexpr bool PERM = true, WIDE = false;
    unsigned char* ACT; float iscale, oscale;
    __device__ __forceinline__ void operator()(const f32x4 (&acc)[2][2][4][2], const Unit& u, int wr, int wc, int fr, int fq) const {
        if (PROBE_DRY && oscale == 0.f) {
#pragma unroll
            for (int ai = 0; ai < 2; ++ai)
#pragma unroll
                for (int bj = 0; bj < 2; ++bj)
#pragma unroll
                    for (int m = 0; m < 4; ++m) asm volatile("" :: "v"(acc[ai][bj][m][0]), "v"(acc[ai][bj][m][1]));
            return; }
        const int row0 = u.pm * BM + wr * 64 + fr, col0 = u.pn * HALF + wc * 32 + 8 * fq;
        const float c1 = -1.4426950408889634f * iscale, kk = oscale == 0.f ? 1.0e30f : 1.0f / (iscale * iscale * oscale);
#pragma unroll
        for (int ai = 0; ai < 2; ++ai)
#pragma unroll
            for (int m = 0; m < 4; ++m) { unsigned char* rowp = ACT + (size_t)(row0 + ai * HALF + m * 16) * DFF + col0;
                float o[8];
#pragma unroll
                for (int n = 0; n < 2; ++n)
#pragma unroll
                    for (int h2 = 0; h2 < 2; ++h2) {
                        const f32x2 a = {acc[ai][0][m][n][2 * h2], acc[ai][0][m][n][2 * h2 + 1]}, b = {acc[ai][1][m][n][2 * h2], acc[ai][1][m][n][2 * h2 + 1]};
                        const f32x2 t = a * c1; f32x2 e; e.x = __builtin_amdgcn_exp2f(t.x); e.y = __builtin_amdgcn_exp2f(t.y);
                        const f32x2 d = e * kk + kk; f32x2 r; r.x = __builtin_amdgcn_rcpf(d.x); r.y = __builtin_amdgcn_rcpf(d.y);
                        const f32x2 p = (a * b) * r;
                        o[n * 4 + 2 * h2] = __builtin_amdgcn_fmed3f(p.x, -448.0f, 448.0f); o[n * 4 + 2 * h2 + 1] = __builtin_amdgcn_fmed3f(p.y, -448.0f, 448.0f); }
                int w0 = 0, w1 = 0;
                w0 = __builtin_amdgcn_cvt_pk_fp8_f32(o[0], o[1], w0, false); w0 = __builtin_amdgcn_cvt_pk_fp8_f32(o[2], o[3], w0, true);
                w1 = __builtin_amdgcn_cvt_pk_fp8_f32(o[4], o[5], w1, false); w1 = __builtin_amdgcn_cvt_pk_fp8_f32(o[6], o[7], w1, true);
                *(u32x2*)rowp = (u32x2){(unsigned)w0, (unsigned)w1}; }
    }
};
struct EpiMoeDown {
    static constexpr bool PERM = true, WIDE = false;
    unsigned char* Y0; unsigned char* Y1; const LAS unsigned char* side; const volatile LAS int* tb; float gscale;
    __device__ __forceinline__ void operator()(const f32x4 (&acc)[2][2][4][2], const Unit& u, int wr, int wc, int fr, int fq) const {
        const int nv = tb[32 + u.g] - (u.pm - tb[u.g]) * 256;
        const LAS int* lt = (const LAS int*)(side + u.par * 2048); const LAS float* lg = (const LAS float*)(side + u.par * 2048 + 1024);
        unsigned char* Y = u.g < 8 ? Y0 : Y1;
        const int col0 = u.pn * BM + wc * 32 + 8 * fq;
        int tok[2][4]; float gt[2][4]; bool ok[2][4];
#pragma unroll
        for (int ai = 0; ai < 2; ++ai)
#pragma unroll
            for (int m = 0; m < 4; ++m) { const int rl = ai * HALF + wr * 64 + m * 16 + fr; ok[ai][m] = rl < nv; const int tk = lt[rl]; const float gg = lg[rl]; tok[ai][m] = ok[ai][m] ? tk : 0; gt[ai][m] = ok[ai][m] ? gg * gscale : 0.f; }
#pragma unroll
        for (int ai = 0; ai < 2; ++ai)
#pragma unroll
            for (int m = 0; m < 4; ++m) if (ok[ai][m]) { unsigned char* yp = Y + (size_t)tok[ai][m] * D + col0; const float gg = gt[ai][m];
#pragma unroll
                for (int bj = 0; bj < 2; ++bj) { const f32x4 a0 = acc[ai][bj][m][0] * gg, a1 = acc[ai][bj][m][1] * gg; int w0 = 0, w1 = 0;
                    w0 = __builtin_amdgcn_cvt_pk_fp8_f32(clamp448(a0[0]), clamp448(a0[1]), w0, false); w0 = __builtin_amdgcn_cvt_pk_fp8_f32(clamp448(a0[2]), clamp448(a0[3]), w0, true);
                    w1 = __builtin_amdgcn_cvt_pk_fp8_f32(clamp448(a1[0]), clamp448(a1[1]), w1, false); w1 = __builtin_amdgcn_cvt_pk_fp8_f32(clamp448(a1[2]), clamp448(a1[3]), w1, true);
                    *(u32x2*)(yp + bj * HALF) = (u32x2){(unsigned)w0, (unsigned)w1}; } }
    }
};
}

struct Args { const float* in[21]; float* out; unsigned char* ws; int lo, hi; };
enum { I_X = 0, I_C, I_CTX, I_CCTX, I_N1G, I_N2G, I_WADA, I_BADA, I_WIN, I_CONVW, I_BG, I_MNG, I_WOUT, I_FW1, I_FW3, I_FW2, I_ROUTER, I_MW1, I_MW3, I_MW2, I_FNG };

struct Frame { LAS unsigned char* lds; int wid, G, wg;
    __device__ __forceinline__ int lane() const { return lane_id(); }
    __device__ __forceinline__ int tid() const { return wid * 64 + lane_id(); } };
typedef const __attribute__((address_space(4))) Args* KArgs;
#define KA() ({ KArgs _k = (KArgs)__builtin_amdgcn_kernarg_segment_ptr(); asm volatile("" : "+s"(_k)); _k; })

__device__ __forceinline__ int conv_row(int mode, int n, float& scale) {
    scale = 1.f;
    if (mode == 0) return n;
    if (mode == 1) { if (n >= 2048 && n < 2560) scale = 0.08838834764831845f;
        if (n >= 512 && n < 1024) { const int j = n - 512; return (2 + (j >> 7)) * 256 + ((j & 127) >> 5) * 64 + (j & 31); }
        if (n >= 1024 && n < 1536) { const int j = n - 1024; return (2 + (j >> 7)) * 256 + ((j & 127) >> 5) * 64 + 32 + (j & 31); }
        if (n < 3072) return n; if (n < 3088) return 3584 + (n - 3072); return n - 16; }
    return (n >> 7) * 256 + (n & 127) + (mode == 3 ? 128 : 0);
}
__device__ __forceinline__ void conv_tiles(const Frame& F, const float* src, bf16_t* dst, int K, int N, int mode, float fp8scale  , int& gbase) {
    const int lane = F.lane();
    LAS float* tile = (LAS float*)(F.lds + F.wid * (64 * 65 * 4 + 64));
    const int GW = F.G * 8, gw = F.wg * 8 + F.wid;
    const int tn = (N + 63) / 64, ntile = (K / 64) * tn;
    int t = (gw - gbase) % GW; if (t < 0) t += GW;
    const int row = lane >> 4, c4 = (lane & 15) * 4;
    for (; t < ntile; t += GW) {
        const int k0 = (t / tn) * 64, n0 = (t % tn) * 64;
        f32x4 v[16];
#pragma unroll
        for (int i = 0; i < 16; ++i) { v[i] = (f32x4){0.f, 0.f, 0.f, 0.f}; if (n0 + c4 < N) v[i] = *(const f32x4*)(src + (size_t)(k0 + row + 4 * i) * N + n0 + c4); }
#pragma unroll
        for (int i = 0; i < 16; ++i) { LAS float* p = tile + (row + 4 * i) * 65 + c4; p[0] = v[i][0]; p[1] = v[i][1]; p[2] = v[i][2]; p[3] = v[i][3]; }
        asm volatile("s_waitcnt lgkmcnt(0)" ::: "memory");
#pragma unroll
        for (int p = 0; p < 8; ++p) { const int n = (lane >> 3) + 8 * p, kc = (lane & 7) * 8;
            if (n0 + n < N) { float sc; const int drow = conv_row(mode, n0 + n, sc); float x[8];
#pragma unroll
                for (int j = 0; j < 8; ++j) x[j] = tile[(kc + j) * 65 + n] * sc;
                if (fp8scale == 0.f) {
                    u32x4 w; w.x = cvt_pk_bf16(x[0], x[1]); w.y = cvt_pk_bf16(x[2], x[3]); w.z = cvt_pk_bf16(x[4], x[5]); w.w = cvt_pk_bf16(x[6], x[7]);
                    *(u32x4*)(dst + (size_t)drow * K + k0 + kc) = w;
                } else {
#pragma unroll
                    for (int j = 0; j < 8; ++j) x[j] = fminf(fmaxf(x[j] * fp8scale, -448.0f), 448.0f);
                    int w0 = 0, w1 = 0;
                    w0 = __builtin_amdgcn_cvt_pk_fp8_f32(x[0], x[1], w0, false); w0 = __builtin_amdgcn_cvt_pk_fp8_f32(x[2], x[3], w0, true);
                    w1 = __builtin_amdgcn_cvt_pk_fp8_f32(x[4], x[5], w1, false); w1 = __builtin_amdgcn_cvt_pk_fp8_f32(x[6], x[7], w1, true);
                    *(u32x2*)((unsigned char*)dst + (size_t)drow * K + k0 + kc) = (u32x2){(unsigned)w0, (unsigned)w1};
                } } }
        asm volatile("s_waitcnt lgkmcnt(0)" ::: "memory");
    }
    gbase = (gbase + ntile) % GW;
}
constexpr int P0_JOBS = 19;
__device__ __forceinline__ void conv_job(const Frame& F, int j, int& gbase) {
    KArgs ka = KA(); unsigned char* const ws = ka->ws;
    const float* src; bf16_t* dst; int K, N, mode; float f8 = 0.f;
    if (j < 2)       { src = ka->in[I_WIN] + (size_t)j * D * PIN; dst = (bf16_t*)(ws + WS_WIN) + (size_t)j * NPAD * D; K = D; N = PIN; mode = 1; }
    else if (j < 4)  { src = ka->in[I_WOUT] + (size_t)(j - 2) * D * D; dst = (bf16_t*)(ws + WS_WOUT) + (size_t)(j - 2) * D * D; K = D; N = D; mode = 0; }
    else if (j == 4) { src = ka->in[I_FW1]; dst = (bf16_t*)(ws + WS_WUP); K = D; N = DFF; mode = 2; f8 = S_W13; }
    else if (j == 5) { src = ka->in[I_FW3]; dst = (bf16_t*)(ws + WS_WUP); K = D; N = DFF; mode = 3; f8 = S_W13; }
    else if (j == 6) { src = ka->in[I_FW2]; dst = (bf16_t*)(ws + WS_WDN); K = DFF; N = D; mode = 0; f8 = S_W2; }
    else if (j < 15) { const int e = j - 7;  src = ka->in[I_MW1] + (size_t)e * D * DFF; dst = (bf16_t*)(ws + WS_MUP + (size_t)e * 2 * DFF * D); K = D; N = DFF; mode = 2; f8 = S_W13; }
    else if (j < 23) { const int e = j - 15; src = ka->in[I_MW3] + (size_t)e * D * DFF; dst = (bf16_t*)(ws + WS_MUP + (size_t)e * 2 * DFF * D); K = D; N = DFF; mode = 3; f8 = S_W13; }
    else             { const int e = j - 23; src = ka->in[I_MW2] + (size_t)e * DFF * D; dst = (bf16_t*)(ws + WS_MDN + (size_t)e * D * DFF); K = DFF; N = D; mode = 0; f8 = S_W2; }
    conv_tiles(F, src, dst, K, N, mode, f8, gbase);
}
__device__ __forceinline__ void p0_prologue(const Frame& F, int skip  ) {
    const int tid = F.tid(); KArgs ka = KA(); unsigned char* const ws = ka->ws;
    if (F.wg < 192 && !(skip & 1)) {
        constexpr int SP = 2080;
        for (int idx = tid; idx < 48 * 512; idx += 512) { const int b = idx >> 9, k2 = (idx & 511) * 2; float v0 = 0.f, v1 = 0.f;
            if (b < 33) { const float* cp = b < 32 ? ka->in[I_C] + b * 1024 : ka->in[I_CCTX]; v0 = cp[k2]; v1 = cp[k2 + 1]; v0 = v0 / (1.0f + __expf(-v0)); v1 = v1 / (1.0f + __expf(-v1)); }
            *(LAS unsigned*)(F.lds + b * SP + k2 * 2) = cvt_pk_bf16(v0, v1); }
        __syncthreads();
        const int layer = F.wg / 96, col0 = (F.wg % 96) * 64, g = F.wid;
        const int gl = F.lane(), gfr = gl & 15, gfq = gl >> 4;
        const float* Wu = ka->in[I_WADA] + (size_t)layer * 1024 * 6144 + col0 + (size_t)(g * 128) * 6144;
        const unsigned loff = (unsigned)(gfr + 8 * gfq * 6144);
        float wv[4][4][8];
#pragma unroll
        for (int ks = 0; ks < 4; ++ks)
#pragma unroll
            for (int nt = 0; nt < 4; ++nt)
#pragma unroll
                for (int j = 0; j < 8; ++j) wv[ks][nt][j] = (Wu + (size_t)(32 * ks + j) * 6144 + 16 * nt)[loff];
        f32x4 acc[4][3];
#pragma unroll
        for (int nt = 0; nt < 4; ++nt)
#pragma unroll
            for (int bt = 0; bt < 3; ++bt) acc[nt][bt] = (f32x4){0.f, 0.f, 0.f, 0.f};
#pragma unroll
        for (int ks = 0; ks < 4; ++ks) {
            bf16x8 Bf[3];
#pragma unroll
            for (int bt = 0; bt < 3; ++bt) Bf[bt] = *(const LAS bf16x8*)(F.lds + (16 * bt + gfr) * SP + (g * 128 + 32 * ks + 8 * gfq) * 2);
#pragma unroll
            for (int nt = 0; nt < 4; ++nt) {
                u32x4 aw; aw.x = cvt_pk_bf16(wv[ks][nt][0], wv[ks][nt][1]); aw.y = cvt_pk_bf16(wv[ks][nt][2], wv[ks][nt][3]); aw.z = cvt_pk_bf16(wv[ks][nt][4], wv[ks][nt][5]); aw.w = cvt_pk_bf16(wv[ks][nt][6], wv[ks][nt][7]);
                const bf16x8 Af = __builtin_bit_cast(bf16x8, aw);
#pragma unroll
                for (int bt = 0; bt < 3; ++bt) acc[nt][bt] = __builtin_amdgcn_mfma_f32_16x16x32_bf16(Af, Bf[bt], acc[nt][bt], 0, 0, 0);
            }
        }
        __syncthreads();
        LAS float* red = (LAS float*)F.lds;
#pragma unroll
        for (int nt = 0; nt < 4; ++nt)
#pragma unroll
            for (int bt = 0; bt < 3; ++bt) { const int b = 16 * bt + gfr;
                if (b < 33) {
#pragma unroll
                    for (int r = 0; r < 4; ++r) red[(g * 33 + b) * 64 + 16 * nt + 4 * gfq + r] = acc[nt][bt][r]; } }
        __syncthreads();
        float* MOD = (float*)(ws + WS_MOD); const float* bada = ka->in[I_BADA];
        for (int idx = tid; idx < 33 * 64; idx += 512) { const int b = idx >> 6, cc = idx & 63; float sum = 0.f;
#pragma unroll
            for (int gg = 0; gg < 8; ++gg) sum += red[(gg * 33 + b) * 64 + cc];
            MOD[((size_t)layer * 33 + b) * 6144 + col0 + cc] = sum + bada[layer * 6144 + col0 + cc]; }
        __syncthreads();
    }
    { bf16_t* WIN = (bf16_t*)(ws + WS_WIN);
      for (int l = 0; l < 2; ++l) { u32x4* p = (u32x4*)(WIN + ((size_t)l * NPAD + PIN) * D); const int n16 = (NPAD - PIN) * D * 2 / 16;
          for (int i = F.wg * 512 + tid; i < n16; i += F.G * 512) p[i] = (u32x4){0u, 0u, 0u, 0u}; } }
    int gbase = 0;
    for (int j = 0; j < ((skip & 2) ? 0 : P0_JOBS); ++j) conv_job(F, j, gbase);
}
__device__ __forceinline__ void tail_convert(const Frame& F, int ntiles, int j0, int j1) {
    const int rem = ntiles % F.G; if (F.wg < rem) return;
    Frame F2 = F; F2.G = F.G - rem; F2.wg = F.wg - rem;
    int gbase = 0;
    for (int j = j0; j < j1; ++j) conv_job(F2, j, gbase);
}

template <bool ROUTER, bool OUT8, bool SRC16, bool GATES>
__device__ __forceinline__ void norm_phase(const Frame& F, const float* srcL, const float* srcC  , int nrows, const float* gain, const float* mod  , int chunk_shift, bf16_t* U, const float* router,
                                           const bf16_t* Wg = nullptr, const float* bgate = nullptr, float* GT = nullptr, bf16_t* HBcopy = nullptr  ) {
    const int lane = F.lane(), wid = F.wid, tid = F.tid();
    constexpr int WG_RB = 2080;
    if constexpr (GATES) {
        for (int i = tid; i < 16 * 128; i += 512) { const int n = i >> 7, ch = i & 127; *(LAS u32x4*)(F.lds + n * WG_RB + ch * 16) = *(const u32x4*)(Wg + (size_t)n * D + ch * 8); }
        __syncthreads();
    }
    const int rpw = (nrows + F.G * 8 - 1) / (F.G * 8);
    const int rbase = (F.wg * 8 + wid) * rpw;
    LAS float* rl = (LAS float*)F.lds;
    LAS int* cntl = (LAS int*)(F.lds + 32768);
    LAS int* sel = (LAS int*)(F.lds + 32768 + 256);
    f32x4 rw[ROUTER ? 16 : 1][2];
    if (ROUTER) {
#pragma unroll
        for (int j = 0; j < 4; ++j)
#pragma unroll
            for (int i = 0; i < 4; ++i) { const float* rp = router + (size_t)(j * 256 + lane * 4 + i) * 8; rw[j * 4 + i][0] = *(const f32x4*)rp; rw[j * 4 + i][1] = *(const f32x4*)(rp + 4); }
        if (tid < 32) cntl[tid] = 0;
        __syncthreads();
    }
    f32x4 gn[4];
#pragma unroll
    for (int j = 0; j < 4; ++j) gn[j] = *(const f32x4*)(gain + j * 256 + lane * 4);
    typedef typename std::conditional<SRC16, u32x2, f32x4>::type raw_t;
    constexpr int NB4 = 4;
#define NP_LOAD(dst, row) do { const int _r = (row); _Pragma("unroll") for (int _j = 0; _j < 4; ++_j) { \
        if constexpr (SRC16) dst[_j] = *(const raw_t*)((const bf16_t*)srcL + (size_t)_r * D + _j * 256 + lane * 4); \
        else dst[_j] = *(const raw_t*)((_r >= NL ? srcC + (size_t)(_r - NL) * D : srcL + (size_t)_r * D) + _j * 256 + lane * 4); } } while (0)
    int cur_b = -1; f32x4 shv[4], scv[4];
#pragma unroll
    for (int j = 0; j < 4; ++j) { shv[j] = (f32x4){0.f, 0.f, 0.f, 0.f}; scv[j] = shv[j]; }
    for (int rr0 = 0; rr0 < rpw; rr0 += NB4) {
      if (rbase + rr0 >= nrows) break;
      { const int r = rbase + rr0; const int bidx = (r >= NL) ? 32 : (r >> 11);
        if (bidx != cur_b) { cur_b = bidx; const float* mv = mod + (size_t)bidx * 6144 + chunk_shift * 1024;
#pragma unroll
            for (int j = 0; j < 4; ++j) { shv[j] = *(const f32x4*)(mv + j * 256 + lane * 4); scv[j] = *(const f32x4*)(mv + 1024 + j * 256 + lane * 4) + 1.0f; }
#pragma unroll
            for (int j = 0; j < 4; ++j) asm volatile("" : "+v"(shv[j]), "+v"(scv[j])); } }
      raw_t bt[NB4][4];
#pragma unroll
      for (int q = 0; q < NB4; ++q) { int rl = rbase + rr0 + q; rl = rl < nrows ? rl : nrows - 1; NP_LOAD(bt[q], rl); }
#pragma unroll
      for (int q = 0; q < NB4; ++q) {
        const int rr = rr0 + q; const int r = rbase + rr; if (rr >= rpw || r >= nrows) continue;
        raw_t cr[4];
#pragma unroll
        for (int j = 0; j < 4; ++j) cr[j] = bt[q][j];
        f32x4 x[4]; float ss = 0.f;
#pragma unroll
        for (int j = 0; j < 4; ++j) {
            if constexpr (SRC16) { const u32x2 w = cr[j]; x[j] = (f32x4){bflo(w.x), bfhi(w.x), bflo(w.y), bfhi(w.y)}; }
            else { x[j] = cr[j];
                if (HBcopy) { u32x2 w; w.x = cvt_pk_bf16(x[j][0], x[j][1]); w.y = cvt_pk_bf16(x[j][2], x[j][3]); *(u32x2*)(HBcopy + (size_t)r * D + j * 256 + lane * 4) = w; } }
            ss += x[j][0] * x[j][0] + x[j][1] * x[j][1] + x[j][2] * x[j][2] + x[j][3] * x[j][3]; }
        ss = wave_sum(ss);
        const float rstd = rsqrtf(ss * (1.0f / 1024.0f) + EPS);
        float lg[8];
        if (ROUTER) {
#pragma unroll
            for (int e = 0; e < 8; ++e) lg[e] = 0.f;
        }
#pragma unroll
        for (int j = 0; j < 4; ++j) {
            f32x4 u = (x[j] * rstd * gn[j]) * scv[j] + shv[j];
            if (OUT8) { int w8 = 0; w8 = __builtin_amdgcn_cvt_pk_fp8_f32(fminf(fmaxf(u[0] * S_A, -448.f), 448.f), fminf(fmaxf(u[1] * S_A, -448.f), 448.f), w8, false);
                w8 = __builtin_amdgcn_cvt_pk_fp8_f32(fminf(fmaxf(u[2] * S_A, -448.f), 448.f), fminf(fmaxf(u[3] * S_A, -448.f), 448.f), w8, true);
                *(int*)((unsigned char*)U + (size_t)r * D + j * 256 + lane * 4) = w8; }
            else { u32x2 w; w.x = cvt_pk_bf16(u[0], u[1]); w.y = cvt_pk_bf16(u[2], u[3]);
                *(u32x2*)(U + (size_t)r * D + j * 256 + lane * 4) = w; }
            if (ROUTER) {
#pragma unroll
                for (int i = 0; i < 4; ++i) { const f32x4 r0 = rw[ROUTER ? j * 4 + i : 0][0], r1 = rw[ROUTER ? j * 4 + i : 0][1];
                    lg[0] += u[i] * r0[0]; lg[1] += u[i] * r0[1]; lg[2] += u[i] * r0[2]; lg[3] += u[i] * r0[3];
                    lg[4] += u[i] * r1[0]; lg[5] += u[i] * r1[1]; lg[6] += u[i] * r1[2]; lg[7] += u[i] * r1[3]; }
            }
        }
        if (ROUTER) {
            { const bool h5 = (lane & 32) != 0, h4 = (lane & 16) != 0, h3 = (lane & 8) != 0;
              float a4[4], a2[2], a1;
#pragma unroll
              for (int q = 0; q < 4; ++q) { const float keep = h5 ? lg[4 + q] : lg[q], send = h5 ? lg[q] : lg[4 + q]; a4[q] = keep + __shfl_xor(send, 32); }
#pragma unroll
              for (int q = 0; q < 2; ++q) { const float keep = h4 ? a4[2 + q] : a4[q], send = h4 ? a4[q] : a4[2 + q]; a2[q] = keep + __shfl_xor(send, 16); }
              { const float keep = h3 ? a2[1] : a2[0], send = h3 ? a2[0] : a2[1]; a1 = keep + __shfl_xor(send, 8); }
              a1 += __shfl_xor(a1, 4); a1 += __shfl_xor(a1, 2); a1 += __shfl_xor(a1, 1);
#pragma unroll
              for (int e = 0; e < 8; ++e) lg[e] = __shfl(a1, ((e >> 2) & 1) * 32 + ((e >> 1) & 1) * 16 + (e & 1) * 8); }
            int e0 = 0; float v0 = lg[0];
#pragma unroll
            for (int e = 1; e < 8; ++e) if (lg[e] > v0) { v0 = lg[e]; e0 = e; }
            int e1 = -1; float v1 = -3.0e38f;
#pragma unroll
            for (int e = 0; e < 8; ++e) if (e != e0 && lg[e] > v1) { v1 = lg[e]; e1 = e; }
            if (lane == 0) {
                const float g0 = 1.0f / (1.0f + __expf(v1 - v0)), g1 = 1.0f - g0;
                const int r0 = atomicAdd((int*)(cntl + e0), 1), r1 = atomicAdd((int*)(cntl + 8 + e1), 1);
                LAS int* sp = sel + (wid * rpw + rr) * 6;
                sp[0] = e0 | (e1 << 8); sp[1] = r0; sp[2] = r1; sp[3] = __float_as_int(g0); sp[4] = __float_as_int(g1); sp[5] = r;
            }
        }
      }
    }
    if constexpr (GATES) {
        asm volatile("s_waitcnt vmcnt(0)" ::: "memory");
        const int fr = lane & 15, fq = lane >> 4;
        int nr = nrows - rbase; nr = nr < 0 ? 0 : (nr > rpw ? rpw : nr);
        const f32x4 bias = *(const f32x4*)(bgate + 4 * fq);
        for (int g0 = 0; g0 < nr; g0 += 16) {
            int rl = g0 + fr; if (rl > nr - 1) rl = nr - 1;
            const bf16_t* up = U + (size_t)(rbase + rl) * D + 8 * fq;
            f32x4 a0 = (f32x4){0.f, 0.f, 0.f, 0.f}, a1 = a0;
#pragma unroll 8
            for (int ks = 0; ks < 32; ks += 2) {
                const bf16x8 u0 = *(const bf16x8*)(up + 32 * ks), u1 = *(const bf16x8*)(up + 32 * ks + 32);
                const bf16x8 w0 = *(const LAS bf16x8*)(F.lds + fr * WG_RB + (32 * ks + 8 * fq) * 2), w1 = *(const LAS bf16x8*)(F.lds + fr * WG_RB + (32 * ks + 32 + 8 * fq) * 2);
                a0 = __builtin_amdgcn_mfma_f32_16x16x32_bf16(w0, u0, a0, 0, 0, 0); a1 = __builtin_amdgcn_mfma_f32_16x16x32_bf16(w1, u1, a1, 0, 0, 0);
            }
            if (g0 + fr < nr) *(f32x4*)(GT + (size_t)(rbase + g0 + fr) * 16 + 4 * fq) = a0 + a1 + bias;
        }
    }
    if (ROUTER) {
        __syncthreads();
        unsigned char* const ws = KA()->ws;
        if (tid < 16) { unsigned* gc = (unsigned*)(ws + WS_CTL + CTL_GCNT); cntl[16 + tid] = (int)__hip_atomic_fetch_add(gc + tid, (unsigned)cntl[tid], __ATOMIC_RELAXED, __HIP_MEMORY_SCOPE_AGENT); }
        __syncthreads();
        int* rowtok = (int*)(ws + WS_RTOK); float* rowgate = (float*)(ws + WS_RGATE);
        for (int i = tid; i < 8 * rpw; i += 512) {
            const int w = i / rpw, rr = i % rpw; const int r = (F.wg * 8 + w) * rpw + rr;
            if (r < nrows) { const LAS int* sp = sel + i * 6; const int e0 = sp[0] & 255, e1 = sp[0] >> 8;
                const int p0 = cntl[16 + e0] + sp[1], p1 = cntl[16 + 8 + e1] + sp[2];
                rowtok[(size_t)e0 * RT_STRIDE + p0] = sp[5]; rowgate[(size_t)e0 * RT_STRIDE + p0] = __int_as_float(sp[3]);
                rowtok[(size_t)(8 + e1) * RT_STRIDE + p1] = sp[5]; rowgate[(size_t)(8 + e1) * RT_STRIDE + p1] = __int_as_float(sp[4]); }
        }
        __syncthreads();
    }
}

#undef NP_LOAD
__device__ __forceinline__ void unpack8(const u32x4 w, float (&v)[8]) { v[0] = bflo(w.x); v[1] = bfhi(w.x); v[2] = bflo(w.y); v[3] = bfhi(w.y); v[4] = bflo(w.z); v[5] = bfhi(w.z); v[6] = bflo(w.w); v[7] = bfhi(w.w); }
__device__ __forceinline__ u32x4 pack8(const float (&v)[8]) { u32x4 w; w.x = cvt_pk_bf16(v[0], v[1]); w.y = cvt_pk_bf16(v[2], v[3]); w.z = cvt_pk_bf16(v[4], v[5]); w.w = cvt_pk_bf16(v[6], v[7]); return w; }
__device__ __forceinline__ void mix_phase(const Frame& F, int nrows, const float* gnorm  ) {
    const int lane = F.lane(); unsigned char* const ws = KA()->ws;
    const bf16_t* P = (const bf16_t*)(ws + WS_PROJ); const bf16_t* HL = (const bf16_t*)KA()->out; bf16_t* A2 = (bf16_t*)(ws + WS_U);
    const int rpw = (nrows + F.G * 8 - 1) / (F.G * 8); const int rbase = (F.wg * 8 + F.wid) * rpw;
    if (rbase >= nrows) return;
    float gnv[8];
#pragma unroll
    for (int j = 0; j < 8; ++j) gnv[j] = gnorm[lane * 8 + j];
    u32x4 n_hf, n_hb, n_og;
#define MX_LOAD(r) do { n_og = *(const u32x4*)(P + (size_t)(r) * NPO + 2560 + lane * 8); n_hf = *(const u32x4*)(HL + (size_t)(r) * 512 + lane * 8); n_hb = *(const u32x4*)(HL + (size_t)(MT + (r)) * 512 + lane * 8); } while (0)
    MX_LOAD(rbase);
    for (int rr = 0; rr < rpw; ++rr) {
        const int r = rbase + rr; if (r >= nrows) break;
        const u32x4 c_hf = n_hf, c_hb = n_hb, c_og = n_og;
        if (rr + 1 < rpw && r + 1 < nrows) MX_LOAD(r + 1);
        float hf[8], hb[8], og[8], y[8];
        unpack8(c_hf, hf); unpack8(c_hb, hb); unpack8(c_og, og);
        float ss = 0.f;
#pragma unroll
        for (int j = 0; j < 8; ++j) { hf[j] += hb[j]; ss += hf[j] * hf[j]; }
        ss += __shfl_xor(ss, 1); ss += __shfl_xor(ss, 2); ss += __shfl_xor(ss, 4); ss += __shfl_xor(ss, 8);
        const float rstd = rsqrtf(ss * (1.0f / 128.0f) + EPS);
#pragma unroll
        for (int j = 0; j < 8; ++j) y[j] = hf[j] * rstd * gnv[j] * sigmoidf_(og[j]);
        *(u32x4*)(A2 + (size_t)r * D + 512 + lane * 8) = pack8(y);
    }
#undef MX_LOAD
}

__device__ __forceinline__ void final_phase(const Frame& F) {
    const int lane = F.lane(); KArgs ka = KA(); const float* gain = ka->in[I_FNG]; float* const outp = ka->out;
    const bf16_t* HB = (const bf16_t*)(ka->ws + WS_HB); const unsigned char* Y0 = (const unsigned char*)(ka->ws + WS_U); const unsigned char* Y1 = (const unsigned char*)(ka->ws + WS_Y1);
    const float* g2 = (const float*)(ka->ws + WS_MOD) + 33 * 6144 + 5 * 1024;
    const int rpw = (NL + F.G * 8 - 1) / (F.G * 8); const int rbase = (F.wg * 8 + F.wid) * rpw;
    f32x4 gn[4], gv[4];
#pragma unroll
    for (int j = 0; j < 4; ++j) { gn[j] = *(const f32x4*)(gain + j * 256 + lane * 4); gv[j] = (f32x4){0.f, 0.f, 0.f, 0.f}; }
    int cur_b = -1;
    for (int rr0 = 0; rr0 < rpw; rr0 += 4) {
      if (rbase + rr0 >= NL) break;
      { const int bidx = (rbase + rr0) >> 11;
        if (bidx != cur_b) { cur_b = bidx;
#pragma unroll
            for (int j = 0; j < 4; ++j) gv[j] = *(const f32x4*)(g2 + (size_t)bidx * 6144 + j * 256 + lane * 4) * (1.0f / S_Y);
#pragma unroll
            for (int j = 0; j < 4; ++j) asm volatile("" : "+v"(gv[j])); } }
      u32x2 bx[4][4]; int by[4][4], bz[4][4];
#pragma unroll
      for (int q = 0; q < 4; ++q) { int rl = rbase + rr0 + q; rl = rl < NL ? rl : NL - 1;
#pragma unroll
          for (int j = 0; j < 4; ++j) { bx[q][j] = *(const u32x2*)(HB + (size_t)rl * D + j * 256 + lane * 4); by[q][j] = *(const int*)(Y0 + (size_t)rl * D + j * 256 + lane * 4); bz[q][j] = *(const int*)(Y1 + (size_t)rl * D + j * 256 + lane * 4); } }
#pragma unroll
      for (int q = 0; q < 4; ++q) {
        const int rr = rr0 + q; const int r = rbase + rr; if (rr >= rpw || r >= NL) continue;
        u32x2 cr[4]; int cy[4], cz[4];
#pragma unroll
        for (int j = 0; j < 4; ++j) { cr[j] = bx[q][j]; cy[j] = by[q][j]; cz[j] = bz[q][j]; }
        f32x4 x[4]; float ss = 0.f;
#pragma unroll
        for (int j = 0; j < 4; ++j) { const u32x2 w = cr[j];
            const f32x2 y0 = __builtin_amdgcn_cvt_pk_f32_fp8(cy[j], false), y1 = __builtin_amdgcn_cvt_pk_f32_fp8(cy[j], true), z0 = __builtin_amdgcn_cvt_pk_f32_fp8(cz[j], false), z1 = __builtin_amdgcn_cvt_pk_f32_fp8(cz[j], true);
            x[j] = (f32x4){bflo(w.x), bfhi(w.x), bflo(w.y), bfhi(w.y)} + gv[j] * (f32x4){y0.x + z0.x, y0.y + z0.y, y1.x + z1.x, y1.y + z1.y};
            ss += x[j][0] * x[j][0] + x[j][1] * x[j][1] + x[j][2] * x[j][2] + x[j][3] * x[j][3]; }
        ss = wave_sum(ss);
        const float rstd = rsqrtf(ss * (1.0f / 1024.0f) + EPS);
        float* p = outp + (size_t)r * D;
#pragma unroll
        for (int j = 0; j < 4; ++j) *(f32x4*)(p + j * 256 + lane * 4) = x[j] * rstd * gn[j];
      }
    }
}

constexpr int ML_RB = 288;
constexpr int ML_RBC = 256;
constexpr int ML_Q = 0, ML_K = 36864, ML_V = 73728, ML_CT = 110592, ML_VEC = 145408, ML_CW = 151552;
__device__ __forceinline__ bf16x8 tr_frag2(const LAS unsigned char* base, int rowA, int rowB, int col0, int lane) {
    const int g = lane >> 4, q = (lane & 15) >> 2, p = lane & 3;
    const s16x4 v0 = __builtin_amdgcn_ds_read_tr16_b64_v4i16((LAS s16x4*)(base + (rowA + 4 * g + q) * ML_RB + (col0 + 4 * p) * 2));
    const s16x4 v1 = __builtin_amdgcn_ds_read_tr16_b64_v4i16((LAS s16x4*)(base + (rowB + 4 * g + q) * ML_RB + (col0 + 4 * p) * 2));
    return (bf16x8){v0[0], v0[1], v0[2], v0[3], v1[0], v1[1], v1[2], v1[3]};
}
__device__ __forceinline__ bf16x8 tr_frag(const LAS unsigned char* base, int row0, int col0, int lane) {
    const int g = lane >> 4, q = (lane & 15) >> 2, p = lane & 3;
    const LAS unsigned char* a = base + (row0 + 8 * g + q) * ML_RB + (col0 + 4 * p) * 2;
    const s16x4 v0 = __builtin_amdgcn_ds_read_tr16_b64_v4i16((LAS s16x4*)a);
    const s16x4 v1 = __builtin_amdgcn_ds_read_tr16_b64_v4i16((LAS s16x4*)(a + 4 * ML_RB));
    return (bf16x8){v0[0], v0[1], v0[2], v0[3], v1[0], v1[1], v1[2], v1[3]};
}
__device__ __forceinline__ void mlstm_phase(const Frame& F, bool ctx_out, int skip  ,
                                             int conv_rows  , const float* convw  ) {
    const int lane = F.lane(), wid = F.wid, tid = wid * 64 + lane, fr = lane & 15, fq = lane >> 4;
    LAS unsigned char* lds = F.lds;
    LAS float* ic = (LAS float*)(lds + ML_VEC); LAS float* fc = ic + 128; LAS float* av = ic + 256; LAS float* Mv = ic + 384; LAS float* bcv = ic + 512;
    LAS float* nvec = ic + 640; LAS float* wkv = ic + 768; LAS float* npart = ic + 896;
    LAS float* eav = ic + 1408;
    LAS float* cw = (LAS float*)(lds + ML_CW);
    for (int i = tid; i < 1536; i += 512) cw[i] = convw[i];
    unsigned char* const ws = KA()->ws;
    const bf16_t* P = (const bf16_t*)(ws + WS_PROJ); const float* GT = (const float*)(ws + WS_GATES); bf16_t* HL = (bf16_t*)KA()->out;
    bf16_t* A2 = (bf16_t*)(ws + WS_U);
    const int crpw = (conv_rows + F.G * 8 - 1) / (F.G * 8), crb = (F.wg * 8 + wid) * crpw; int cri = 0;
    int cnr = conv_rows - crb; cnr = cnr < 0 ? 0 : (cnr > crpw ? crpw : cnr);
#define MC_HASL(r) ((r) < NL ? (((r) & 63) != 0) : ((((r) - NL) & 255) != 0))
#define MC_HASR(r) ((r) < NL ? (((r) & 63) != 63) : ((((r) - NL) & 255) != 255))
    float zl[8], zc[8];
#pragma unroll
    for (int j = 0; j < 8; ++j) { zl[j] = 0.f; zc[j] = 0.f; }
    if (cnr > 0) { const bf16_t* pr = P + (size_t)crb * NPO + lane * 8;
        unpack8(*(const u32x4*)(pr + 512), zc);
        if (MC_HASL(crb)) unpack8(*(const u32x4*)(pr - NPO + 512), zl); }
    for (int unit = F.wg; unit < 256; unit += F.G) {
        const int b = unit >> 3, hd = (unit >> 1) & 3, dir = unit & 1;
        f32x4 Cacc[8];
#pragma unroll
        for (int a = 0; a < 8; ++a) Cacc[a] = (f32x4){0.f, 0.f, 0.f, 0.f};
        float m = 0.f, dec_prev = 0.f;
        if (tid < 128) nvec[tid] = 0.f;
        if (tid < 512) npart[tid] = 0.f;
        u32x4 st[12]; float gi = 0.f, gf = 0.f;
#define ML_ROW0(ci) ((ci) < 2 ? NL + b * 256 + (dir ? 1 - (ci) : (ci)) * 128 : b * 2048 + (dir ? 15 - ((ci) - 2) : ((ci) - 2)) * 128)
#define ML_LOAD(ci) do { const int _r0 = ML_ROW0(ci); _Pragma("unroll") for (int _p = 0; _p < 4; ++_p) { const int _id = tid + 512 * _p, _row = _id >> 4, _ch = _id & 15; \
            const bf16_t* _g = P + (size_t)(_r0 + _row) * NPO + 1024 + hd * 128 + _ch * 8; st[_p] = *(const u32x4*)_g; st[4 + _p] = *(const u32x4*)(_g + 512); st[8 + _p] = *(const u32x4*)(_g + 1024); } \
            if (tid < 128) { gi = GT[(size_t)(_r0 + tid) * 16 + (2 * dir) * 4 + hd]; gf = GT[(size_t)(_r0 + tid) * 16 + (2 * dir + 1) * 4 + hd]; } } while (0)
#define ML_BAR() do { asm volatile("s_waitcnt lgkmcnt(0)" ::: "memory"); __builtin_amdgcn_s_barrier(); asm volatile("" ::: "memory"); } while (0)
        ML_LOAD(0);
        __syncthreads();
        for (int ci = 0; ci < 18; ++ci) {
            const int row0 = ML_ROW0(ci);
            const bool need_out = ((ci >= 2) || ctx_out) && !(skip & 1);
            int lane_c = lane; asm volatile("" : "+v"(lane_c));
            const int lane = lane_c, fr = lane & 15, fq = lane >> 4, tid = wid * 64 + lane;
#pragma unroll
            for (int p = 0; p < 4; ++p) { const int id = tid + 512 * p, row = id >> 4, ch = id & 15; const int o = row * ML_RB + ch * 16;
                *(LAS u32x4*)(lds + ML_Q + o) = st[p]; *(LAS u32x4*)(lds + ML_K + o) = st[4 + p]; *(LAS u32x4*)(lds + ML_V + o) = st[8 + p]; }
#pragma unroll
            for (int a = 0; a < 8; ++a) { u32x2 w; w.x = cvt_pk_bf16(Cacc[a][0], Cacc[a][1]); w.y = cvt_pk_bf16(Cacc[a][2], Cacc[a][3]);
                *(LAS u32x2*)(lds + ML_CT + (16 * wid + fr) * ML_RBC + (((2 * a + (fq >> 1)) ^ fr) << 4) + (fq & 1) * 8) = w; }
            if (tid < 128) { ic[tid] = gi; fc[tid] = fminf(gf, 0.f) - __logf(1.0f + __expf(-fabsf(gf)));
                nvec[tid] = dec_prev * nvec[tid] + ((npart[tid] + npart[128 + tid]) + (npart[256 + tid] + npart[384 + tid])); }
            if (ci + 1 < 18 && !(skip & 4)) ML_LOAD(ci + 1);
            ML_BAR();
            float bL, Mlast, amax;
            { const int p0 = 2 * lane, p1 = p0 + 1, s0 = dir ? 127 - p0 : p0, s1 = dir ? 127 - p1 : p1;
              const float f0 = fc[s0], f1 = fc[s1], i0 = ic[s0], i1 = ic[s1];
              const float incl = wave_scan_add(f0 + f1);
              const float bc1 = incl, bc0 = incl - f1;
              const float a0 = i0 - bc0, a1 = i1 - bc1;
              const float im = wave_scan_max(fmaxf(a0, a1));
              float ex = __shfl_up(im, 1); if (lane == 0) ex = -3.0e38f;
              const float M0 = fmaxf(fmaxf(m, ex), a0), M1 = fmaxf(m, im);
              bL = __shfl(incl, 63); Mlast = __shfl(M1, 63); amax = __shfl(im, 63);
              av[s0] = a0; av[s1] = a1; Mv[s0] = M0; Mv[s1] = M1; bcv[s0] = bc0; bcv[s1] = bc1;
              wkv[s0] = __expf(a0 - Mlast); wkv[s1] = __expf(a1 - Mlast);
              eav[s0] = __expf(a0 - amax); eav[s1] = __expf(a1 - amax); }
            if (need_out) {
                int tq = __builtin_amdgcn_readfirstlane(wid < 4 ? 2 * wid : 15 - 2 * wid); asm volatile("" : "+s"(tq));
                const int t = 16 * tq + fr; const float Mt = Mv[t];
                bf16x8 Qf[4];
#pragma unroll
                for (int ks = 0; ks < 4; ++ks) Qf[ks] = *(const LAS bf16x8*)(lds + ML_Q + t * ML_RB + (32 * ks + 8 * fq) * 2);
                float rowsum = 0.f; u32x2 Sp[8];
#pragma unroll
                for (int j = 0; j < 8; ++j) {
                    Sp[j] = (u32x2){0u, 0u};
                    const bool act = dir ? (j >= tq) : (j <= tq);
                    if (act) {
                        f32x4 acc = (f32x4){0.f, 0.f, 0.f, 0.f};
#pragma unroll
                        for (int ks = 0; ks < 4; ++ks) { const bf16x8 Kf = *(const LAS bf16x8*)(lds + ML_K + (16 * j + fr) * ML_RB + (32 * ks + 8 * fq) * 2); acc = __builtin_amdgcn_mfma_f32_16x16x32_bf16(Kf, Qf[ks], acc, 0, 0, 0); }
                        const f32x4 e4 = *(const LAS f32x4*)(eav + 16 * j + 4 * fq);
                        float v[4];
#pragma unroll
                        for (int r = 0; r < 4; ++r) v[r] = acc[r] * e4[r];
                        if (j == tq) {
#pragma unroll
                            for (int r = 0; r < 4; ++r) { const bool valid = dir ? (4 * fq + r >= fr) : (4 * fq + r <= fr); v[r] = valid ? v[r] : 0.f; } }
                        rowsum += (v[0] + v[1]) + (v[2] + v[3]);
                        Sp[j].x = cvt_pk_bf16(v[0], v[1]); Sp[j].y = cvt_pk_bf16(v[2], v[3]);
                    }
                }
                rowsum += __shfl_xor(rowsum, 16); rowsum += __shfl_xor(rowsum, 32);
                float qn = 0.f;
#pragma unroll
                for (int ks = 0; ks < 4; ++ks) { const f32x4 n0 = *(const LAS f32x4*)(nvec + 32 * ks + 8 * fq), n1 = *(const LAS f32x4*)(nvec + 32 * ks + 8 * fq + 4);
#pragma unroll
                    for (int jj = 0; jj < 4; ++jj) { qn += bf2f((unsigned short)Qf[ks][jj]) * n0[jj]; qn += bf2f((unsigned short)Qf[ks][4 + jj]) * n1[jj]; } }
                qn += __shfl_xor(qn, 16); qn += __shfl_xor(qn, 32);
                const float em = __expf(amax - Mt), wi = __expf(m - Mt), den = em * rowsum + wi * qn, rd = 1.0f / fmaxf(fabsf(den), __expf(-(bcv[t] + Mt)));
                const float ems = em * rd, wis = wi * rd;
                bf16x8 Sf[4];
#pragma unroll
                for (int ks = 0; ks < 4; ++ks) { const u32x4 w = (u32x4){Sp[2 * ks].x, Sp[2 * ks].y, Sp[2 * ks + 1].x, Sp[2 * ks + 1].y}; Sf[ks] = __builtin_bit_cast(bf16x8, w); }
                LAS unsigned char* const obuf = lds + ML_Q + 16 * tq * ML_RB;
#pragma unroll 2
                for (int d = 0; d < 8; ++d) {
                    f32x4 aS = (f32x4){0.f, 0.f, 0.f, 0.f}, aC = (f32x4){0.f, 0.f, 0.f, 0.f};
#pragma unroll
                    for (int ks = 0; ks < 4; ++ks) { const bool act = dir ? (2 * ks + 1 >= tq) : (2 * ks <= tq);
                        if (act) { const bf16x8 Vt = tr_frag2(lds + ML_V, 32 * ks, 32 * ks + 16, 16 * d, lane); aS = __builtin_amdgcn_mfma_f32_16x16x32_bf16(Vt, Sf[ks], aS, 0, 0, 0); } }
#pragma unroll
                    for (int kp = 0; kp < 4; ++kp) { const bf16x8 Cf = *(const LAS bf16x8*)(lds + ML_CT + (16 * d + fr) * ML_RBC + (((4 * kp + fq) ^ fr) << 4)); aC = __builtin_amdgcn_mfma_f32_16x16x32_bf16(Cf, Qf[kp], aC, 0, 0, 0); }
                    u32x2 w; w.x = cvt_pk_bf16(ems * aS[0] + wis * aC[0], ems * aS[1] + wis * aC[1]); w.y = cvt_pk_bf16(ems * aS[2] + wis * aC[2], ems * aS[3] + wis * aC[3]);
                    *(LAS u32x2*)(obuf + fr * 272 + (16 * d + 4 * fq) * 2) = w;
                }
#pragma unroll
                for (int i = 0; i < 4; ++i) { const int orow = (lane >> 4) + 4 * i; const u32x4 v = *(const LAS u32x4*)(obuf + orow * 272 + (lane & 15) * 16);
                    *(u32x4*)(HL + ((size_t)dir * MT + row0 + 16 * tq + orow) * 512 + hd * 128 + (lane & 15) * 8) = v; }
            }
            u32x4 c_gb[2], c_gc[2]; int c_n = 0;
            {
                c_n = cnr - cri; c_n = c_n > 2 ? 2 : (c_n < 0 ? 0 : c_n); if (skip & 8) c_n = 0;
#pragma unroll
                for (int q = 0; q < 2; ++q) if (q < c_n) { const bf16_t* pr = P + (size_t)(crb + cri + q) * NPO + lane * 8; c_gb[q] = *(const u32x4*)pr; c_gc[q] = *(const u32x4*)(pr + NPO + 512); }
                asm volatile("" ::: "memory");
                const float dec = __expf(m - Mlast);
                bf16x8 Vw[4], Wk[4];
#pragma unroll
                for (int ks = 0; ks < 4; ++ks) { const bf16x8 Vf = tr_frag2(lds + ML_V, 32 * ks, 32 * ks + 16, 16 * wid, lane);
                    const f32x4 k0 = *(const LAS f32x4*)(wkv + 32 * ks + 4 * fq), k1 = *(const LAS f32x4*)(wkv + 32 * ks + 16 + 4 * fq);
                    u32x4 w;
                    w.x = cvt_pk_bf16(bf2f((unsigned short)Vf[0]) * k0[0], bf2f((unsigned short)Vf[1]) * k0[1]); w.y = cvt_pk_bf16(bf2f((unsigned short)Vf[2]) * k0[2], bf2f((unsigned short)Vf[3]) * k0[3]);
                    w.z = cvt_pk_bf16(bf2f((unsigned short)Vf[4]) * k1[0], bf2f((unsigned short)Vf[5]) * k1[1]); w.w = cvt_pk_bf16(bf2f((unsigned short)Vf[6]) * k1[2], bf2f((unsigned short)Vf[7]) * k1[3]);
                    Vw[ks] = __builtin_bit_cast(bf16x8, w);
                    u32x4 wq = (u32x4){0u, 0u, 0u, 0u};
                    if (fr == 0) { wq.x = cvt_pk_bf16(k0[0], k0[1]); wq.y = cvt_pk_bf16(k0[2], k0[3]); wq.z = cvt_pk_bf16(k1[0], k1[1]); wq.w = cvt_pk_bf16(k1[2], k1[3]); }
                    Wk[ks] = __builtin_bit_cast(bf16x8, wq); }
                f32x4 nacc = (f32x4){0.f, 0.f, 0.f, 0.f};
                if (!(skip & 2)) {
#pragma unroll
                for (int a = 0; a < 8; ++a) { Cacc[a] = Cacc[a] * dec;
#pragma unroll
                    for (int ks = 0; ks < 4; ++ks) { const bf16x8 Kt = tr_frag2(lds + ML_K, 32 * ks, 32 * ks + 16, 16 * a, lane); Cacc[a] = __builtin_amdgcn_mfma_f32_16x16x32_bf16(Kt, Vw[ks], Cacc[a], 0, 0, 0);
                        if (a == wid) nacc = __builtin_amdgcn_mfma_f32_16x16x32_bf16(Kt, Wk[ks], nacc, 0, 0, 0); } } }
                if (fr == 0) *(LAS f32x4*)(npart + 16 * wid + 4 * fq) = nacc;
                dec_prev = dec;
                m = bL + Mlast;
            }
#pragma unroll
            for (int q = 0; q < 2; ++q) if (q < c_n) { const int r = crb + cri + q;
                float gb[8], zr[8], y[8];
                unpack8(c_gb[q], gb); unpack8(c_gc[q], zr);
                const f32x4 wa0 = *(const LAS f32x4*)(cw + lane * 8), wa1 = *(const LAS f32x4*)(cw + lane * 8 + 4), wb0 = *(const LAS f32x4*)(cw + 512 + lane * 8), wb1 = *(const LAS f32x4*)(cw + 512 + lane * 8 + 4),
                            wc0 = *(const LAS f32x4*)(cw + 1024 + lane * 8), wc1 = *(const LAS f32x4*)(cw + 1024 + lane * 8 + 4);
                const bool hasR = MC_HASR(r);
#pragma unroll
                for (int j = 0; j < 8; ++j) {
                    const float w0 = j < 4 ? wa0[j & 3] : wa1[j & 3], w1 = j < 4 ? wb0[j & 3] : wb1[j & 3], w2 = j < 4 ? wc0[j & 3] : wc1[j & 3];
                    y[j] = gb[j] * (w0 * zl[j] + w1 * zc[j] + (hasR ? w2 * zr[j] : 0.f)); }
                *(u32x4*)(A2 + (size_t)r * D + lane * 8) = pack8(y);
#pragma unroll
                for (int j = 0; j < 8; ++j) { zl[j] = hasR ? zc[j] : 0.f; zc[j] = zr[j]; } }
            cri += c_n;
            ML_BAR();
        }
#undef ML_ROW0
#undef ML_LOAD
#undef ML_BAR
#undef MC_HASL
#undef MC_HASR
    }
}

constexpr int NPH = 20;
constexpr int REP[NPH] = {1, 1, 1, 1, 1, 1, 1, 1, 1, 1, 1, 1, 1, 1, 1, 1, 1, 1, 1, 1};
#define REPEAT(k) for (int _r = 0; _r < REP[k]; ++_r)
#define GSCALE(k) ((_r == REP[k] - 1) ? 1.0f : 0.0f)
__global__ void __launch_bounds__(512, 2) mk_fwd(Args args_unused) {
    extern __shared__ __attribute__((aligned(16))) unsigned char smem[];
    Frame F;
    F.lds = (LAS unsigned char*)smem; F.wid = __builtin_amdgcn_readfirstlane((int)threadIdx.x >> 6); F.G = gridDim.x; F.wg = blockIdx.x;
    volatile LAS unsigned* misc = (volatile LAS unsigned*)(F.lds + MISC_OFF);
    if (F.tid() < 64) misc[F.tid()] = 0u;
    __syncthreads();
    int lo, hi;
    { KArgs ka = KA(); lo = ka->lo; hi = ka->hi; }
    XcdBarrier bar;
    { KArgs ka = KA(); bar.bar = (unsigned*)(ka->ws + WS_CTL); bar.x = 0; bar.st = misc; bar.wid = F.wid;
      if (hi - lo > 1) bar = xcd_barrier_post((unsigned*)(ka->ws + WS_CTL), misc, F.wid); }
#define IN(k) (lo <= (k) && (k) < hi)
#define SEAM(k) do { if (IN(k) && IN((k) + 1)) { KArgs _ka = KA(); bar.bar = (unsigned*)(_ka->ws + WS_CTL); xcd_barrier(bar); } } while (0)
    const volatile LAS int* tb = (const volatile LAS int*)(F.lds + MISC_OFF + 64);
    volatile LAS int* tbw = (volatile LAS int*)(F.lds + MISC_OFF + 64);

#ifdef PROBE_MFMA
    {
        f32x4 a0 = {0.f, 0.f, 0.f, 0.f}, a1 = a0, a2 = a0, a3 = a0; bf16x8 x = {1, 2, 3, 4, 5, 6, 7, 8}, y = {8, 7, 6, 5, 4, 3, 2, 1};
        asm volatile("" : "+v"(x), "+v"(y));
        for (int it = 0; it < 10000; ++it) {
            a0 = __builtin_amdgcn_mfma_f32_16x16x32_bf16(x, y, a0, 0, 0, 0); a1 = __builtin_amdgcn_mfma_f32_16x16x32_bf16(x, y, a1, 0, 0, 0);
            a2 = __builtin_amdgcn_mfma_f32_16x16x32_bf16(x, y, a2, 0, 0, 0); a3 = __builtin_amdgcn_mfma_f32_16x16x32_bf16(x, y, a3, 0, 0, 0); }
        asm volatile("" :: "v"(a0), "v"(a1), "v"(a2), "v"(a3));
    }
#endif
    if (IN(0)) REPEAT(0) { p0_prologue(F, _r < REP[0] - 1 ? PROBE_P0SKIP : 0); }
    SEAM(0);
    if (IN(1)) REPEAT(1) { KArgs ka = KA(); unsigned char* ws = ka->ws;
        norm_phase<false, false, false, true>(F, ka->in[I_X], ka->in[I_CTX], MT, ka->in[I_N1G], (const float*)(ws + WS_MOD), 0, (bf16_t*)(ws + WS_U), nullptr,
            (const bf16_t*)(ws + WS_WIN) + (size_t)NPROJ * D, ka->in[I_BG], (float*)(ws + WS_GATES), (bf16_t*)(ws + WS_HB)); }
    SEAM(1);
    if (IN(2)) REPEAT(2) { KArgs ka = KA(); unsigned char* ws = ka->ws;
        pg8::DenseSched S{MT / 256, NPROJ / 256, F.G, F.wg, 2 * D, 4};
        pg8::EpiProj E{(bf16_t*)(ws + WS_PROJ), GSCALE(2) == 0.0f};
        pg8::gemm_phase<false>(F.lds, F.wid, (const char*)(ws + WS_U), (const char*)(ws + WS_WIN), 2 * D, S, E, 0);
        tail_convert(F, (MT / 256) * (NPROJ / 256), 30, 31); }
    SEAM(2);
    if (IN(3)) REPEAT(3) { mlstm_phase(F, true, _r < REP[3] - 1 ? PROBE_MLSKIP : 0, MT, KA()->in[I_CONVW]); }
    SEAM(3);
    if (IN(4)) REPEAT(4) { KArgs ka = KA(); mix_phase(F, MT, ka->in[I_MNG]); }
    SEAM(4);
    if (IN(5)) REPEAT(5) { KArgs ka = KA(); unsigned char* ws = ka->ws;
        pg8::DenseSched S{MT / 256, D / 256, F.G, F.wg, 2 * D, 4};
        pg8::EpiResid E{(bf16_t*)(ws + WS_HB), (const float*)(ws + WS_MOD) + 2 * 1024, 1.0f};
        pg8::gemm_phase<false>(F.lds, F.wid, (const char*)(ws + WS_U), (const char*)(ws + WS_WOUT), 2 * D, S, E, 0);
        tail_convert(F, (MT / 256) * (D / 256), 27, 30); }
    SEAM(5);
    if (IN(6)) REPEAT(6) { KArgs ka = KA(); unsigned char* ws = ka->ws;
        norm_phase<false, true, true, false>(F, (const float*)(ws + WS_HB), nullptr, MT, ka->in[I_N2G], (const float*)(ws + WS_MOD), 3, (bf16_t*)(ws + WS_U), nullptr); }
    SEAM(6);
    if (IN(7)) REPEAT(7) { KArgs ka = KA(); unsigned char* ws = ka->ws;
        pg8::DenseSched S{MT / 256, 2 * DFF / 256, F.G, F.wg, D, 8};
        pg8::EpiSwiglu E{(unsigned char*)(ws + WS_PROJ), 1.0f / (S_A * S_W13), S_H * GSCALE(7)};
        pg8::gemm_phase<true>(F.lds, F.wid, (const char*)(ws + WS_U), (const char*)(ws + WS_WUP), D, S, E, 0);
        tail_convert(F, (MT / 256) * (2 * DFF / 256), 26, 27); }
    SEAM(7);
    if (IN(8)) REPEAT(8) { KArgs ka = KA(); unsigned char* ws = ka->ws;
        pg8::DenseSched S{MT / 256, D / 256, F.G, F.wg, DFF, 4};
        pg8::EpiResid E{(bf16_t*)(ws + WS_HB), (const float*)(ws + WS_MOD) + 5 * 1024, GSCALE(8) / (S_H * S_W2)};
        pg8::gemm_phase<true>(F.lds, F.wid, (const char*)(ws + WS_PROJ), (const char*)(ws + WS_WDN), DFF, S, E, 0);
        tail_convert(F, (MT / 256) * (D / 256), 20, 26); }
    SEAM(8);
    if (IN(9)) REPEAT(9) { KArgs ka = KA(); unsigned char* ws = ka->ws;
        norm_phase<false, false, true, true>(F, (const float*)(ws + WS_HB), nullptr, MT, ka->in[I_N1G] + D, (const float*)(ws + WS_MOD) + 33 * 6144, 0, (bf16_t*)(ws + WS_U), nullptr,
            (const bf16_t*)(ws + WS_WIN) + (size_t)(NPAD + NPROJ) * D, ka->in[I_BG] + 16, (float*)(ws + WS_GATES)); }
    SEAM(9);
    if (IN(10)) REPEAT(10) { KArgs ka = KA(); unsigned char* ws = ka->ws;
        pg8::InProjL1Sched S{F.G, F.wg};
        pg8::EpiProj E{(bf16_t*)(ws + WS_PROJ), GSCALE(10) == 0.0f};
        pg8::gemm_phase<false>(F.lds, F.wid, (const char*)(ws + WS_U), (const char*)(ws + WS_WIN) + (size_t)NPAD * D * 2, 2 * D, S, E, 0);
        tail_convert(F, 3584 + 192, 19, 20); }
    SEAM(10);
    if (IN(11)) REPEAT(11) { mlstm_phase(F, false, _r < REP[11] - 1 ? PROBE_MLSKIP : 0, NL, KA()->in[I_CONVW] + 3 * 512); }
    SEAM(11);
    if (IN(12)) REPEAT(12) { KArgs ka = KA(); mix_phase(F, NL, ka->in[I_MNG] + 512); }
    SEAM(12);
    if (IN(13)) REPEAT(13) { KArgs ka = KA(); unsigned char* ws = ka->ws;
        pg8::DenseSched S{NL / 256, D / 256, F.G, F.wg, 2 * D, 4};
        pg8::EpiResid E{(bf16_t*)(ws + WS_HB), (const float*)(ws + WS_MOD) + 33 * 6144 + 2 * 1024, GSCALE(13)};
        pg8::gemm_phase<false>(F.lds, F.wid, (const char*)(ws + WS_U), (const char*)(ws + WS_WOUT) + (size_t)D * D * 2, 2 * D, S, E, 0); }
    SEAM(13);
    if (IN(14)) REPEAT(14) { KArgs ka = KA(); unsigned char* ws = ka->ws;
        norm_phase<true, true, true, false>(F, (const float*)(ws + WS_HB), nullptr, NL, ka->in[I_N2G] + D, (const float*)(ws + WS_MOD) + 33 * 6144, 3, (bf16_t*)(ws + WS_U), ka->in[I_ROUTER]); }
    SEAM(14);
    if (IN(15) || IN(16)) {
        __syncthreads();
        { const int tidl = F.tid();
          if (tidl < 64) {
            KArgs ka = KA(); const unsigned* gc = (const unsigned*)(ka->ws + WS_CTL + CTL_GCNT);
            const int c = tidl < 16 ? (int)__hip_atomic_load(gc + tidl, __ATOMIC_RELAXED, __HIP_MEMORY_SCOPE_AGENT) : 0;
            const int nt_ = (c + 255) >> 8; int incl = nt_;
#pragma unroll
            for (int d = 1; d < 16; d <<= 1) { const int t = __shfl_up(incl, d); if (tidl >= d) incl += t; }
            if (tidl < 16) { tbw[tidl] = incl - nt_; tbw[32 + tidl] = c; }
            if (tidl == 15) tbw[16] = incl; } }
        __syncthreads();
    }
    if (IN(15)) REPEAT(15) { KArgs ka = KA(); unsigned char* ws = ka->ws;
        pg8::MoeUpSched S{F.G, F.wg, (const int*)(ws + WS_RTOK), tb};
        pg8::EpiSwiglu E{(unsigned char*)(ws + WS_PROJ), 1.0f / (S_A * S_W13), S_H};
        pg8::gemm_phase<true>(F.lds, F.wid, (const char*)(ws + WS_U), (const char*)(ws + WS_MUP), D, S, E, 0); }
    SEAM(15);
    if (IN(16)) { KArgs ka = KA(); unsigned char* ws = ka->ws;
        pg8::MoeDownSched S{F.G, F.wg, tb, (const int*)(ws + WS_RTOK), (const float*)(ws + WS_RGATE)};
        pg8::EpiMoeDown E{(unsigned char*)(ws + WS_U), (unsigned char*)(ws + WS_Y1), F.lds + pg8::STAGE_BYTES, tb, S_Y / (S_H * S_W2)};
        pg8::gemm_phase<true>(F.lds, F.wid, (const char*)(ws + WS_PROJ), (const char*)(ws + WS_MDN), DFF, S, E, 0); }
    SEAM(16);
    if (IN(19)) REPEAT(19) { final_phase(F); }
#undef IN
#undef SEAM
}

extern "C" void kernel_launch(void* const* d_in, const int* in_sizes, int n_in, void* d_out, int out_size, void* d_ws, size_t ws_size, hipStream_t stream) {
    static int grid = 0;
    if (grid == 0) {
        if (n_in != 21 || ws_size < WS_END) { fprintf(stderr, "kernel_launch: expected 21 inputs and >= %zu bytes of workspace; got %d, %zu\n", (size_t)WS_END, n_in, ws_size); grid = -1; return; }
        int dev = 0, cus = 0, per_cu = 0;
        if (hipGetDevice(&dev) != hipSuccess || hipDeviceGetAttribute(&cus, hipDeviceAttributeMultiprocessorCount, dev) != hipSuccess) { grid = -1; return; }
        if (hipFuncSetAttribute((const void*)mk_fwd, hipFuncAttributeMaxDynamicSharedMemorySize, LDS_BYTES) != hipSuccess) { fprintf(stderr, "kernel_launch: hipFuncSetAttribute failed\n"); grid = -1; return; }
        if (hipOccupancyMaxActiveBlocksPerMultiprocessor(&per_cu, (const void*)mk_fwd, 512, LDS_BYTES) != hipSuccess || per_cu < 1) fprintf(stderr, "kernel_launch: occupancy query reports %d\n", per_cu);
        (void)hipGetLastError();
        grid = cus;
    }
    if (grid < 0) return;
    (void)hipMemsetAsync((char*)d_ws + WS_CTL, 0, CTL_BYTES, stream);
    Args a{};
    for (int i = 0; i < 21; ++i) a.in[i] = (const float*)d_in[i];
    a.out = (float*)d_out; a.ws = (unsigned char*)d_ws;
#if MK_PER_PHASE
    for (int p = 0; p < NPH; ++p) { a.lo = p; a.hi = p + 1; hipLaunchKernelGGL(mk_fwd, dim3(grid), dim3(512), LDS_BYTES, stream, a); }
#else
    a.lo = 0; a.hi = NPH; hipLaunchKernelGGL(mk_fwd, dim3(grid), dim3(512), LDS_BYTES, stream, a);
#endif
}
```

```cpp
#include <hip/hip_runtime.h>
#include <cstdio>
#include <cstdint>
#include <type_traits>

#ifndef MK_PER_PHASE
#define MK_PER_PHASE 0
#endif

#define LAS __attribute__((address_space(3)))
typedef unsigned short bf16_t;
typedef short bf16x8 __attribute__((ext_vector_type(8)));
typedef short s16x4 __attribute__((ext_vector_type(4)));
typedef float f32x4 __attribute__((ext_vector_type(4)));
typedef float f32x2 __attribute__((ext_vector_type(2)));
typedef unsigned u32x4 __attribute__((ext_vector_type(4)));
typedef unsigned u32x2 __attribute__((ext_vector_type(2)));

constexpr int D = 1024, NB = 32, SEQ = 2048, CTXL = 256;
constexpr int NL = NB * SEQ;
constexpr int NCX = NB * CTXL;
constexpr int MT = NL + NCX;
constexpr int PIN = 3600, NPROJ = 3584, NPAD = 3840;
constexpr int NPO = 3072;
constexpr int DFF = 2816, NE = 8;
constexpr float EPS = 1e-6f;
constexpr int PROBE_P0SKIP = 0;
constexpr int PROBE_MLSKIP = 0;
constexpr bool PROBE_DRY = false;
constexpr int RT_STRIDE = 65536;
constexpr float S_A = 16.0f, S_W13 = 256.0f, S_H = 8.0f, S_W2 = 256.0f, S_Y = 32.0f;

constexpr size_t WS_CTL = 0;
constexpr size_t CTL_BYTES = 65536;
constexpr size_t CTL_GCNT = 16384;
constexpr size_t WS_MOD = 65536;
constexpr size_t WS_WIN = 2097152;
constexpr size_t WS_WOUT = WS_WIN + (size_t)2 * NPAD * D * 2;
constexpr size_t WS_WUP = WS_WOUT + (size_t)2 * D * D * 2;
constexpr size_t WS_WDN = WS_WUP + (size_t)2 * DFF * D * 2;
constexpr size_t WS_MUP = WS_WDN + (size_t)D * DFF * 2;
constexpr size_t WS_MDN = WS_MUP + (size_t)NE * 2 * DFF * D * 2;
constexpr size_t WS_HC = WS_MDN + (size_t)NE * D * DFF * 2;
constexpr size_t WS_U = WS_HC + (size_t)NCX * D * 4;
constexpr size_t WS_PROJ = WS_U + (size_t)MT * D * 2;
constexpr size_t WS_GATES = WS_PROJ + (size_t)MT * NPROJ * 2;
constexpr size_t WS_HL = WS_GATES + (size_t)MT * 16 * 4;
constexpr size_t WS_HB = WS_HL;
constexpr size_t WS_Y1 = WS_PROJ + (size_t)368 * 1048576;
static_assert(WS_Y1 + (size_t)NL * D * 2 <= WS_GATES && (size_t)528 * 256 * DFF <= (size_t)368 * 1048576, "Y1 placement");
constexpr size_t WS_RTOK = WS_HL + (size_t)2 * MT * 512 * 2;
constexpr size_t WS_RGATE = WS_RTOK + (size_t)16 * RT_STRIDE * 4;
constexpr size_t WS_END = WS_RGATE + (size_t)16 * RT_STRIDE * 4;

constexpr int LDS_BYTES = 163840;
constexpr int MISC_OFF = 161792;

__device__ __forceinline__ unsigned cvt_pk_bf16(float lo, float hi) { unsigned r; asm volatile("v_cvt_pk_bf16_f32 %0, %1, %2" : "=v"(r) : "v"(lo), "v"(hi)); return r; }
__device__ __forceinline__ float bf2f(unsigned short b) { return __uint_as_float(((unsigned)b) << 16); }
__device__ __forceinline__ float bflo(unsigned w) { return __uint_as_float(w << 16); }
__device__ __forceinline__ float bfhi(unsigned w) { return __uint_as_float(w & 0xffff0000u); }
__device__ __forceinline__ float wave_sum(float v) {
#pragma unroll
    for (int o = 32; o >= 1; o >>= 1) v += __shfl_xor(v, o);
    return v;
}
__device__ __forceinline__ int lane_id() { int l; asm volatile("v_mbcnt_lo_u32_b32 %0, -1, 0\n\tv_mbcnt_hi_u32_b32 %0, -1, %0" : "=v"(l)); return l; }
template <int CTRL, int RM> __device__ __forceinline__ float dppf(float ident, float v) {
    return __builtin_bit_cast(float, __builtin_amdgcn_update_dpp(__builtin_bit_cast(int, ident), __builtin_bit_cast(int, v), CTRL, RM, 0xf, false)); }
__device__ __forceinline__ float wave_scan_add(float v) {
    v += dppf<0x111, 0xf>(0.f, v); v += dppf<0x112, 0xf>(0.f, v); v += dppf<0x114, 0xf>(0.f, v); v += dppf<0x118, 0xf>(0.f, v);
    v += dppf<0x142, 0xa>(0.f, v); v += dppf<0x143, 0xc>(0.f, v); return v; }
__device__ __forceinline__ float wave_scan_max(float v) {
    v = fmaxf(v, dppf<0x111, 0xf>(-3.0e38f, v)); v = fmaxf(v, dppf<0x112, 0xf>(-3.0e38f, v)); v = fmaxf(v, dppf<0x114, 0xf>(-3.0e38f, v)); v = fmaxf(v, dppf<0x118, 0xf>(-3.0e38f, v));
    v = fmaxf(v, dppf<0x142, 0xa>(-3.0e38f, v)); v = fmaxf(v, dppf<0x143, 0xc>(-3.0e38f, v)); return v; }
__device__ __forceinline__ float sigmoidf_(float x) { return 1.0f / (1.0f + __expf(-x)); }

#define XB_TMO      128
#define XB_XCNT(j)  (256  + 64 * (j))
#define XB_XSUB(j)  (1280 + 64 * (j))
#define XB_XGEN(j)  (2304 + 64 * (j))
#define XB_TOP      3328
#define XB_TOPGEN   3392
#define XCD_BAR_WORDS 3456
#define XB_SPIN_CAP (1u << 18)

__device__ __forceinline__ unsigned xb_ld(unsigned* p)              { return __hip_atomic_load(p, __ATOMIC_RELAXED, __HIP_MEMORY_SCOPE_AGENT); }
__device__ __forceinline__ unsigned xb_add(unsigned* p, unsigned v) { return __hip_atomic_fetch_add(p, v, __ATOMIC_RELAXED, __HIP_MEMORY_SCOPE_AGENT); }
__device__ __forceinline__ unsigned xb_xcc_id() { return (unsigned)__builtin_amdgcn_s_getreg((3 << 11) | 20) & 0xFu; }
#define XB_SPIN(cond, bar) do { unsigned _sp = 0; while (cond) { __builtin_amdgcn_s_sleep(1); \
    if ((++_sp & 255u) == 0u) { if (xb_ld(&(bar)[XB_TMO])) break; if (_sp > XB_SPIN_CAP) { atomicAdd(&(bar)[XB_TMO], 1u); break; } } } } while (0)

struct XcdBarrier {
    unsigned* bar; unsigned x;
    volatile LAS unsigned* st;
    int wid;
};
#define XB_THREAD0(b) ((b).wid == 0 && lane_id() == 0)
__device__ __forceinline__ XcdBarrier xcd_barrier_post(unsigned* bar, volatile LAS unsigned* st, int wid) {
    XcdBarrier b; b.bar = bar; b.x = xb_xcc_id(); b.st = st; b.wid = wid;
    if (XB_THREAD0(b)) (void)xb_add(&bar[XB_XCNT(b.x)], 1u);
    return b;
}
__device__ __forceinline__ void xcd_barrier_complete(unsigned* bar, unsigned x, unsigned& nloc, unsigned& nx) {
    const unsigned G = gridDim.x * gridDim.y * gridDim.z;
    unsigned sum, cnt, mine, sp = 0u;
    for (;;) {
        sum = 0u; cnt = 0u; mine = 0u;
#pragma unroll
        for (unsigned j = 0; j < 16; ++j) { const unsigned c = xb_ld(&bar[XB_XCNT(j)]); sum += c; cnt += (c > 0u) ? 1u : 0u; mine = (j == x) ? c : mine; }
        if (sum == G) break;
        __builtin_amdgcn_s_sleep(1);
        if ((++sp & 255u) == 0u) { if (xb_ld(&bar[XB_TMO])) break; if (sp > XB_SPIN_CAP) { atomicAdd(&bar[XB_TMO], 1u); break; } }
    }
    nloc = mine > 0u ? mine : 1u; nx = cnt > 0u ? cnt : 1u;
}
__device__ __forceinline__ void xcd_barrier(const XcdBarrier& b) {
    asm volatile("s_waitcnt vmcnt(0)" ::: "memory");
    __syncthreads();
    if (XB_THREAD0(b)) {
        unsigned* bar = b.bar;
        __builtin_amdgcn_s_waitcnt(0);
        unsigned nloc = b.st[0], nx = b.st[1];
        if (nloc == 0u) { xcd_barrier_complete(bar, b.x, nloc, nx); b.st[0] = nloc; b.st[1] = nx; }
        const unsigned old = xb_add(&bar[XB_XSUB(b.x)], 1u);
        const unsigned gen = old / nloc;
        if (old + 1u == (gen + 1u) * nloc) {
            __builtin_amdgcn_fence(__ATOMIC_RELEASE, "agent");
            asm volatile("s_waitcnt vmcnt(0)" ::: "memory");
            const unsigned og = xb_add(&bar[XB_TOP], 1u);
            const unsigned tg = og / nx;
            if (og + 1u == (tg + 1u) * nx) xb_add(&bar[XB_TOPGEN], 1u);
            else XB_SPIN(xb_ld(&bar[XB_TOPGEN]) == tg, bar);
            __builtin_amdgcn_fence(__ATOMIC_ACQUIRE, "agent");
            xb_add(&bar[XB_XGEN(b.x)], 1u);
            asm volatile("s_waitcnt vmcnt(0)" ::: "memory");
        } else {
            XB_SPIN(xb_ld(&bar[XB_XGEN(b.x)]) == gen, bar);
            __builtin_amdgcn_fence(__ATOMIC_ACQUIRE, "agent");
            asm volatile("s_waitcnt vmcnt(0)" ::: "memory");
        }
    }
    __syncthreads();
}

namespace pg8 {
constexpr int BM = 256, BK = 64, HALF = 128, HTB = HALF * BK * 2, STAGE_BYTES = 8 * HTB, NXCD = 8, WGM = 4;
__device__ __forceinline__ int lds_byte(int r, int c) { const int st = (r >> 4) * 2 + (c >> 5), rr = r & 15, cc = c & 31, ob = rr * 64 + cc * 2; return st * 1024 + (ob ^ (((ob >> 9) & 1) << 5)); }
__device__ __forceinline__ void stage_rc(int b, int& R, int& C) { const int st = b / 1024, sb = b % 1024, swz = sb ^ (((sb >> 9) & 1) << 5); R = (st >> 1) * 16 + swz / 64; C = (st & 1) * 32 + (swz % 64) / 2; }
__device__ __forceinline__ int perm32(int rho) { const int n = rho >> 4, i = rho & 15; return 8 * (i >> 2) + 4 * n + (i & 3); }

struct Unit { int pm, pn; unsigned B; int g; int par; };

__device__ __forceinline__ void tile_map(int L, int nM, int nN, int& pm, int& pn, const int WGM = pg8::WGM) {
    const int nwg = nM * nN; int wgid = L;
    { const int q = nwg / NXCD, r = nwg % NXCD, xcd = wgid % NXCD, off = wgid / NXCD; wgid = (xcd < r ? xcd * (q + 1) : r * (q + 1) + (xcd - r) * q) + off; }
    const int nig = WGM * nN, gid = wgid / nig, fm = gid * WGM, gsz = (nM - fm) < WGM ? (nM - fm) : WGM;
    pm = fm + ((wgid % nig) % gsz); pn = (wgid % nig) / gsz;
}

typedef int i32x8 __attribute__((ext_vector_type(8)));
template <bool FP8, class Epi, class Sched>
__device__ __forceinline__ void gemm_phase(LAS unsigned char* lds, const int wid, const char* Abase, const char* Bbase, const int KB, const Sched& S, const Epi& E, const int skew_ticks  ) {
    const int lane = lane_id(), tid = wid * 64 + lane, wr = wid >> 2, wc = wid & 3, fr = lane & 15, fq = lane >> 4;
    const int nt = KB / 128;
    int R0, C0; stage_rc(tid * 16, R0, C0);
    unsigned voffB[2];
#pragma unroll
    for (int i = 0; i < 2; ++i) { const int R = R0 + 64 * i; const int Rb = Epi::PERM ? (Epi::WIDE ? ((R >> 5) * 64 + perm32(R & 31)) : ((R & ~31) + perm32(R & 31))) : R; voffB[i] = (unsigned)(Rb * KB + C0 * 2); }
    const unsigned kstep = (unsigned)(BK * 2);
    const unsigned hstep = (unsigned)(HALF * KB);
    const unsigned hstepB = Epi::WIDE ? (unsigned)(32 * KB) : hstep;
    const __amdgpu_buffer_rsrc_t rsA = __builtin_amdgcn_make_buffer_rsrc((void*)Abase, (short)0, 0x7ffff000, 0x00020000);
    const __amdgpu_buffer_rsrc_t rsB = __builtin_amdgcn_make_buffer_rsrc((void*)Bbase, (short)0, 0x7ffff000, 0x00020000);
    const unsigned ldsw = (unsigned)wid * 1024u;
    const int aoff = lds_byte(wr * 64 + fr, fq * 8), boff = lds_byte(wc * 32 + fr, fq * 8);
#define PG8_SA(b, h) (((b) * 2 + (h)) * HTB)
#define PG8_SB(b, h) ((4 + (b) * 2 + (h)) * HTB)
#define PG8_STAGE(bufoff, soff, voff) do { _Pragma("unroll") for (int _i = 0; _i < 2; ++_i) \
        __builtin_amdgcn_raw_ptr_buffer_load_lds(rsB, (LAS unsigned*)(lds + (bufoff) + ldsw + _i * 8192), 16, (int)(voff)[_i], (int)(soff), 0, 0); } while (0)
#define PG8_STAGE_A(bufoff, o0, o1, soff) do { \
        __builtin_amdgcn_raw_ptr_buffer_load_lds(rsA, (LAS unsigned*)(lds + (bufoff) + ldsw), 16, (int)(o0), (int)(soff), 0, 0); \
        __builtin_amdgcn_raw_ptr_buffer_load_lds(rsA, (LAS unsigned*)(lds + (bufoff) + ldsw + 8192), 16, (int)(o1), (int)(soff), 0, 0); } while (0)
#define PG8_LDA(dst, b, h) do { _Pragma("unroll") for (int m = 0; m < 4; ++m) _Pragma("unroll") for (int k = 0; k < 2; ++k) dst[m][k] = *(const LAS bf16x8*)(lds + PG8_SA(b, h) + aoff + m * 2048 + k * 1024); } while (0)
#define PG8_LDB(dst, b, h) do { _Pragma("unroll") for (int n = 0; n < 2; ++n) _Pragma("unroll") for (int k = 0; k < 2; ++k) dst[n][k] = *(const LAS bf16x8*)(lds + PG8_SB(b, h) + boff + n * 2048 + k * 1024); } while (0)
#define PG8_MMA(ai, bj, At, Bt) do { __builtin_amdgcn_s_setprio(1); \
        if constexpr (FP8) { _Pragma("unroll") for (int m = 0; m < 4; ++m) _Pragma("unroll") for (int n = 0; n < 2; ++n) { \
            const u32x4 _b0 = __builtin_bit_cast(u32x4, Bt[n][0]), _b1 = __builtin_bit_cast(u32x4, Bt[n][1]), _a0 = __builtin_bit_cast(u32x4, At[m][0]), _a1 = __builtin_bit_cast(u32x4, At[m][1]); \
            const i32x8 _bb = {(int)_b0.x, (int)_b0.y, (int)_b0.z, (int)_b0.w, (int)_b1.x, (int)_b1.y, (int)_b1.z, (int)_b1.w}, _aa = {(int)_a0.x, (int)_a0.y, (int)_a0.z, (int)_a0.w, (int)_a1.x, (int)_a1.y, (int)_a1.z, (int)_a1.w}; \
            acc[ai][bj][m][n] = __builtin_amdgcn_mfma_scale_f32_16x16x128_f8f6f4(_bb, _aa, acc[ai][bj][m][n], 0, 0, 0, 0, 0, 0); } } \
        else { _Pragma("unroll") for (int m = 0; m < 4; ++m) _Pragma("unroll") for (int n = 0; n < 2; ++n) _Pragma("unroll") for (int k = 0; k < 2; ++k) \
            acc[ai][bj][m][n] = __builtin_amdgcn_mfma_f32_16x16x32_bf16(Bt[n][k], At[m][k], acc[ai][bj][m][n], 0, 0, 0); } \
        __builtin_amdgcn_s_setprio(0); } while (0)
#define PG8_WAIT_V(n) asm volatile("s_waitcnt vmcnt(" #n ")" ::: "memory")
#define PG8_WAIT_L(n) asm volatile("s_waitcnt lgkmcnt(" #n ")" ::: "memory")
#define PG8_BAR __builtin_amdgcn_s_barrier()
#define PG8_SCHED __builtin_amdgcn_sched_barrier(0)
    Unit cur, nxt; int ui = 0;
    if (!S.next(0, cur)) return;
    if (skew_ticks > 0) { const unsigned long long t0 = __builtin_amdgcn_s_memrealtime(); while (__builtin_amdgcn_s_memrealtime() - t0 < (unsigned long long)skew_ticks) __builtin_amdgcn_s_sleep(8); }
    f32x4 acc[2][2][4][2];
#pragma unroll
    for (int a = 0; a < 2; ++a)
#pragma unroll
        for (int b = 0; b < 2; ++b)
#pragma unroll
            for (int m = 0; m < 4; ++m)
#pragma unroll
                for (int n = 0; n < 2; ++n) acc[a][b][m][n] = (f32x4){0.f, 0.f, 0.f, 0.f};
    bf16x8 At[4][2], B0[2][2], B1[2][2];
    unsigned voffA[2]; voffA[0] = (unsigned)(R0 * KB + C0 * 2); voffA[1] = voffA[0] + (unsigned)(64 * KB);
    unsigned oc00 = 0, oc01 = 0, oc10 = 0, oc11 = 0;
    int nvr = -1;
    __amdgpu_buffer_rsrc_t rsT = rsA;
    if constexpr (Sched::GATHER) rsT = __builtin_amdgcn_make_buffer_rsrc((void*)S.tok_base(), (short)0, 16 * RT_STRIDE * 4, 0x00020000);
    unsigned cA = 0, nA = 0;
    if constexpr (Sched::GATHER) { S.aoff(cur, R0, C0, oc00, oc01, oc10, oc11); asm volatile("" : "+v"(oc00), "+v"(oc01), "+v"(oc10), "+v"(oc11)); }
    else cA = S.abase(cur);
    cur.par = 0;
    if constexpr (Sched::UNIT_DMA) { if (wid == 0) S.unit_dma(cur, lds + STAGE_BYTES, lane); }
#define PG8_STA(bufoff, ptr, h, kb) do { if constexpr (Sched::GATHER) { if ((h) == 0) PG8_STAGE_A(bufoff, oc00, oc01, kb); else PG8_STAGE_A(bufoff, oc10, oc11, kb); } \
        else PG8_STAGE_A(bufoff, voffA[0], voffA[1], (ptr) + (unsigned)(h) * hstep + (unsigned)(kb)); } while (0)
    unsigned cB = cur.B;
    PG8_STAGE(PG8_SB(0, 0), cB, voffB); PG8_STA(PG8_SA(0, 0), cA, 0, 0); PG8_STAGE(PG8_SB(0, 1), cB + hstepB, voffB); PG8_STA(PG8_SA(0, 1), cA, 1, 0);
    if (wr == 1) PG8_BAR;
    PG8_WAIT_V(4); PG8_BAR;
    PG8_STAGE(PG8_SB(1, 0), cB + kstep, voffB); PG8_STA(PG8_SA(1, 0), cA, 0, kstep); PG8_STAGE(PG8_SB(1, 1), cB + hstepB + kstep, voffB);
    PG8_WAIT_V(6); PG8_BAR;
    for (;;) {
        const bool has_next = S.next(ui + 1, nxt); nxt.par = (ui + 1) & 1;
        if constexpr (Sched::GATHER) {
            nvr = has_next ? S.valid_rows(nxt) : -1;
            if (has_next && wid == 0) __builtin_amdgcn_raw_ptr_buffer_load_lds(rsT, (LAS unsigned*)(lds + STAGE_BYTES), 16, lane * 16, (int)S.tokoff(nxt), 0, 0);
        } else nA = has_next ? S.abase(nxt) : cA;
        const unsigned nB = has_next ? nxt.B : cB;
#pragma unroll 1
        for (int t = 0; t < nt; t += 2) {
            const bool last = (t == nt - 2);
            const unsigned k1 = (unsigned)(t + 1) * kstep;
            const unsigned k2 = last ? 0u : (unsigned)(t + 2) * kstep; const unsigned k3 = k2 + kstep;
            const unsigned a2 = last ? nA : cA;
            const unsigned b2 = last ? nB : cB + (unsigned)(t + 2) * kstep; const unsigned b3 = b2 + kstep;
            PG8_LDB(B0, 0, 0); PG8_SCHED; PG8_LDA(At, 0, 0); PG8_STA(PG8_SA(1, 1), cA, 1, k1);
            PG8_WAIT_L(8); PG8_BAR; PG8_WAIT_L(0); PG8_MMA(0, 0, At, B0); PG8_BAR; PG8_SCHED;
            if constexpr (Sched::UNIT_DMA) { if (t == 0 && has_next && wid == 0) S.unit_dma(nxt, lds + STAGE_BYTES, lane); }
            if constexpr (Sched::GATHER) { if (last && nvr >= 0) { const LAS int* lt = (const LAS int*)(lds + STAGE_BYTES);
                const int t00 = R0 < nvr ? lt[R0] : 0, t01 = R0 + 64 < nvr ? lt[R0 + 64] : 0, t10 = R0 + 128 < nvr ? lt[R0 + 128] : 0, t11 = R0 + 192 < nvr ? lt[R0 + 192] : 0;
                oc00 = (unsigned)(t00 * KB + C0 * 2); oc01 = (unsigned)(t01 * KB + C0 * 2); oc10 = (unsigned)(t10 * KB + C0 * 2); oc11 = (unsigned)(t11 * KB + C0 * 2); } }
            PG8_LDB(B1, 0, 1); PG8_STAGE(PG8_SB(0, 0), b2, voffB);
            PG8_BAR; PG8_WAIT_L(0); PG8_MMA(0, 1, At, B1); PG8_BAR;
            PG8_LDA(At, 0, 1); PG8_STA(PG8_SA(0, 0), a2, 0, k2);
            PG8_BAR; PG8_WAIT_L(0); PG8_MMA(1, 0, At, B0); PG8_BAR; PG8_SCHED;
            PG8_STAGE(PG8_SB(0, 1), b2 + hstepB, voffB);
            PG8_WAIT_V(6); PG8_BAR; PG8_MMA(1, 1, At, B1); PG8_BAR;
            PG8_LDB(B0, 1, 0); PG8_SCHED; PG8_LDA(At, 1, 0); PG8_STA(PG8_SA(0, 1), a2, 1, k2);
            PG8_WAIT_L(8); PG8_BAR; PG8_WAIT_L(0); PG8_MMA(0, 0, At, B0); PG8_BAR; PG8_SCHED;
            PG8_LDB(B1, 1, 1); PG8_STAGE(PG8_SB(1, 0), b3, voffB);
            PG8_BAR; PG8_WAIT_L(0); PG8_MMA(0, 1, At, B1); PG8_BAR;
            PG8_LDA(At, 1, 1); PG8_STA(PG8_SA(1, 0), a2, 0, k3);
            PG8_BAR; PG8_WAIT_L(0); PG8_MMA(1, 0, At, B0); PG8_BAR; PG8_SCHED;
            PG8_STAGE(PG8_SB(1, 1), b3 + hstepB, voffB);
            PG8_WAIT_V(6); PG8_BAR; PG8_MMA(1, 1, At, B1); PG8_BAR;
        }
        { const int _l = lane_id(); const int _fr = _l & 15, _fq = _l >> 4;
          E(acc, cur, wr, wc, _fr, _fq); }
        if (!has_next) break;
#pragma unroll
        for (int a = 0; a < 2; ++a)
#pragma unroll
            for (int b = 0; b < 2; ++b)
#pragma unroll
                for (int m = 0; m < 4; ++m)
#pragma unroll
                    for (int n = 0; n < 2; ++n) acc[a][b][m][n] = (f32x4){0.f, 0.f, 0.f, 0.f};
        cur = nxt; cB = nB; cA = nA; ++ui;
    }
    PG8_WAIT_V(0);
    if (wr == 0) PG8_BAR;
    PG8_BAR;
#undef PG8_SA
#undef PG8_SB
#undef PG8_STAGE
#undef PG8_STAGE_A
#undef PG8_STA
#undef PG8_LDA
#undef PG8_LDB
#undef PG8_MMA
#undef PG8_WAIT_V
#undef PG8_WAIT_L
#undef PG8_BAR
#undef PG8_SCHED
}

struct DenseSched {
    static constexpr bool GATHER = false, UNIT_DMA = false;
    int nM, nN, G, c, KB, wgm;
    __device__ __forceinline__ unsigned abase(const Unit& u) const { return (unsigned)(u.pm * 256 * KB); }
    __device__ __forceinline__ bool next(int i, Unit& u) const {
        const long L = (long)i * G + c; if (L >= (long)nM * nN) return false;
        tile_map((int)L, nM, nN, u.pm, u.pn, wgm); u.B = (unsigned)(u.pn * 256 * KB); u.g = 0; return true;
    }
    __device__ __forceinline__ void aoff(const Unit& u, int R0, int C0, unsigned& o00, unsigned& o01, unsigned& o10, unsigned& o11) const {
        const unsigned base = (unsigned)((u.pm * 256 + R0) * KB + C0 * 2), r64 = (unsigned)(64 * KB);
        o00 = base; o01 = base + r64; o10 = base + 2u * r64; o11 = base + 3u * r64;
    }
};
struct InProjL1Sched {
    static constexpr bool GATHER = false, UNIT_DMA = false;
    int G, c;
    __device__ __forceinline__ unsigned abase(const Unit& u) const { return (unsigned)(u.pm * 256 * D * 2); }
    __device__ __forceinline__ bool next(int i, Unit& u) const {
        const int L = i * G + c; if (L >= 3584 + 192) return false;
        if (L < 3584) tile_map(L, 256, 14, u.pm, u.pn);
        else { const int Lc = L - 3584; u.pm = 256 + Lc / 6; u.pn = 6 + Lc % 6; }
        u.B = (unsigned)(u.pn * 256 * D * 2); u.g = 0; return true;
    }
    __device__ __forceinline__ void aoff(const Unit& u, int R0, int C0, unsigned& o00, unsigned& o01, unsigned& o10, unsigned& o11) const {
        const unsigned base = (unsigned)((u.pm * 256 + R0) * D + C0) * 2u, r64 = (unsigned)(64 * D) * 2u;
        o00 = base; o01 = base + r64; o10 = base + 2u * r64; o11 = base + 3u * r64;
    }
};
struct MoeUpSched {
    static constexpr bool GATHER = true, UNIT_DMA = false;
    int G, c; const int* rowtok; const volatile LAS int* tb;
    __device__ __forceinline__ unsigned abase(const Unit&) const { return 0u; }
    __device__ __forceinline__ bool next(int i, Unit& u) const {
        const int T = tb[16]; const int L = i * G + c; if (L >= T * 22) return false;
        tile_map(L, T, 22, u.pm, u.pn, 8); int g = 0;
#pragma unroll
        for (int j = 1; j < 16; ++j) g += (u.pm >= tb[j]) ? 1 : 0;
        u.g = g; u.B = (unsigned)(((g & 7) * 5632 + u.pn * 256) * D); return true;
    }
    __device__ __forceinline__ const int* tok_base() const { return rowtok; }
    __device__ __forceinline__ unsigned tokoff(const Unit& u) const { return (unsigned)((u.g * RT_STRIDE + (u.pm - tb[u.g]) * 256) * 4); }
    __device__ __forceinline__ int valid_rows(const Unit& u) const { return tb[32 + u.g] - (u.pm - tb[u.g]) * 256; }
    __device__ __forceinline__ void aoff(const Unit& u, int R0, int C0, unsigned& o00, unsigned& o01, unsigned& o10, unsigned& o11) const {
        const int s0 = (u.pm - tb[u.g]) * 256 + R0, cnt = tb[32 + u.g]; const int* rt = rowtok + (size_t)u.g * RT_STRIDE;
        const int t00 = s0 < cnt ? rt[s0] : 0, t01 = s0 + 64 < cnt ? rt[s0 + 64] : 0, t10 = s0 + 128 < cnt ? rt[s0 + 128] : 0, t11 = s0 + 192 < cnt ? rt[s0 + 192] : 0;
        o00 = (unsigned)(t00 * D + C0 * 2); o01 = (unsigned)(t01 * D + C0 * 2); o10 = (unsigned)(t10 * D + C0 * 2); o11 = (unsigned)(t11 * D + C0 * 2);
    }
};
struct MoeDownSched {
    static constexpr bool GATHER = false, UNIT_DMA = true;
    int G, c; const volatile LAS int* tb; const int* rowtok; const float* rowgate;
    __device__ __forceinline__ unsigned abase(const Unit& u) const { return (unsigned)(u.pm * 256 * DFF); }
    __device__ __forceinline__ void unit_dma(const Unit& u, LAS unsigned char* side, int lane) const {
        const __amdgpu_buffer_rsrc_t rt = __builtin_amdgcn_make_buffer_rsrc((void*)rowtok, (short)0, 16 * RT_STRIDE * 4, 0x00020000);
        const __amdgpu_buffer_rsrc_t rg = __builtin_amdgcn_make_buffer_rsrc((void*)rowgate, (short)0, 16 * RT_STRIDE * 4, 0x00020000);
        const int off = (u.g * RT_STRIDE + (u.pm - tb[u.g]) * 256) * 4;
        __builtin_amdgcn_raw_ptr_buffer_load_lds(rt, (LAS unsigned*)(side + u.par * 2048), 16, lane * 16, off, 0, 0);
        __builtin_amdgcn_raw_ptr_buffer_load_lds(rg, (LAS unsigned*)(side + u.par * 2048 + 1024), 16, lane * 16, off, 0, 0);
    }
    __device__ __forceinline__ bool next(int i, Unit& u) const {
        const int T = tb[16]; const int L = i * G + c; if (L >= T * 4) return false;
        tile_map(L, T, 4, u.pm, u.pn); int g = 0;
#pragma unroll
        for (int j = 1; j < 16; ++j) g += (u.pm >= tb[j]) ? 1 : 0;
        u.g = g; u.B = (unsigned)(((g & 7) * D + u.pn * 256) * DFF); return true;
    }
};

struct EpiProj {
    static constexpr bool PERM = true, WIDE = true;
    bf16_t* P; bool dry;
    __device__ __forceinline__ void operator()(const f32x4 (&acc)[2][2][4][2], const Unit& u, int wr, int wc, int fr, int fq) const {
        if (dry) {
#pragma unroll
            for (int ai = 0; ai < 2; ++ai)
#pragma unroll
                for (int bj = 0; bj < 2; ++bj)
#pragma unroll
                    for (int m = 0; m < 4; ++m) asm volatile("" :: "v"(acc[ai][bj][m][0]), "v"(acc[ai][bj][m][1]));
            return; }
        const int row0 = u.pm * BM + wr * 64 + fr;
        if (u.pn >= 2 && u.pn < 6) {
            const int col0 = 512 + (u.pn - 2) * HALF + wc * 32 + 8 * fq;
#pragma unroll
            for (int ai = 0; ai < 2; ++ai)
#pragma unroll
                for (int m = 0; m < 4; ++m) { const f32x4 z0 = acc[ai][0][m][0] * acc[ai][1][m][0], z1 = acc[ai][0][m][1] * acc[ai][1][m][1];
                    u32x4 w; w.x = cvt_pk_bf16(z0[0], z0[1]); w.y = cvt_pk_bf16(z0[2], z0[3]); w.z = cvt_pk_bf16(z1[0], z1[1]); w.w = cvt_pk_bf16(z1[2], z1[3]);
                    *(u32x4*)(P + (size_t)(row0 + ai * HALF + m * 16) * NPO + col0) = w; }
            return; }
        const int colb = (u.pn < 2 ? u.pn * BM : u.pn * BM - 512) + wc * 64 + (fr < 8 ? 0 : 32) + 8 * fq; const bool lo = fr < 8;
#pragma unroll
        for (int ai = 0; ai < 2; ++ai)
#pragma unroll
            for (int m = 0; m < 4; ++m) { u32x4 a, b;
                { const f32x4 v0 = acc[ai][0][m][0], v1 = acc[ai][0][m][1]; a.x = cvt_pk_bf16(v0[0], v0[1]); a.y = cvt_pk_bf16(v0[2], v0[3]); a.z = cvt_pk_bf16(v1[0], v1[1]); a.w = cvt_pk_bf16(v1[2], v1[3]); }
                { const f32x4 v0 = acc[ai][1][m][0], v1 = acc[ai][1][m][1]; b.x = cvt_pk_bf16(v0[0], v0[1]); b.y = cvt_pk_bf16(v0[2], v0[3]); b.z = cvt_pk_bf16(v1[0], v1[1]); b.w = cvt_pk_bf16(v1[2], v1[3]); }
                u32x4 x = lo ? b : a, y;
                y.x = (unsigned)__builtin_amdgcn_update_dpp(0, (int)x.x, 0x128, 0xf, 0xf, false); y.y = (unsigned)__builtin_amdgcn_update_dpp(0, (int)x.y, 0x128, 0xf, 0xf, false);
                y.z = (unsigned)__builtin_amdgcn_update_dpp(0, (int)x.z, 0x128, 0xf, 0xf, false); y.w = (unsigned)__builtin_amdgcn_update_dpp(0, (int)x.w, 0x128, 0xf, 0xf, false);
                const u32x4 first = lo ? a : y, second = lo ? y : b;
                bf16_t* rowp = P + (size_t)(u.pm * BM + wr * 64 + ai * HALF + m * 16 + (fr & 7)) * NPO + colb;
                *(u32x4*)rowp = first; *(u32x4*)(rowp + (size_t)8 * NPO) = second; }
    }
};
struct EpiResid {
    static constexpr bool PERM = true, WIDE = true;
    bf16_t* HB; const float* gate; float gscale;
    __device__ __forceinline__ void operator()(const f32x4 (&acc)[2][2][4][2], const Unit& u, int wr, int wc, int fr, int fq) const {
        if (PROBE_DRY && gscale == 0.f) {
#pragma unroll
            for (int ai = 0; ai < 2; ++ai)
#pragma unroll
                for (int bj = 0; bj < 2; ++bj)
#pragma unroll
                    for (int m = 0; m < 4; ++m) asm volatile("" :: "v"(acc[ai][bj][m][0]), "v"(acc[ai][bj][m][1]));
            return; }
        const int rowg = u.pm * BM; const bool isc = rowg >= NL;
        const int bidx = isc ? 32 : (rowg >> 11);
        const bool lo = fr < 8;
        const int colw = u.pn * BM + wc * 64 + 8 * fq;
        const float* gv = gate + (size_t)bidx * 6144 + colw;
        bf16_t* out = HB + (size_t)(rowg + wr * 64 + (fr & 7)) * D + colw + (lo ? 0 : 32);
        u32x4 r[2][4][2];
#pragma unroll
        for (int ai = 0; ai < 2; ++ai)
#pragma unroll
            for (int m = 0; m < 4; ++m)
#pragma unroll
                for (int h = 0; h < 2; ++h) r[ai][m][h] = *(const u32x4*)(out + (size_t)(ai * HALF + m * 16 + 8 * h) * D);
        f32x4 g[2][2];
#pragma unroll
        for (int bj = 0; bj < 2; ++bj)
#pragma unroll
            for (int n = 0; n < 2; ++n) g[bj][n] = *(const f32x4*)(gv + bj * 32 + n * 4) * gscale;
#pragma unroll
        for (int ai = 0; ai < 2; ++ai)
#pragma unroll
            for (int m = 0; m < 4; ++m) {
                const f32x4 a0 = g[0][0] * acc[ai][0][m][0], a1 = g[0][1] * acc[ai][0][m][1], b0 = g[1][0] * acc[ai][1][m][0], b1 = g[1][1] * acc[ai][1][m][1];
                float x[8], y[8];
#pragma unroll
                for (int i = 0; i < 4; ++i) { x[i] = lo ? b0[i] : a0[i]; x[4 + i] = lo ? b1[i] : a1[i]; }
#pragma unroll
                for (int i = 0; i < 8; ++i) y[i] = __builtin_bit_cast(float, __builtin_amdgcn_update_dpp(0, __builtin_bit_cast(int, x[i]), 0x128, 0xf, 0xf, false));
                float f[8], s2[8];
#pragma unroll
                for (int i = 0; i < 4; ++i) { f[i] = lo ? a0[i] : y[i]; f[4 + i] = lo ? a1[i] : y[4 + i]; s2[i] = lo ? y[i] : b0[i]; s2[4 + i] = lo ? y[4 + i] : b1[i]; }
#pragma unroll
                for (int h = 0; h < 2; ++h) { const u32x4 rr = r[ai][m][h]; const float* v = h ? s2 : f;
                    u32x4 w; w.x = cvt_pk_bf16(bflo(rr.x) + v[0], bfhi(rr.x) + v[1]); w.y = cvt_pk_bf16(bflo(rr.y) + v[2], bfhi(rr.y) + v[3]);
                    w.z = cvt_pk_bf16(bflo(rr.z) + v[4], bfhi(rr.z) + v[5]); w.w = cvt_pk_bf16(bflo(rr.w) + v[6], bfhi(rr.w) + v[7]);
                    *(u32x4*)(out + (size_t)(ai * HALF + m * 16 + 8 * h) * D) = w; } }
    }
};
__device__ __forceinline__ float clamp448(float x) { return fminf(fmaxf(x, -448.0f), 448.0f); }
struct EpiSwiglu {
    static constexpr bool PERM = true, WIDE = false;
    unsigned char* ACT; float iscale, oscale;
    __device__ __forceinline__ void operator()(const f32x4 (&acc)[2][2][4][2], const Unit& u, int wr, int wc, int fr, int fq) const {
        if (PROBE_DRY && oscale == 0.f) {
#pragma unroll
            for (int ai = 0; ai < 2; ++ai)
#pragma unroll
                for (int bj = 0; bj < 2; ++bj)
#pragma unroll
                    for (int m = 0; m < 4; ++m) asm volatile("" :: "v"(acc[ai][bj][m][0]), "v"(acc[ai][bj][m][1]));
            return; }
        const int row0 = u.pm * BM + wr * 64 + fr, col0 = u.pn * HALF + wc * 32 + 8 * fq;
        const float c1 = -1.4426950408889634f * iscale, kk = oscale == 0.f ? 1.0e30f : 1.0f / (iscale * iscale * oscale);
#pragma unroll
        for (int ai = 0; ai < 2; ++ai)
#pragma unroll
            for (int m = 0; m < 4; ++m) { unsigned char* rowp = ACT + (size_t)(row0 + ai * HALF + m * 16) * DFF + col0;
                float o[8];
#pragma unroll
                for (int n = 0; n < 2; ++n)
#pragma unroll
                    for (int h2 = 0; h2 < 2; ++h2) {
                        const f32x2 a = {acc[ai][0][m][n][2 * h2], acc[ai][0][m][n][2 * h2 + 1]}, b = {acc[ai][1][m][n][2 * h2], acc[ai][1][m][n][2 * h2 + 1]};
                        const f32x2 t = a * c1; f32x2 e; e.x = __builtin_amdgcn_exp2f(t.x); e.y = __builtin_amdgcn_exp2f(t.y);
                        const f32x2 d = e * kk + kk; f32x2 r; r.x = __builtin_amdgcn_rcpf(d.x); r.y = __builtin_amdgcn_rcpf(d.y);
                        const f32x2 p = (a * b) * r;
                        o[n * 4 + 2 * h2] = __builtin_amdgcn_fmed3f(p.x, -448.0f, 448.0f); o[n * 4 + 2 * h2 + 1] = __builtin_amdgcn_fmed3f(p.y, -448.0f, 448.0f); }
                int w0 = 0, w1 = 0;
                w0 = __builtin_amdgcn_cvt_pk_fp8_f32(o[0], o[1], w0, false); w0 = __builtin_amdgcn_cvt_pk_fp8_f32(o[2], o[3], w0, true);
                w1 = __builtin_amdgcn_cvt_pk_fp8_f32(o[4], o[5], w1, false); w1 = __builtin_amdgcn_cvt_pk_fp8_f32(o[6], o[7], w1, true);
                *(u32x2*)rowp = (u32x2){(unsigned)w0, (unsigned)w1}; }
    }
};
struct EpiMoeDown {
    static constexpr bool PERM = true, WIDE = false;
    unsigned char* Y0; unsigned char* Y1; const LAS unsigned char* side; const volatile LAS int* tb; float gscale;
    __device__ __forceinline__ void operator()(const f32x4 (&acc)[2][2][4][2], const Unit& u, int wr, int wc, int fr, int fq) const {
        const int nv = tb[32 + u.g] - (u.pm - tb[u.g]) * 256;
        const LAS int* lt = (const LAS int*)(side + u.par * 2048); const LAS float* lg = (const LAS float*)(side + u.par * 2048 + 1024);
        unsigned char* Y = u.g < 8 ? Y0 : Y1;
        const int col0 = u.pn * BM + wc * 32 + 8 * fq;
        int tok[2][4]; float gt[2][4]; bool ok[2][4];
#pragma unroll
        for (int ai = 0; ai < 2; ++ai)
#pragma unroll
            for (int m = 0; m < 4; ++m) { const int rl = ai * HALF + wr * 64 + m * 16 + fr; ok[ai][m] = rl < nv; const int tk = lt[rl]; const float gg = lg[rl]; tok[ai][m] = ok[ai][m] ? tk : 0; gt[ai][m] = ok[ai][m] ? gg * gscale : 0.f; }
#pragma unroll
        for (int ai = 0; ai < 2; ++ai)
#pragma unroll
            for (int m = 0; m < 4; ++m) if (ok[ai][m]) { unsigned char* yp = Y + (size_t)tok[ai][m] * D + col0; const float gg = gt[ai][m];
#pragma unroll
                for (int bj = 0; bj < 2; ++bj) { const f32x4 a0 = acc[ai][bj][m][0] * gg, a1 = acc[ai][bj][m][1] * gg; int w0 = 0, w1 = 0;
                    w0 = __builtin_amdgcn_cvt_pk_fp8_f32(clamp448(a0[0]), clamp448(a0[1]), w0, false); w0 = __builtin_amdgcn_cvt_pk_fp8_f32(clamp448(a0[2]), clamp448(a0[3]), w0, true);
                    w1 = __builtin_amdgcn_cvt_pk_fp8_f32(clamp448(a1[0]), clamp448(a1[1]), w1, false); w1 = __builtin_amdgcn_cvt_pk_fp8_f32(clamp448(a1[2]), clamp448(a1[3]), w1, true);
                    *(u32x2*)(yp + bj * HALF) = (u32x2){(unsigned)w0, (unsigned)w1}; } }
    }
};
}

struct Args { const float* in[21]; float* out; unsigned char* ws; int lo, hi; };
enum { I_X = 0, I_C, I_CTX, I_CCTX, I_N1G, I_N2G, I_WADA, I_BADA, I_WIN, I_CONVW, I_BG, I_MNG, I_WOUT, I_FW1, I_FW3, I_FW2, I_ROUTER, I_MW1, I_MW3, I_MW2, I_FNG };

struct Frame { LAS unsigned char* lds; int wid, G, wg;
    __device__ __forceinline__ int lane() const { return lane_id(); }
    __device__ __forceinline__ int tid() const { return wid * 64 + lane_id(); } };
typedef const __attribute__((address_space(4))) Args* KArgs;
#define KA() ({ KArgs _k = (KArgs)__builtin_amdgcn_kernarg_segment_ptr(); asm volatile("" : "+s"(_k)); _k; })

__device__ __forceinline__ int conv_row(int mode, int n, float& scale) {
    scale = 1.f;
    if (mode == 0) return n;
    if (mode == 1) { if (n >= 2048 && n < 2560) scale = 0.08838834764831845f;
        if (n >= 512 && n < 1024) { const int j = n - 512; return (2 + (j >> 7)) * 256 + ((j & 127) >> 5) * 64 + (j & 31); }
        if (n >= 1024 && n < 1536) { const int j = n - 1024; return (2 + (j >> 7)) * 256 + ((j & 127) >> 5) * 64 + 32 + (j & 31); }
        if (n < 3072) return n; if (n < 3088) return 3584 + (n - 3072); return n - 16; }
    return (n >> 7) * 256 + (n & 127) + (mode == 3 ? 128 : 0);
}
__device__ __forceinline__ void conv_tiles(const Frame& F, const float* src, bf16_t* dst, int K, int N, int mode, float fp8scale  , int& gbase) {
    const int lane = F.lane();
    LAS float* tile = (LAS float*)(F.lds + F.wid * (64 * 65 * 4 + 64));
    const int GW = F.G * 8, gw = F.wg * 8 + F.wid;
    const int tn = (N + 63) / 64, ntile = (K / 64) * tn;
    int t = (gw - gbase) % GW; if (t < 0) t += GW;
    const int row = lane >> 4, c4 = (lane & 15) * 4;
    for (; t < ntile; t += GW) {
        const int k0 = (t / tn) * 64, n0 = (t % tn) * 64;
        f32x4 v[16];
#pragma unroll
        for (int i = 0; i < 16; ++i) { v[i] = (f32x4){0.f, 0.f, 0.f, 0.f}; if (n0 + c4 < N) v[i] = *(const f32x4*)(src + (size_t)(k0 + row + 4 * i) * N + n0 + c4); }
#pragma unroll
        for (int i = 0; i < 16; ++i) { LAS float* p = tile + (row + 4 * i) * 65 + c4; p[0] = v[i][0]; p[1] = v[i][1]; p[2] = v[i][2]; p[3] = v[i][3]; }
        asm volatile("s_waitcnt lgkmcnt(0)" ::: "memory");
#pragma unroll
        for (int p = 0; p < 8; ++p) { const int n = (lane >> 3) + 8 * p, kc = (lane & 7) * 8;
            if (n0 + n < N) { float sc; const int drow = conv_row(mode, n0 + n, sc); float x[8];
#pragma unroll
                for (int j = 0; j < 8; ++j) x[j] = tile[(kc + j) * 65 + n] * sc;
                if (fp8scale == 0.f) {
                    u32x4 w; w.x = cvt_pk_bf16(x[0], x[1]); w.y = cvt_pk_bf16(x[2], x[3]); w.z = cvt_pk_bf16(x[4], x[5]); w.w = cvt_pk_bf16(x[6], x[7]);
                    *(u32x4*)(dst + (size_t)drow * K + k0 + kc) = w;
                } else {
#pragma unroll
                    for (int j = 0; j < 8; ++j) x[j] = fminf(fmaxf(x[j] * fp8scale, -448.0f), 448.0f);
                    int w0 = 0, w1 = 0;
                    w0 = __builtin_amdgcn_cvt_pk_fp8_f32(x[0], x[1], w0, false); w0 = __builtin_amdgcn_cvt_pk_fp8_f32(x[2], x[3], w0, true);
                    w1 = __builtin_amdgcn_cvt_pk_fp8_f32(x[4], x[5], w1, false); w1 = __builtin_amdgcn_cvt_pk_fp8_f32(x[6], x[7], w1, true);
                    *(u32x2*)((unsigned char*)dst + (size_t)drow * K + k0 + kc) = (u32x2){(unsigned)w0, (unsigned)w1};
                } } }
        asm volatile("s_waitcnt lgkmcnt(0)" ::: "memory");
    }
    gbase = (gbase + ntile) % GW;
}
constexpr int P0_JOBS = 19;
__device__ __forceinline__ void conv_job(const Frame& F, int j, int& gbase) {
    KArgs ka = KA(); unsigned char* const ws = ka->ws;
    const float* src; bf16_t* dst; int K, N, mode; float f8 = 0.f;
    if (j < 2)       { src = ka->in[I_WIN] + (size_t)j * D * PIN; dst = (bf16_t*)(ws + WS_WIN) + (size_t)j * NPAD * D; K = D; N = PIN; mode = 1; }
    else if (j < 4)  { src = ka->in[I_WOUT] + (size_t)(j - 2) * D * D; dst = (bf16_t*)(ws + WS_WOUT) + (size_t)(j - 2) * D * D; K = D; N = D; mode = 0; }
    else if (j == 4) { src = ka->in[I_FW1]; dst = (bf16_t*)(ws + WS_WUP); K = D; N = DFF; mode = 2; f8 = S_W13; }
    else if (j == 5) { src = ka->in[I_FW3]; dst = (bf16_t*)(ws + WS_WUP); K = D; N = DFF; mode = 3; f8 = S_W13; }
    else if (j == 6) { src = ka->in[I_FW2]; dst = (bf16_t*)(ws + WS_WDN); K = DFF; N = D; mode = 0; f8 = S_W2; }
    else if (j < 15) { const int e = j - 7;  src = ka->in[I_MW1] + (size_t)e * D * DFF; dst = (bf16_t*)(ws + WS_MUP + (size_t)e * 2 * DFF * D); K = D; N = DFF; mode = 2; f8 = S_W13; }
    else if (j < 23) { const int e = j - 15; src = ka->in[I_MW3] + (size_t)e * D * DFF; dst = (bf16_t*)(ws + WS_MUP + (size_t)e * 2 * DFF * D); K = D; N = DFF; mode = 3; f8 = S_W13; }
    else             { const int e = j - 23; src = ka->in[I_MW2] + (size_t)e * DFF * D; dst = (bf16_t*)(ws + WS_MDN + (size_t)e * D * DFF); K = DFF; N = D; mode = 0; f8 = S_W2; }
    conv_tiles(F, src, dst, K, N, mode, f8, gbase);
}
__device__ __forceinline__ void p0_prologue(const Frame& F, int skip  ) {
    const int tid = F.tid(); KArgs ka = KA(); unsigned char* const ws = ka->ws;
    if (F.wg < 192 && !(skip & 1)) {
        constexpr int SP = 2080;
        for (int idx = tid; idx < 48 * 512; idx += 512) { const int b = idx >> 9, k2 = (idx & 511) * 2; float v0 = 0.f, v1 = 0.f;
            if (b < 33) { const float* cp = b < 32 ? ka->in[I_C] + b * 1024 : ka->in[I_CCTX]; v0 = cp[k2]; v1 = cp[k2 + 1]; v0 = v0 / (1.0f + __expf(-v0)); v1 = v1 / (1.0f + __expf(-v1)); }
            *(LAS unsigned*)(F.lds + b * SP + k2 * 2) = cvt_pk_bf16(v0, v1); }
        __syncthreads();
        const int layer = F.wg / 96, col0 = (F.wg % 96) * 64, g = F.wid;
        const int gl = F.lane(), gfr = gl & 15, gfq = gl >> 4;
        const float* Wu = ka->in[I_WADA] + (size_t)layer * 1024 * 6144 + col0 + (size_t)(g * 128) * 6144;
        const unsigned loff = (unsigned)(gfr + 8 * gfq * 6144);
        float wv[4][4][8];
#pragma unroll
        for (int ks = 0; ks < 4; ++ks)
#pragma unroll
            for (int nt = 0; nt < 4; ++nt)
#pragma unroll
                for (int j = 0; j < 8; ++j) wv[ks][nt][j] = (Wu + (size_t)(32 * ks + j) * 6144 + 16 * nt)[loff];
        f32x4 acc[4][3];
#pragma unroll
        for (int nt = 0; nt < 4; ++nt)
#pragma unroll
            for (int bt = 0; bt < 3; ++bt) acc[nt][bt] = (f32x4){0.f, 0.f, 0.f, 0.f};
#pragma unroll
        for (int ks = 0; ks < 4; ++ks) {
            bf16x8 Bf[3];
#pragma unroll
            for (int bt = 0; bt < 3; ++bt) Bf[bt] = *(const LAS bf16x8*)(F.lds + (16 * bt + gfr) * SP + (g * 128 + 32 * ks + 8 * gfq) * 2);
#pragma unroll
            for (int nt = 0; nt < 4; ++nt) {
                u32x4 aw; aw.x = cvt_pk_bf16(wv[ks][nt][0], wv[ks][nt][1]); aw.y = cvt_pk_bf16(wv[ks][nt][2], wv[ks][nt][3]); aw.z = cvt_pk_bf16(wv[ks][nt][4], wv[ks][nt][5]); aw.w = cvt_pk_bf16(wv[ks][nt][6], wv[ks][nt][7]);
                const bf16x8 Af = __builtin_bit_cast(bf16x8, aw);
#pragma unroll
                for (int bt = 0; bt < 3; ++bt) acc[nt][bt] = __builtin_amdgcn_mfma_f32_16x16x32_bf16(Af, Bf[bt], acc[nt][bt], 0, 0, 0);
            }
        }
        __syncthreads();
        LAS float* red = (LAS float*)F.lds;
#pragma unroll
        for (int nt = 0; nt < 4; ++nt)
#pragma unroll
            for (int bt = 0; bt < 3; ++bt) { const int b = 16 * bt + gfr;
                if (b < 33) {
#pragma unroll
                    for (int r = 0; r < 4; ++r) red[(g * 33 + b) * 64 + 16 * nt + 4 * gfq + r] = acc[nt][bt][r]; } }
        __syncthreads();
        float* MOD = (float*)(ws + WS_MOD); const float* bada = ka->in[I_BADA];
        for (int idx = tid; idx < 33 * 64; idx += 512) { const int b = idx >> 6, cc = idx & 63; float sum = 0.f;
#pragma unroll
            for (int gg = 0; gg < 8; ++gg) sum += red[(gg * 33 + b) * 64 + cc];
            MOD[((size_t)layer * 33 + b) * 6144 + col0 + cc] = sum + bada[layer * 6144 + col0 + cc]; }
        __syncthreads();
    }
    { bf16_t* WIN = (bf16_t*)(ws + WS_WIN);
      for (int l = 0; l < 2; ++l) { u32x4* p = (u32x4*)(WIN + ((size_t)l * NPAD + PIN) * D); const int n16 = (NPAD - PIN) * D * 2 / 16;
          for (int i = F.wg * 512 + tid; i < n16; i += F.G * 512) p[i] = (u32x4){0u, 0u, 0u, 0u}; } }
    int gbase = 0;
    for (int j = 0; j < ((skip & 2) ? 0 : P0_JOBS); ++j) conv_job(F, j, gbase);
}
__device__ __forceinline__ void tail_convert(const Frame& F, int ntiles, int j0, int j1) {
    const int rem = ntiles % F.G; if (F.wg < rem) return;
    Frame F2 = F; F2.G = F.G - rem; F2.wg = F.wg - rem;
    int gbase = 0;
    for (int j = j0; j < j1; ++j) conv_job(F2, j, gbase);
}

template <bool ROUTER, bool OUT8, bool SRC16, bool GATES>
__device__ __forceinline__ void norm_phase(const Frame& F, const float* srcL, const float* srcC  , int nrows, const float* gain, const float* mod  , int chunk_shift, bf16_t* U, const float* router,
                                           const bf16_t* Wg = nullptr, const float* bgate = nullptr, float* GT = nullptr, bf16_t* HBcopy = nullptr  ) {
    const int lane = F.lane(), wid = F.wid, tid = F.tid();
    constexpr int WG_RB = 2080;
    if constexpr (GATES) {
        for (int i = tid; i < 16 * 128; i += 512) { const int n = i >> 7, ch = i & 127; *(LAS u32x4*)(F.lds + n * WG_RB + ch * 16) = *(const u32x4*)(Wg + (size_t)n * D + ch * 8); }
        __syncthreads();
    }
    const int rpw = (nrows + F.G * 8 - 1) / (F.G * 8);
    const int rbase = (F.wg * 8 + wid) * rpw;
    LAS float* rl = (LAS float*)F.lds;
    LAS int* cntl = (LAS int*)(F.lds + 32768);
    LAS int* sel = (LAS int*)(F.lds + 32768 + 256);
    f32x4 rw[ROUTER ? 16 : 1][2];
    if (ROUTER) {
#pragma unroll
        for (int j = 0; j < 4; ++j)
#pragma unroll
            for (int i = 0; i < 4; ++i) { const float* rp = router + (size_t)(j * 256 + lane * 4 + i) * 8; rw[j * 4 + i][0] = *(const f32x4*)rp; rw[j * 4 + i][1] = *(const f32x4*)(rp + 4); }
        if (tid < 32) cntl[tid] = 0;
        __syncthreads();
    }
    f32x4 gn[4];
#pragma unroll
    for (int j = 0; j < 4; ++j) gn[j] = *(const f32x4*)(gain + j * 256 + lane * 4);
    typedef typename std::conditional<SRC16, u32x2, f32x4>::type raw_t;
    constexpr int NB4 = 4;
#define NP_LOAD(dst, row) do { const int _r = (row); _Pragma("unroll") for (int _j = 0; _j < 4; ++_j) { \
        if constexpr (SRC16) dst[_j] = *(const raw_t*)((const bf16_t*)srcL + (size_t)_r * D + _j * 256 + lane * 4); \
        else dst[_j] = *(const raw_t*)((_r >= NL ? srcC + (size_t)(_r - NL) * D : srcL + (size_t)_r * D) + _j * 256 + lane * 4); } } while (0)
    int cur_b = -1; f32x4 shv[4], scv[4];
#pragma unroll
    for (int j = 0; j < 4; ++j) { shv[j] = (f32x4){0.f, 0.f, 0.f, 0.f}; scv[j] = shv[j]; }
    for (int rr0 = 0; rr0 < rpw; rr0 += NB4) {
      if (rbase + rr0 >= nrows) break;
      { const int r = rbase + rr0; const int bidx = (r >= NL) ? 32 : (r >> 11);
        if (bidx != cur_b) { cur_b = bidx; const float* mv = mod + (size_t)bidx * 6144 + chunk_shift * 1024;
#pragma unroll
            for (int j = 0; j < 4; ++j) { shv[j] = *(const f32x4*)(mv + j * 256 + lane * 4); scv[j] = *(const f32x4*)(mv + 1024 + j * 256 + lane * 4) + 1.0f; }
#pragma unroll
            for (int j = 0; j < 4; ++j) asm volatile("" : "+v"(shv[j]), "+v"(scv[j])); } }
      raw_t bt[NB4][4];
#pragma unroll
      for (int q = 0; q < NB4; ++q) { int rl = rbase + rr0 + q; rl = rl < nrows ? rl : nrows - 1; NP_LOAD(bt[q], rl); }
#pragma unroll
      for (int q = 0; q < NB4; ++q) {
        const int rr = rr0 + q; const int r = rbase + rr; if (rr >= rpw || r >= nrows) continue;
        raw_t cr[4];
#pragma unroll
        for (int j = 0; j < 4; ++j) cr[j] = bt[q][j];
        f32x4 x[4]; float ss = 0.f;
#pragma unroll
        for (int j = 0; j < 4; ++j) {
            if constexpr (SRC16) { const u32x2 w = cr[j]; x[j] = (f32x4){bflo(w.x), bfhi(w.x), bflo(w.y), bfhi(w.y)}; }
            else { x[j] = cr[j];
                if (HBcopy) { u32x2 w; w.x = cvt_pk_bf16(x[j][0], x[j][1]); w.y = cvt_pk_bf16(x[j][2], x[j][3]); *(u32x2*)(HBcopy + (size_t)r * D + j * 256 + lane * 4) = w; } }
            ss += x[j][0] * x[j][0] + x[j][1] * x[j][1] + x[j][2] * x[j][2] + x[j][3] * x[j][3]; }
        ss = wave_sum(ss);
        const float rstd = rsqrtf(ss * (1.0f / 1024.0f) + EPS);
        float lg[8];
        if (ROUTER) {
#pragma unroll
            for (int e = 0; e < 8; ++e) lg[e] = 0.f;
        }
#pragma unroll
        for (int j = 0; j < 4; ++j) {
            f32x4 u = (x[j] * rstd * gn[j]) * scv[j] + shv[j];
            if (OUT8) { int w8 = 0; w8 = __builtin_amdgcn_cvt_pk_fp8_f32(fminf(fmaxf(u[0] * S_A, -448.f), 448.f), fminf(fmaxf(u[1] * S_A, -448.f), 448.f), w8, false);
                w8 = __builtin_amdgcn_cvt_pk_fp8_f32(fminf(fmaxf(u[2] * S_A, -448.f), 448.f), fminf(fmaxf(u[3] * S_A, -448.f), 448.f), w8, true);
                *(int*)((unsigned char*)U + (size_t)r * D + j * 256 + lane * 4) = w8; }
            else { u32x2 w; w.x = cvt_pk_bf16(u[0], u[1]); w.y = cvt_pk_bf16(u[2], u[3]);
                *(u32x2*)(U + (size_t)r * D + j * 256 + lane * 4) = w; }
            if (ROUTER) {
#pragma unroll
                for (int i = 0; i < 4; ++i) { const f32x4 r0 = rw[ROUTER ? j * 4 + i : 0][0], r1 = rw[ROUTER ? j * 4 + i : 0][1];
                    lg[0] += u[i] * r0[0]; lg[1] += u[i] * r0[1]; lg[2] += u[i] * r0[2]; lg[3] += u[i] * r0[3];
                    lg[4] += u[i] * r1[0]; lg[5] += u[i] * r1[1]; lg[6] += u[i] * r1[2]; lg[7] += u[i] * r1[3]; }
            }
        }
        if (ROUTER) {
            { const bool h5 = (lane & 32) != 0, h4 = (lane & 16) != 0, h3 = (lane & 8) != 0;
              float a4[4], a2[2], a1;
#pragma unroll
              for (int q = 0; q < 4; ++q) { const float keep = h5 ? lg[4 + q] : lg[q], send = h5 ? lg[q] : lg[4 + q]; a4[q] = keep + __shfl_xor(send, 32); }
#pragma unroll
              for (int q = 0; q < 2; ++q) { const float keep = h4 ? a4[2 + q] : a4[q], send = h4 ? a4[q] : a4[2 + q]; a2[q] = keep + __shfl_xor(send, 16); }
              { const float keep = h3 ? a2[1] : a2[0], send = h3 ? a2[0] : a2[1]; a1 = keep + __shfl_xor(send, 8); }
              a1 += __shfl_xor(a1, 4); a1 += __shfl_xor(a1, 2); a1 += __shfl_xor(a1, 1);
#pragma unroll
              for (int e = 0; e < 8; ++e) lg[e] = __shfl(a1, ((e >> 2) & 1) * 32 + ((e >> 1) & 1) * 16 + (e & 1) * 8); }
            int e0 = 0; float v0 = lg[0];
#pragma unroll
            for (int e = 1; e < 8; ++e) if (lg[e] > v0) { v0 = lg[e]; e0 = e; }
            int e1 = -1; float v1 = -3.0e38f;
#pragma unroll
            for (int e = 0; e < 8; ++e) if (e != e0 && lg[e] > v1) { v1 = lg[e]; e1 = e; }
            if (lane == 0) {
                const float g0 = 1.0f / (1.0f + __expf(v1 - v0)), g1 = 1.0f - g0;
                const int r0 = atomicAdd((int*)(cntl + e0), 1), r1 = atomicAdd((int*)(cntl + 8 + e1), 1);
                LAS int* sp = sel + (wid * rpw + rr) * 6;
                sp[0] = e0 | (e1 << 8); sp[1] = r0; sp[2] = r1; sp[3] = __float_as_int(g0); sp[4] = __float_as_int(g1); sp[5] = r;
            }
        }
      }
    }
    if constexpr (GATES) {
        asm volatile("s_waitcnt vmcnt(0)" ::: "memory");
        const int fr = lane & 15, fq = lane >> 4;
        int nr = nrows - rbase; nr = nr < 0 ? 0 : (nr > rpw ? rpw : nr);
        const f32x4 bias = *(const f32x4*)(bgate + 4 * fq);
        for (int g0 = 0; g0 < nr; g0 += 16) {
            int rl = g0 + fr; if (rl > nr - 1) rl = nr - 1;
            const bf16_t* up = U + (size_t)(rbase + rl) * D + 8 * fq;
            f32x4 a0 = (f32x4){0.f, 0.f, 0.f, 0.f}, a1 = a0;
#pragma unroll 8
            for (int ks = 0; ks < 32; ks += 2) {
                const bf16x8 u0 = *(const bf16x8*)(up + 32 * ks), u1 = *(const bf16x8*)(up + 32 * ks + 32);
                const bf16x8 w0 = *(const LAS bf16x8*)(F.lds + fr * WG_RB + (32 * ks + 8 * fq) * 2), w1 = *(const LAS bf16x8*)(F.lds + fr * WG_RB + (32 * ks + 32 + 8 * fq) * 2);
                a0 = __builtin_amdgcn_mfma_f32_16x16x32_bf16(w0, u0, a0, 0, 0, 0); a1 = __builtin_amdgcn_mfma_f32_16x16x32_bf16(w1, u1, a1, 0, 0, 0);
            }
            if (g0 + fr < nr) *(f32x4*)(GT + (size_t)(rbase + g0 + fr) * 16 + 4 * fq) = a0 + a1 + bias;
        }
    }
    if (ROUTER) {
        __syncthreads();
        unsigned char* const ws = KA()->ws;
        if (tid < 16) { unsigned* gc = (unsigned*)(ws + WS_CTL + CTL_GCNT); cntl[16 + tid] = (int)__hip_atomic_fetch_add(gc + tid, (unsigned)cntl[tid], __ATOMIC_RELAXED, __HIP_MEMORY_SCOPE_AGENT); }
        __syncthreads();
        int* rowtok = (int*)(ws + WS_RTOK); float* rowgate = (float*)(ws + WS_RGATE);
        for (int i = tid; i < 8 * rpw; i += 512) {
            const int w = i / rpw, rr = i % rpw; const int r = (F.wg * 8 + w) * rpw + rr;
            if (r < nrows) { const LAS int* sp = sel + i * 6; const int e0 = sp[0] & 255, e1 = sp[0] >> 8;
                const int p0 = cntl[16 + e0] + sp[1], p1 = cntl[16 + 8 + e1] + sp[2];
                rowtok[(size_t)e0 * RT_STRIDE + p0] = sp[5]; rowgate[(size_t)e0 * RT_STRIDE + p0] = __int_as_float(sp[3]);
                rowtok[(size_t)(8 + e1) * RT_STRIDE + p1] = sp[5]; rowgate[(size_t)(8 + e1) * RT_STRIDE + p1] = __int_as_float(sp[4]); }
        }
        __syncthreads();
    }
}

#undef NP_LOAD
__device__ __forceinline__ void unpack8(const u32x4 w, float (&v)[8]) { v[0] = bflo(w.x); v[1] = bfhi(w.x); v[2] = bflo(w.y); v[3] = bfhi(w.y); v[4] = bflo(w.z); v[5] = bfhi(w.z); v[6] = bflo(w.w); v[7] = bfhi(w.w); }
__device__ __forceinline__ u32x4 pack8(const float (&v)[8]) { u32x4 w; w.x = cvt_pk_bf16(v[0], v[1]); w.y = cvt_pk_bf16(v[2], v[3]); w.z = cvt_pk_bf16(v[4], v[5]); w.w = cvt_pk_bf16(v[6], v[7]); return w; }
__device__ __forceinline__ void mix_phase(const Frame& F, int nrows, const float* gnorm  ) {
    const int lane = F.lane(); unsigned char* const ws = KA()->ws;
    const bf16_t* P = (const bf16_t*)(ws + WS_PROJ); const bf16_t* HL = (const bf16_t*)KA()->out; bf16_t* A2 = (bf16_t*)(ws + WS_U);
    const int rpw = (nrows + F.G * 8 - 1) / (F.G * 8); const int rbase = (F.wg * 8 + F.wid) * rpw;
    if (rbase >= nrows) return;
    float gnv[8];
#pragma unroll
    for (int j = 0; j < 8; ++j) gnv[j] = gnorm[lane * 8 + j];
    u32x4 n_hf, n_hb, n_og;
#define MX_LOAD(r) do { n_og = *(const u32x4*)(P + (size_t)(r) * NPO + 2560 + lane * 8); n_hf = *(const u32x4*)(HL + (size_t)(r) * 512 + lane * 8); n_hb = *(const u32x4*)(HL + (size_t)(MT + (r)) * 512 + lane * 8); } while (0)
    MX_LOAD(rbase);
    for (int rr = 0; rr < rpw; ++rr) {
        const int r = rbase + rr; if (r >= nrows) break;
        const u32x4 c_hf = n_hf, c_hb = n_hb, c_og = n_og;
        if (rr + 1 < rpw && r + 1 < nrows) MX_LOAD(r + 1);
        float hf[8], hb[8], og[8], y[8];
        unpack8(c_hf, hf); unpack8(c_hb, hb); unpack8(c_og, og);
        float ss = 0.f;
#pragma unroll
        for (int j = 0; j < 8; ++j) { hf[j] += hb[j]; ss += hf[j] * hf[j]; }
        ss += __shfl_xor(ss, 1); ss += __shfl_xor(ss, 2); ss += __shfl_xor(ss, 4); ss += __shfl_xor(ss, 8);
        const float rstd = rsqrtf(ss * (1.0f / 128.0f) + EPS);
#pragma unroll
        for (int j = 0; j < 8; ++j) y[j] = hf[j] * rstd * gnv[j] * sigmoidf_(og[j]);
        *(u32x4*)(A2 + (size_t)r * D + 512 + lane * 8) = pack8(y);
    }
#undef MX_LOAD
}

__device__ __forceinline__ void final_phase(const Frame& F) {
    const int lane = F.lane(); KArgs ka = KA(); const float* gain = ka->in[I_FNG]; float* const outp = ka->out;
    const bf16_t* HB = (const bf16_t*)(ka->ws + WS_HB); const unsigned char* Y0 = (const unsigned char*)(ka->ws + WS_U); const unsigned char* Y1 = (const unsigned char*)(ka->ws + WS_Y1);
    const float* g2 = (const float*)(ka->ws + WS_MOD) + 33 * 6144 + 5 * 1024;
    const int rpw = (NL + F.G * 8 - 1) / (F.G * 8); const int rbase = (F.wg * 8 + F.wid) * rpw;
    f32x4 gn[4], gv[4];
#pragma unroll
    for (int j = 0; j < 4; ++j) { gn[j] = *(const f32x4*)(gain + j * 256 + lane * 4); gv[j] = (f32x4){0.f, 0.f, 0.f, 0.f}; }
    int cur_b = -1;
    u32x2 nx[4]; int ny[4], nz[4];
#define FP_LOAD(row) do { _Pragma("unroll") for (int _j = 0; _j < 4; ++_j) { nx[_j] = *(const u32x2*)(HB + (size_t)(row) * D + _j * 256 + lane * 4); \
        ny[_j] = *(const int*)(Y0 + (size_t)(row) * D + _j * 256 + lane * 4); nz[_j] = *(const int*)(Y1 + (size_t)(row) * D + _j * 256 + lane * 4); } } while (0)
    if (rbase < NL) FP_LOAD(rbase);
    for (int rr = 0; rr < rpw; ++rr) {
        const int r = rbase + rr; if (r >= NL) break;
        u32x2 cr[4]; int cy[4], cz[4];
#pragma unroll
        for (int j = 0; j < 4; ++j) { cr[j] = nx[j]; cy[j] = ny[j]; cz[j] = nz[j]; }
        if (rr + 1 < rpw && r + 1 < NL) FP_LOAD(r + 1);
        const int bidx = r >> 11;
        if (bidx != cur_b) { cur_b = bidx;
#pragma unroll
            for (int j = 0; j < 4; ++j) gv[j] = *(const f32x4*)(g2 + (size_t)bidx * 6144 + j * 256 + lane * 4) * (1.0f / S_Y); }
        f32x4 x[4]; float ss = 0.f;
#pragma unroll
        for (int j = 0; j < 4; ++j) { const u32x2 w = cr[j];
            const f32x2 y0 = __builtin_amdgcn_cvt_pk_f32_fp8(cy[j], false), y1 = __builtin_amdgcn_cvt_pk_f32_fp8(cy[j], true), z0 = __builtin_amdgcn_cvt_pk_f32_fp8(cz[j], false), z1 = __builtin_amdgcn_cvt_pk_f32_fp8(cz[j], true);
            x[j] = (f32x4){bflo(w.x), bfhi(w.x), bflo(w.y), bfhi(w.y)} + gv[j] * (f32x4){y0.x + z0.x, y0.y + z0.y, y1.x + z1.x, y1.y + z1.y};
            ss += x[j][0] * x[j][0] + x[j][1] * x[j][1] + x[j][2] * x[j][2] + x[j][3] * x[j][3]; }
        ss = wave_sum(ss);
        const float rstd = rsqrtf(ss * (1.0f / 1024.0f) + EPS);
        float* p = outp + (size_t)r * D;
#pragma unroll
        for (int j = 0; j < 4; ++j) *(f32x4*)(p + j * 256 + lane * 4) = x[j] * rstd * gn[j];
    }
#undef FP_LOAD
}

constexpr int ML_RB = 288;
constexpr int ML_RBC = 256;
constexpr int ML_Q = 0, ML_K = 36864, ML_V = 73728, ML_CT = 110592, ML_VEC = 145408, ML_CW = 151552;
__device__ __forceinline__ bf16x8 tr_frag2(const LAS unsigned char* base, int rowA, int rowB, int col0, int lane) {
    const int g = lane >> 4, q = (lane & 15) >> 2, p = lane & 3;
    const s16x4 v0 = __builtin_amdgcn_ds_read_tr16_b64_v4i16((LAS s16x4*)(base + (rowA + 4 * g + q) * ML_RB + (col0 + 4 * p) * 2));
    const s16x4 v1 = __builtin_amdgcn_ds_read_tr16_b64_v4i16((LAS s16x4*)(base + (rowB + 4 * g + q) * ML_RB + (col0 + 4 * p) * 2));
    return (bf16x8){v0[0], v0[1], v0[2], v0[3], v1[0], v1[1], v1[2], v1[3]};
}
__device__ __forceinline__ bf16x8 tr_frag(const LAS unsigned char* base, int row0, int col0, int lane) {
    const int g = lane >> 4, q = (lane & 15) >> 2, p = lane & 3;
    const LAS unsigned char* a = base + (row0 + 8 * g + q) * ML_RB + (col0 + 4 * p) * 2;
    const s16x4 v0 = __builtin_amdgcn_ds_read_tr16_b64_v4i16((LAS s16x4*)a);
    const s16x4 v1 = __builtin_amdgcn_ds_read_tr16_b64_v4i16((LAS s16x4*)(a + 4 * ML_RB));
    return (bf16x8){v0[0], v0[1], v0[2], v0[3], v1[0], v1[1], v1[2], v1[3]};
}
__device__ __forceinline__ void mlstm_phase(const Frame& F, bool ctx_out, int skip  ,
                                             int conv_rows  , const float* convw  ) {
    const int lane = F.lane(), wid = F.wid, tid = wid * 64 + lane, fr = lane & 15, fq = lane >> 4;
    LAS unsigned char* lds = F.lds;
    LAS float* ic = (LAS float*)(lds + ML_VEC); LAS float* fc = ic + 128; LAS float* av = ic + 256; LAS float* Mv = ic + 384; LAS float* bcv = ic + 512;
    LAS float* nvec = ic + 640; LAS float* wkv = ic + 768; LAS float* npart = ic + 896;
    LAS float* eav = ic + 1408;
    LAS float* cw = (LAS float*)(lds + ML_CW);
    for (int i = tid; i < 1536; i += 512) cw[i] = convw[i];
    unsigned char* const ws = KA()->ws;
    const bf16_t* P = (const bf16_t*)(ws + WS_PROJ); const float* GT = (const float*)(ws + WS_GATES); bf16_t* HL = (bf16_t*)KA()->out;
    bf16_t* A2 = (bf16_t*)(ws + WS_U);
    const int crpw = (conv_rows + F.G * 8 - 1) / (F.G * 8), crb = (F.wg * 8 + wid) * crpw; int cri = 0;
    int cnr = conv_rows - crb; cnr = cnr < 0 ? 0 : (cnr > crpw ? crpw : cnr);
#define MC_HASL(r) ((r) < NL ? (((r) & 63) != 0) : ((((r) - NL) & 255) != 0))
#define MC_HASR(r) ((r) < NL ? (((r) & 63) != 63) : ((((r) - NL) & 255) != 255))
    float zl[8], zc[8];
#pragma unroll
    for (int j = 0; j < 8; ++j) { zl[j] = 0.f; zc[j] = 0.f; }
    if (cnr > 0) { const bf16_t* pr = P + (size_t)crb * NPO + lane * 8;
        unpack8(*(const u32x4*)(pr + 512), zc);
        if (MC_HASL(crb)) unpack8(*(const u32x4*)(pr - NPO + 512), zl); }
    for (int unit = F.wg; unit < 256; unit += F.G) {
        const int b = unit >> 3, hd = (unit >> 1) & 3, dir = unit & 1;
        f32x4 Cacc[8];
#pragma unroll
        for (int a = 0; a < 8; ++a) Cacc[a] = (f32x4){0.f, 0.f, 0.f, 0.f};
        float m = 0.f, dec_prev = 0.f;
        if (tid < 128) nvec[tid] = 0.f;
        if (tid < 512) npart[tid] = 0.f;
        u32x4 st[12]; float gi = 0.f, gf = 0.f;
#define ML_ROW0(ci) ((ci) < 2 ? NL + b * 256 + (dir ? 1 - (ci) : (ci)) * 128 : b * 2048 + (dir ? 15 - ((ci) - 2) : ((ci) - 2)) * 128)
#define ML_LOAD(ci) do { const int _r0 = ML_ROW0(ci); _Pragma("unroll") for (int _p = 0; _p < 4; ++_p) { const int _id = tid + 512 * _p, _row = _id >> 4, _ch = _id & 15; \
            const bf16_t* _g = P + (size_t)(_r0 + _row) * NPO + 1024 + hd * 128 + _ch * 8; st[_p] = *(const u32x4*)_g; st[4 + _p] = *(const u32x4*)(_g + 512); st[8 + _p] = *(const u32x4*)(_g + 1024); } \
            if (tid < 128) { gi = GT[(size_t)(_r0 + tid) * 16 + (2 * dir) * 4 + hd]; gf = GT[(size_t)(_r0 + tid) * 16 + (2 * dir + 1) * 4 + hd]; } } while (0)
#define ML_BAR() do { asm volatile("s_waitcnt lgkmcnt(0)" ::: "memory"); __builtin_amdgcn_s_barrier(); asm volatile("" ::: "memory"); } while (0)
        ML_LOAD(0);
        __syncthreads();
        for (int ci = 0; ci < 18; ++ci) {
            const int row0 = ML_ROW0(ci);
            const bool need_out = ((ci >= 2) || ctx_out) && !(skip & 1);
            int lane_c = lane; asm volatile("" : "+v"(lane_c));
            const int lane = lane_c, fr = lane & 15, fq = lane >> 4, tid = wid * 64 + lane;
#pragma unroll
            for (int p = 0; p < 4; ++p) { const int id = tid + 512 * p, row = id >> 4, ch = id & 15; const int o = row * ML_RB + ch * 16;
                *(LAS u32x4*)(lds + ML_Q + o) = st[p]; *(LAS u32x4*)(lds + ML_K + o) = st[4 + p]; *(LAS u32x4*)(lds + ML_V + o) = st[8 + p]; }
#pragma unroll
            for (int a = 0; a < 8; ++a) { u32x2 w; w.x = cvt_pk_bf16(Cacc[a][0], Cacc[a][1]); w.y = cvt_pk_bf16(Cacc[a][2], Cacc[a][3]);
                *(LAS u32x2*)(lds + ML_CT + (16 * wid + fr) * ML_RBC + (((2 * a + (fq >> 1)) ^ fr) << 4) + (fq & 1) * 8) = w; }
            if (tid < 128) { ic[tid] = gi; fc[tid] = fminf(gf, 0.f) - __logf(1.0f + __expf(-fabsf(gf)));
                nvec[tid] = dec_prev * nvec[tid] + ((npart[tid] + npart[128 + tid]) + (npart[256 + tid] + npart[384 + tid])); }
            if (ci + 1 < 18 && !(skip & 4)) ML_LOAD(ci + 1);
            ML_BAR();
            int tq = __builtin_amdgcn_readfirstlane(wid < 4 ? 2 * wid : 15 - 2 * wid); asm volatile("" : "+s"(tq));
            bf16x8 Qf[4]; f32x4 aCh[8];
            if (need_out) {
#pragma unroll
                for (int ks = 0; ks < 4; ++ks) Qf[ks] = *(const LAS bf16x8*)(lds + ML_Q + (16 * tq + fr) * ML_RB + (32 * ks + 8 * fq) * 2);
#pragma unroll
                for (int d = 0; d < 8; ++d) { f32x4 aC = (f32x4){0.f, 0.f, 0.f, 0.f};
#pragma unroll
                    for (int kp = 0; kp < 4; ++kp) { const bf16x8 Cf = *(const LAS bf16x8*)(lds + ML_CT + (16 * d + fr) * ML_RBC + (((4 * kp + fq) ^ fr) << 4)); aC = __builtin_amdgcn_mfma_f32_16x16x32_bf16(Cf, Qf[kp], aC, 0, 0, 0); }
                    aCh[d] = aC; }
            }
            float bL, Mlast, amax;
            { const int p0 = 2 * lane, p1 = p0 + 1, s0 = dir ? 127 - p0 : p0, s1 = dir ? 127 - p1 : p1;
              const float f0 = fc[s0], f1 = fc[s1], i0 = ic[s0], i1 = ic[s1];
              const float incl = wave_scan_add(f0 + f1);
              const float bc1 = incl, bc0 = incl - f1;
              const float a0 = i0 - bc0, a1 = i1 - bc1;
              const float im = wave_scan_max(fmaxf(a0, a1));
              float ex = __shfl_up(im, 1); if (lane == 0) ex = -3.0e38f;
              const float M0 = fmaxf(fmaxf(m, ex), a0), M1 = fmaxf(m, im);
              bL = __shfl(incl, 63); Mlast = __shfl(M1, 63); amax = __shfl(im, 63);
              av[s0] = a0; av[s1] = a1; Mv[s0] = M0; Mv[s1] = M1; bcv[s0] = bc0; bcv[s1] = bc1;
              wkv[s0] = __expf(a0 - Mlast); wkv[s1] = __expf(a1 - Mlast);
              eav[s0] = __expf(a0 - amax); eav[s1] = __expf(a1 - amax); }
            if (need_out) {
                const int t = 16 * tq + fr; const float Mt = Mv[t];
                float rowsum = 0.f; u32x2 Sp[8];
#pragma unroll
                for (int j = 0; j < 8; ++j) {
                    Sp[j] = (u32x2){0u, 0u};
                    const bool act = dir ? (j >= tq) : (j <= tq);
                    if (act) {
                        f32x4 acc = (f32x4){0.f, 0.f, 0.f, 0.f};
#pragma unroll
                        for (int ks = 0; ks < 4; ++ks) { const bf16x8 Kf = *(const LAS bf16x8*)(lds + ML_K + (16 * j + fr) * ML_RB + (32 * ks + 8 * fq) * 2); acc = __builtin_amdgcn_mfma_f32_16x16x32_bf16(Kf, Qf[ks], acc, 0, 0, 0); }
                        const f32x4 e4 = *(const LAS f32x4*)(eav + 16 * j + 4 * fq);
                        float v[4];
#pragma unroll
                        for (int r = 0; r < 4; ++r) v[r] = acc[r] * e4[r];
                        if (j == tq) {
#pragma unroll
                            for (int r = 0; r < 4; ++r) { const bool valid = dir ? (4 * fq + r >= fr) : (4 * fq + r <= fr); v[r] = valid ? v[r] : 0.f; } }
                        rowsum += (v[0] + v[1]) + (v[2] + v[3]);
                        Sp[j].x = cvt_pk_bf16(v[0], v[1]); Sp[j].y = cvt_pk_bf16(v[2], v[3]);
                    }
                }
                rowsum += __shfl_xor(rowsum, 16); rowsum += __shfl_xor(rowsum, 32);
                float qn = 0.f;
#pragma unroll
                for (int ks = 0; ks < 4; ++ks) { const f32x4 n0 = *(const LAS f32x4*)(nvec + 32 * ks + 8 * fq), n1 = *(const LAS f32x4*)(nvec + 32 * ks + 8 * fq + 4);
#pragma unroll
                    for (int jj = 0; jj < 4; ++jj) { qn += bf2f((unsigned short)Qf[ks][jj]) * n0[jj]; qn += bf2f((unsigned short)Qf[ks][4 + jj]) * n1[jj]; } }
                qn += __shfl_xor(qn, 16); qn += __shfl_xor(qn, 32);
                const float em = __expf(amax - Mt), wi = __expf(m - Mt), den = em * rowsum + wi * qn, rd = 1.0f / fmaxf(fabsf(den), __expf(-(bcv[t] + Mt)));
                const float ems = em * rd, wis = wi * rd;
                bf16x8 Sf[4];
#pragma unroll
                for (int ks = 0; ks < 4; ++ks) { const u32x4 w = (u32x4){Sp[2 * ks].x, Sp[2 * ks].y, Sp[2 * ks + 1].x, Sp[2 * ks + 1].y}; Sf[ks] = __builtin_bit_cast(bf16x8, w); }
                LAS unsigned char* const obuf = lds + ML_Q + 16 * tq * ML_RB;
#pragma unroll
                for (int d = 0; d < 8; ++d) {
                    f32x4 aS = (f32x4){0.f, 0.f, 0.f, 0.f}, aC = (f32x4){0.f, 0.f, 0.f, 0.f};
#pragma unroll
                    for (int ks = 0; ks < 4; ++ks) { const bool act = dir ? (2 * ks + 1 >= tq) : (2 * ks <= tq);
                        if (act) { const bf16x8 Vt = tr_frag2(lds + ML_V, 32 * ks, 32 * ks + 16, 16 * d, lane); aS = __builtin_amdgcn_mfma_f32_16x16x32_bf16(Vt, Sf[ks], aS, 0, 0, 0); } }
aC = aCh[d];
                    u32x2 w; w.x = cvt_pk_bf16(ems * aS[0] + wis * aC[0], ems * aS[1] + wis * aC[1]); w.y = cvt_pk_bf16(ems * aS[2] + wis * aC[2], ems * aS[3] + wis * aC[3]);
                    *(LAS u32x2*)(obuf + fr * 272 + (16 * d + 4 * fq) * 2) = w;
                }
#pragma unroll
                for (int i = 0; i < 4; ++i) { const int orow = (lane >> 4) + 4 * i; const u32x4 v = *(const LAS u32x4*)(obuf + orow * 272 + (lane & 15) * 16);
                    *(u32x4*)(HL + ((size_t)dir * MT + row0 + 16 * tq + orow) * 512 + hd * 128 + (lane & 15) * 8) = v; }
            }
            u32x4 c_gb[2], c_gc[2]; int c_n = 0;
            {
                c_n = cnr - cri; c_n = c_n > 2 ? 2 : (c_n < 0 ? 0 : c_n); if (skip & 8) c_n = 0;
#pragma unroll
                for (int q = 0; q < 2; ++q) if (q < c_n) { const bf16_t* pr = P + (size_t)(crb + cri + q) * NPO + lane * 8; c_gb[q] = *(const u32x4*)pr; c_gc[q] = *(const u32x4*)(pr + NPO + 512); }
                asm volatile("" ::: "memory");
                const float dec = __expf(m - Mlast);
                bf16x8 Vw[4], Wk[4];
#pragma unroll
                for (int ks = 0; ks < 4; ++ks) { const bf16x8 Vf = tr_frag2(lds + ML_V, 32 * ks, 32 * ks + 16, 16 * wid, lane);
                    const f32x4 k0 = *(const LAS f32x4*)(wkv + 32 * ks + 4 * fq), k1 = *(const LAS f32x4*)(wkv + 32 * ks + 16 + 4 * fq);
                    u32x4 w;
                    w.x = cvt_pk_bf16(bf2f((unsigned short)Vf[0]) * k0[0], bf2f((unsigned short)Vf[1]) * k0[1]); w.y = cvt_pk_bf16(bf2f((unsigned short)Vf[2]) * k0[2], bf2f((unsigned short)Vf[3]) * k0[3]);
                    w.z = cvt_pk_bf16(bf2f((unsigned short)Vf[4]) * k1[0], bf2f((unsigned short)Vf[5]) * k1[1]); w.w = cvt_pk_bf16(bf2f((unsigned short)Vf[6]) * k1[2], bf2f((unsigned short)Vf[7]) * k1[3]);
                    Vw[ks] = __builtin_bit_cast(bf16x8, w);
                    u32x4 wq = (u32x4){0u, 0u, 0u, 0u};
                    if (fr == 0) { wq.x = cvt_pk_bf16(k0[0], k0[1]); wq.y = cvt_pk_bf16(k0[2], k0[3]); wq.z = cvt_pk_bf16(k1[0], k1[1]); wq.w = cvt_pk_bf16(k1[2], k1[3]); }
                    Wk[ks] = __builtin_bit_cast(bf16x8, wq); }
                f32x4 nacc = (f32x4){0.f, 0.f, 0.f, 0.f};
                if (!(skip & 2)) {
#pragma unroll
                for (int a = 0; a < 8; ++a) { Cacc[a] = Cacc[a] * dec;
#pragma unroll
                    for (int ks = 0; ks < 4; ++ks) { const bf16x8 Kt = tr_frag2(lds + ML_K, 32 * ks, 32 * ks + 16, 16 * a, lane); Cacc[a] = __builtin_amdgcn_mfma_f32_16x16x32_bf16(Kt, Vw[ks], Cacc[a], 0, 0, 0);
                        if (a == wid) nacc = __builtin_amdgcn_mfma_f32_16x16x32_bf16(Kt, Wk[ks], nacc, 0, 0, 0); } } }
                if (fr == 0) *(LAS f32x4*)(npart + 16 * wid + 4 * fq) = nacc;
                dec_prev = dec;
                m = bL + Mlast;
            }
#pragma unroll
            for (int q = 0; q < 2; ++q) if (q < c_n) { const int r = crb + cri + q;
                float gb[8], zr[8], y[8];
                unpack8(c_gb[q], gb); unpack8(c_gc[q], zr);
                const f32x4 wa0 = *(const LAS f32x4*)(cw + lane * 8), wa1 = *(const LAS f32x4*)(cw + lane * 8 + 4), wb0 = *(const LAS f32x4*)(cw + 512 + lane * 8), wb1 = *(const LAS f32x4*)(cw + 512 + lane * 8 + 4),
                            wc0 = *(const LAS f32x4*)(cw + 1024 + lane * 8), wc1 = *(const LAS f32x4*)(cw + 1024 + lane * 8 + 4);
                const bool hasR = MC_HASR(r);
#pragma unroll
                for (int j = 0; j < 8; ++j) {
                    const float w0 = j < 4 ? wa0[j & 3] : wa1[j & 3], w1 = j < 4 ? wb0[j & 3] : wb1[j & 3], w2 = j < 4 ? wc0[j & 3] : wc1[j & 3];
                    y[j] = gb[j] * (w0 * zl[j] + w1 * zc[j] + (hasR ? w2 * zr[j] : 0.f)); }
                *(u32x4*)(A2 + (size_t)r * D + lane * 8) = pack8(y);
#pragma unroll
                for (int j = 0; j < 8; ++j) { zl[j] = hasR ? zc[j] : 0.f; zc[j] = zr[j]; } }
            cri += c_n;
            ML_BAR();
        }
#undef ML_ROW0
#undef ML_LOAD
#undef ML_BAR
#undef MC_HASL
#undef MC_HASR
    }
}

constexpr int NPH = 20;
constexpr int REP[NPH] = {1, 1, 1, 1, 1, 1, 1, 1, 1, 1, 1, 1, 1, 1, 1, 1, 1, 1, 1, 1};
#define REPEAT(k) for (int _r = 0; _r < REP[k]; ++_r)
#define GSCALE(k) ((_r == REP[k] - 1) ? 1.0f : 0.0f)
__global__ void __launch_bounds__(512, 2) mk_fwd(Args args_unused) {
    extern __shared__ __attribute__((aligned(16))) unsigned char smem[];
    Frame F;
    F.lds = (LAS unsigned char*)smem; F.wid = __builtin_amdgcn_readfirstlane((int)threadIdx.x >> 6); F.G = gridDim.x; F.wg = blockIdx.x;
    volatile LAS unsigned* misc = (volatile LAS unsigned*)(F.lds + MISC_OFF);
    if (F.tid() < 64) misc[F.tid()] = 0u;
    __syncthreads();
    int lo, hi;
    { KArgs ka = KA(); lo = ka->lo; hi = ka->hi; }
    XcdBarrier bar;
    { KArgs ka = KA(); bar.bar = (unsigned*)(ka->ws + WS_CTL); bar.x = 0; bar.st = misc; bar.wid = F.wid;
      if (hi - lo > 1) bar = xcd_barrier_post((unsigned*)(ka->ws + WS_CTL), misc, F.wid); }
#define IN(k) (lo <= (k) && (k) < hi)
#define SEAM(k) do { if (IN(k) && IN((k) + 1)) { KArgs _ka = KA(); bar.bar = (unsigned*)(_ka->ws + WS_CTL); xcd_barrier(bar); } } while (0)
    const volatile LAS int* tb = (const volatile LAS int*)(F.lds + MISC_OFF + 64);
    volatile LAS int* tbw = (volatile LAS int*)(F.lds + MISC_OFF + 64);

#ifdef PROBE_MFMA
    {
        f32x4 a0 = {0.f, 0.f, 0.f, 0.f}, a1 = a0, a2 = a0, a3 = a0; bf16x8 x = {1, 2, 3, 4, 5, 6, 7, 8}, y = {8, 7, 6, 5, 4, 3, 2, 1};
        asm volatile("" : "+v"(x), "+v"(y));
        for (int it = 0; it < 10000; ++it) {
            a0 = __builtin_amdgcn_mfma_f32_16x16x32_bf16(x, y, a0, 0, 0, 0); a1 = __builtin_amdgcn_mfma_f32_16x16x32_bf16(x, y, a1, 0, 0, 0);
            a2 = __builtin_amdgcn_mfma_f32_16x16x32_bf16(x, y, a2, 0, 0, 0); a3 = __builtin_amdgcn_mfma_f32_16x16x32_bf16(x, y, a3, 0, 0, 0); }
        asm volatile("" :: "v"(a0), "v"(a1), "v"(a2), "v"(a3));
    }
#endif
    if (IN(0)) REPEAT(0) { p0_prologue(F, _r < REP[0] - 1 ? PROBE_P0SKIP : 0); }
    SEAM(0);
    if (IN(1)) REPEAT(1) { KArgs ka = KA(); unsigned char* ws = ka->ws;
        norm_phase<false, false, false, true>(F, ka->in[I_X], ka->in[I_CTX], MT, ka->in[I_N1G], (const float*)(ws + WS_MOD), 0, (bf16_t*)(ws + WS_U), nullptr,
            (const bf16_t*)(ws + WS_WIN) + (size_t)NPROJ * D, ka->in[I_BG], (float*)(ws + WS_GATES), (bf16_t*)(ws + WS_HB)); }
    SEAM(1);
    if (IN(2)) REPEAT(2) { KArgs ka = KA(); unsigned char* ws = ka->ws;
        pg8::DenseSched S{MT / 256, NPROJ / 256, F.G, F.wg, 2 * D, 4};
        pg8::EpiProj E{(bf16_t*)(ws + WS_PROJ), GSCALE(2) == 0.0f};
        pg8::gemm_phase<false>(F.lds, F.wid, (const char*)(ws + WS_U), (const char*)(ws + WS_WIN), 2 * D, S, E, 0);
        tail_convert(F, (MT / 256) * (NPROJ / 256), 30, 31); }
    SEAM(2);
    if (IN(3)) REPEAT(3) { mlstm_phase(F, true, _r < REP[3] - 1 ? PROBE_MLSKIP : 0, MT, KA()->in[I_CONVW]); }
    SEAM(3);
    if (IN(4)) REPEAT(4) { KArgs ka = KA(); mix_phase(F, MT, ka->in[I_MNG]); }
    SEAM(4);
    if (IN(5)) REPEAT(5) { KArgs ka = KA(); unsigned char* ws = ka->ws;
        pg8::DenseSched S{MT / 256, D / 256, F.G, F.wg, 2 * D, 4};
        pg8::EpiResid E{(bf16_t*)(ws + WS_HB), (const float*)(ws + WS_MOD) + 2 * 1024, 1.0f};
        pg8::gemm_phase<false>(F.lds, F.wid, (const char*)(ws + WS_U), (const char*)(ws + WS_WOUT), 2 * D, S, E, 0);
        tail_convert(F, (MT / 256) * (D / 256), 27, 30); }
    SEAM(5);
    if (IN(6)) REPEAT(6) { KArgs ka = KA(); unsigned char* ws = ka->ws;
        norm_phase<false, true, true, false>(F, (const float*)(ws + WS_HB), nullptr, MT, ka->in[I_N2G], (const float*)(ws + WS_MOD), 3, (bf16_t*)(ws + WS_U), nullptr); }
    SEAM(6);
    if (IN(7)) REPEAT(7) { KArgs ka = KA(); unsigned char* ws = ka->ws;
        pg8::DenseSched S{MT / 256, 2 * DFF / 256, F.G, F.wg, D, 8};
        pg8::EpiSwiglu E{(unsigned char*)(ws + WS_PROJ), 1.0f / (S_A * S_W13), S_H * GSCALE(7)};
        pg8::gemm_phase<true>(F.lds, F.wid, (const char*)(ws + WS_U), (const char*)(ws + WS_WUP), D, S, E, 0);
        tail_convert(F, (MT / 256) * (2 * DFF / 256), 26, 27); }
    SEAM(7);
    if (IN(8)) REPEAT(8) { KArgs ka = KA(); unsigned char* ws = ka->ws;
        pg8::DenseSched S{MT / 256, D / 256, F.G, F.wg, DFF, 4};
        pg8::EpiResid E{(bf16_t*)(ws + WS_HB), (const float*)(ws + WS_MOD) + 5 * 1024, GSCALE(8) / (S_H * S_W2)};
        pg8::gemm_phase<true>(F.lds, F.wid, (const char*)(ws + WS_PROJ), (const char*)(ws + WS_WDN), DFF, S, E, 0);
        tail_convert(F, (MT / 256) * (D / 256), 20, 26); }
    SEAM(8);
    if (IN(9)) REPEAT(9) { KArgs ka = KA(); unsigned char* ws = ka->ws;
        norm_phase<false, false, true, true>(F, (const float*)(ws + WS_HB), nullptr, MT, ka->in[I_N1G] + D, (const float*)(ws + WS_MOD) + 33 * 6144, 0, (bf16_t*)(ws + WS_U), nullptr,
            (const bf16_t*)(ws + WS_WIN) + (size_t)(NPAD + NPROJ) * D, ka->in[I_BG] + 16, (float*)(ws + WS_GATES)); }
    SEAM(9);
    if (IN(10)) REPEAT(10) { KArgs ka = KA(); unsigned char* ws = ka->ws;
        pg8::InProjL1Sched S{F.G, F.wg};
        pg8::EpiProj E{(bf16_t*)(ws + WS_PROJ), GSCALE(10) == 0.0f};
        pg8::gemm_phase<false>(F.lds, F.wid, (const char*)(ws + WS_U), (const char*)(ws + WS_WIN) + (size_t)NPAD * D * 2, 2 * D, S, E, 0);
        tail_convert(F, 3584 + 192, 19, 20); }
    SEAM(10);
    if (IN(11)) REPEAT(11) { mlstm_phase(F, false, _r < REP[11] - 1 ? PROBE_MLSKIP : 0, NL, KA()->in[I_CONVW] + 3 * 512); }
    SEAM(11);
    if (IN(12)) REPEAT(12) { KArgs ka = KA(); mix_phase(F, NL, ka->in[I_MNG] + 512); }
    SEAM(12);
    if (IN(13)) REPEAT(13) { KArgs ka = KA(); unsigned char* ws = ka->ws;
        pg8::DenseSched S{NL / 256, D / 256, F.G, F.wg, 2 * D, 4};
        pg8::EpiResid E{(bf16_t*)(ws + WS_HB), (const float*)(ws + WS_MOD) + 33 * 6144 + 2 * 1024, GSCALE(13)};
        pg8::gemm_phase<false>(F.lds, F.wid, (const char*)(ws + WS_U), (const char*)(ws + WS_WOUT) + (size_t)D * D * 2, 2 * D, S, E, 0); }
    SEAM(13);
    if (IN(14)) REPEAT(14) { KArgs ka = KA(); unsigned char* ws = ka->ws;
        norm_phase<true, true, true, false>(F, (const float*)(ws + WS_HB), nullptr, NL, ka->in[I_N2G] + D, (const float*)(ws + WS_MOD) + 33 * 6144, 3, (bf16_t*)(ws + WS_U), ka->in[I_ROUTER]); }
    SEAM(14);
    if (IN(15) || IN(16)) {
        __syncthreads();
        { const int tidl = F.tid();
          if (tidl < 64) {
            KArgs ka = KA(); const unsigned* gc = (const unsigned*)(ka->ws + WS_CTL + CTL_GCNT);
            const int c = tidl < 16 ? (int)__hip_atomic_load(gc + tidl, __ATOMIC_RELAXED, __HIP_MEMORY_SCOPE_AGENT) : 0;
            const int nt_ = (c + 255) >> 8; int incl = nt_;
#pragma unroll
            for (int d = 1; d < 16; d <<= 1) { const int t = __shfl_up(incl, d); if (tidl >= d) incl += t; }
            if (tidl < 16) { tbw[tidl] = incl - nt_; tbw[32 + tidl] = c; }
            if (tidl == 15) tbw[16] = incl; } }
        __syncthreads();
    }
    if (IN(15)) REPEAT(15) { KArgs ka = KA(); unsigned char* ws = ka->ws;
        pg8::MoeUpSched S{F.G, F.wg, (const int*)(ws + WS_RTOK), tb};
        pg8::EpiSwiglu E{(unsigned char*)(ws + WS_PROJ), 1.0f / (S_A * S_W13), S_H};
        pg8::gemm_phase<true>(F.lds, F.wid, (const char*)(ws + WS_U), (const char*)(ws + WS_MUP), D, S, E, 0); }
    SEAM(15);
    if (IN(16)) { KArgs ka = KA(); unsigned char* ws = ka->ws;
        pg8::MoeDownSched S{F.G, F.wg, tb, (const int*)(ws + WS_RTOK), (const float*)(ws + WS_RGATE)};
        pg8::EpiMoeDown E{(unsigned char*)(ws + WS_U), (unsigned char*)(ws + WS_Y1), F.lds + pg8::STAGE_BYTES, tb, S_Y / (S_H * S_W2)};
        pg8::gemm_phase<true>(F.lds, F.wid, (const char*)(ws + WS_PROJ), (const char*)(ws + WS_MDN), DFF, S, E, 0); }
    SEAM(16);
    if (IN(19)) REPEAT(19) { final_phase(F); }
#undef IN
#undef SEAM
}

extern "C" void kernel_launch(void* const* d_in, const int* in_sizes, int n_in, void* d_out, int out_size, void* d_ws, size_t ws_size, hipStream_t stream) {
    static int grid = 0;
    if (grid == 0) {
        if (n_in != 21 || ws_size < WS_END) { fprintf(stderr, "kernel_launch: expected 21 inputs and >= %zu bytes of workspace; got %d, %zu\n", (size_t)WS_END, n_in, ws_size); grid = -1; return; }
        int dev = 0, cus = 0, per_cu = 0;
        if (hipGetDevice(&dev) != hipSuccess || hipDeviceGetAttribute(&cus, hipDeviceAttributeMultiprocessorCount, dev) != hipSuccess) { grid = -1; return; }
        if (hipFuncSetAttribute((const void*)mk_fwd, hipFuncAttributeMaxDynamicSharedMemorySize, LDS_BYTES) != hipSuccess) { fprintf(stderr, "kernel_launch: hipFuncSetAttribute failed\n"); grid = -1; return; }
        if (hipOccupancyMaxActiveBlocksPerMultiprocessor(&per_cu, (const void*)mk_fwd, 512, LDS_BYTES) != hipSuccess || per_cu < 1) fprintf(stderr, "kernel_launch: occupancy query reports %d\n", per_cu);
        (void)hipGetLastError();
        grid = cus;
    }
    if (grid < 0) return;
    (void)hipMemsetAsync((char*)d_ws + WS_CTL, 0, CTL_BYTES, stream);
    Args a{};
    for (int i = 0; i < 21; ++i) a.in[i] = (const float*)d_in[i];
    a.out = (float*)d_out; a.ws = (unsigned char*)d_ws;
#if MK_PER_PHASE
    for (int p = 0; p < NPH; ++p) { a.lo = p; a.hi = p + 1; hipLaunchKernelGGL(mk_fwd, dim3(grid), dim3(512), LDS_BYTES, stream, a); }
#else
    a.lo = 0; a.hi = NPH; hipLaunchKernelGGL(mk_fwd, dim3(grid), dim3(512), LDS_BYTES, stream, a);
#endif
}
```

```cpp
#include <hip/hip_runtime.h>
#include <cstdio>
#include <cstdint>
#include <type_traits>

#ifndef MK_PER_PHASE
#define MK_PER_PHASE 0
#endif

#define LAS __attribute__((address_space(3)))
typedef unsigned short bf16_t;
typedef short bf16x8 __attribute__((ext_vector_type(8)));
typedef short s16x4 __attribute__((ext_vector_type(4)));
typedef float f32x4 __attribute__((ext_vector_type(4)));
typedef float f32x2 __attribute__((ext_vector_type(2)));
typedef unsigned u32x4 __attribute__((ext_vector_type(4)));
typedef unsigned u32x2 __attribute__((ext_vector_type(2)));

constexpr int D = 1024, NB = 32, SEQ = 2048, CTXL = 256;
constexpr int NL = NB * SEQ;
constexpr int NCX = NB * CTXL;
constexpr int MT = NL + NCX;
constexpr int PIN = 3600, NPROJ = 3584, NPAD = 3840;
constexpr int NPO = 3072;
constexpr int DFF = 2816, NE = 8;
constexpr float EPS = 1e-6f;
constexpr int PROBE_P0SKIP = 0;
constexpr int PROBE_MLSKIP = 0;
constexpr bool PROBE_DRY = false;
constexpr int RT_STRIDE = 65536;
constexpr float S_A = 16.0f, S_W13 = 256.0f, S_H = 8.0f, S_W2 = 256.0f, S_Y = 32.0f;

constexpr size_t WS_CTL = 0;
constexpr size_t CTL_BYTES = 65536;
constexpr size_t CTL_GCNT = 16384;
constexpr size_t WS_MOD = 65536;
constexpr size_t WS_WIN = 2097152;
constexpr size_t WS_WOUT = WS_WIN + (size_t)2 * NPAD * D * 2;
constexpr size_t WS_WUP = WS_WOUT + (size_t)2 * D * D * 2;
constexpr size_t WS_WDN = WS_WUP + (size_t)2 * DFF * D * 2;
constexpr size_t WS_MUP = WS_WDN + (size_t)D * DFF * 2;
constexpr size_t WS_MDN = WS_MUP + (size_t)NE * 2 * DFF * D * 2;
constexpr size_t WS_HC = WS_MDN + (size_t)NE * D * DFF * 2;
constexpr size_t WS_U = WS_HC + (size_t)NCX * D * 4;
constexpr size_t WS_PROJ = WS_U + (size_t)MT * D * 2;
constexpr size_t WS_GATES = WS_PROJ + (size_t)MT * NPROJ * 2;
constexpr size_t WS_HL = WS_GATES + (size_t)MT * 16 * 4;
constexpr size_t WS_HB = WS_HL;
constexpr size_t WS_Y1 = WS_PROJ + (size_t)368 * 1048576;
static_assert(WS_Y1 + (size_t)NL * D * 2 <= WS_GATES && (size_t)528 * 256 * DFF <= (size_t)368 * 1048576, "Y1 placement");
constexpr size_t WS_RTOK = WS_HL + (size_t)2 * MT * 512 * 2;
constexpr size_t WS_RGATE = WS_RTOK + (size_t)16 * RT_STRIDE * 4;
constexpr size_t WS_END = WS_RGATE + (size_t)16 * RT_STRIDE * 4;

constexpr int LDS_BYTES = 163840;
constexpr int MISC_OFF = 161792;

__device__ __forceinline__ unsigned cvt_pk_bf16(float lo, float hi) { unsigned r; asm volatile("v_cvt_pk_bf16_f32 %0, %1, %2" : "=v"(r) : "v"(lo), "v"(hi)); return r; }
__device__ __forceinline__ float bf2f(unsigned short b) { return __uint_as_float(((unsigned)b) << 16); }
__device__ __forceinline__ float bflo(unsigned w) { return __uint_as_float(w << 16); }
__device__ __forceinline__ float bfhi(unsigned w) { return __uint_as_float(w & 0xffff0000u); }
__device__ __forceinline__ float wave_sum(float v) {
#pragma unroll
    for (int o = 32; o >= 1; o >>= 1) v += __shfl_xor(v, o);
    return v;
}
__device__ __forceinline__ int lane_id() { int l; asm volatile("v_mbcnt_lo_u32_b32 %0, -1, 0\n\tv_mbcnt_hi_u32_b32 %0, -1, %0" : "=v"(l)); return l; }
template <int CTRL, int RM> __device__ __forceinline__ float dppf(float ident, float v) {
    return __builtin_bit_cast(float, __builtin_amdgcn_update_dpp(__builtin_bit_cast(int, ident), __builtin_bit_cast(int, v), CTRL, RM, 0xf, false)); }
__device__ __forceinline__ float wave_scan_add(float v) {
    v += dppf<0x111, 0xf>(0.f, v); v += dppf<0x112, 0xf>(0.f, v); v += dppf<0x114, 0xf>(0.f, v); v += dppf<0x118, 0xf>(0.f, v);
    v += dppf<0x142, 0xa>(0.f, v); v += dppf<0x143, 0xc>(0.f, v); return v; }
__device__ __forceinline__ float wave_scan_max(float v) {
    v = fmaxf(v, dppf<0x111, 0xf>(-3.0e38f, v)); v = fmaxf(v, dppf<0x112, 0xf>(-3.0e38f, v)); v = fmaxf(v, dppf<0x114, 0xf>(-3.0e38f, v)); v = fmaxf(v, dppf<0x118, 0xf>(-3.0e38f, v));
    v = fmaxf(v, dppf<0x142, 0xa>(-3.0e38f, v)); v = fmaxf(v, dppf<0x143, 0xc>(-3.0e38f, v)); return v; }
__device__ __forceinline__ float sigmoidf_(float x) { return 1.0f / (1.0f + __expf(-x)); }

#define XB_TMO      128
#define XB_XCNT(j)  (256  + 64 * (j))
#define XB_XSUB(j)  (1280 + 64 * (j))
#define XB_XGEN(j)  (2304 + 64 * (j))
#define XB_TOP      3328
#define XB_TOPGEN   3392
#define XCD_BAR_WORDS 3456
#define XB_SPIN_CAP (1u << 18)

__device__ __forceinline__ unsigned xb_ld(unsigned* p)              { return __hip_atomic_load(p, __ATOMIC_RELAXED, __HIP_MEMORY_SCOPE_AGENT); }
__device__ __forceinline__ unsigned xb_add(unsigned* p, unsigned v) { return __hip_atomic_fetch_add(p, v, __ATOMIC_RELAXED, __HIP_MEMORY_SCOPE_AGENT); }
__device__ __forceinline__ unsigned xb_xcc_id() { return (unsigned)__builtin_amdgcn_s_getreg((3 << 11) | 20) & 0xFu; }
#define XB_SPIN(cond, bar) do { unsigned _sp = 0; while (cond) { __builtin_amdgcn_s_sleep(1); \
    if ((++_sp & 255u) == 0u) { if (xb_ld(&(bar)[XB_TMO])) break; if (_sp > XB_SPIN_CAP) { atomicAdd(&(bar)[XB_TMO], 1u); break; } } } } while (0)

struct XcdBarrier {
    unsigned* bar; unsigned x;
    volatile LAS unsigned* st;
    int wid;
};
#define XB_THREAD0(b) ((b).wid == 0 && lane_id() == 0)
__device__ __forceinline__ XcdBarrier xcd_barrier_post(unsigned* bar, volatile LAS unsigned* st, int wid) {
    XcdBarrier b; b.bar = bar; b.x = xb_xcc_id(); b.st = st; b.wid = wid;
    if (XB_THREAD0(b)) (void)xb_add(&bar[XB_XCNT(b.x)], 1u);
    return b;
}
__device__ __forceinline__ void xcd_barrier_complete(unsigned* bar, unsigned x, unsigned& nloc, unsigned& nx) {
    const unsigned G = gridDim.x * gridDim.y * gridDim.z;
    unsigned sum, cnt, mine, sp = 0u;
    for (;;) {
        sum = 0u; cnt = 0u; mine = 0u;
#pragma unroll
        for (unsigned j = 0; j < 16; ++j) { const unsigned c = xb_ld(&bar[XB_XCNT(j)]); sum += c; cnt += (c > 0u) ? 1u : 0u; mine = (j == x) ? c : mine; }
        if (sum == G) break;
        __builtin_amdgcn_s_sleep(1);
        if ((++sp & 255u) == 0u) { if (xb_ld(&bar[XB_TMO])) break; if (sp > XB_SPIN_CAP) { atomicAdd(&bar[XB_TMO], 1u); break; } }
    }
    nloc = mine > 0u ? mine : 1u; nx = cnt > 0u ? cnt : 1u;
}
__device__ __forceinline__ void xcd_barrier(const XcdBarrier& b) {
    asm volatile("s_waitcnt vmcnt(0)" ::: "memory");
    __syncthreads();
    if (XB_THREAD0(b)) {
        unsigned* bar = b.bar;
        __builtin_amdgcn_s_waitcnt(0);
        unsigned nloc = b.st[0], nx = b.st[1];
        if (nloc == 0u) { xcd_barrier_complete(bar, b.x, nloc, nx); b.st[0] = nloc; b.st[1] = nx; }
        const unsigned old = xb_add(&bar[XB_XSUB(b.x)], 1u);
        const unsigned gen = old / nloc;
        if (old + 1u == (gen + 1u) * nloc) {
            __builtin_amdgcn_fence(__ATOMIC_RELEASE, "agent");
            asm volatile("s_waitcnt vmcnt(0)" ::: "memory");
            const unsigned og = xb_add(&bar[XB_TOP], 1u);
            const unsigned tg = og / nx;
            if (og + 1u == (tg + 1u) * nx) xb_add(&bar[XB_TOPGEN], 1u);
            else XB_SPIN(xb_ld(&bar[XB_TOPGEN]) == tg, bar);
            __builtin_amdgcn_fence(__ATOMIC_ACQUIRE, "agent");
            xb_add(&bar[XB_XGEN(b.x)], 1u);
            asm volatile("s_waitcnt vmcnt(0)" ::: "memory");
        } else {
            XB_SPIN(xb_ld(&bar[XB_XGEN(b.x)]) == gen, bar);
            __builtin_amdgcn_fence(__ATOMIC_ACQUIRE, "agent");
            asm volatile("s_waitcnt vmcnt(0)" ::: "memory");
        }
    }
    __syncthreads();
}

namespace pg8 {
constexpr int BM = 256, BK = 64, HALF = 128, HTB = HALF * BK * 2, STAGE_BYTES = 8 * HTB, NXCD = 8, WGM = 4;
__device__ __forceinline__ int lds_byte(int r, int c) { const int st = (r >> 4) * 2 + (c >> 5), rr = r & 15, cc = c & 31, ob = rr * 64 + cc * 2; return st * 1024 + (ob ^ (((ob >> 9) & 1) << 5)); }
__device__ __forceinline__ void stage_rc(int b, int& R, int& C) { const int st = b / 1024, sb = b % 1024, swz = sb ^ (((sb >> 9) & 1) << 5); R = (st >> 1) * 16 + swz / 64; C = (st & 1) * 32 + (swz % 64) / 2; }
__device__ __forceinline__ int perm32(int rho) { const int n = rho >> 4, i = rho & 15; return 8 * (i >> 2) + 4 * n + (i & 3); }

struct Unit { int pm, pn; unsigned B; int g; int par; };

__device__ __forceinline__ void tile_map(int L, int nM, int nN, int& pm, int& pn, const int WGM = pg8::WGM) {
    const int nwg = nM * nN; int wgid = L;
    { const int q = nwg / NXCD, r = nwg % NXCD, xcd = wgid % NXCD, off = wgid / NXCD; wgid = (xcd < r ? xcd * (q + 1) : r * (q + 1) + (xcd - r) * q) + off; }
    const int nig = WGM * nN, gid = wgid / nig, fm = gid * WGM, gsz = (nM - fm) < WGM ? (nM - fm) : WGM;
    pm = fm + ((wgid % nig) % gsz); pn = (wgid % nig) / gsz;
}

typedef int i32x8 __attribute__((ext_vector_type(8)));
template <bool FP8, class Epi, class Sched>
__device__ __forceinline__ void gemm_phase(LAS unsigned char* lds, const int wid, const char* Abase, const char* Bbase, const int KB, const Sched& S, const Epi& E, const int skew_ticks  ) {
    const int lane = lane_id(), tid = wid * 64 + lane, wr = wid >> 2, wc = wid & 3, fr = lane & 15, fq = lane >> 4;
    const int nt = KB / 128;
    int R0, C0; stage_rc(tid * 16, R0, C0);
    unsigned voffB[2];
#pragma unroll
    for (int i = 0; i < 2; ++i) { const int R = R0 + 64 * i; const int Rb = Epi::PERM ? (Epi::WIDE ? ((R >> 5) * 64 + perm32(R & 31)) : ((R & ~31) + perm32(R & 31))) : R; voffB[i] = (unsigned)(Rb * KB + C0 * 2); }
    const unsigned kstep = (unsigned)(BK * 2);
    const unsigned hstep = (unsigned)(HALF * KB);
    const unsigned hstepB = Epi::WIDE ? (unsigned)(32 * KB) : hstep;
    const __amdgpu_buffer_rsrc_t rsA = __builtin_amdgcn_make_buffer_rsrc((void*)Abase, (short)0, 0x7ffff000, 0x00020000);
    const __amdgpu_buffer_rsrc_t rsB = __builtin_amdgcn_make_buffer_rsrc((void*)Bbase, (short)0, 0x7ffff000, 0x00020000);
    const unsigned ldsw = (unsigned)wid * 1024u;
    const int aoff = lds_byte(wr * 64 + fr, fq * 8), boff = lds_byte(wc * 32 + fr, fq * 8);
#define PG8_SA(b, h) (((b) * 2 + (h)) * HTB)
#define PG8_SB(b, h) ((4 + (b) * 2 + (h)) * HTB)
#define PG8_STAGE(bufoff, soff, voff) do { _Pragma("unroll") for (int _i = 0; _i < 2; ++_i) \
        __builtin_amdgcn_raw_ptr_buffer_load_lds(rsB, (LAS unsigned*)(lds + (bufoff) + ldsw + _i * 8192), 16, (int)(voff)[_i], (int)(soff), 0, 0); } while (0)
#define PG8_STAGE_A(bufoff, o0, o1, soff) do { \
        __builtin_amdgcn_raw_ptr_buffer_load_lds(rsA, (LAS unsigned*)(lds + (bufoff) + ldsw), 16, (int)(o0), (int)(soff), 0, 0); \
        __builtin_amdgcn_raw_ptr_buffer_load_lds(rsA, (LAS unsigned*)(lds + (bufoff) + ldsw + 8192), 16, (int)(o1), (int)(soff), 0, 0); } while (0)
#define PG8_LDA(dst, b, h) do { _Pragma("unroll") for (int m = 0; m < 4; ++m) _Pragma("unroll") for (int k = 0; k < 2; ++k) dst[m][k] = *(const LAS bf16x8*)(lds + PG8_SA(b, h) + aoff + m * 2048 + k * 1024); } while (0)
#define PG8_LDB(dst, b, h) do { _Pragma("unroll") for (int n = 0; n < 2; ++n) _Pragma("unroll") for (int k = 0; k < 2; ++k) dst[n][k] = *(const LAS bf16x8*)(lds + PG8_SB(b, h) + boff + n * 2048 + k * 1024); } while (0)
#define PG8_MMA(ai, bj, At, Bt) do { __builtin_amdgcn_s_setprio(1); \
        if constexpr (FP8) { _Pragma("unroll") for (int m = 0; m < 4; ++m) _Pragma("unroll") for (int n = 0; n < 2; ++n) { \
            const u32x4 _b0 = __builtin_bit_cast(u32x4, Bt[n][0]), _b1 = __builtin_bit_cast(u32x4, Bt[n][1]), _a0 = __builtin_bit_cast(u32x4, At[m][0]), _a1 = __builtin_bit_cast(u32x4, At[m][1]); \
            const i32x8 _bb = {(int)_b0.x, (int)_b0.y, (int)_b0.z, (int)_b0.w, (int)_b1.x, (int)_b1.y, (int)_b1.z, (int)_b1.w}, _aa = {(int)_a0.x, (int)_a0.y, (int)_a0.z, (int)_a0.w, (int)_a1.x, (int)_a1.y, (int)_a1.z, (int)_a1.w}; \
            acc[ai][bj][m][n] = __builtin_amdgcn_mfma_scale_f32_16x16x128_f8f6f4(_bb, _aa, acc[ai][bj][m][n], 0, 0, 0, 0, 0, 0); } } \
        else { _Pragma("unroll") for (int m = 0; m < 4; ++m) _Pragma("unroll") for (int n = 0; n < 2; ++n) _Pragma("unroll") for (int k = 0; k < 2; ++k) \
            acc[ai][bj][m][n] = __builtin_amdgcn_mfma_f32_16x16x32_bf16(Bt[n][k], At[m][k], acc[ai][bj][m][n], 0, 0, 0); } \
        __builtin_amdgcn_s_setprio(0); } while (0)
#define PG8_WAIT_V(n) asm volatile("s_waitcnt vmcnt(" #n ")" ::: "memory")
#define PG8_WAIT_L(n) asm volatile("s_waitcnt lgkmcnt(" #n ")" ::: "memory")
#define PG8_BAR __builtin_amdgcn_s_barrier()
#define PG8_SCHED __builtin_amdgcn_sched_barrier(0)
    Unit cur, nxt; int ui = 0;
    if (!S.next(0, cur)) return;
    if (skew_ticks > 0) { const unsigned long long t0 = __builtin_amdgcn_s_memrealtime(); while (__builtin_amdgcn_s_memrealtime() - t0 < (unsigned long long)skew_ticks) __builtin_amdgcn_s_sleep(8); }
    f32x4 acc[2][2][4][2];
#pragma unroll
    for (int a = 0; a < 2; ++a)
#pragma unroll
        for (int b = 0; b < 2; ++b)
#pragma unroll
            for (int m = 0; m < 4; ++m)
#pragma unroll
                for (int n = 0; n < 2; ++n) acc[a][b][m][n] = (f32x4){0.f, 0.f, 0.f, 0.f};
    bf16x8 At[4][2], B0[2][2], B1[2][2];
    unsigned voffA[2]; voffA[0] = (unsigned)(R0 * KB + C0 * 2); voffA[1] = voffA[0] + (unsigned)(64 * KB);
    unsigned oc00 = 0, oc01 = 0, oc10 = 0, oc11 = 0;
    int nvr = -1;
    __amdgpu_buffer_rsrc_t rsT = rsA;
    if constexpr (Sched::GATHER) rsT = __builtin_amdgcn_make_buffer_rsrc((void*)S.tok_base(), (short)0, 16 * RT_STRIDE * 4, 0x00020000);
    unsigned cA = 0, nA = 0;
    if constexpr (Sched::GATHER) { S.aoff(cur, R0, C0, oc00, oc01, oc10, oc11); asm volatile("" : "+v"(oc00), "+v"(oc01), "+v"(oc10), "+v"(oc11)); }
    else cA = S.abase(cur);
    cur.par = 0;
    if constexpr (Sched::UNIT_DMA) { if (wid == 0) S.unit_dma(cur, lds + STAGE_BYTES, lane); }
#define PG8_STA(bufoff, ptr, h, kb) do { if constexpr (Sched::GATHER) { if ((h) == 0) PG8_STAGE_A(bufoff, oc00, oc01, kb); else PG8_STAGE_A(bufoff, oc10, oc11, kb); } \
        else PG8_STAGE_A(bufoff, voffA[0], voffA[1], (ptr) + (unsigned)(h) * hstep + (unsigned)(kb)); } while (0)
    unsigned cB = cur.B;
    PG8_STAGE(PG8_SB(0, 0), cB, voffB); PG8_STA(PG8_SA(0, 0), cA, 0, 0); PG8_STAGE(PG8_SB(0, 1), cB + hstepB, voffB); PG8_STA(PG8_SA(0, 1), cA, 1, 0);
    if (wr == 1) PG8_BAR;
    PG8_WAIT_V(4); PG8_BAR;
    PG8_STAGE(PG8_SB(1, 0), cB + kstep, voffB); PG8_STA(PG8_SA(1, 0), cA, 0, kstep); PG8_STAGE(PG8_SB(1, 1), cB + hstepB + kstep, voffB);
    PG8_WAIT_V(6); PG8_BAR;
    for (;;) {
        const bool has_next = S.next(ui + 1, nxt); nxt.par = (ui + 1) & 1;
        if constexpr (Sched::GATHER) {
            nvr = has_next ? S.valid_rows(nxt) : -1;
            if (has_next && wid == 0) __builtin_amdgcn_raw_ptr_buffer_load_lds(rsT, (LAS unsigned*)(lds + STAGE_BYTES), 16, lane * 16, (int)S.tokoff(nxt), 0, 0);
        } else nA = has_next ? S.abase(nxt) : cA;
        const unsigned nB = has_next ? nxt.B : cB;
#pragma unroll 1
        for (int t = 0; t < nt; t += 2) {
            const bool last = (t == nt - 2);
            const unsigned k1 = (unsigned)(t + 1) * kstep;
            const unsigned k2 = last ? 0u : (unsigned)(t + 2) * kstep; const unsigned k3 = k2 + kstep;
            const unsigned a2 = last ? nA : cA;
            const unsigned b2 = last ? nB : cB + (unsigned)(t + 2) * kstep; const unsigned b3 = b2 + kstep;
            PG8_LDB(B0, 0, 0); PG8_SCHED; PG8_LDA(At, 0, 0); PG8_STA(PG8_SA(1, 1), cA, 1, k1);
            PG8_WAIT_L(8); PG8_BAR; PG8_WAIT_L(0); PG8_MMA(0, 0, At, B0); PG8_BAR; PG8_SCHED;
            if constexpr (Sched::UNIT_DMA) { if (t == 0 && has_next && wid == 0) S.unit_dma(nxt, lds + STAGE_BYTES, lane); }
            if constexpr (Sched::GATHER) { if (last && nvr >= 0) { const LAS int* lt = (const LAS int*)(lds + STAGE_BYTES);
                const int t00 = R0 < nvr ? lt[R0] : 0, t01 = R0 + 64 < nvr ? lt[R0 + 64] : 0, t10 = R0 + 128 < nvr ? lt[R0 + 128] : 0, t11 = R0 + 192 < nvr ? lt[R0 + 192] : 0;
                oc00 = (unsigned)(t00 * KB + C0 * 2); oc01 = (unsigned)(t01 * KB + C0 * 2); oc10 = (unsigned)(t10 * KB + C0 * 2); oc11 = (unsigned)(t11 * KB + C0 * 2); } }
            PG8_LDB(B1, 0, 1); PG8_STAGE(PG8_SB(0, 0), b2, voffB);
            PG8_BAR; PG8_WAIT_L(0); PG8_MMA(0, 1, At, B1); PG8_BAR;
            PG8_LDA(At, 0, 1); PG8_STA(PG8_SA(0, 0), a2, 0, k2);
            PG8_BAR; PG8_WAIT_L(0); PG8_MMA(1, 0, At, B0); PG8_BAR; PG8_SCHED;
            PG8_STAGE(PG8_SB(0, 1), b2 + hstepB, voffB);
            PG8_WAIT_V(6); PG8_BAR; PG8_MMA(1, 1, At, B1); PG8_BAR;
            PG8_LDB(B0, 1, 0); PG8_SCHED; PG8_LDA(At, 1, 0); PG8_STA(PG8_SA(0, 1), a2, 1, k2);
            PG8_WAIT_L(8); PG8_BAR; PG8_WAIT_L(0); PG8_MMA(0, 0, At, B0); PG8_BAR; PG8_SCHED;
            PG8_LDB(B1, 1, 1); PG8_STAGE(PG8_SB(1, 0), b3, voffB);
            PG8_BAR; PG8_WAIT_L(0); PG8_MMA(0, 1, At, B1); PG8_BAR;
            PG8_LDA(At, 1, 1); PG8_STA(PG8_SA(1, 0), a2, 0, k3);
            PG8_BAR; PG8_WAIT_L(0); PG8_MMA(1, 0, At, B0); PG8_BAR; PG8_SCHED;
            PG8_STAGE(PG8_SB(1, 1), b3 + hstepB, voffB);
            PG8_WAIT_V(6); PG8_BAR; PG8_MMA(1, 1, At, B1); PG8_BAR;
        }
        { const int _l = lane_id(); const int _fr = _l & 15, _fq = _l >> 4;
          E(acc, cur, wr, wc, _fr, _fq); }
        if (!has_next) break;
#pragma unroll
        for (int a = 0; a < 2; ++a)
#pragma unroll
            for (int b = 0; b < 2; ++b)
#pragma unroll
                for (int m = 0; m < 4; ++m)
#pragma unroll
                    for (int n = 0; n < 2; ++n) acc[a][b][m][n] = (f32x4){0.f, 0.f, 0.f, 0.f};
        cur = nxt; cB = nB; cA = nA; ++ui;
    }
    PG8_WAIT_V(0);
    if (wr == 0) PG8_BAR;
    PG8_BAR;
#undef PG8_SA
#undef PG8_SB
#undef PG8_STAGE
#undef PG8_STAGE_A
#undef PG8_STA
#undef PG8_LDA
#undef PG8_LDB
#undef PG8_MMA
#undef PG8_WAIT_V
#undef PG8_WAIT_L
#undef PG8_BAR
#undef PG8_SCHED
}

struct DenseSched {
    static constexpr bool GATHER = false, UNIT_DMA = false;
    int nM, nN, G, c, KB, wgm;
    __device__ __forceinline__ unsigned abase(const Unit& u) const { return (unsigned)(u.pm * 256 * KB); }
    __device__ __forceinline__ bool next(int i, Unit& u) const {
        const long L = (long)i * G + c; if (L >= (long)nM * nN) return false;
        tile_map((int)L, nM, nN, u.pm, u.pn, wgm); u.B = (unsigned)(u.pn * 256 * KB); u.g = 0; return true;
    }
    __device__ __forceinline__ void aoff(const Unit& u, int R0, int C0, unsigned& o00, unsigned& o01, unsigned& o10, unsigned& o11) const {
        const unsigned base = (unsigned)((u.pm * 256 + R0) * KB + C0 * 2), r64 = (unsigned)(64 * KB);
        o00 = base; o01 = base + r64; o10 = base + 2u * r64; o11 = base + 3u * r64;
    }
};
struct InProjL1Sched {
    static constexpr bool GATHER = false, UNIT_DMA = false;
    int G, c;
    __device__ __forceinline__ unsigned abase(const Unit& u) const { return (unsigned)(u.pm * 256 * D * 2); }
    __device__ __forceinline__ bool next(int i, Unit& u) const {
        const int L = i * G + c; if (L >= 3584 + 192) return false;
        if (L < 3584) tile_map(L, 256, 14, u.pm, u.pn);
        else { const int Lc = L - 3584; u.pm = 256 + Lc / 6; u.pn = 6 + Lc % 6; }
        u.B = (unsigned)(u.pn * 256 * D * 2); u.g = 0; return true;
    }
    __device__ __forceinline__ void aoff(const Unit& u, int R0, int C0, unsigned& o00, unsigned& o01, unsigned& o10, unsigned& o11) const {
        const unsigned base = (unsigned)((u.pm * 256 + R0) * D + C0) * 2u, r64 = (unsigned)(64 * D) * 2u;
        o00 = base; o01 = base + r64; o10 = base + 2u * r64; o11 = base + 3u * r64;
    }
};
struct MoeUpSched {
    static constexpr bool GATHER = true, UNIT_DMA = false;
    int G, c; const int* rowtok; const volatile LAS int* tb;
    __device__ __forceinline__ unsigned abase(const Unit&) const { return 0u; }
    __device__ __forceinline__ bool next(int i, Unit& u) const {
        const int T = tb[16]; const int L = i * G + c; if (L >= T * 22) return false;
        tile_map(L, T, 22, u.pm, u.pn, 8); int g = 0;
#pragma unroll
        for (int j = 1; j < 16; ++j) g += (u.pm >= tb[j]) ? 1 : 0;
        u.g = g; u.B = (unsigned)(((g & 7) * 5632 + u.pn * 256) * D); return true;
    }
    __device__ __forceinline__ const int* tok_base() const { return rowtok; }
    __device__ __forceinline__ unsigned tokoff(const Unit& u) const { return (unsigned)((u.g * RT_STRIDE + (u.pm - tb[u.g]) * 256) * 4); }
    __device__ __forceinline__ int valid_rows(const Unit& u) const { return tb[32 + u.g] - (u.pm - tb[u.g]) * 256; }
    __device__ __forceinline__ void aoff(const Unit& u, int R0, int C0, unsigned& o00, unsigned& o01, unsigned& o10, unsigned& o11) const {
        const int s0 = (u.pm - tb[u.g]) * 256 + R0, cnt = tb[32 + u.g]; const int* rt = rowtok + (size_t)u.g * RT_STRIDE;
        const int t00 = s0 < cnt ? rt[s0] : 0, t01 = s0 + 64 < cnt ? rt[s0 + 64] : 0, t10 = s0 + 128 < cnt ? rt[s0 + 128] : 0, t11 = s0 + 192 < cnt ? rt[s0 + 192] : 0;
        o00 = (unsigned)(t00 * D + C0 * 2); o01 = (unsigned)(t01 * D + C0 * 2); o10 = (unsigned)(t10 * D + C0 * 2); o11 = (unsigned)(t11 * D + C0 * 2);
    }
};
struct MoeDownSched {
    static constexpr bool GATHER = false, UNIT_DMA = true;
    int G, c; const volatile LAS int* tb; const int* rowtok; const float* rowgate;
    __device__ __forceinline__ unsigned abase(const Unit& u) const { return (unsigned)(u.pm * 256 * DFF); }
    __device__ __forceinline__ void unit_dma(const Unit& u, LAS unsigned char* side, int lane) const {
        const __amdgpu_buffer_rsrc_t rt = __builtin_amdgcn_make_buffer_rsrc((void*)rowtok, (short)0, 16 * RT_STRIDE * 4, 0x00020000);
        const __amdgpu_buffer_rsrc_t rg = __builtin_amdgcn_make_buffer_rsrc((void*)rowgate, (short)0, 16 * RT_STRIDE * 4, 0x00020000);
        const int off = (u.g * RT_STRIDE + (u.pm - tb[u.g]) * 256) * 4;
        __builtin_amdgcn_raw_ptr_buffer_load_lds(rt, (LAS unsigned*)(side + u.par * 2048), 16, lane * 16, off, 0, 0);
        __builtin_amdgcn_raw_ptr_buffer_load_lds(rg, (LAS unsigned*)(side + u.par * 2048 + 1024), 16, lane * 16, off, 0, 0);
    }
    __device__ __forceinline__ bool next(int i, Unit& u) const {
        const int T = tb[16]; const int L = i * G + c; if (L >= T * 4) return false;
        tile_map(L, T, 4, u.pm, u.pn); int g = 0;
#pragma unroll
        for (int j = 1; j < 16; ++j) g += (u.pm >= tb[j]) ? 1 : 0;
        u.g = g; u.B = (unsigned)(((g & 7) * D + u.pn * 256) * DFF); return true;
    }
};

struct EpiProj {
    static constexpr bool PERM = true, WIDE = true;
    bf16_t* P; bool dry;
    __device__ __forceinline__ void operator()(const f32x4 (&acc)[2][2][4][2], const Unit& u, int wr, int wc, int fr, int fq) const {
        if (dry) {
#pragma unroll
            for (int ai = 0; ai < 2; ++ai)
#pragma unroll
                for (int bj = 0; bj < 2; ++bj)
#pragma unroll
                    for (int m = 0; m < 4; ++m) asm volatile("" :: "v"(acc[ai][bj][m][0]), "v"(acc[ai][bj][m][1]));
            return; }
        const int row0 = u.pm * BM + wr * 64 + fr;
        if (u.pn >= 2 && u.pn < 6) {
            const int col0 = 512 + (u.pn - 2) * HALF + wc * 32 + 8 * fq;
#pragma unroll
            for (int ai = 0; ai < 2; ++ai)
#pragma unroll
                for (int m = 0; m < 4; ++m) { const f32x4 z0 = acc[ai][0][m][0] * acc[ai][1][m][0], z1 = acc[ai][0][m][1] * acc[ai][1][m][1];
                    u32x4 w; w.x = cvt_pk_bf16(z0[0], z0[1]); w.y = cvt_pk_bf16(z0[2], z0[3]); w.z = cvt_pk_bf16(z1[0], z1[1]); w.w = cvt_pk_bf16(z1[2], z1[3]);
                    *(u32x4*)(P + (size_t)(row0 + ai * HALF + m * 16) * NPO + col0) = w; }
            return; }
        const int colb = (u.pn < 2 ? u.pn * BM : u.pn * BM - 512) + wc * 64 + (fr < 8 ? 0 : 32) + 8 * fq; const bool lo = fr < 8;
#pragma unroll
        for (int ai = 0; ai < 2; ++ai)
#pragma unroll
            for (int m = 0; m < 4; ++m) { u32x4 a, b;
                { const f32x4 v0 = acc[ai][0][m][0], v1 = acc[ai][0][m][1]; a.x = cvt_pk_bf16(v0[0], v0[1]); a.y = cvt_pk_bf16(v0[2], v0[3]); a.z = cvt_pk_bf16(v1[0], v1[1]); a.w = cvt_pk_bf16(v1[2], v1[3]); }
                { const f32x4 v0 = acc[ai][1][m][0], v1 = acc[ai][1][m][1]; b.x = cvt_pk_bf16(v0[0], v0[1]); b.y = cvt_pk_bf16(v0[2], v0[3]); b.z = cvt_pk_bf16(v1[0], v1[1]); b.w = cvt_pk_bf16(v1[2], v1[3]); }
                u32x4 x = lo ? b : a, y;
                y.x = (unsigned)__builtin_amdgcn_update_dpp(0, (int)x.x, 0x128, 0xf, 0xf, false); y.y = (unsigned)__builtin_amdgcn_update_dpp(0, (int)x.y, 0x128, 0xf, 0xf, false);
                y.z = (unsigned)__builtin_amdgcn_update_dpp(0, (int)x.z, 0x128, 0xf, 0xf, false); y.w = (unsigned)__builtin_amdgcn_update_dpp(0, (int)x.w, 0x128, 0xf, 0xf, false);
                const u32x4 first = lo ? a : y, second = lo ? y : b;
                bf16_t* rowp = P + (size_t)(u.pm * BM + wr * 64 + ai * HALF + m * 16 + (fr & 7)) * NPO + colb;
                *(u32x4*)rowp = first; *(u32x4*)(rowp + (size_t)8 * NPO) = second; }
    }
};
struct EpiResid {
    static constexpr bool PERM = true, WIDE = true;
    bf16_t* HB; const float* gate; float gscale;
    __device__ __forceinline__ void operator()(const f32x4 (&acc)[2][2][4][2], const Unit& u, int wr, int wc, int fr, int fq) const {
        if (PROBE_DRY && gscale == 0.f) {
#pragma unroll
            for (int ai = 0; ai < 2; ++ai)
#pragma unroll
                for (int bj = 0; bj < 2; ++bj)
#pragma unroll
                    for (int m = 0; m < 4; ++m) asm volatile("" :: "v"(acc[ai][bj][m][0]), "v"(acc[ai][bj][m][1]));
            return; }
        const int rowg = u.pm * BM; const bool isc = rowg >= NL;
        const int bidx = isc ? 32 : (rowg >> 11);
        const bool lo = fr < 8;
        const int colw = u.pn * BM + wc * 64 + 8 * fq;
        const float* gv = gate + (size_t)bidx * 6144 + colw;
        bf16_t* out = HB + (size_t)(rowg + wr * 64 + (fr & 7)) * D + colw + (lo ? 0 : 32);
        u32x4 r[2][4][2];
#pragma unroll
        for (int ai = 0; ai < 2; ++ai)
#pragma unroll
            for (int m = 0; m < 4; ++m)
#pragma unroll
                for (int h = 0; h < 2; ++h) r[ai][m][h] = *(const u32x4*)(out + (size_t)(ai * HALF + m * 16 + 8 * h) * D);
        f32x4 g[2][2];
#pragma unroll
        for (int bj = 0; bj < 2; ++bj)
#pragma unroll
            for (int n = 0; n < 2; ++n) g[bj][n] = *(const f32x4*)(gv + bj * 32 + n * 4) * gscale;
#pragma unroll
        for (int ai = 0; ai < 2; ++ai)
#pragma unroll
            for (int m = 0; m < 4; ++m) {
                const f32x4 a0 = g[0][0] * acc[ai][0][m][0], a1 = g[0][1] * acc[ai][0][m][1], b0 = g[1][0] * acc[ai][1][m][0], b1 = g[1][1] * acc[ai][1][m][1];
                float x[8], y[8];
#pragma unroll
                for (int i = 0; i < 4; ++i) { x[i] = lo ? b0[i] : a0[i]; x[4 + i] = lo ? b1[i] : a1[i]; }
#pragma unroll
                for (int i = 0; i < 8; ++i) y[i] = __builtin_bit_cast(float, __builtin_amdgcn_update_dpp(0, __builtin_bit_cast(int, x[i]), 0x128, 0xf, 0xf, false));
                float f[8], s2[8];
#pragma unroll
                for (int i = 0; i < 4; ++i) { f[i] = lo ? a0[i] : y[i]; f[4 + i] = lo ? a1[i] : y[4 + i]; s2[i] = lo ? y[i] : b0[i]; s2[4 + i] = lo ? y[4 + i] : b1[i]; }
#pragma unroll
                for (int h = 0; h < 2; ++h) { const u32x4 rr = r[ai][m][h]; const float* v = h ? s2 : f;
                    u32x4 w; w.x = cvt_pk_bf16(bflo(rr.x) + v[0], bfhi(rr.x) + v[1]); w.y = cvt_pk_bf16(bflo(rr.y) + v[2], bfhi(rr.y) + v[3]);
                    w.z = cvt_pk_bf16(bflo(rr.z) + v[4], bfhi(rr.z) + v[5]); w.w = cvt_pk_bf16(bflo(rr.w) + v[6], bfhi(rr.w) + v[7]);
                    *(u32x4*)(out + (size_t)(ai * HALF + m * 16 + 8 * h) * D) = w; } }
    }
};
__device__ __forceinline__ float clamp448(float x) { return fminf(fmaxf(x, -448.0f), 448.0f); }
struct EpiSwiglu {
    static constexpr bool PERM = true, WIDE = false;
    unsigned char* ACT; float iscale, oscale;
    __device__ __forceinline__ void operator()(const f32x4 (&acc)[2][2][4][2], const Unit& u, int wr, int wc, int fr, int fq) const {
        if (PROBE_DRY && oscale == 0.f) {
#pragma unroll
            for (int ai = 0; ai < 2; ++ai)
#pragma unroll
                for (int bj = 0; bj < 2; ++bj)
#pragma unroll
                    for (int m = 0; m < 4; ++m) asm volatile("" :: "v"(acc[ai][bj][m][0]), "v"(acc[ai][bj][m][1]));
            return; }
        const int row0 = u.pm * BM + wr * 64 + fr, col0 = u.pn * HALF + wc * 32 + 8 * fq;
        const float c1 = -1.4426950408889634f * iscale, kk = oscale == 0.f ? 1.0e30f : 1.0f / (iscale * iscale * oscale);
#pragma unroll
        for (int ai = 0; ai < 2; ++ai)
#pragma unroll
            for (int m = 0; m < 4; ++m) { unsigned char* rowp = ACT + (size_t)(row0 + ai * HALF + m * 16) * DFF + col0;
                float o[8];
#pragma unroll
                for (int n = 0; n < 2; ++n)
#pragma unroll
                    for (int h2 = 0; h2 < 2; ++h2) {
                        const f32x2 a = {acc[ai][0][m][n][2 * h2], acc[ai][0][m][n][2 * h2 + 1]}, b = {acc[ai][1][m][n][2 * h2], acc[ai][1][m][n][2 * h2 + 1]};
                        const f32x2 t = a * c1; f32x2 e; e.x = __builtin_amdgcn_exp2f(t.x); e.y = __builtin_amdgcn_exp2f(t.y);
                        const f32x2 d = e * kk + kk; f32x2 r; r.x = __builtin_amdgcn_rcpf(d.x); r.y = __builtin_amdgcn_rcpf(d.y);
                        const f32x2 p = (a * b) * r;
                        o[n * 4 + 2 * h2] = __builtin_amdgcn_fmed3f(p.x, -448.0f, 448.0f); o[n * 4 + 2 * h2 + 1] = __builtin_amdgcn_fmed3f(p.y, -448.0f, 448.0f); }
                int w0 = 0, w1 = 0;
                w0 = __builtin_amdgcn_cvt_pk_fp8_f32(o[0], o[1], w0, false); w0 = __builtin_amdgcn_cvt_pk_fp8_f32(o[2], o[3], w0, true);
                w1 = __builtin_amdgcn_cvt_pk_fp8_f32(o[4], o[5], w1, false); w1 = __builtin_amdgcn_cvt_pk_fp8_f32(o[6], o[7], w1, true);
                *(u32x2*)rowp = (u32x2){(unsigned)w0, (unsigned)w1}; }
    }
};
struct EpiMoeDown {
    static constexpr bool PERM = true, WIDE = false;
    unsigned char* Y0; unsigned char* Y1; const LAS unsigned char* side; const volatile LAS int* tb; float gscale;
    __device__ __forceinline__ void operator()(const f32x4 (&acc)[2][2][4][2], const Unit& u, int wr, int wc, int fr, int fq) const {
        const int nv = tb[32 + u.g] - (u.pm - tb[u.g]) * 256;
        const LAS int* lt = (const LAS int*)(side + u.par * 2048); const LAS float* lg = (const LAS float*)(side + u.par * 2048 + 1024);
        unsigned char* Y = u.g < 8 ? Y0 : Y1;
        const int col0 = u.pn * BM + wc * 32 + 8 * fq;
        int tok[2][4]; float gt[2][4]; bool ok[2][4];
#pragma unroll
        for (int ai = 0; ai < 2; ++ai)
#pragma unroll
            for (int m = 0; m < 4; ++m) { const int rl = ai * HALF + wr * 64 + m * 16 + fr; ok[ai][m] = rl < nv; const int tk = lt[rl]; const float gg = lg[rl]; tok[ai][m] = ok[ai][m] ? tk : 0; gt[ai][m] = ok[ai][m] ? gg * gscale : 0.f; }
#pragma unroll
        for (int ai = 0; ai < 2; ++ai)
#pragma unroll
            for (int m = 0; m < 4; ++m) if (ok[ai][m]) { unsigned char* yp = Y + (size_t)tok[ai][m] * D + col0; const float gg = gt[ai][m];
#pragma unroll
                for (int bj = 0; bj < 2; ++bj) { const f32x4 a0 = acc[ai][bj][m][0] * gg, a1 = acc[ai][bj][m][1] * gg; int w0 = 0, w1 = 0;
                    w0 = __builtin_amdgcn_cvt_pk_fp8_f32(clamp448(a0[0]), clamp448(a0[1]), w0, false); w0 = __builtin_amdgcn_cvt_pk_fp8_f32(clamp448(a0[2]), clamp448(a0[3]), w0, true);
                    w1 = __builtin_amdgcn_cvt_pk_fp8_f32(clamp448(a1[0]), clamp448(a1[1]), w1, false); w1 = __builtin_amdgcn_cvt_pk_fp8_f32(clamp448(a1[2]), clamp448(a1[3]), w1, true);
                    *(u32x2*)(yp + bj * HALF) = (u32x2){(unsigned)w0, (unsigned)w1}; } }
    }
};
}

struct Args { const float* in[21]; float* out; unsigned char* ws; int lo, hi; };
enum { I_X = 0, I_C, I_CTX, I_CCTX, I_N1G, I_N2G, I_WADA, I_BADA, I_WIN, I_CONVW, I_BG, I_MNG, I_WOUT, I_FW1, I_FW3, I_FW2, I_ROUTER, I_MW1, I_MW3, I_MW2, I_FNG };

struct Frame { LAS unsigned char* lds; int wid, G, wg;
    __device__ __forceinline__ int lane() const { return lane_id(); }
    __device__ __forceinline__ int tid() const { return wid * 64 + lane_id(); } };
typedef const __attribute__((address_space(4))) Args* KArgs;
#define KA() ({ KArgs _k = (KArgs)__builtin_amdgcn_kernarg_segment_ptr(); asm volatile("" : "+s"(_k)); _k; })

__device__ __forceinline__ int conv_row(int mode, int n, float& scale) {
    scale = 1.f;
    if (mode == 0) return n;
    if (mode == 1) { if (n >= 2048 && n < 2560) scale = 0.08838834764831845f;
        if (n >= 512 && n < 1024) { const int j = n - 512; return (2 + (j >> 7)) * 256 + ((j & 127) >> 5) * 64 + (j & 31); }
        if (n >= 1024 && n < 1536) { const int j = n - 1024; return (2 + (j >> 7)) * 256 + ((j & 127) >> 5) * 64 + 32 + (j & 31); }
        if (n < 3072) return n; if (n < 3088) return 3584 + (n - 3072); return n - 16; }
    return (n >> 7) * 256 + (n & 127) + (mode == 3 ? 128 : 0);
}
__device__ __forceinline__ void conv_tiles(const Frame& F, const float* src, bf16_t* dst, int K, int N, int mode, float fp8scale  , int& gbase) {
    const int lane = F.lane();
    LAS float* tile = (LAS float*)(F.lds + F.wid * (64 * 65 * 4 + 64));
    const int GW = F.G * 8, gw = F.wg * 8 + F.wid;
    const int tn = (N + 63) / 64, ntile = (K / 64) * tn;
    int t = (gw - gbase) % GW; if (t < 0) t += GW;
    const int row = lane >> 4, c4 = (lane & 15) * 4;
    for (; t < ntile; t += GW) {
        const int k0 = (t / tn) * 64, n0 = (t % tn) * 64;
        f32x4 v[16];
#pragma unroll
        for (int i = 0; i < 16; ++i) { v[i] = (f32x4){0.f, 0.f, 0.f, 0.f}; if (n0 + c4 < N) v[i] = *(const f32x4*)(src + (size_t)(k0 + row + 4 * i) * N + n0 + c4); }
#pragma unroll
        for (int i = 0; i < 16; ++i) { LAS float* p = tile + (row + 4 * i) * 65 + c4; p[0] = v[i][0]; p[1] = v[i][1]; p[2] = v[i][2]; p[3] = v[i][3]; }
        asm volatile("s_waitcnt lgkmcnt(0)" ::: "memory");
#pragma unroll
        for (int p = 0; p < 8; ++p) { const int n = (lane >> 3) + 8 * p, kc = (lane & 7) * 8;
            if (n0 + n < N) { float sc; const int drow = conv_row(mode, n0 + n, sc); float x[8];
#pragma unroll
                for (int j = 0; j < 8; ++j) x[j] = tile[(kc + j) * 65 + n] * sc;
                if (fp8scale == 0.f) {
                    u32x4 w; w.x = cvt_pk_bf16(x[0], x[1]); w.y = cvt_pk_bf16(x[2], x[3]); w.z = cvt_pk_bf16(x[4], x[5]); w.w = cvt_pk_bf16(x[6], x[7]);
                    *(u32x4*)(dst + (size_t)drow * K + k0 + kc) = w;
                } else {
#pragma unroll
                    for (int j = 0; j < 8; ++j) x[j] = fminf(fmaxf(x[j] * fp8scale, -448.0f), 448.0f);
                    int w0 = 0, w1 = 0;
                    w0 = __builtin_amdgcn_cvt_pk_fp8_f32(x[0], x[1], w0, false); w0 = __builtin_amdgcn_cvt_pk_fp8_f32(x[2], x[3], w0, true);
                    w1 = __builtin_amdgcn_cvt_pk_fp8_f32(x[4], x[5], w1, false); w1 = __builtin_amdgcn_cvt_pk_fp8_f32(x[6], x[7], w1, true);
                    *(u32x2*)((unsigned char*)dst + (size_t)drow * K + k0 + kc) = (u32x2){(unsigned)w0, (unsigned)w1};
                } } }
        asm volatile("s_waitcnt lgkmcnt(0)" ::: "memory");
    }
    gbase = (gbase + ntile) % GW;
}
constexpr int P0_JOBS = 20;
__device__ __forceinline__ void conv_job(const Frame& F, int j, int& gbase) {
    KArgs ka = KA(); unsigned char* const ws = ka->ws;
    const float* src; bf16_t* dst; int K, N, mode; float f8 = 0.f;
    if (j < 2)       { src = ka->in[I_WIN] + (size_t)j * D * PIN; dst = (bf16_t*)(ws + WS_WIN) + (size_t)j * NPAD * D; K = D; N = PIN; mode = 1; }
    else if (j < 4)  { src = ka->in[I_WOUT] + (size_t)(j - 2) * D * D; dst = (bf16_t*)(ws + WS_WOUT) + (size_t)(j - 2) * D * D; K = D; N = D; mode = 0; }
    else if (j == 4) { src = ka->in[I_FW1]; dst = (bf16_t*)(ws + WS_WUP); K = D; N = DFF; mode = 2; f8 = S_W13; }
    else if (j == 5) { src = ka->in[I_FW3]; dst = (bf16_t*)(ws + WS_WUP); K = D; N = DFF; mode = 3; f8 = S_W13; }
    else if (j == 6) { src = ka->in[I_FW2]; dst = (bf16_t*)(ws + WS_WDN); K = DFF; N = D; mode = 0; f8 = S_W2; }
    else if (j < 15) { const int e = j - 7;  src = ka->in[I_MW1] + (size_t)e * D * DFF; dst = (bf16_t*)(ws + WS_MUP + (size_t)e * 2 * DFF * D); K = D; N = DFF; mode = 2; f8 = S_W13; }
    else if (j < 23) { const int e = j - 15; src = ka->in[I_MW3] + (size_t)e * D * DFF; dst = (bf16_t*)(ws + WS_MUP + (size_t)e * 2 * DFF * D); K = D; N = DFF; mode = 3; f8 = S_W13; }
    else             { const int e = j - 23; src = ka->in[I_MW2] + (size_t)e * DFF * D; dst = (bf16_t*)(ws + WS_MDN + (size_t)e * D * DFF); K = DFF; N = D; mode = 0; f8 = S_W2; }
    conv_tiles(F, src, dst, K, N, mode, f8, gbase);
}
__device__ __forceinline__ void p0_prologue(const Frame& F, int skip  ) {
    const int tid = F.tid(); KArgs ka = KA(); unsigned char* const ws = ka->ws;
    if (F.wg < 192 && !(skip & 1)) {
        constexpr int SP = 2080;
        for (int idx = tid; idx < 48 * 512; idx += 512) { const int b = idx >> 9, k2 = (idx & 511) * 2; float v0 = 0.f, v1 = 0.f;
            if (b < 33) { const float* cp = b < 32 ? ka->in[I_C] + b * 1024 : ka->in[I_CCTX]; v0 = cp[k2]; v1 = cp[k2 + 1]; v0 = v0 / (1.0f + __expf(-v0)); v1 = v1 / (1.0f + __expf(-v1)); }
            *(LAS unsigned*)(F.lds + b * SP + k2 * 2) = cvt_pk_bf16(v0, v1); }
        __syncthreads();
        const int layer = F.wg / 96, col0 = (F.wg % 96) * 64, g = F.wid;
        const int gl = F.lane(), gfr = gl & 15, gfq = gl >> 4;
        const float* Wu = ka->in[I_WADA] + (size_t)layer * 1024 * 6144 + col0 + (size_t)(g * 128) * 6144;
        const unsigned loff = (unsigned)(gfr + 8 * gfq * 6144);
        float wv[4][4][8];
#pragma unroll
        for (int ks = 0; ks < 4; ++ks)
#pragma unroll
            for (int nt = 0; nt < 4; ++nt)
#pragma unroll
                for (int j = 0; j < 8; ++j) wv[ks][nt][j] = (Wu + (size_t)(32 * ks + j) * 6144 + 16 * nt)[loff];
        f32x4 acc[4][3];
#pragma unroll
        for (int nt = 0; nt < 4; ++nt)
#pragma unroll
            for (int bt = 0; bt < 3; ++bt) acc[nt][bt] = (f32x4){0.f, 0.f, 0.f, 0.f};
#pragma unroll
        for (int ks = 0; ks < 4; ++ks) {
            bf16x8 Bf[3];
#pragma unroll
            for (int bt = 0; bt < 3; ++bt) Bf[bt] = *(const LAS bf16x8*)(F.lds + (16 * bt + gfr) * SP + (g * 128 + 32 * ks + 8 * gfq) * 2);
#pragma unroll
            for (int nt = 0; nt < 4; ++nt) {
                u32x4 aw; aw.x = cvt_pk_bf16(wv[ks][nt][0], wv[ks][nt][1]); aw.y = cvt_pk_bf16(wv[ks][nt][2], wv[ks][nt][3]); aw.z = cvt_pk_bf16(wv[ks][nt][4], wv[ks][nt][5]); aw.w = cvt_pk_bf16(wv[ks][nt][6], wv[ks][nt][7]);
                const bf16x8 Af = __builtin_bit_cast(bf16x8, aw);
#pragma unroll
                for (int bt = 0; bt < 3; ++bt) acc[nt][bt] = __builtin_amdgcn_mfma_f32_16x16x32_bf16(Af, Bf[bt], acc[nt][bt], 0, 0, 0);
            }
        }
        __syncthreads();
        LAS float* red = (LAS float*)F.lds;
#pragma unroll
        for (int nt = 0; nt < 4; ++nt)
#pragma unroll
            for (int bt = 0; bt < 3; ++bt) { const int b = 16 * bt + gfr;
                if (b < 33) {
#pragma unroll
                    for (int r = 0; r < 4; ++r) red[(g * 33 + b) * 64 + 16 * nt + 4 * gfq + r] = acc[nt][bt][r]; } }
        __syncthreads();
        float* MOD = (float*)(ws + WS_MOD); const float* bada = ka->in[I_BADA];
        for (int idx = tid; idx < 33 * 64; idx += 512) { const int b = idx >> 6, cc = idx & 63; float sum = 0.f;
#pragma unroll
            for (int gg = 0; gg < 8; ++gg) sum += red[(gg * 33 + b) * 64 + cc];
            MOD[((size_t)layer * 33 + b) * 6144 + col0 + cc] = sum + bada[layer * 6144 + col0 + cc]; }
        __syncthreads();
    }
    { bf16_t* WIN = (bf16_t*)(ws + WS_WIN);
      for (int l = 0; l < 2; ++l) { u32x4* p = (u32x4*)(WIN + ((size_t)l * NPAD + PIN) * D); const int n16 = (NPAD - PIN) * D * 2 / 16;
          for (int i = F.wg * 512 + tid; i < n16; i += F.G * 512) p[i] = (u32x4){0u, 0u, 0u, 0u}; } }
    int gbase = 0;
    for (int j = 0; j < ((skip & 2) ? 0 : P0_JOBS); ++j) conv_job(F, j, gbase);
}
__device__ __forceinline__ void tail_convert(const Frame& F, int ntiles, int j0, int j1) {
    const int rem = ntiles % F.G; if (F.wg < rem) return;
    Frame F2 = F; F2.G = F.G - rem; F2.wg = F.wg - rem;
    int gbase = 0;
    for (int j = j0; j < j1; ++j) conv_job(F2, j, gbase);
}

template <bool ROUTER, bool OUT8, bool SRC16, bool GATES>
__device__ __forceinline__ void norm_phase(const Frame& F, const float* srcL, const float* srcC  , int nrows, const float* gain, const float* mod  , int chunk_shift, bf16_t* U, const float* router,
                                           const bf16_t* Wg = nullptr, const float* bgate = nullptr, float* GT = nullptr, bf16_t* HBcopy = nullptr  ) {
    const int lane = F.lane(), wid = F.wid, tid = F.tid();
    constexpr int WG_RB = 2080;
    if constexpr (GATES) {
        for (int i = tid; i < 16 * 128; i += 512) { const int n = i >> 7, ch = i & 127; *(LAS u32x4*)(F.lds + n * WG_RB + ch * 16) = *(const u32x4*)(Wg + (size_t)n * D + ch * 8); }
        __syncthreads();
    }
    const int rpw = (nrows + F.G * 8 - 1) / (F.G * 8);
    const int rbase = (F.wg * 8 + wid) * rpw;
    LAS float* rl = (LAS float*)F.lds;
    LAS int* cntl = (LAS int*)(F.lds + 32768);
    LAS int* sel = (LAS int*)(F.lds + 32768 + 256);
    f32x4 rw[ROUTER ? 16 : 1][2];
    if (ROUTER) {
#pragma unroll
        for (int j = 0; j < 4; ++j)
#pragma unroll
            for (int i = 0; i < 4; ++i) { const float* rp = router + (size_t)(j * 256 + lane * 4 + i) * 8; rw[j * 4 + i][0] = *(const f32x4*)rp; rw[j * 4 + i][1] = *(const f32x4*)(rp + 4); }
        if (tid < 32) cntl[tid] = 0;
        __syncthreads();
    }
    f32x4 gn[4];
#pragma unroll
    for (int j = 0; j < 4; ++j) gn[j] = *(const f32x4*)(gain + j * 256 + lane * 4);
    typedef typename std::conditional<SRC16, u32x2, f32x4>::type raw_t;
    constexpr int NB4 = 4;
#define NP_LOAD(dst, row) do { const int _r = (row); _Pragma("unroll") for (int _j = 0; _j < 4; ++_j) { \
        if constexpr (SRC16) dst[_j] = *(const raw_t*)((const bf16_t*)srcL + (size_t)_r * D + _j * 256 + lane * 4); \
        else dst[_j] = *(const raw_t*)((_r >= NL ? srcC + (size_t)(_r - NL) * D : srcL + (size_t)_r * D) + _j * 256 + lane * 4); } } while (0)
    int cur_b = -1; f32x4 shv[4], scv[4];
#pragma unroll
    for (int j = 0; j < 4; ++j) { shv[j] = (f32x4){0.f, 0.f, 0.f, 0.f}; scv[j] = shv[j]; }
    for (int rr0 = 0; rr0 < rpw; rr0 += NB4) {
      if (rbase + rr0 >= nrows) break;
      { const int r = rbase + rr0; const int bidx = (r >= NL) ? 32 : (r >> 11);
        if (bidx != cur_b) { cur_b = bidx; const float* mv = mod + (size_t)bidx * 6144 + chunk_shift * 1024;
#pragma unroll
            for (int j = 0; j < 4; ++j) { shv[j] = *(const f32x4*)(mv + j * 256 + lane * 4); scv[j] = *(const f32x4*)(mv + 1024 + j * 256 + lane * 4) + 1.0f; }
#pragma unroll
            for (int j = 0; j < 4; ++j) asm volatile("" : "+v"(shv[j]), "+v"(scv[j])); } }
      raw_t bt[NB4][4];
#pragma unroll
      for (int q = 0; q < NB4; ++q) { int rl = rbase + rr0 + q; rl = rl < nrows ? rl : nrows - 1; NP_LOAD(bt[q], rl); }
#pragma unroll
      for (int q = 0; q < NB4; ++q) {
        const int rr = rr0 + q; const int r = rbase + rr; if (rr >= rpw || r >= nrows) continue;
        raw_t cr[4];
#pragma unroll
        for (int j = 0; j < 4; ++j) cr[j] = bt[q][j];
        f32x4 x[4]; float ss = 0.f;
#pragma unroll
        for (int j = 0; j < 4; ++j) {
            if constexpr (SRC16) { const u32x2 w = cr[j]; x[j] = (f32x4){bflo(w.x), bfhi(w.x), bflo(w.y), bfhi(w.y)}; }
            else { x[j] = cr[j];
                if (HBcopy) { u32x2 w; w.x = cvt_pk_bf16(x[j][0], x[j][1]); w.y = cvt_pk_bf16(x[j][2], x[j][3]); *(u32x2*)(HBcopy + (size_t)r * D + j * 256 + lane * 4) = w; } }
            ss += x[j][0] * x[j][0] + x[j][1] * x[j][1] + x[j][2] * x[j][2] + x[j][3] * x[j][3]; }
        ss = wave_sum(ss);
        const float rstd = rsqrtf(ss * (1.0f / 1024.0f) + EPS);
        float lg[8];
        if (ROUTER) {
#pragma unroll
            for (int e = 0; e < 8; ++e) lg[e] = 0.f;
        }
#pragma unroll
        for (int j = 0; j < 4; ++j) {
            f32x4 u = (x[j] * rstd * gn[j]) * scv[j] + shv[j];
            if (OUT8) { int w8 = 0; w8 = __builtin_amdgcn_cvt_pk_fp8_f32(fminf(fmaxf(u[0] * S_A, -448.f), 448.f), fminf(fmaxf(u[1] * S_A, -448.f), 448.f), w8, false);
                w8 = __builtin_amdgcn_cvt_pk_fp8_f32(fminf(fmaxf(u[2] * S_A, -448.f), 448.f), fminf(fmaxf(u[3] * S_A, -448.f), 448.f), w8, true);
                *(int*)((unsigned char*)U + (size_t)r * D + j * 256 + lane * 4) = w8; }
            else { u32x2 w; w.x = cvt_pk_bf16(u[0], u[1]); w.y = cvt_pk_bf16(u[2], u[3]);
                *(u32x2*)(U + (size_t)r * D + j * 256 + lane * 4) = w; }
            if (ROUTER) {
#pragma unroll
                for (int i = 0; i < 4; ++i) { const f32x4 r0 = rw[ROUTER ? j * 4 + i : 0][0], r1 = rw[ROUTER ? j * 4 + i : 0][1];
                    lg[0] += u[i] * r0[0]; lg[1] += u[i] * r0[1]; lg[2] += u[i] * r0[2]; lg[3] += u[i] * r0[3];
                    lg[4] += u[i] * r1[0]; lg[5] += u[i] * r1[1]; lg[6] += u[i] * r1[2]; lg[7] += u[i] * r1[3]; }
            }
        }
        if (ROUTER) {
            { const bool h5 = (lane & 32) != 0, h4 = (lane & 16) != 0, h3 = (lane & 8) != 0;
              float a4[4], a2[2], a1;
#pragma unroll
              for (int q = 0; q < 4; ++q) { const float keep = h5 ? lg[4 + q] : lg[q], send = h5 ? lg[q] : lg[4 + q]; a4[q] = keep + __shfl_xor(send, 32); }
#pragma unroll
              for (int q = 0; q < 2; ++q) { const float keep = h4 ? a4[2 + q] : a4[q], send = h4 ? a4[q] : a4[2 + q]; a2[q] = keep + __shfl_xor(send, 16); }
              { const float keep = h3 ? a2[1] : a2[0], send = h3 ? a2[0] : a2[1]; a1 = keep + __shfl_xor(send, 8); }
              a1 += __shfl_xor(a1, 4); a1 += __shfl_xor(a1, 2); a1 += __shfl_xor(a1, 1);
#pragma unroll
              for (int e = 0; e < 8; ++e) lg[e] = __shfl(a1, ((e >> 2) & 1) * 32 + ((e >> 1) & 1) * 16 + (e & 1) * 8); }
            int e0 = 0; float v0 = lg[0];
#pragma unroll
            for (int e = 1; e < 8; ++e) if (lg[e] > v0) { v0 = lg[e]; e0 = e; }
            int e1 = -1; float v1 = -3.0e38f;
#pragma unroll
            for (int e = 0; e < 8; ++e) if (e != e0 && lg[e] > v1) { v1 = lg[e]; e1 = e; }
            if (lane == 0) {
                const float g0 = 1.0f / (1.0f + __expf(v1 - v0)), g1 = 1.0f - g0;
                const int r0 = atomicAdd((int*)(cntl + e0), 1), r1 = atomicAdd((int*)(cntl + 8 + e1), 1);
                LAS int* sp = sel + (wid * rpw + rr) * 6;
                sp[0] = e0 | (e1 << 8); sp[1] = r0; sp[2] = r1; sp[3] = __float_as_int(g0); sp[4] = __float_as_int(g1); sp[5] = r;
            }
        }
      }
    }
    if constexpr (GATES) {
        asm volatile("s_waitcnt vmcnt(0)" ::: "memory");
        const int fr = lane & 15, fq = lane >> 4;
        int nr = nrows - rbase; nr = nr < 0 ? 0 : (nr > rpw ? rpw : nr);
        const f32x4 bias = *(const f32x4*)(bgate + 4 * fq);
        for (int g0 = 0; g0 < nr; g0 += 16) {
            int rl = g0 + fr; if (rl > nr - 1) rl = nr - 1;
            const bf16_t* up = U + (size_t)(rbase + rl) * D + 8 * fq;
            f32x4 a0 = (f32x4){0.f, 0.f, 0.f, 0.f}, a1 = a0;
#pragma unroll 8
            for (int ks = 0; ks < 32; ks += 2) {
                const bf16x8 u0 = *(const bf16x8*)(up + 32 * ks), u1 = *(const bf16x8*)(up + 32 * ks + 32);
                const bf16x8 w0 = *(const LAS bf16x8*)(F.lds + fr * WG_RB + (32 * ks + 8 * fq) * 2), w1 = *(const LAS bf16x8*)(F.lds + fr * WG_RB + (32 * ks + 32 + 8 * fq) * 2);
                a0 = __builtin_amdgcn_mfma_f32_16x16x32_bf16(w0, u0, a0, 0, 0, 0); a1 = __builtin_amdgcn_mfma_f32_16x16x32_bf16(w1, u1, a1, 0, 0, 0);
            }
            if (g0 + fr < nr) *(f32x4*)(GT + (size_t)(rbase + g0 + fr) * 16 + 4 * fq) = a0 + a1 + bias;
        }
    }
    if (ROUTER) {
        __syncthreads();
        unsigned char* const ws = KA()->ws;
        if (tid < 16) { unsigned* gc = (unsigned*)(ws + WS_CTL + CTL_GCNT); cntl[16 + tid] = (int)__hip_atomic_fetch_add(gc + tid, (unsigned)cntl[tid], __ATOMIC_RELAXED, __HIP_MEMORY_SCOPE_AGENT); }
        __syncthreads();
        int* rowtok = (int*)(ws + WS_RTOK); float* rowgate = (float*)(ws + WS_RGATE);
        for (int i = tid; i < 8 * rpw; i += 512) {
            const int w = i / rpw, rr = i % rpw; const int r = (F.wg * 8 + w) * rpw + rr;
            if (r < nrows) { const LAS int* sp = sel + i * 6; const int e0 = sp[0] & 255, e1 = sp[0] >> 8;
                const int p0 = cntl[16 + e0] + sp[1], p1 = cntl[16 + 8 + e1] + sp[2];
                rowtok[(size_t)e0 * RT_STRIDE + p0] = sp[5]; rowgate[(size_t)e0 * RT_STRIDE + p0] = __int_as_float(sp[3]);
                rowtok[(size_t)(8 + e1) * RT_STRIDE + p1] = sp[5]; rowgate[(size_t)(8 + e1) * RT_STRIDE + p1] = __int_as_float(sp[4]); }
        }
        __syncthreads();
    }
}

#undef NP_LOAD
__device__ __forceinline__ void unpack8(const u32x4 w, float (&v)[8]) { v[0] = bflo(w.x); v[1] = bfhi(w.x); v[2] = bflo(w.y); v[3] = bfhi(w.y); v[4] = bflo(w.z); v[5] = bfhi(w.z); v[6] = bflo(w.w); v[7] = bfhi(w.w); }
__device__ __forceinline__ u32x4 pack8(const float (&v)[8]) { u32x4 w; w.x = cvt_pk_bf16(v[0], v[1]); w.y = cvt_pk_bf16(v[2], v[3]); w.z = cvt_pk_bf16(v[4], v[5]); w.w = cvt_pk_bf16(v[6], v[7]); return w; }
__device__ __forceinline__ void mix_phase(const Frame& F, int nrows, const float* gnorm  ) {
    const int lane = F.lane(); unsigned char* const ws = KA()->ws;
    const bf16_t* P = (const bf16_t*)(ws + WS_PROJ); const bf16_t* HL = (const bf16_t*)KA()->out; bf16_t* A2 = (bf16_t*)(ws + WS_U);
    const int rpw = (nrows + F.G * 8 - 1) / (F.G * 8); const int rbase = (F.wg * 8 + F.wid) * rpw;
    if (rbase >= nrows) return;
    float gnv[8];
#pragma unroll
    for (int j = 0; j < 8; ++j) gnv[j] = gnorm[lane * 8 + j];
    u32x4 n_hf, n_hb, n_og;
#define MX_LOAD(r) do { n_og = *(const u32x4*)(P + (size_t)(r) * NPO + 2560 + lane * 8); n_hf = *(const u32x4*)(HL + (size_t)(r) * 512 + lane * 8); n_hb = *(const u32x4*)(HL + (size_t)(MT + (r)) * 512 + lane * 8); } while (0)
    MX_LOAD(rbase);
    for (int rr = 0; rr < rpw; ++rr) {
        const int r = rbase + rr; if (r >= nrows) break;
        const u32x4 c_hf = n_hf, c_hb = n_hb, c_og = n_og;
        if (rr + 1 < rpw && r + 1 < nrows) MX_LOAD(r + 1);
        float hf[8], hb[8], og[8], y[8];
        unpack8(c_hf, hf); unpack8(c_hb, hb); unpack8(c_og, og);
        float ss = 0.f;
#pragma unroll
        for (int j = 0; j < 8; ++j) { hf[j] += hb[j]; ss += hf[j] * hf[j]; }
        ss += __shfl_xor(ss, 1); ss += __shfl_xor(ss, 2); ss += __shfl_xor(ss, 4); ss += __shfl_xor(ss, 8);
        const float rstd = rsqrtf(ss * (1.0f / 128.0f) + EPS);
#pragma unroll
        for (int j = 0; j < 8; ++j) y[j] = hf[j] * rstd * gnv[j] * sigmoidf_(og[j]);
        *(u32x4*)(A2 + (size_t)r * D + 512 + lane * 8) = pack8(y);
    }
#undef MX_LOAD
}

__device__ __forceinline__ void final_phase(const Frame& F) {
    const int lane = F.lane(); KArgs ka = KA(); const float* gain = ka->in[I_FNG]; float* const outp = ka->out;
    const bf16_t* HB = (const bf16_t*)(ka->ws + WS_HB); const unsigned char* Y0 = (const unsigned char*)(ka->ws + WS_U); const unsigned char* Y1 = (const unsigned char*)(ka->ws + WS_Y1);
    const float* g2 = (const float*)(ka->ws + WS_MOD) + 33 * 6144 + 5 * 1024;
    const int rpw = (NL + F.G * 8 - 1) / (F.G * 8); const int rbase = (F.wg * 8 + F.wid) * rpw;
    f32x4 gn[4], gv[4];
#pragma unroll
    for (int j = 0; j < 4; ++j) { gn[j] = *(const f32x4*)(gain + j * 256 + lane * 4); gv[j] = (f32x4){0.f, 0.f, 0.f, 0.f}; }
    int cur_b = -1;
    u32x2 nx[4]; int ny[4], nz[4];
#define FP_LOAD(row) do { _Pragma("unroll") for (int _j = 0; _j < 4; ++_j) { nx[_j] = *(const u32x2*)(HB + (size_t)(row) * D + _j * 256 + lane * 4); \
        ny[_j] = *(const int*)(Y0 + (size_t)(row) * D + _j * 256 + lane * 4); nz[_j] = *(const int*)(Y1 + (size_t)(row) * D + _j * 256 + lane * 4); } } while (0)
    if (rbase < NL) FP_LOAD(rbase);
    for (int rr = 0; rr < rpw; ++rr) {
        const int r = rbase + rr; if (r >= NL) break;
        u32x2 cr[4]; int cy[4], cz[4];
#pragma unroll
        for (int j = 0; j < 4; ++j) { cr[j] = nx[j]; cy[j] = ny[j]; cz[j] = nz[j]; }
        if (rr + 1 < rpw && r + 1 < NL) FP_LOAD(r + 1);
        const int bidx = r >> 11;
        if (bidx != cur_b) { cur_b = bidx;
#pragma unroll
            for (int j = 0; j < 4; ++j) gv[j] = *(const f32x4*)(g2 + (size_t)bidx * 6144 + j * 256 + lane * 4) * (1.0f / S_Y); }
        f32x4 x[4]; float ss = 0.f;
#pragma unroll
        for (int j = 0; j < 4; ++j) { const u32x2 w = cr[j];
            const f32x2 y0 = __builtin_amdgcn_cvt_pk_f32_fp8(cy[j], false), y1 = __builtin_amdgcn_cvt_pk_f32_fp8(cy[j], true), z0 = __builtin_amdgcn_cvt_pk_f32_fp8(cz[j], false), z1 = __builtin_amdgcn_cvt_pk_f32_fp8(cz[j], true);
            x[j] = (f32x4){bflo(w.x), bfhi(w.x), bflo(w.y), bfhi(w.y)} + gv[j] * (f32x4){y0.x + z0.x, y0.y + z0.y, y1.x + z1.x, y1.y + z1.y};
            ss += x[j][0] * x[j][0] + x[j][1] * x[j][1] + x[j][2] * x[j][2] + x[j][3] * x[j][3]; }
        ss = wave_sum(ss);
        const float rstd = rsqrtf(ss * (1.0f / 1024.0f) + EPS);
        float* p = outp + (size_t)r * D;
#pragma unroll
        for (int j = 0; j < 4; ++j) *(f32x4*)(p + j * 256 + lane * 4) = x[j] * rstd * gn[j];
    }
#undef FP_LOAD
}

constexpr int ML_RB = 288;
constexpr int ML_RBC = 256;
constexpr int ML_Q = 0, ML_K = 36864, ML_V = 73728, ML_CT = 110592, ML_VEC = 145408, ML_CW = 151552;
__device__ __forceinline__ bf16x8 tr_frag2(const LAS unsigned char* base, int rowA, int rowB, int col0, int lane) {
    const int g = lane >> 4, q = (lane & 15) >> 2, p = lane & 3;
    const s16x4 v0 = __builtin_amdgcn_ds_read_tr16_b64_v4i16((LAS s16x4*)(base + (rowA + 4 * g + q) * ML_RB + (col0 + 4 * p) * 2));
    const s16x4 v1 = __builtin_amdgcn_ds_read_tr16_b64_v4i16((LAS s16x4*)(base + (rowB + 4 * g + q) * ML_RB + (col0 + 4 * p) * 2));
    return (bf16x8){v0[0], v0[1], v0[2], v0[3], v1[0], v1[1], v1[2], v1[3]};
}
__device__ __forceinline__ bf16x8 tr_frag(const LAS unsigned char* base, int row0, int col0, int lane) {
    const int g = lane >> 4, q = (lane & 15) >> 2, p = lane & 3;
    const LAS unsigned char* a = base + (row0 + 8 * g + q) * ML_RB + (col0 + 4 * p) * 2;
    const s16x4 v0 = __builtin_amdgcn_ds_read_tr16_b64_v4i16((LAS s16x4*)a);
    const s16x4 v1 = __builtin_amdgcn_ds_read_tr16_b64_v4i16((LAS s16x4*)(a + 4 * ML_RB));
    return (bf16x8){v0[0], v0[1], v0[2], v0[3], v1[0], v1[1], v1[2], v1[3]};
}
__device__ __forceinline__ void mlstm_phase(const Frame& F, bool ctx_out, int skip  ,
                                             int conv_rows  , const float* convw  ) {
    const int lane = F.lane(), wid = F.wid, tid = wid * 64 + lane, fr = lane & 15, fq = lane >> 4;
    LAS unsigned char* lds = F.lds;
    LAS float* ic = (LAS float*)(lds + ML_VEC); LAS float* fc = ic + 128; LAS float* av = ic + 256; LAS float* Mv = ic + 384; LAS float* bcv = ic + 512;
    LAS float* nvec = ic + 640; LAS float* wkv = ic + 768; LAS float* npart = ic + 896;
    LAS float* eav = ic + 1408;
    LAS float* cw = (LAS float*)(lds + ML_CW);
    for (int i = tid; i < 1536; i += 512) cw[i] = convw[i];
    unsigned char* const ws = KA()->ws;
    const bf16_t* P = (const bf16_t*)(ws + WS_PROJ); const float* GT = (const float*)(ws + WS_GATES); bf16_t* HL = (bf16_t*)KA()->out;
    bf16_t* A2 = (bf16_t*)(ws + WS_U);
    const int crpw = (conv_rows + F.G * 8 - 1) / (F.G * 8), crb = (F.wg * 8 + wid) * crpw; int cri = 0;
    int cnr = conv_rows - crb; cnr = cnr < 0 ? 0 : (cnr > crpw ? crpw : cnr);
#define MC_HASL(r) ((r) < NL ? (((r) & 63) != 0) : ((((r) - NL) & 255) != 0))
#define MC_HASR(r) ((r) < NL ? (((r) & 63) != 63) : ((((r) - NL) & 255) != 255))
    float zl[8], zc[8];
#pragma unroll
    for (int j = 0; j < 8; ++j) { zl[j] = 0.f; zc[j] = 0.f; }
    if (cnr > 0) { const bf16_t* pr = P + (size_t)crb * NPO + lane * 8;
        unpack8(*(const u32x4*)(pr + 512), zc);
        if (MC_HASL(crb)) unpack8(*(const u32x4*)(pr - NPO + 512), zl); }
    for (int unit = F.wg; unit < 256; unit += F.G) {
        const int b = unit >> 3, hd = (unit >> 1) & 3, dir = unit & 1;
        f32x4 Cacc[8];
#pragma unroll
        for (int a = 0; a < 8; ++a) Cacc[a] = (f32x4){0.f, 0.f, 0.f, 0.f};
        float m = 0.f, dec_prev = 0.f;
        if (tid < 128) nvec[tid] = 0.f;
        if (tid < 512) npart[tid] = 0.f;
        u32x4 st[12]; float gi = 0.f, gf = 0.f;
#define ML_ROW0(ci) ((ci) < 2 ? NL + b * 256 + (dir ? 1 - (ci) : (ci)) * 128 : b * 2048 + (dir ? 15 - ((ci) - 2) : ((ci) - 2)) * 128)
#define ML_LOAD(ci) do { const int _r0 = ML_ROW0(ci); _Pragma("unroll") for (int _p = 0; _p < 4; ++_p) { const int _id = tid + 512 * _p, _row = _id >> 4, _ch = _id & 15; \
            const bf16_t* _g = P + (size_t)(_r0 + _row) * NPO + 1024 + hd * 128 + _ch * 8; st[_p] = *(const u32x4*)_g; st[4 + _p] = *(const u32x4*)(_g + 512); st[8 + _p] = *(const u32x4*)(_g + 1024); } \
            if (tid < 128) { gi = GT[(size_t)(_r0 + tid) * 16 + (2 * dir) * 4 + hd]; gf = GT[(size_t)(_r0 + tid) * 16 + (2 * dir + 1) * 4 + hd]; } } while (0)
#define ML_BAR() do { asm volatile("s_waitcnt lgkmcnt(0)" ::: "memory"); __builtin_amdgcn_s_barrier(); asm volatile("" ::: "memory"); } while (0)
        ML_LOAD(0);
        __syncthreads();
        for (int ci = 0; ci < 18; ++ci) {
            const int row0 = ML_ROW0(ci);
            const bool need_out = ((ci >= 2) || ctx_out) && !(skip & 1);
            int lane_c = lane; asm volatile("" : "+v"(lane_c));
            const int lane = lane_c, fr = lane & 15, fq = lane >> 4, tid = wid * 64 + lane;
#pragma unroll
            for (int p = 0; p < 4; ++p) { const int id = tid + 512 * p, row = id >> 4, ch = id & 15; const int o = row * ML_RB + ch * 16;
                *(LAS u32x4*)(lds + ML_Q + o) = st[p]; *(LAS u32x4*)(lds + ML_K + o) = st[4 + p]; *(LAS u32x4*)(lds + ML_V + o) = st[8 + p]; }
#pragma unroll
            for (int a = 0; a < 8; ++a) { u32x2 w; w.x = cvt_pk_bf16(Cacc[a][0], Cacc[a][1]); w.y = cvt_pk_bf16(Cacc[a][2], Cacc[a][3]);
                *(LAS u32x2*)(lds + ML_CT + (16 * wid + fr) * ML_RBC + (((2 * a + (fq >> 1)) ^ fr) << 4) + (fq & 1) * 8) = w; }
            if (tid < 128) { ic[tid] = gi; fc[tid] = fminf(gf, 0.f) - __logf(1.0f + __expf(-fabsf(gf)));
                nvec[tid] = dec_prev * nvec[tid] + ((npart[tid] + npart[128 + tid]) + (npart[256 + tid] + npart[384 + tid])); }
            if (ci + 1 < 18 && !(skip & 4)) ML_LOAD(ci + 1);
            ML_BAR();
            float bL, Mlast, amax;
            { const int p0 = 2 * lane, p1 = p0 + 1, s0 = dir ? 127 - p0 : p0, s1 = dir ? 127 - p1 : p1;
              const float f0 = fc[s0], f1 = fc[s1], i0 = ic[s0], i1 = ic[s1];
              const float incl = wave_scan_add(f0 + f1);
              const float bc1 = incl, bc0 = incl - f1;
              const float a0 = i0 - bc0, a1 = i1 - bc1;
              const float im = wave_scan_max(fmaxf(a0, a1));
              float ex = __shfl_up(im, 1); if (lane == 0) ex = -3.0e38f;
              const float M0 = fmaxf(fmaxf(m, ex), a0), M1 = fmaxf(m, im);
              bL = __shfl(incl, 63); Mlast = __shfl(M1, 63); amax = __shfl(im, 63);
              av[s0] = a0; av[s1] = a1; Mv[s0] = M0; Mv[s1] = M1; bcv[s0] = bc0; bcv[s1] = bc1;
              wkv[s0] = __expf(a0 - Mlast); wkv[s1] = __expf(a1 - Mlast);
              eav[s0] = __expf(a0 - amax); eav[s1] = __expf(a1 - amax); }
            if (need_out) {
                int tq = __builtin_amdgcn_readfirstlane(wid < 4 ? 2 * wid : 15 - 2 * wid); asm volatile("" : "+s"(tq));
                const int t = 16 * tq + fr; const float Mt = Mv[t];
                bf16x8 Qf[4];
#pragma unroll
                for (int ks = 0; ks < 4; ++ks) Qf[ks] = *(const LAS bf16x8*)(lds + ML_Q + t * ML_RB + (32 * ks + 8 * fq) * 2);
                float rowsum = 0.f; u32x2 Sp[8];
#pragma unroll
                for (int j = 0; j < 8; ++j) {
                    Sp[j] = (u32x2){0u, 0u};
                    const bool act = dir ? (j >= tq) : (j <= tq);
                    if (act) {
                        f32x4 acc = (f32x4){0.f, 0.f, 0.f, 0.f};
#pragma unroll
                        for (int ks = 0; ks < 4; ++ks) { const bf16x8 Kf = *(const LAS bf16x8*)(lds + ML_K + (16 * j + fr) * ML_RB + (32 * ks + 8 * fq) * 2); acc = __builtin_amdgcn_mfma_f32_16x16x32_bf16(Kf, Qf[ks], acc, 0, 0, 0); }
                        const f32x4 e4 = *(const LAS f32x4*)(eav + 16 * j + 4 * fq);
                        float v[4];
#pragma unroll
                        for (int r = 0; r < 4; ++r) v[r] = acc[r] * e4[r];
                        if (j == tq) {
#pragma unroll
                            for (int r = 0; r < 4; ++r) { const bool valid = dir ? (4 * fq + r >= fr) : (4 * fq + r <= fr); v[r] = valid ? v[r] : 0.f; } }
                        rowsum += (v[0] + v[1]) + (v[2] + v[3]);
                        Sp[j].x = cvt_pk_bf16(v[0], v[1]); Sp[j].y = cvt_pk_bf16(v[2], v[3]);
                    }
                }
                rowsum += __shfl_xor(rowsum, 16); rowsum += __shfl_xor(rowsum, 32);
                float qn = 0.f;
#pragma unroll
                for (int ks = 0; ks < 4; ++ks) { const f32x4 n0 = *(const LAS f32x4*)(nvec + 32 * ks + 8 * fq), n1 = *(const LAS f32x4*)(nvec + 32 * ks + 8 * fq + 4);
#pragma unroll
                    for (int jj = 0; jj < 4; ++jj) { qn += bf2f((unsigned short)Qf[ks][jj]) * n0[jj]; qn += bf2f((unsigned short)Qf[ks][4 + jj]) * n1[jj]; } }
                qn += __shfl_xor(qn, 16); qn += __shfl_xor(qn, 32);
                const float em = __expf(amax - Mt), wi = __expf(m - Mt), den = em * rowsum + wi * qn, rd = 1.0f / fmaxf(fabsf(den), __expf(-(bcv[t] + Mt)));
                const float ems = em * rd, wis = wi * rd;
                bf16x8 Sf[4];
#pragma unroll
                for (int ks = 0; ks < 4; ++ks) { const u32x4 w = (u32x4){Sp[2 * ks].x, Sp[2 * ks].y, Sp[2 * ks + 1].x, Sp[2 * ks + 1].y}; Sf[ks] = __builtin_bit_cast(bf16x8, w); }
                LAS unsigned char* const obuf = lds + ML_Q + 16 * tq * ML_RB;
#pragma unroll 2
                for (int d = 0; d < 8; ++d) {
                    f32x4 aS = (f32x4){0.f, 0.f, 0.f, 0.f}, aC = (f32x4){0.f, 0.f, 0.f, 0.f};
#pragma unroll
                    for (int ks = 0; ks < 4; ++ks) { const bool act = dir ? (2 * ks + 1 >= tq) : (2 * ks <= tq);
                        if (act) { const bf16x8 Vt = tr_frag2(lds + ML_V, 32 * ks, 32 * ks + 16, 16 * d, lane); aS = __builtin_amdgcn_mfma_f32_16x16x32_bf16(Vt, Sf[ks], aS, 0, 0, 0); } }
#pragma unroll
                    for (int kp = 0; kp < 4; ++kp) { const bf16x8 Cf = *(const LAS bf16x8*)(lds + ML_CT + (16 * d + fr) * ML_RBC + (((4 * kp + fq) ^ fr) << 4)); aC = __builtin_amdgcn_mfma_f32_16x16x32_bf16(Cf, Qf[kp], aC, 0, 0, 0); }
                    u32x2 w; w.x = cvt_pk_bf16(ems * aS[0] + wis * aC[0], ems * aS[1] + wis * aC[1]); w.y = cvt_pk_bf16(ems * aS[2] + wis * aC[2], ems * aS[3] + wis * aC[3]);
                    *(LAS u32x2*)(obuf + fr * 272 + (16 * d + 4 * fq) * 2) = w;
                }
#pragma unroll
                for (int i = 0; i < 4; ++i) { const int orow = (lane >> 4) + 4 * i; const u32x4 v = *(const LAS u32x4*)(obuf + orow * 272 + (lane & 15) * 16);
                    *(u32x4*)(HL + ((size_t)dir * MT + row0 + 16 * tq + orow) * 512 + hd * 128 + (lane & 15) * 8) = v; }
            }
            u32x4 c_gb[2], c_gc[2]; int c_n = 0;
            {
                c_n = cnr - cri; c_n = c_n > 2 ? 2 : (c_n < 0 ? 0 : c_n); if (skip & 8) c_n = 0;
#pragma unroll
                for (int q = 0; q < 2; ++q) if (q < c_n) { const bf16_t* pr = P + (size_t)(crb + cri + q) * NPO + lane * 8; c_gb[q] = *(const u32x4*)pr; c_gc[q] = *(const u32x4*)(pr + NPO + 512); }
                asm volatile("" ::: "memory");
                const float dec = __expf(m - Mlast);
                bf16x8 Vw[4], Wk[4];
#pragma unroll
                for (int ks = 0; ks < 4; ++ks) { const bf16x8 Vf = tr_frag2(lds + ML_V, 32 * ks, 32 * ks + 16, 16 * wid, lane);
                    const f32x4 k0 = *(const LAS f32x4*)(wkv + 32 * ks + 4 * fq), k1 = *(const LAS f32x4*)(wkv + 32 * ks + 16 + 4 * fq);
                    u32x4 w;
                    w.x = cvt_pk_bf16(bf2f((unsigned short)Vf[0]) * k0[0], bf2f((unsigned short)Vf[1]) * k0[1]); w.y = cvt_pk_bf16(bf2f((unsigned short)Vf[2]) * k0[2], bf2f((unsigned short)Vf[3]) * k0[3]);
                    w.z = cvt_pk_bf16(bf2f((unsigned short)Vf[4]) * k1[0], bf2f((unsigned short)Vf[5]) * k1[1]); w.w = cvt_pk_bf16(bf2f((unsigned short)Vf[6]) * k1[2], bf2f((unsigned short)Vf[7]) * k1[3]);
                    Vw[ks] = __builtin_bit_cast(bf16x8, w);
                    u32x4 wq = (u32x4){0u, 0u, 0u, 0u};
                    if (fr == 0) { wq.x = cvt_pk_bf16(k0[0], k0[1]); wq.y = cvt_pk_bf16(k0[2], k0[3]); wq.z = cvt_pk_bf16(k1[0], k1[1]); wq.w = cvt_pk_bf16(k1[2], k1[3]); }
                    Wk[ks] = __builtin_bit_cast(bf16x8, wq); }
                f32x4 nacc = (f32x4){0.f, 0.f, 0.f, 0.f};
                if (!(skip & 2)) {
#pragma unroll
                for (int a = 0; a < 8; ++a) { Cacc[a] = Cacc[a] * dec;
#pragma unroll
                    for (int ks = 0; ks < 4; ++ks) { const bf16x8 Kt = tr_frag2(lds + ML_K, 32 * ks, 32 * ks + 16, 16 * a, lane); Cacc[a] = __builtin_amdgcn_mfma_f32_16x16x32_bf16(Kt, Vw[ks], Cacc[a], 0, 0, 0);
                        if (a == wid) nacc = __builtin_amdgcn_mfma_f32_16x16x32_bf16(Kt, Wk[ks], nacc, 0, 0, 0); } } }
                if (fr == 0) *(LAS f32x4*)(npart + 16 * wid + 4 * fq) = nacc;
                dec_prev = dec;
                m = bL + Mlast;
            }
#pragma unroll
            for (int q = 0; q < 2; ++q) if (q < c_n) { const int r = crb + cri + q;
                float gb[8], zr[8], y[8];
                unpack8(c_gb[q], gb); unpack8(c_gc[q], zr);
                const f32x4 wa0 = *(const LAS f32x4*)(cw + lane * 8), wa1 = *(const LAS f32x4*)(cw + lane * 8 + 4), wb0 = *(const LAS f32x4*)(cw + 512 + lane * 8), wb1 = *(const LAS f32x4*)(cw + 512 + lane * 8 + 4),
                            wc0 = *(const LAS f32x4*)(cw + 1024 + lane * 8), wc1 = *(const LAS f32x4*)(cw + 1024 + lane * 8 + 4);
                const bool hasR = MC_HASR(r);
#pragma unroll
                for (int j = 0; j < 8; ++j) {
                    const float w0 = j < 4 ? wa0[j & 3] : wa1[j & 3], w1 = j < 4 ? wb0[j & 3] : wb1[j & 3], w2 = j < 4 ? wc0[j & 3] : wc1[j & 3];
                    y[j] = gb[j] * (w0 * zl[j] + w1 * zc[j] + (hasR ? w2 * zr[j] : 0.f)); }
                *(u32x4*)(A2 + (size_t)r * D + lane * 8) = pack8(y);
#pragma unroll
                for (int j = 0; j < 8; ++j) { zl[j] = hasR ? zc[j] : 0.f; zc[j] = zr[j]; } }
            cri += c_n;
            ML_BAR();
        }
#undef ML_ROW0
#undef ML_LOAD
#undef ML_BAR
#undef MC_HASL
#undef MC_HASR
    }
}

constexpr int NPH = 20;
constexpr int REP[NPH] = {1, 1, 1, 1, 1, 1, 1, 1, 1, 1, 1, 1, 1, 1, 1, 1, 1, 1, 1, 1};
#define REPEAT(k) for (int _r = 0; _r < REP[k]; ++_r)
#define GSCALE(k) ((_r == REP[k] - 1) ? 1.0f : 0.0f)
__global__ void __launch_bounds__(512, 2) mk_fwd(Args args_unused) {
    extern __shared__ __attribute__((aligned(16))) unsigned char smem[];
    Frame F;
    F.lds = (LAS unsigned char*)smem; F.wid = __builtin_amdgcn_readfirstlane((int)threadIdx.x >> 6); F.G = gridDim.x; F.wg = blockIdx.x;
    volatile LAS unsigned* misc = (volatile LAS unsigned*)(F.lds + MISC_OFF);
    if (F.tid() < 64) misc[F.tid()] = 0u;
    __syncthreads();
    int lo, hi;
    { KArgs ka = KA(); lo = ka->lo; hi = ka->hi; }
    XcdBarrier bar;
    { KArgs ka = KA(); bar.bar = (unsigned*)(ka->ws + WS_CTL); bar.x = 0; bar.st = misc; bar.wid = F.wid;
      if (hi - lo > 1) bar = xcd_barrier_post((unsigned*)(ka->ws + WS_CTL), misc, F.wid); }
#define IN(k) (lo <= (k) && (k) < hi)
#define SEAM(k) do { if (IN(k) && IN((k) + 1)) { KArgs _ka = KA(); bar.bar = (unsigned*)(_ka->ws + WS_CTL); xcd_barrier(bar); } } while (0)
    const volatile LAS int* tb = (const volatile LAS int*)(F.lds + MISC_OFF + 64);
    volatile LAS int* tbw = (volatile LAS int*)(F.lds + MISC_OFF + 64);

#ifdef PROBE_MFMA
    {
        f32x4 a0 = {0.f, 0.f, 0.f, 0.f}, a1 = a0, a2 = a0, a3 = a0; bf16x8 x = {1, 2, 3, 4, 5, 6, 7, 8}, y = {8, 7, 6, 5, 4, 3, 2, 1};
        asm volatile("" : "+v"(x), "+v"(y));
        for (int it = 0; it < 10000; ++it) {
            a0 = __builtin_amdgcn_mfma_f32_16x16x32_bf16(x, y, a0, 0, 0, 0); a1 = __builtin_amdgcn_mfma_f32_16x16x32_bf16(x, y, a1, 0, 0, 0);
            a2 = __builtin_amdgcn_mfma_f32_16x16x32_bf16(x, y, a2, 0, 0, 0); a3 = __builtin_amdgcn_mfma_f32_16x16x32_bf16(x, y, a3, 0, 0, 0); }
        asm volatile("" :: "v"(a0), "v"(a1), "v"(a2), "v"(a3));
    }
#endif
    if (IN(0)) REPEAT(0) { p0_prologue(F, _r < REP[0] - 1 ? PROBE_P0SKIP : 0); }
    SEAM(0);
    if (IN(1)) REPEAT(1) { KArgs ka = KA(); unsigned char* ws = ka->ws;
        norm_phase<false, false, false, true>(F, ka->in[I_X], ka->in[I_CTX], MT, ka->in[I_N1G], (const float*)(ws + WS_MOD), 0, (bf16_t*)(ws + WS_U), nullptr,
            (const bf16_t*)(ws + WS_WIN) + (size_t)NPROJ * D, ka->in[I_BG], (float*)(ws + WS_GATES), (bf16_t*)(ws + WS_HB)); }
    SEAM(1);
    if (IN(2)) REPEAT(2) { KArgs ka = KA(); unsigned char* ws = ka->ws;
        pg8::DenseSched S{MT / 256, NPROJ / 256, F.G, F.wg, 2 * D, 4};
        pg8::EpiProj E{(bf16_t*)(ws + WS_PROJ), GSCALE(2) == 0.0f};
        pg8::gemm_phase<false>(F.lds, F.wid, (const char*)(ws + WS_U), (const char*)(ws + WS_WIN), 2 * D, S, E, 0);
        tail_convert(F, (MT / 256) * (NPROJ / 256), 30, 31); }
    SEAM(2);
    if (IN(3)) REPEAT(3) { mlstm_phase(F, true, _r < REP[3] - 1 ? PROBE_MLSKIP : 0, MT, KA()->in[I_CONVW]); }
    SEAM(3);
    if (IN(4)) REPEAT(4) { KArgs ka = KA(); mix_phase(F, MT, ka->in[I_MNG]); }
    SEAM(4);
    if (IN(5)) REPEAT(5) { KArgs ka = KA(); unsigned char* ws = ka->ws;
        pg8::DenseSched S{MT / 256, D / 256, F.G, F.wg, 2 * D, 4};
        pg8::EpiResid E{(bf16_t*)(ws + WS_HB), (const float*)(ws + WS_MOD) + 2 * 1024, 1.0f};
        pg8::gemm_phase<false>(F.lds, F.wid, (const char*)(ws + WS_U), (const char*)(ws + WS_WOUT), 2 * D, S, E, 0);
        tail_convert(F, (MT / 256) * (D / 256), 27, 30); }
    SEAM(5);
    if (IN(6)) REPEAT(6) { KArgs ka = KA(); unsigned char* ws = ka->ws;
        norm_phase<false, true, true, false>(F, (const float*)(ws + WS_HB), nullptr, MT, ka->in[I_N2G], (const float*)(ws + WS_MOD), 3, (bf16_t*)(ws + WS_U), nullptr); }
    SEAM(6);
    if (IN(7)) REPEAT(7) { KArgs ka = KA(); unsigned char* ws = ka->ws;
        pg8::DenseSched S{MT / 256, 2 * DFF / 256, F.G, F.wg, D, 8};
        pg8::EpiSwiglu E{(unsigned char*)(ws + WS_PROJ), 1.0f / (S_A * S_W13), S_H * GSCALE(7)};
        pg8::gemm_phase<true>(F.lds, F.wid, (const char*)(ws + WS_U), (const char*)(ws + WS_WUP), D, S, E, 0);
        tail_convert(F, (MT / 256) * (2 * DFF / 256), 26, 27); }
    SEAM(7);
    if (IN(8)) REPEAT(8) { KArgs ka = KA(); unsigned char* ws = ka->ws;
        pg8::DenseSched S{MT / 256, D / 256, F.G, F.wg, DFF, 4};
        pg8::EpiResid E{(bf16_t*)(ws + WS_HB), (const float*)(ws + WS_MOD) + 5 * 1024, GSCALE(8) / (S_H * S_W2)};
        pg8::gemm_phase<true>(F.lds, F.wid, (const char*)(ws + WS_PROJ), (const char*)(ws + WS_WDN), DFF, S, E, 0);
        tail_convert(F, (MT / 256) * (D / 256), 21, 26); }
    SEAM(8);
    if (IN(9)) REPEAT(9) { KArgs ka = KA(); unsigned char* ws = ka->ws;
        norm_phase<false, false, true, true>(F, (const float*)(ws + WS_HB), nullptr, MT, ka->in[I_N1G] + D, (const float*)(ws + WS_MOD) + 33 * 6144, 0, (bf16_t*)(ws + WS_U), nullptr,
            (const bf16_t*)(ws + WS_WIN) + (size_t)(NPAD + NPROJ) * D, ka->in[I_BG] + 16, (float*)(ws + WS_GATES)); }
    SEAM(9);
    if (IN(10)) REPEAT(10) { KArgs ka = KA(); unsigned char* ws = ka->ws;
        pg8::InProjL1Sched S{F.G, F.wg};
        pg8::EpiProj E{(bf16_t*)(ws + WS_PROJ), GSCALE(10) == 0.0f};
        pg8::gemm_phase<false>(F.lds, F.wid, (const char*)(ws + WS_U), (const char*)(ws + WS_WIN) + (size_t)NPAD * D * 2, 2 * D, S, E, 0);
        tail_convert(F, 3584 + 192, 20, 21); }
    SEAM(10);
    if (IN(11)) REPEAT(11) { mlstm_phase(F, false, _r < REP[11] - 1 ? PROBE_MLSKIP : 0, NL, KA()->in[I_CONVW] + 3 * 512); }
    SEAM(11);
    if (IN(12)) REPEAT(12) { KArgs ka = KA(); mix_phase(F, NL, ka->in[I_MNG] + 512); }
    SEAM(12);
    if (IN(13)) REPEAT(13) { KArgs ka = KA(); unsigned char* ws = ka->ws;
        pg8::DenseSched S{NL / 256, D / 256, F.G, F.wg, 2 * D, 4};
        pg8::EpiResid E{(bf16_t*)(ws + WS_HB), (const float*)(ws + WS_MOD) + 33 * 6144 + 2 * 1024, GSCALE(13)};
        pg8::gemm_phase<false>(F.lds, F.wid, (const char*)(ws + WS_U), (const char*)(ws + WS_WOUT) + (size_t)D * D * 2, 2 * D, S, E, 0); }
    SEAM(13);
    if (IN(14)) REPEAT(14) { KArgs ka = KA(); unsigned char* ws = ka->ws;
        norm_phase<true, true, true, false>(F, (const float*)(ws + WS_HB), nullptr, NL, ka->in[I_N2G] + D, (const float*)(ws + WS_MOD) + 33 * 6144, 3, (bf16_t*)(ws + WS_U), ka->in[I_ROUTER]); }
    SEAM(14);
    if (IN(15) || IN(16)) {
        __syncthreads();
        { const int tidl = F.tid();
          if (tidl < 64) {
            KArgs ka = KA(); const unsigned* gc = (const unsigned*)(ka->ws + WS_CTL + CTL_GCNT);
            const int c = tidl < 16 ? (int)__hip_atomic_load(gc + tidl, __ATOMIC_RELAXED, __HIP_MEMORY_SCOPE_AGENT) : 0;
            const int nt_ = (c + 255) >> 8; int incl = nt_;
#pragma unroll
            for (int d = 1; d < 16; d <<= 1) { const int t = __shfl_up(incl, d); if (tidl >= d) incl += t; }
            if (tidl < 16) { tbw[tidl] = incl - nt_; tbw[32 + tidl] = c; }
            if (tidl == 15) tbw[16] = incl; } }
        __syncthreads();
    }
    if (IN(15)) REPEAT(15) { KArgs ka = KA(); unsigned char* ws = ka->ws;
        pg8::MoeUpSched S{F.G, F.wg, (const int*)(ws + WS_RTOK), tb};
        pg8::EpiSwiglu E{(unsigned char*)(ws + WS_PROJ), 1.0f / (S_A * S_W13), S_H};
        pg8::gemm_phase<true>(F.lds, F.wid, (const char*)(ws + WS_U), (const char*)(ws + WS_MUP), D, S, E, 0); }
    SEAM(15);
    if (IN(16)) { KArgs ka = KA(); unsigned char* ws = ka->ws;
        pg8::MoeDownSched S{F.G, F.wg, tb, (const int*)(ws + WS_RTOK), (const float*)(ws + WS_RGATE)};
        pg8::EpiMoeDown E{(unsigned char*)(ws + WS_U), (unsigned char*)(ws + WS_Y1), F.lds + pg8::STAGE_BYTES, tb, S_Y / (S_H * S_W2)};
        pg8::gemm_phase<true>(F.lds, F.wid, (const char*)(ws + WS_PROJ), (const char*)(ws + WS_MDN), DFF, S, E, 0); }
    SEAM(16);
    if (IN(19)) REPEAT(19) { final_phase(F); }
#undef IN
#undef SEAM
}

extern "C" void kernel_launch(void* const* d_in, const int* in_sizes, int n_in, void* d_out, int out_size, void* d_ws, size_t ws_size, hipStream_t stream) {
    static int grid = 0;
    if (grid == 0) {
        if (n_in != 21 || ws_size < WS_END) { fprintf(stderr, "kernel_launch: expected 21 inputs and >= %zu bytes of workspace; got %d, %zu\n", (size_t)WS_END, n_in, ws_size); grid = -1; return; }
        int dev = 0, cus = 0, per_cu = 0;
        if (hipGetDevice(&dev) != hipSuccess || hipDeviceGetAttribute(&cus, hipDeviceAttributeMultiprocessorCount, dev) != hipSuccess) { grid = -1; return; }
        if (hipFuncSetAttribute((const void*)mk_fwd, hipFuncAttributeMaxDynamicSharedMemorySize, LDS_BYTES) != hipSuccess) { fprintf(stderr, "kernel_launch: hipFuncSetAttribute failed\n"); grid = -1; return; }
        if (hipOccupancyMaxActiveBlocksPerMultiprocessor(&per_cu, (const void*)mk_fwd, 512, LDS_BYTES) != hipSuccess || per_cu < 1) fprintf(stderr, "kernel_launch: occupancy query reports %d\n", per_cu);
        (void)hipGetLastError();
        grid = cus;
    }
    if (grid < 0) return;
    (void)hipMemsetAsync((char*)d_ws + WS_CTL, 0, CTL_BYTES, stream);
    Args a{};
    for (int i = 0; i < 21; ++i) a.in[i] = (const float*)d_in[i];
    a.out = (float*)d_out; a.ws = (unsigned char*)d_ws;
#if MK_PER_PHASE
    for (int p = 0; p < NPH; ++p) { a.lo = p; a.hi = p + 1; hipLaunchKernelGGL(mk_fwd, dim3(grid), dim3(512), LDS_BYTES, stream, a); }
#else
    a.lo = 0; a.hi = NPH; hipLaunchKernelGGL(mk_fwd, dim3(grid), dim3(512), LDS_BYTES, stream, a);
#endif
}
```

```cpp
#include <hip/hip_runtime.h>
#include <cstdio>
#include <cstdint>
#include <type_traits>

#ifndef MK_PER_PHASE
#define MK_PER_PHASE 0
#endif

#define LAS __attribute__((address_space(3)))
typedef unsigned short bf16_t;
typedef short bf16x8 __attribute__((ext_vector_type(8)));
typedef short s16x4 __attribute__((ext_vector_type(4)));
typedef float f32x4 __attribute__((ext_vector_type(4)));
typedef float f32x2 __attribute__((ext_vector_type(2)));
typedef unsigned u32x4 __attribute__((ext_vector_type(4)));
typedef unsigned u32x2 __attribute__((ext_vector_type(2)));

constexpr int D = 1024, NB = 32, SEQ = 2048, CTXL = 256;
constexpr int NL = NB * SEQ;
constexpr int NCX = NB * CTXL;
constexpr int MT = NL + NCX;
constexpr int PIN = 3600, NPROJ = 3584, NPAD = 3840;
constexpr int NPO = 3072;
constexpr int DFF = 2816, NE = 8;
constexpr float EPS = 1e-6f;
constexpr int PROBE_P0SKIP = 0;
constexpr int PROBE_MLSKIP = 0;
constexpr bool PROBE_DRY = false;
constexpr int RT_STRIDE = 65536;
constexpr float S_A = 16.0f, S_W13 = 256.0f, S_H = 8.0f, S_W2 = 256.0f, S_Y = 32.0f;

constexpr size_t WS_CTL = 0;
constexpr size_t CTL_BYTES = 65536;
constexpr size_t CTL_GCNT = 16384;
constexpr size_t WS_MOD = 65536;
constexpr size_t WS_WIN = 2097152;
constexpr size_t WS_WOUT = WS_WIN + (size_t)2 * NPAD * D * 2;
constexpr size_t WS_WUP = WS_WOUT + (size_t)2 * D * D * 2;
constexpr size_t WS_WDN = WS_WUP + (size_t)2 * DFF * D * 2;
constexpr size_t WS_MUP = WS_WDN + (size_t)D * DFF * 2;
constexpr size_t WS_MDN = WS_MUP + (size_t)NE * 2 * DFF * D * 2;
constexpr size_t WS_HC = WS_MDN + (size_t)NE * D * DFF * 2;
constexpr size_t WS_U = WS_HC + (size_t)NCX * D * 4;
constexpr size_t WS_PROJ = WS_U + (size_t)MT * D * 2;
constexpr size_t WS_GATES = WS_PROJ + (size_t)MT * NPROJ * 2;
constexpr size_t WS_HL = WS_GATES + (size_t)MT * 16 * 4;
constexpr size_t WS_HB = WS_HL;
constexpr size_t WS_Y1 = WS_PROJ + (size_t)368 * 1048576;
static_assert(WS_Y1 + (size_t)NL * D * 2 <= WS_GATES && (size_t)528 * 256 * DFF <= (size_t)368 * 1048576, "Y1 placement");
constexpr size_t WS_RTOK = WS_HL + (size_t)2 * MT * 512 * 2;
constexpr size_t WS_RGATE = WS_RTOK + (size_t)16 * RT_STRIDE * 4;
constexpr size_t WS_END = WS_RGATE + (size_t)16 * RT_STRIDE * 4;

constexpr int LDS_BYTES = 163840;
constexpr int MISC_OFF = 161792;

__device__ __forceinline__ unsigned cvt_pk_bf16(float lo, float hi) { unsigned r; asm volatile("v_cvt_pk_bf16_f32 %0, %1, %2" : "=v"(r) : "v"(lo), "v"(hi)); return r; }
__device__ __forceinline__ float bf2f(unsigned short b) { return __uint_as_float(((unsigned)b) << 16); }
__device__ __forceinline__ float bflo(unsigned w) { return __uint_as_float(w << 16); }
__device__ __forceinline__ float bfhi(unsigned w) { return __uint_as_float(w & 0xffff0000u); }
__device__ __forceinline__ float wave_sum(float v) {
#pragma unroll
    for (int o = 32; o >= 1; o >>= 1) v += __shfl_xor(v, o);
    return v;
}
__device__ __forceinline__ int lane_id() { int l; asm volatile("v_mbcnt_lo_u32_b32 %0, -1, 0\n\tv_mbcnt_hi_u32_b32 %0, -1, %0" : "=v"(l)); return l; }
template <int CTRL, int RM> __device__ __forceinline__ float dppf(float ident, float v) {
    return __builtin_bit_cast(float, __builtin_amdgcn_update_dpp(__builtin_bit_cast(int, ident), __builtin_bit_cast(int, v), CTRL, RM, 0xf, false)); }
__device__ __forceinline__ float wave_scan_add(float v) {
    v += dppf<0x111, 0xf>(0.f, v); v += dppf<0x112, 0xf>(0.f, v); v += dppf<0x114, 0xf>(0.f, v); v += dppf<0x118, 0xf>(0.f, v);
    v += dppf<0x142, 0xa>(0.f, v); v += dppf<0x143, 0xc>(0.f, v); return v; }
__device__ __forceinline__ float wave_scan_max(float v) {
    v = fmaxf(v, dppf<0x111, 0xf>(-3.0e38f, v)); v = fmaxf(v, dppf<0x112, 0xf>(-3.0e38f, v)); v = fmaxf(v, dppf<0x114, 0xf>(-3.0e38f, v)); v = fmaxf(v, dppf<0x118, 0xf>(-3.0e38f, v));
    v = fmaxf(v, dppf<0x142, 0xa>(-3.0e38f, v)); v = fmaxf(v, dppf<0x143, 0xc>(-3.0e38f, v)); return v; }
__device__ __forceinline__ float sigmoidf_(float x) { return 1.0f / (1.0f + __expf(-x)); }

#define XB_TMO      128
#define XB_XCNT(j)  (256  + 64 * (j))
#define XB_XSUB(j)  (1280 + 64 * (j))
#define XB_XGEN(j)  (2304 + 64 * (j))
#define XB_TOP      3328
#define XB_TOPGEN   3392
#define XCD_BAR_WORDS 3456
#define XB_SPIN_CAP (1u << 18)

__device__ __forceinline__ unsigned xb_ld(unsigned* p)              { return __hip_atomic_load(p, __ATOMIC_RELAXED, __HIP_MEMORY_SCOPE_AGENT); }
__device__ __forceinline__ unsigned xb_add(unsigned* p, unsigned v) { return __hip_atomic_fetch_add(p, v, __ATOMIC_RELAXED, __HIP_MEMORY_SCOPE_AGENT); }
__device__ __forceinline__ unsigned xb_xcc_id() { return (unsigned)__builtin_amdgcn_s_getreg((3 << 11) | 20) & 0xFu; }
#define XB_SPIN(cond, bar) do { unsigned _sp = 0; while (cond) { __builtin_amdgcn_s_sleep(1); \
    if ((++_sp & 255u) == 0u) { if (xb_ld(&(bar)[XB_TMO])) break; if (_sp > XB_SPIN_CAP) { atomicAdd(&(bar)[XB_TMO], 1u); break; } } } } while (0)

struct XcdBarrier {
    unsigned* bar; unsigned x;
    volatile LAS unsigned* st;
    int wid;
};
#define XB_THREAD0(b) ((b).wid == 0 && lane_id() == 0)
__device__ __forceinline__ XcdBarrier xcd_barrier_post(unsigned* bar, volatile LAS unsigned* st, int wid) {
    XcdBarrier b; b.bar = bar; b.x = xb_xcc_id(); b.st = st; b.wid = wid;
    if (XB_THREAD0(b)) (void)xb_add(&bar[XB_XCNT(b.x)], 1u);
    return b;
}
__device__ __forceinline__ void xcd_barrier_complete(unsigned* bar, unsigned x, unsigned& nloc, unsigned& nx) {
    const unsigned G = gridDim.x * gridDim.y * gridDim.z;
    unsigned sum, cnt, mine, sp = 0u;
    for (;;) {
        sum = 0u; cnt = 0u; mine = 0u;
#pragma unroll
        for (unsigned j = 0; j < 16; ++j) { const unsigned c = xb_ld(&bar[XB_XCNT(j)]); sum += c; cnt += (c > 0u) ? 1u : 0u; mine = (j == x) ? c : mine; }
        if (sum == G) break;
        __builtin_amdgcn_s_sleep(1);
        if ((++sp & 255u) == 0u) { if (xb_ld(&bar[XB_TMO])) break; if (sp > XB_SPIN_CAP) { atomicAdd(&bar[XB_TMO], 1u); break; } }
    }
    nloc = mine > 0u ? mine : 1u; nx = cnt > 0u ? cnt : 1u;
}
__device__ __forceinline__ void xcd_barrier(const XcdBarrier& b) {
    asm volatile("s_waitcnt vmcnt(0)" ::: "memory");
    __syncthreads();
    if (XB_THREAD0(b)) {
        unsigned* bar = b.bar;
        __builtin_amdgcn_s_waitcnt(0);
        unsigned nloc = b.st[0], nx = b.st[1];
        if (nloc == 0u) { xcd_barrier_complete(bar, b.x, nloc, nx); b.st[0] = nloc; b.st[1] = nx; }
        const unsigned old = xb_add(&bar[XB_XSUB(b.x)], 1u);
        const unsigned gen = old / nloc;
        if (old + 1u == (gen + 1u) * nloc) {
            __builtin_amdgcn_fence(__ATOMIC_RELEASE, "agent");
            asm volatile("s_waitcnt vmcnt(0)" ::: "memory");
            const unsigned og = xb_add(&bar[XB_TOP], 1u);
            const unsigned tg = og / nx;
            if (og + 1u == (tg + 1u) * nx) xb_add(&bar[XB_TOPGEN], 1u);
            else XB_SPIN(xb_ld(&bar[XB_TOPGEN]) == tg, bar);
            __builtin_amdgcn_fence(__ATOMIC_ACQUIRE, "agent");
            xb_add(&bar[XB_XGEN(b.x)], 1u);
            asm volatile("s_waitcnt vmcnt(0)" ::: "memory");
        } else {
            XB_SPIN(xb_ld(&bar[XB_XGEN(b.x)]) == gen, bar);
            __builtin_amdgcn_fence(__ATOMIC_ACQUIRE, "agent");
            asm volatile("s_waitcnt vmcnt(0)" ::: "memory");
        }
    }
    __syncthreads();
}

namespace pg8 {
constexpr int BM = 256, BK = 64, HALF = 128, HTB = HALF * BK * 2, STAGE_BYTES = 8 * HTB, NXCD = 8, WGM = 4;
__device__ __forceinline__ int lds_byte(int r, int c) { const int st = (r >> 4) * 2 + (c >> 5), rr = r & 15, cc = c & 31, ob = rr * 64 + cc * 2; return st * 1024 + (ob ^ (((ob >> 9) & 1) << 5)); }
__device__ __forceinline__ void stage_rc(int b, int& R, int& C) { const int st = b / 1024, sb = b % 1024, swz = sb ^ (((sb >> 9) & 1) << 5); R = (st >> 1) * 16 + swz / 64; C = (st & 1) * 32 + (swz % 64) / 2; }
__device__ __forceinline__ int perm32(int rho) { const int n = rho >> 4, i = rho & 15; return 8 * (i >> 2) + 4 * n + (i & 3); }

struct Unit { int pm, pn; unsigned B; int g; int par; };

__device__ __forceinline__ void tile_map(int L, int nM, int nN, int& pm, int& pn, const int WGM = pg8::WGM) {
    const int nwg = nM * nN; int wgid = L;
    { const int q = nwg / NXCD, r = nwg % NXCD, xcd = wgid % NXCD, off = wgid / NXCD; wgid = (xcd < r ? xcd * (q + 1) : r * (q + 1) + (xcd - r) * q) + off; }
    const int nig = WGM * nN, gid = wgid / nig, fm = gid * WGM, gsz = (nM - fm) < WGM ? (nM - fm) : WGM;
    pm = fm + ((wgid % nig) % gsz); pn = (wgid % nig) / gsz;
}

typedef int i32x8 __attribute__((ext_vector_type(8)));
template <bool FP8, class Epi, class Sched>
__device__ __forceinline__ void gemm_phase(LAS unsigned char* lds, const int wid, const char* Abase, const char* Bbase, const int KB, const Sched& S, const Epi& E, const int skew_ticks  ) {
    const int lane = lane_id(), tid = wid * 64 + lane, wr = wid >> 2, wc = wid & 3, fr = lane & 15, fq = lane >> 4;
    const int nt = KB / 128;
    int R0, C0; stage_rc(tid * 16, R0, C0);
    unsigned voffB[2];
#pragma unroll
    for (int i = 0; i < 2; ++i) { const int R = R0 + 64 * i; const int Rb = Epi::PERM ? (Epi::WIDE ? ((R >> 5) * 64 + perm32(R & 31)) : ((R & ~31) + perm32(R & 31))) : R; voffB[i] = (unsigned)(Rb * KB + C0 * 2); }
    const unsigned kstep = (unsigned)(BK * 2);
    const unsigned hstep = (unsigned)(HALF * KB);
    const unsigned hstepB = Epi::WIDE ? (unsigned)(32 * KB) : hstep;
    const __amdgpu_buffer_rsrc_t rsA = __builtin_amdgcn_make_buffer_rsrc((void*)Abase, (short)0, 0x7ffff000, 0x00020000);
    const __amdgpu_buffer_rsrc_t rsB = __builtin_amdgcn_make_buffer_rsrc((void*)Bbase, (short)0, 0x7ffff000, 0x00020000);
    const unsigned ldsw = (unsigned)wid * 1024u;
    const int aoff = lds_byte(wr * 64 + fr, fq * 8), boff = lds_byte(wc * 32 + fr, fq * 8);
#define PG8_SA(b, h) (((b) * 2 + (h)) * HTB)
#define PG8_SB(b, h) ((4 + (b) * 2 + (h)) * HTB)
#define PG8_STAGE(bufoff, soff, voff) do { _Pragma("unroll") for (int _i = 0; _i < 2; ++_i) \
        __builtin_amdgcn_raw_ptr_buffer_load_lds(rsB, (LAS unsigned*)(lds + (bufoff) + ldsw + _i * 8192), 16, (int)(voff)[_i], (int)(soff), 0, 0); } while (0)
#define PG8_STAGE_A(bufoff, o0, o1, soff) do { \
        __builtin_amdgcn_raw_ptr_buffer_load_lds(rsA, (LAS unsigned*)(lds + (bufoff) + ldsw), 16, (int)(o0), (int)(soff), 0, 0); \
        __builtin_amdgcn_raw_ptr_buffer_load_lds(rsA, (LAS unsigned*)(lds + (bufoff) + ldsw + 8192), 16, (int)(o1), (int)(soff), 0, 0); } while (0)
#define PG8_LDA(dst, b, h) do { _Pragma("unroll") for (int m = 0; m < 4; ++m) _Pragma("unroll") for (int k = 0; k < 2; ++k) dst[m][k] = *(const LAS bf16x8*)(lds + PG8_SA(b, h) + aoff + m * 2048 + k * 1024); } while (0)
#define PG8_LDB(dst, b, h) do { _Pragma("unroll") for (int n = 0; n < 2; ++n) _Pragma("unroll") for (int k = 0; k < 2; ++k) dst[n][k] = *(const LAS bf16x8*)(lds + PG8_SB(b, h) + boff + n * 2048 + k * 1024); } while (0)
#define PG8_MMA(ai, bj, At, Bt) do { __builtin_amdgcn_s_setprio(1); \
        if constexpr (FP8) { _Pragma("unroll") for (int m = 0; m < 4; ++m) _Pragma("unroll") for (int n = 0; n < 2; ++n) { \
            const u32x4 _b0 = __builtin_bit_cast(u32x4, Bt[n][0]), _b1 = __builtin_bit_cast(u32x4, Bt[n][1]), _a0 = __builtin_bit_cast(u32x4, At[m][0]), _a1 = __builtin_bit_cast(u32x4, At[m][1]); \
            const i32x8 _bb = {(int)_b0.x, (int)_b0.y, (int)_b0.z, (int)_b0.w, (int)_b1.x, (int)_b1.y, (int)_b1.z, (int)_b1.w}, _aa = {(int)_a0.x, (int)_a0.y, (int)_a0.z, (int)_a0.w, (int)_a1.x, (int)_a1.y, (int)_a1.z, (int)_a1.w}; \
            acc[ai][bj][m][n] = __builtin_amdgcn_mfma_scale_f32_16x16x128_f8f6f4(_bb, _aa, acc[ai][bj][m][n], 0, 0, 0, 0, 0, 0); } } \
        else { _Pragma("unroll") for (int m = 0; m < 4; ++m) _Pragma("unroll") for (int n = 0; n < 2; ++n) _Pragma("unroll") for (int k = 0; k < 2; ++k) \
            acc[ai][bj][m][n] = __builtin_amdgcn_mfma_f32_16x16x32_bf16(Bt[n][k], At[m][k], acc[ai][bj][m][n], 0, 0, 0); } \
        __builtin_amdgcn_s_setprio(0); } while (0)
#define PG8_WAIT_V(n) asm volatile("s_waitcnt vmcnt(" #n ")" ::: "memory")
#define PG8_WAIT_L(n) asm volatile("s_waitcnt lgkmcnt(" #n ")" ::: "memory")
#define PG8_BAR __builtin_amdgcn_s_barrier()
#define PG8_SCHED __builtin_amdgcn_sched_barrier(0)
    Unit cur, nxt; int ui = 0;
    if (!S.next(0, cur)) return;
    if (skew_ticks > 0) { const unsigned long long t0 = __builtin_amdgcn_s_memrealtime(); while (__builtin_amdgcn_s_memrealtime() - t0 < (unsigned long long)skew_ticks) __builtin_amdgcn_s_sleep(8); }
    f32x4 acc[2][2][4][2];
#pragma unroll
    for (int a = 0; a < 2; ++a)
#pragma unroll
        for (int b = 0; b < 2; ++b)
#pragma unroll
            for (int m = 0; m < 4; ++m)
#pragma unroll
                for (int n = 0; n < 2; ++n) acc[a][b][m][n] = (f32x4){0.f, 0.f, 0.f, 0.f};
    bf16x8 At[4][2], B0[2][2], B1[2][2];
    unsigned voffA[2]; voffA[0] = (unsigned)(R0 * KB + C0 * 2); voffA[1] = voffA[0] + (unsigned)(64 * KB);
    unsigned oc00 = 0, oc01 = 0, oc10 = 0, oc11 = 0;
    int nvr = -1;
    __amdgpu_buffer_rsrc_t rsT = rsA;
    if constexpr (Sched::GATHER) rsT = __builtin_amdgcn_make_buffer_rsrc((void*)S.tok_base(), (short)0, 16 * RT_STRIDE * 4, 0x00020000);
    unsigned cA = 0, nA = 0;
    if constexpr (Sched::GATHER) { S.aoff(cur, R0, C0, oc00, oc01, oc10, oc11); asm volatile("" : "+v"(oc00), "+v"(oc01), "+v"(oc10), "+v"(oc11)); }
    else cA = S.abase(cur);
    cur.par = 0;
    if constexpr (Sched::UNIT_DMA) { if (wid == 0) S.unit_dma(cur, lds + STAGE_BYTES, lane); }
#define PG8_STA(bufoff, ptr, h, kb) do { if constexpr (Sched::GATHER) { if ((h) == 0) PG8_STAGE_A(bufoff, oc00, oc01, kb); else PG8_STAGE_A(bufoff, oc10, oc11, kb); } \
        else PG8_STAGE_A(bufoff, voffA[0], voffA[1], (ptr) + (unsigned)(h) * hstep + (unsigned)(kb)); } while (0)
    unsigned cB = cur.B;
    PG8_STAGE(PG8_SB(0, 0), cB, voffB); PG8_STA(PG8_SA(0, 0), cA, 0, 0); PG8_STAGE(PG8_SB(0, 1), cB + hstepB, voffB); PG8_STA(PG8_SA(0, 1), cA, 1, 0);
    if (wr == 1) PG8_BAR;
    PG8_WAIT_V(4); PG8_BAR;
    PG8_STAGE(PG8_SB(1, 0), cB + kstep, voffB); PG8_STA(PG8_SA(1, 0), cA, 0, kstep); PG8_STAGE(PG8_SB(1, 1), cB + hstepB + kstep, voffB);
    PG8_WAIT_V(6); PG8_BAR;
    for (;;) {
        const bool has_next = S.next(ui + 1, nxt); nxt.par = (ui + 1) & 1;
        if constexpr (Sched::GATHER) {
            nvr = has_next ? S.valid_rows(nxt) : -1;
            if (has_next && wid == 0) __builtin_amdgcn_raw_ptr_buffer_load_lds(rsT, (LAS unsigned*)(lds + STAGE_BYTES), 16, lane * 16, (int)S.tokoff(nxt), 0, 0);
        } else nA = has_next ? S.abase(nxt) : cA;
        const unsigned nB = has_next ? nxt.B : cB;
#pragma unroll 1
        for (int t = 0; t < nt; t += 2) {
            const bool last = (t == nt - 2);
            const unsigned k1 = (unsigned)(t + 1) * kstep;
            const unsigned k2 = last ? 0u : (unsigned)(t + 2) * kstep; const unsigned k3 = k2 + kstep;
            const unsigned a2 = last ? nA : cA;
            const unsigned b2 = last ? nB : cB + (unsigned)(t + 2) * kstep; const unsigned b3 = b2 + kstep;
            PG8_LDB(B0, 0, 0); PG8_SCHED; PG8_LDA(At, 0, 0); PG8_STA(PG8_SA(1, 1), cA, 1, k1);
            PG8_WAIT_L(8); PG8_BAR; PG8_WAIT_L(0); PG8_MMA(0, 0, At, B0); PG8_BAR; PG8_SCHED;
            if constexpr (Sched::UNIT_DMA) { if (t == 0 && has_next && wid == 0) S.unit_dma(nxt, lds + STAGE_BYTES, lane); }
            if constexpr (Sched::GATHER) { if (last && nvr >= 0) { const LAS int* lt = (const LAS int*)(lds + STAGE_BYTES);
                const int t00 = R0 < nvr ? lt[R0] : 0, t01 = R0 + 64 < nvr ? lt[R0 + 64] : 0, t10 = R0 + 128 < nvr ? lt[R0 + 128] : 0, t11 = R0 + 192 < nvr ? lt[R0 + 192] : 0;
                oc00 = (unsigned)(t00 * KB + C0 * 2); oc01 = (unsigned)(t01 * KB + C0 * 2); oc10 = (unsigned)(t10 * KB + C0 * 2); oc11 = (unsigned)(t11 * KB + C0 * 2); } }
            PG8_LDB(B1, 0, 1); PG8_STAGE(PG8_SB(0, 0), b2, voffB);
            PG8_BAR; PG8_WAIT_L(0); PG8_MMA(0, 1, At, B1); PG8_BAR;
            PG8_LDA(At, 0, 1); PG8_STA(PG8_SA(0, 0), a2, 0, k2);
            PG8_BAR; PG8_WAIT_L(0); PG8_MMA(1, 0, At, B0); PG8_BAR; PG8_SCHED;
            PG8_STAGE(PG8_SB(0, 1), b2 + hstepB, voffB);
            PG8_WAIT_V(6); PG8_BAR; PG8_MMA(1, 1, At, B1); PG8_BAR;
            PG8_LDB(B0, 1, 0); PG8_SCHED; PG8_LDA(At, 1, 0); PG8_STA(PG8_SA(0, 1), a2, 1, k2);
            PG8_WAIT_L(8); PG8_BAR; PG8_WAIT_L(0); PG8_MMA(0, 0, At, B0); PG8_BAR; PG8_SCHED;
            PG8_LDB(B1, 1, 1); PG8_STAGE(PG8_SB(1, 0), b3, voffB);
            PG8_BAR; PG8_WAIT_L(0); PG8_MMA(0, 1, At, B1); PG8_BAR;
            PG8_LDA(At, 1, 1); PG8_STA(PG8_SA(1, 0), a2, 0, k3);
            PG8_BAR; PG8_WAIT_L(0); PG8_MMA(1, 0, At, B0); PG8_BAR; PG8_SCHED;
            PG8_STAGE(PG8_SB(1, 1), b3 + hstepB, voffB);
            PG8_WAIT_V(6); PG8_BAR; PG8_MMA(1, 1, At, B1); PG8_BAR;
        }
        { const int _l = lane_id(); const int _fr = _l & 15, _fq = _l >> 4;
          E(acc, cur, wr, wc, _fr, _fq); }
        if (!has_next) break;
#pragma unroll
        for (int a = 0; a < 2; ++a)
#pragma unroll
            for (int b = 0; b < 2; ++b)
#pragma unroll
                for (int m = 0; m < 4; ++m)
#pragma unroll
                    for (int n = 0; n < 2; ++n) acc[a][b][m][n] = (f32x4){0.f, 0.f, 0.f, 0.f};
        cur = nxt; cB = nB; cA = nA; ++ui;
    }
    PG8_WAIT_V(0);
    if (wr == 0) PG8_BAR;
    PG8_BAR;
#undef PG8_SA
#undef PG8_SB
#undef PG8_STAGE
#undef PG8_STAGE_A
#undef PG8_STA
#undef PG8_LDA
#undef PG8_LDB
#undef PG8_MMA
#undef PG8_WAIT_V
#undef PG8_WAIT_L
#undef PG8_BAR
#undef PG8_SCHED
}

struct DenseSched {
    static constexpr bool GATHER = false, UNIT_DMA = false;
    int nM, nN, G, c, KB, wgm;
    __device__ __forceinline__ unsigned abase(const Unit& u) const { return (unsigned)(u.pm * 256 * KB); }
    __device__ __forceinline__ bool next(int i, Unit& u) const {
        const long L = (long)i * G + c; if (L >= (long)nM * nN) return false;
        tile_map((int)L, nM, nN, u.pm, u.pn, wgm); u.B = (unsigned)(u.pn * 256 * KB); u.g = 0; return true;
    }
    __device__ __forceinline__ void aoff(const Unit& u, int R0, int C0, unsigned& o00, unsigned& o01, unsigned& o10, unsigned& o11) const {
        const unsigned base = (unsigned)((u.pm * 256 + R0) * KB + C0 * 2), r64 = (unsigned)(64 * KB);
        o00 = base; o01 = base + r64; o10 = base + 2u * r64; o11 = base + 3u * r64;
    }
};
struct InProjL1Sched {
    static constexpr bool GATHER = false, UNIT_DMA = false;
    int G, c;
    __device__ __forceinline__ unsigned abase(const Unit& u) const { return (unsigned)(u.pm * 256 * D * 2); }
    __device__ __forceinline__ bool next(int i, Unit& u) const {
        const int L = i * G + c; if (L >= 3584 + 192) return false;
        if (L < 3584) tile_map(L, 256, 14, u.pm, u.pn);
        else { const int Lc = L - 3584; u.pm = 256 + Lc / 6; u.pn = 6 + Lc % 6; }
        u.B = (unsigned)(u.pn * 256 * D * 2); u.g = 0; return true;
    }
    __device__ __forceinline__ void aoff(const Unit& u, int R0, int C0, unsigned& o00, unsigned& o01, unsigned& o10, unsigned& o11) const {
        const unsigned base = (unsigned)((u.pm * 256 + R0) * D + C0) * 2u, r64 = (unsigned)(64 * D) * 2u;
        o00 = base; o01 = base + r64; o10 = base + 2u * r64; o11 = base + 3u * r64;
    }
};
struct MoeUpSched {
    static constexpr bool GATHER = true, UNIT_DMA = false;
    int G, c; const int* rowtok; const volatile LAS int* tb;
    __device__ __forceinline__ unsigned abase(const Unit&) const { return 0u; }
    __device__ __forceinline__ bool next(int i, Unit& u) const {
        const int T = tb[16]; const int L = i * G + c; if (L >= T * 22) return false;
        tile_map(L, T, 22, u.pm, u.pn, 8); int g = 0;
#pragma unroll
        for (int j = 1; j < 16; ++j) g += (u.pm >= tb[j]) ? 1 : 0;
        u.g = g; u.B = (unsigned)(((g & 7) * 5632 + u.pn * 256) * D); return true;
    }
    __device__ __forceinline__ const int* tok_base() const { return rowtok; }
    __device__ __forceinline__ unsigned tokoff(const Unit& u) const { return (unsigned)((u.g * RT_STRIDE + (u.pm - tb[u.g]) * 256) * 4); }
    __device__ __forceinline__ int valid_rows(const Unit& u) const { return tb[32 + u.g] - (u.pm - tb[u.g]) * 256; }
    __device__ __forceinline__ void aoff(const Unit& u, int R0, int C0, unsigned& o00, unsigned& o01, unsigned& o10, unsigned& o11) const {
        const int s0 = (u.pm - tb[u.g]) * 256 + R0, cnt = tb[32 + u.g]; const int* rt = rowtok + (size_t)u.g * RT_STRIDE;
        const int t00 = s0 < cnt ? rt[s0] : 0, t01 = s0 + 64 < cnt ? rt[s0 + 64] : 0, t10 = s0 + 128 < cnt ? rt[s0 + 128] : 0, t11 = s0 + 192 < cnt ? rt[s0 + 192] : 0;
        o00 = (unsigned)(t00 * D + C0 * 2); o01 = (unsigned)(t01 * D + C0 * 2); o10 = (unsigned)(t10 * D + C0 * 2); o11 = (unsigned)(t11 * D + C0 * 2);
    }
};
struct MoeDownSched {
    static constexpr bool GATHER = false, UNIT_DMA = true;
    int G, c; const volatile LAS int* tb; const int* rowtok; const float* rowgate;
    __device__ __forceinline__ unsigned abase(const Unit& u) const { return (unsigned)(u.pm * 256 * DFF); }
    __device__ __forceinline__ void unit_dma(const Unit& u, LAS unsigned char* side, int lane) const {
        const __amdgpu_buffer_rsrc_t rt = __builtin_amdgcn_make_buffer_rsrc((void*)rowtok, (short)0, 16 * RT_STRIDE * 4, 0x00020000);
        const __amdgpu_buffer_rsrc_t rg = __builtin_amdgcn_make_buffer_rsrc((void*)rowgate, (short)0, 16 * RT_STRIDE * 4, 0x00020000);
        const int off = (u.g * RT_STRIDE + (u.pm - tb[u.g]) * 256) * 4;
        __builtin_amdgcn_raw_ptr_buffer_load_lds(rt, (LAS unsigned*)(side + u.par * 2048), 16, lane * 16, off, 0, 0);
        __builtin_amdgcn_raw_ptr_buffer_load_lds(rg, (LAS unsigned*)(side + u.par * 2048 + 1024), 16, lane * 16, off, 0, 0);
    }
    __device__ __forceinline__ bool next(int i, Unit& u) const {
        const int T = tb[16]; const int L = i * G + c; if (L >= T * 4) return false;
        tile_map(L, T, 4, u.pm, u.pn); int g = 0;
#pragma unroll
        for (int j = 1; j < 16; ++j) g += (u.pm >= tb[j]) ? 1 : 0;
        u.g = g; u.B = (unsigned)(((g & 7) * D + u.pn * 256) * DFF); return true;
    }
};

struct EpiProj {
    static constexpr bool PERM = true, WIDE = true;
    bf16_t* P; bool dry;
    __device__ __forceinline__ void operator()(const f32x4 (&acc)[2][2][4][2], const Unit& u, int wr, int wc, int fr, int fq) const {
        if (dry) {
#pragma unroll
            for (int ai = 0; ai < 2; ++ai)
#pragma unroll
                for (int bj = 0; bj < 2; ++bj)
#pragma unroll
                    for (int m = 0; m < 4; ++m) asm volatile("" :: "v"(acc[ai][bj][m][0]), "v"(acc[ai][bj][m][1]));
            return; }
        const int row0 = u.pm * BM + wr * 64 + fr;
        if (u.pn >= 2 && u.pn < 6) {
            const int col0 = 512 + (u.pn - 2) * HALF + wc * 32 + 8 * fq;
#pragma unroll
            for (int ai = 0; ai < 2; ++ai)
#pragma unroll
                for (int m = 0; m < 4; ++m) { const f32x4 z0 = acc[ai][0][m][0] * acc[ai][1][m][0], z1 = acc[ai][0][m][1] * acc[ai][1][m][1];
                    u32x4 w; w.x = cvt_pk_bf16(z0[0], z0[1]); w.y = cvt_pk_bf16(z0[2], z0[3]); w.z = cvt_pk_bf16(z1[0], z1[1]); w.w = cvt_pk_bf16(z1[2], z1[3]);
                    *(u32x4*)(P + (size_t)(row0 + ai * HALF + m * 16) * NPO + col0) = w; }
            return; }
        const int colb = (u.pn < 2 ? u.pn * BM : u.pn * BM - 512) + wc * 64 + (fr < 8 ? 0 : 32) + 8 * fq; const bool lo = fr < 8;
#pragma unroll
        for (int ai = 0; ai < 2; ++ai)
#pragma unroll
            for (int m = 0; m < 4; ++m) { u32x4 a, b;
                { const f32x4 v0 = acc[ai][0][m][0], v1 = acc[ai][0][m][1]; a.x = cvt_pk_bf16(v0[0], v0[1]); a.y = cvt_pk_bf16(v0[2], v0[3]); a.z = cvt_pk_bf16(v1[0], v1[1]); a.w = cvt_pk_bf16(v1[2], v1[3]); }
                { const f32x4 v0 = acc[ai][1][m][0], v1 = acc[ai][1][m][1]; b.x = cvt_pk_bf16(v0[0], v0[1]); b.y = cvt_pk_bf16(v0[2], v0[3]); b.z = cvt_pk_bf16(v1[0], v1[1]); b.w = cvt_pk_bf16(v1[2], v1[3]); }
                u32x4 x = lo ? b : a, y;
                y.x = (unsigned)__builtin_amdgcn_update_dpp(0, (int)x.x, 0x128, 0xf, 0xf, false); y.y = (unsigned)__builtin_amdgcn_update_dpp(0, (int)x.y, 0x128, 0xf, 0xf, false);
                y.z = (unsigned)__builtin_amdgcn_update_dpp(0, (int)x.z, 0x128, 0xf, 0xf, false); y.w = (unsigned)__builtin_amdgcn_update_dpp(0, (int)x.w, 0x128, 0xf, 0xf, false);
                const u32x4 first = lo ? a : y, second = lo ? y : b;
                bf16_t* rowp = P + (size_t)(u.pm * BM + wr * 64 + ai * HALF + m * 16 + (fr & 7)) * NPO + colb;
                *(u32x4*)rowp = first; *(u32x4*)(rowp + (size_t)8 * NPO) = second; }
    }
};
struct EpiResid {
    static constexpr bool PERM = true, WIDE = true;
    bf16_t* HB; const float* gate; float gscale;
    __device__ __forceinline__ void operator()(const f32x4 (&acc)[2][2][4][2], const Unit& u, int wr, int wc, int fr, int fq) const {
        if (PROBE_DRY && gscale == 0.f) {
#pragma unroll
            for (int ai = 0; ai < 2; ++ai)
#pragma unroll
                for (int bj = 0; bj < 2; ++bj)
#pragma unroll
                    for (int m = 0; m < 4; ++m) asm volatile("" :: "v"(acc[ai][bj][m][0]), "v"(acc[ai][bj][m][1]));
            return; }
        const int rowg = u.pm * BM; const bool isc = rowg >= NL;
        const int bidx = isc ? 32 : (rowg >> 11);
        const bool lo = fr < 8;
        const int colw = u.pn * BM + wc * 64 + 8 * fq;
        const float* gv = gate + (size_t)bidx * 6144 + colw;
        bf16_t* out = HB + (size_t)(rowg + wr * 64 + (fr & 7)) * D + colw + (lo ? 0 : 32);
        u32x4 r[2][4][2];
#pragma unroll
        for (int ai = 0; ai < 2; ++ai)
#pragma unroll
            for (int m = 0; m < 4; ++m)
#pragma unroll
                for (int h = 0; h < 2; ++h) r[ai][m][h] = *(const u32x4*)(out + (size_t)(ai * HALF + m * 16 + 8 * h) * D);
        f32x4 g[2][2];
#pragma unroll
        for (int bj = 0; bj < 2; ++bj)
#pragma unroll
            for (int n = 0; n < 2; ++n) g[bj][n] = *(const f32x4*)(gv + bj * 32 + n * 4) * gscale;
#pragma unroll
        for (int ai = 0; ai < 2; ++ai)
#pragma unroll
            for (int m = 0; m < 4; ++m) {
                const f32x4 a0 = g[0][0] * acc[ai][0][m][0], a1 = g[0][1] * acc[ai][0][m][1], b0 = g[1][0] * acc[ai][1][m][0], b1 = g[1][1] * acc[ai][1][m][1];
                float x[8], y[8];
#pragma unroll
                for (int i = 0; i < 4; ++i) { x[i] = lo ? b0[i] : a0[i]; x[4 + i] = lo ? b1[i] : a1[i]; }
#pragma unroll
                for (int i = 0; i < 8; ++i) y[i] = __builtin_bit_cast(float, __builtin_amdgcn_update_dpp(0, __builtin_bit_cast(int, x[i]), 0x128, 0xf, 0xf, false));
                float f[8], s2[8];
#pragma unroll
                for (int i = 0; i < 4; ++i) { f[i] = lo ? a0[i] : y[i]; f[4 + i] = lo ? a1[i] : y[4 + i]; s2[i] = lo ? y[i] : b0[i]; s2[4 + i] = lo ? y[4 + i] : b1[i]; }
#pragma unroll
                for (int h = 0; h < 2; ++h) { const u32x4 rr = r[ai][m][h]; const float* v = h ? s2 : f;
                    u32x4 w; w.x = cvt_pk_bf16(bflo(rr.x) + v[0], bfhi(rr.x) + v[1]); w.y = cvt_pk_bf16(bflo(rr.y) + v[2], bfhi(rr.y) + v[3]);
                    w.z = cvt_pk_bf16(bflo(rr.z) + v[4], bfhi(rr.z) + v[5]); w.w = cvt_pk_bf16(bflo(rr.w) + v[6], bfhi(rr.w) + v[7]);
                    *(u32x4*)(out + (size_t)(ai * HALF + m * 16 + 8 * h) * D) = w; } }
    }
};
__device__ __forceinline__ float clamp448(float x) { return fminf(fmaxf(x, -448.0f), 448.0f); }
struct EpiSwiglu {
    static constexpr bool PERM = true, WIDE = false;
    unsigned char* ACT; float iscale, oscale;
    __device__ __forceinline__ void operator()(const f32x4 (&acc)[2][2][4][2], const Unit& u, int wr, int wc, int fr, int fq) const {
        if (PROBE_DRY && oscale == 0.f) {
#pragma unroll
            for (int ai = 0; ai < 2; ++ai)
#pragma unroll
                for (int bj = 0; bj < 2; ++bj)
#pragma unroll
                    for (int m = 0; m < 4; ++m) asm volatile("" :: "v"(acc[ai][bj][m][0]), "v"(acc[ai][bj][m][1]));
            return; }
        const int row0 = u.pm * BM + wr * 64 + fr, col0 = u.pn * HALF + wc * 32 + 8 * fq;
        const float c1 = -1.4426950408889634f * iscale, kk = oscale == 0.f ? 1.0e30f : 1.0f / (iscale * iscale * oscale);
#pragma unroll
        for (int ai = 0; ai < 2; ++ai)
#pragma unroll
            for (int m = 0; m < 4; ++m) { unsigned char* rowp = ACT + (size_t)(row0 + ai * HALF + m * 16) * DFF + col0;
                float o[8];
#pragma unroll
                for (int n = 0; n < 2; ++n)
#pragma unroll
                    for (int h2 = 0; h2 < 2; ++h2) {
                        const f32x2 a = {acc[ai][0][m][n][2 * h2], acc[ai][0][m][n][2 * h2 + 1]}, b = {acc[ai][1][m][n][2 * h2], acc[ai][1][m][n][2 * h2 + 1]};
                        const f32x2 t = a * c1; f32x2 e; e.x = __builtin_amdgcn_exp2f(t.x); e.y = __builtin_amdgcn_exp2f(t.y);
                        const f32x2 d = e * kk + kk; f32x2 r; r.x = __builtin_amdgcn_rcpf(d.x); r.y = __builtin_amdgcn_rcpf(d.y);
                        const f32x2 p = (a * b) * r;
                        o[n * 4 + 2 * h2] = __builtin_amdgcn_fmed3f(p.x, -448.0f, 448.0f); o[n * 4 + 2 * h2 + 1] = __builtin_amdgcn_fmed3f(p.y, -448.0f, 448.0f); }
                int w0 = 0, w1 = 0;
                w0 = __builtin_amdgcn_cvt_pk_fp8_f32(o[0], o[1], w0, false); w0 = __builtin_amdgcn_cvt_pk_fp8_f32(o[2], o[3], w0, true);
                w1 = __builtin_amdgcn_cvt_pk_fp8_f32(o[4], o[5], w1, false); w1 = __builtin_amdgcn_cvt_pk_fp8_f32(o[6], o[7], w1, true);
                *(u32x2*)rowp = (u32x2){(unsigned)w0, (unsigned)w1}; }
    }
};
struct EpiMoeDown {
    static constexpr bool PERM = true, WIDE = false;
    unsigned char* Y0; unsigned char* Y1; const LAS unsigned char* side; const volatile LAS int* tb; float gscale;
    __device__ __forceinline__ void operator()(const f32x4 (&acc)[2][2][4][2], const Unit& u, int wr, int wc, int fr, int fq) const {
        const int nv = tb[32 + u.g] - (u.pm - tb[u.g]) * 256;
        const LAS int* lt = (const LAS int*)(side + u.par * 2048); const LAS float* lg = (const LAS float*)(side + u.par * 2048 + 1024);
        unsigned char* Y = u.g < 8 ? Y0 : Y1;
        const int col0 = u.pn * BM + wc * 32 + 8 * fq;
        int tok[2][4]; float gt[2][4]; bool ok[2][4];
#pragma unroll
        for (int ai = 0; ai < 2; ++ai)
#pragma unroll
            for (int m = 0; m < 4; ++m) { const int rl = ai * HALF + wr * 64 + m * 16 + fr; ok[ai][m] = rl < nv; const int tk = lt[rl]; const float gg = lg[rl]; tok[ai][m] = ok[ai][m] ? tk : 0; gt[ai][m] = ok[ai][m] ? gg * gscale : 0.f; }
#pragma unroll
        for (int ai = 0; ai < 2; ++ai)
#pragma unroll
            for (int m = 0; m < 4; ++m) if (ok[ai][m]) { unsigned char* yp = Y + (size_t)tok[ai][m] * D + col0; const float gg = gt[ai][m];
#pragma unroll
                for (int bj = 0; bj < 2; ++bj) { const f32x4 a0 = acc[ai][bj][m][0] * gg, a1 = acc[ai][bj][m][1] * gg; int w0 = 0, w1 = 0;
                    w0 = __builtin_amdgcn_cvt_pk_fp8_f32(clamp448(a0[0]), clamp448(a0[1]), w0, false); w0 = __builtin_amdgcn_cvt_pk_fp8_f32(clamp448(a0[2]), clamp448(a0[3]), w0, true);
                    w1 = __builtin_amdgcn_cvt_pk_fp8_f32(clamp448(a1[0]), clamp448(a1[1]), w1, false); w1 = __builtin_amdgcn_cvt_pk_fp8_f32(clamp448(a1[2]), clamp448(a1[3]), w1, true);
                    *(u32x2*)(yp + bj * HALF) = (u32x2){(unsigned)w0, (unsigned)w1}; } }
    }
};
}

struct Args { const float* in[21]; float* out; unsigned char* ws; int lo, hi; };
enum { I_X = 0, I_C, I_CTX, I_CCTX, I_N1G, I_N2G, I_WADA, I_BADA, I_WIN, I_CONVW, I_BG, I_MNG, I_WOUT, I_FW1, I_FW3, I_FW2, I_ROUTER, I_MW1, I_MW3, I_MW2, I_FNG };

struct Frame { LAS unsigned char* lds; int wid, G, wg;
    __device__ __forceinline__ int lane() const { return lane_id(); }
    __device__ __forceinline__ int tid() const { return wid * 64 + lane_id(); } };
typedef const __attribute__((address_space(4))) Args* KArgs;
#define KA() ({ KArgs _k = (KArgs)__builtin_amdgcn_kernarg_segment_ptr(); asm volatile("" : "+s"(_k)); _k; })

__device__ __forceinline__ int conv_row(int mode, int n, float& scale) {
    scale = 1.f;
    if (mode == 0) return n;
    if (mode == 1) { if (n >= 2048 && n < 2560) scale = 0.08838834764831845f;
        if (n >= 512 && n < 1024) { const int j = n - 512; return (2 + (j >> 7)) * 256 + ((j & 127) >> 5) * 64 + (j & 31); }
        if (n >= 1024 && n < 1536) { const int j = n - 1024; return (2 + (j >> 7)) * 256 + ((j & 127) >> 5) * 64 + 32 + (j & 31); }
        if (n < 3072) return n; if (n < 3088) return 3584 + (n - 3072); return n - 16; }
    return (n >> 7) * 256 + (n & 127) + (mode == 3 ? 128 : 0);
}
__device__ __forceinline__ void conv_tiles(const Frame& F, const float* src, bf16_t* dst, int K, int N, int mode, float fp8scale  , int& gbase) {
    const int lane = F.lane();
    LAS float* tile = (LAS float*)(F.lds + F.wid * (64 * 65 * 4 + 64));
    const int GW = F.G * 8, gw = F.wg * 8 + F.wid;
    const int tn = (N + 63) / 64, ntile = (K / 64) * tn;
    int t = (gw - gbase) % GW; if (t < 0) t += GW;
    const int row = lane >> 4, c4 = (lane & 15) * 4;
    for (; t < ntile; t += GW) {
        const int k0 = (t / tn) * 64, n0 = (t % tn) * 64;
        f32x4 v[16];
#pragma unroll
        for (int i = 0; i < 16; ++i) { v[i] = (f32x4){0.f, 0.f, 0.f, 0.f}; if (n0 + c4 < N) v[i] = *(const f32x4*)(src + (size_t)(k0 + row + 4 * i) * N + n0 + c4); }
#pragma unroll
        for (int i = 0; i < 16; ++i) { LAS float* p = tile + (row + 4 * i) * 65 + c4; p[0] = v[i][0]; p[1] = v[i][1]; p[2] = v[i][2]; p[3] = v[i][3]; }
        asm volatile("s_waitcnt lgkmcnt(0)" ::: "memory");
#pragma unroll
        for (int p = 0; p < 8; ++p) { const int n = (lane >> 3) + 8 * p, kc = (lane & 7) * 8;
            if (n0 + n < N) { float sc; const int drow = conv_row(mode, n0 + n, sc); float x[8];
#pragma unroll
                for (int j = 0; j < 8; ++j) x[j] = tile[(kc + j) * 65 + n] * sc;
                if (fp8scale == 0.f) {
                    u32x4 w; w.x = cvt_pk_bf16(x[0], x[1]); w.y = cvt_pk_bf16(x[2], x[3]); w.z = cvt_pk_bf16(x[4], x[5]); w.w = cvt_pk_bf16(x[6], x[7]);
                    *(u32x4*)(dst + (size_t)drow * K + k0 + kc) = w;
                } else {
#pragma unroll
                    for (int j = 0; j < 8; ++j) x[j] = fminf(fmaxf(x[j] * fp8scale, -448.0f), 448.0f);
                    int w0 = 0, w1 = 0;
                    w0 = __builtin_amdgcn_cvt_pk_fp8_f32(x[0], x[1], w0, false); w0 = __builtin_amdgcn_cvt_pk_fp8_f32(x[2], x[3], w0, true);
                    w1 = __builtin_amdgcn_cvt_pk_fp8_f32(x[4], x[5], w1, false); w1 = __builtin_amdgcn_cvt_pk_fp8_f32(x[6], x[7], w1, true);
                    *(u32x2*)((unsigned char*)dst + (size_t)drow * K + k0 + kc) = (u32x2){(unsigned)w0, (unsigned)w1};
                } } }
        asm volatile("s_waitcnt lgkmcnt(0)" ::: "memory");
    }
    gbase = (gbase + ntile) % GW;
}
constexpr int P0_JOBS = 20;
__device__ __forceinline__ void conv_job(const Frame& F, int j, int& gbase) {
    KArgs ka = KA(); unsigned char* const ws = ka->ws;
    const float* src; bf16_t* dst; int K, N, mode; float f8 = 0.f;
    if (j < 2)       { src = ka->in[I_WIN] + (size_t)j * D * PIN; dst = (bf16_t*)(ws + WS_WIN) + (size_t)j * NPAD * D; K = D; N = PIN; mode = 1; }
    else if (j < 4)  { src = ka->in[I_WOUT] + (size_t)(j - 2) * D * D; dst = (bf16_t*)(ws + WS_WOUT) + (size_t)(j - 2) * D * D; K = D; N = D; mode = 0; }
    else if (j == 4) { src = ka->in[I_FW1]; dst = (bf16_t*)(ws + WS_WUP); K = D; N = DFF; mode = 2; f8 = S_W13; }
    else if (j == 5) { src = ka->in[I_FW3]; dst = (bf16_t*)(ws + WS_WUP); K = D; N = DFF; mode = 3; f8 = S_W13; }
    else if (j == 6) { src = ka->in[I_FW2]; dst = (bf16_t*)(ws + WS_WDN); K = DFF; N = D; mode = 0; f8 = S_W2; }
    else if (j < 15) { const int e = j - 7;  src = ka->in[I_MW1] + (size_t)e * D * DFF; dst = (bf16_t*)(ws + WS_MUP + (size_t)e * 2 * DFF * D); K = D; N = DFF; mode = 2; f8 = S_W13; }
    else if (j < 23) { const int e = j - 15; src = ka->in[I_MW3] + (size_t)e * D * DFF; dst = (bf16_t*)(ws + WS_MUP + (size_t)e * 2 * DFF * D); K = D; N = DFF; mode = 3; f8 = S_W13; }
    else             { const int e = j - 23; src = ka->in[I_MW2] + (size_t)e * DFF * D; dst = (bf16_t*)(ws + WS_MDN + (size_t)e * D * DFF); K = DFF; N = D; mode = 0; f8 = S_W2; }
    conv_tiles(F, src, dst, K, N, mode, f8, gbase);
}
__device__ __forceinline__ void p0_prologue(const Frame& F, int skip  ) {
    const int tid = F.tid(); KArgs ka = KA(); unsigned char* const ws = ka->ws;
    if (F.wg < 192 && !(skip & 1)) {
        constexpr int SP = 2080;
        for (int idx = tid; idx < 48 * 512; idx += 512) { const int b = idx >> 9, k2 = (idx & 511) * 2; float v0 = 0.f, v1 = 0.f;
            if (b < 33) { const float* cp = b < 32 ? ka->in[I_C] + b * 1024 : ka->in[I_CCTX]; v0 = cp[k2]; v1 = cp[k2 + 1]; v0 = v0 / (1.0f + __expf(-v0)); v1 = v1 / (1.0f + __expf(-v1)); }
            *(LAS unsigned*)(F.lds + b * SP + k2 * 2) = cvt_pk_bf16(v0, v1); }
        __syncthreads();
        const int layer = F.wg / 96, col0 = (F.wg % 96) * 64, g = F.wid;
        const int gl = F.lane(), gfr = gl & 15, gfq = gl >> 4;
        const float* Wu = ka->in[I_WADA] + (size_t)layer * 1024 * 6144 + col0 + (size_t)(g * 128) * 6144;
        const unsigned loff = (unsigned)(gfr + 8 * gfq * 6144);
        float wv[4][4][8];
#pragma unroll
        for (int ks = 0; ks < 4; ++ks)
#pragma unroll
            for (int nt = 0; nt < 4; ++nt)
#pragma unroll
                for (int j = 0; j < 8; ++j) wv[ks][nt][j] = (Wu + (size_t)(32 * ks + j) * 6144 + 16 * nt)[loff];
        f32x4 acc[4][3];
#pragma unroll
        for (int nt = 0; nt < 4; ++nt)
#pragma unroll
            for (int bt = 0; bt < 3; ++bt) acc[nt][bt] = (f32x4){0.f, 0.f, 0.f, 0.f};
#pragma unroll
        for (int ks = 0; ks < 4; ++ks) {
            bf16x8 Bf[3];
#pragma unroll
            for (int bt = 0; bt < 3; ++bt) Bf[bt] = *(const LAS bf16x8*)(F.lds + (16 * bt + gfr) * SP + (g * 128 + 32 * ks + 8 * gfq) * 2);
#pragma unroll
            for (int nt = 0; nt < 4; ++nt) {
                u32x4 aw; aw.x = cvt_pk_bf16(wv[ks][nt][0], wv[ks][nt][1]); aw.y = cvt_pk_bf16(wv[ks][nt][2], wv[ks][nt][3]); aw.z = cvt_pk_bf16(wv[ks][nt][4], wv[ks][nt][5]); aw.w = cvt_pk_bf16(wv[ks][nt][6], wv[ks][nt][7]);
                const bf16x8 Af = __builtin_bit_cast(bf16x8, aw);
#pragma unroll
                for (int bt = 0; bt < 3; ++bt) acc[nt][bt] = __builtin_amdgcn_mfma_f32_16x16x32_bf16(Af, Bf[bt], acc[nt][bt], 0, 0, 0);
            }
        }
        __syncthreads();
        LAS float* red = (LAS float*)F.lds;
#pragma unroll
        for (int nt = 0; nt < 4; ++nt)
#pragma unroll
            for (int bt = 0; bt < 3; ++bt) { const int b = 16 * bt + gfr;
                if (b < 33) {
#pragma unroll
                    for (int r = 0; r < 4; ++r) red[(g * 33 + b) * 64 + 16 * nt + 4 * gfq + r] = acc[nt][bt][r]; } }
        __syncthreads();
        float* MOD = (float*)(ws + WS_MOD); const float* bada = ka->in[I_BADA];
        for (int idx = tid; idx < 33 * 64; idx += 512) { const int b = idx >> 6, cc = idx & 63; float sum = 0.f;
#pragma unroll
            for (int gg = 0; gg < 8; ++gg) sum += red[(gg * 33 + b) * 64 + cc];
            MOD[((size_t)layer * 33 + b) * 6144 + col0 + cc] = sum + bada[layer * 6144 + col0 + cc]; }
        __syncthreads();
    }
    { bf16_t* WIN = (bf16_t*)(ws + WS_WIN);
      for (int l = 0; l < 2; ++l) { u32x4* p = (u32x4*)(WIN + ((size_t)l * NPAD + PIN) * D); const int n16 = (NPAD - PIN) * D * 2 / 16;
          for (int i = F.wg * 512 + tid; i < n16; i += F.G * 512) p[i] = (u32x4){0u, 0u, 0u, 0u}; } }
    int gbase = 0;
    for (int j = 0; j < ((skip & 2) ? 0 : P0_JOBS); ++j) conv_job(F, j, gbase);
}
__device__ __forceinline__ void tail_convert(const Frame& F, int ntiles, int j0, int j1) {
    const int rem = ntiles % F.G; if (F.wg < rem) return;
    Frame F2 = F; F2.G = F.G - rem; F2.wg = F.wg - rem;
    int gbase = 0;
    for (int j = j0; j < j1; ++j) conv_job(F2, j, gbase);
}

template <bool ROUTER, bool OUT8, bool SRC16, bool GATES>
__device__ __forceinline__ void norm_phase(const Frame& F, const float* srcL, const float* srcC  , int nrows, const float* gain, const float* mod  , int chunk_shift, bf16_t* U, const float* router,
                                           const bf16_t* Wg = nullptr, const float* bgate = nullptr, float* GT = nullptr, bf16_t* HBcopy = nullptr  ) {
    const int lane = F.lane(), wid = F.wid, tid = F.tid();
    constexpr int WG_RB = 2080;
    if constexpr (GATES) {
        for (int i = tid; i < 16 * 128; i += 512) { const int n = i >> 7, ch = i & 127; *(LAS u32x4*)(F.lds + n * WG_RB + ch * 16) = *(const u32x4*)(Wg + (size_t)n * D + ch * 8); }
        __syncthreads();
    }
    const int rpw = (nrows + F.G * 8 - 1) / (F.G * 8);
    const int rbase = (F.wg * 8 + wid) * rpw;
    LAS float* rl = (LAS float*)F.lds;
    LAS int* cntl = (LAS int*)(F.lds + 32768);
    LAS int* sel = (LAS int*)(F.lds + 32768 + 256);
    f32x4 rw[ROUTER ? 16 : 1][2];
    if (ROUTER) {
#pragma unroll
        for (int j = 0; j < 4; ++j)
#pragma unroll
            for (int i = 0; i < 4; ++i) { const float* rp = router + (size_t)(j * 256 + lane * 4 + i) * 8; rw[j * 4 + i][0] = *(const f32x4*)rp; rw[j * 4 + i][1] = *(const f32x4*)(rp + 4); }
        if (tid < 32) cntl[tid] = 0;
        __syncthreads();
    }
    f32x4 gn[4];
#pragma unroll
    for (int j = 0; j < 4; ++j) gn[j] = *(const f32x4*)(gain + j * 256 + lane * 4);
    typedef typename std::conditional<SRC16, u32x2, f32x4>::type raw_t;
    constexpr int NB4 = 4;
#define NP_LOAD(dst, row) do { const int _r = (row); _Pragma("unroll") for (int _j = 0; _j < 4; ++_j) { \
        if constexpr (SRC16) dst[_j] = *(const raw_t*)((const bf16_t*)srcL + (size_t)_r * D + _j * 256 + lane * 4); \
        else dst[_j] = *(const raw_t*)((_r >= NL ? srcC + (size_t)(_r - NL) * D : srcL + (size_t)_r * D) + _j * 256 + lane * 4); } } while (0)
    int cur_b = -1; f32x4 shv[4], scv[4];
#pragma unroll
    for (int j = 0; j < 4; ++j) { shv[j] = (f32x4){0.f, 0.f, 0.f, 0.f}; scv[j] = shv[j]; }
    for (int rr0 = 0; rr0 < rpw; rr0 += NB4) {
      if (rbase + rr0 >= nrows) break;
      { const int r = rbase + rr0; const int bidx = (r >= NL) ? 32 : (r >> 11);
        if (bidx != cur_b) { cur_b = bidx; const float* mv = mod + (size_t)bidx * 6144 + chunk_shift * 1024;
#pragma unroll
            for (int j = 0; j < 4; ++j) { shv[j] = *(const f32x4*)(mv + j * 256 + lane * 4); scv[j] = *(const f32x4*)(mv + 1024 + j * 256 + lane * 4) + 1.0f; }
#pragma unroll
            for (int j = 0; j < 4; ++j) asm volatile("" : "+v"(shv[j]), "+v"(scv[j])); } }
      raw_t bt[NB4][4];
#pragma unroll
      for (int q = 0; q < NB4; ++q) { int rl = rbase + rr0 + q; rl = rl < nrows ? rl : nrows - 1; NP_LOAD(bt[q], rl); }
#pragma unroll
      for (int q = 0; q < NB4; ++q) {
        const int rr = rr0 + q; const int r = rbase + rr; if (rr >= rpw || r >= nrows) continue;
        raw_t cr[4];
#pragma unroll
        for (int j = 0; j < 4; ++j) cr[j] = bt[q][j];
        f32x4 x[4]; float ss = 0.f;
#pragma unroll
        for (int j = 0; j < 4; ++j) {
            if constexpr (SRC16) { const u32x2 w = cr[j]; x[j] = (f32x4){bflo(w.x), bfhi(w.x), bflo(w.y), bfhi(w.y)}; }
            else { x[j] = cr[j];
                if (HBcopy) { u32x2 w; w.x = cvt_pk_bf16(x[j][0], x[j][1]); w.y = cvt_pk_bf16(x[j][2], x[j][3]); *(u32x2*)(HBcopy + (size_t)r * D + j * 256 + lane * 4) = w; } }
            ss += x[j][0] * x[j][0] + x[j][1] * x[j][1] + x[j][2] * x[j][2] + x[j][3] * x[j][3]; }
        ss = wave_sum(ss);
        const float rstd = rsqrtf(ss * (1.0f / 1024.0f) + EPS);
        float lg[8];
        if (ROUTER) {
#pragma unroll
            for (int e = 0; e < 8; ++e) lg[e] = 0.f;
        }
#pragma unroll
        for (int j = 0; j < 4; ++j) {
            f32x4 u = (x[j] * rstd * gn[j]) * scv[j] + shv[j];
            if (OUT8) { int w8 = 0; w8 = __builtin_amdgcn_cvt_pk_fp8_f32(fminf(fmaxf(u[0] * S_A, -448.f), 448.f), fminf(fmaxf(u[1] * S_A, -448.f), 448.f), w8, false);
                w8 = __builtin_amdgcn_cvt_pk_fp8_f32(fminf(fmaxf(u[2] * S_A, -448.f), 448.f), fminf(fmaxf(u[3] * S_A, -448.f), 448.f), w8, true);
                *(int*)((unsigned char*)U + (size_t)r * D + j * 256 + lane * 4) = w8; }
            else { u32x2 w; w.x = cvt_pk_bf16(u[0], u[1]); w.y = cvt_pk_bf16(u[2], u[3]);
                *(u32x2*)(U + (size_t)r * D + j * 256 + lane * 4) = w; }
            if (ROUTER) {
#pragma unroll
                for (int i = 0; i < 4; ++i) { const f32x4 r0 = rw[ROUTER ? j * 4 + i : 0][0], r1 = rw[ROUTER ? j * 4 + i : 0][1];
                    lg[0] += u[i] * r0[0]; lg[1] += u[i] * r0[1]; lg[2] += u[i] * r0[2]; lg[3] += u[i] * r0[3];
                    lg[4] += u[i] * r1[0]; lg[5] += u[i] * r1[1]; lg[6] += u[i] * r1[2]; lg[7] += u[i] * r1[3]; }
            }
        }
        if (ROUTER) {
            { const bool h5 = (lane & 32) != 0, h4 = (lane & 16) != 0, h3 = (lane & 8) != 0;
              float a4[4], a2[2], a1;
#pragma unroll
              for (int q = 0; q < 4; ++q) { const float keep = h5 ? lg[4 + q] : lg[q], send = h5 ? lg[q] : lg[4 + q]; a4[q] = keep + __shfl_xor(send, 32); }
#pragma unroll
              for (int q = 0; q < 2; ++q) { const float keep = h4 ? a4[2 + q] : a4[q], send = h4 ? a4[q] : a4[2 + q]; a2[q] = keep + __shfl_xor(send, 16); }
              { const float keep = h3 ? a2[1] : a2[0], send = h3 ? a2[0] : a2[1]; a1 = keep + __shfl_xor(send, 8); }
              a1 += __shfl_xor(a1, 4); a1 += __shfl_xor(a1, 2); a1 += __shfl_xor(a1, 1);
#pragma unroll
              for (int e = 0; e < 8; ++e) lg[e] = __shfl(a1, ((e >> 2) & 1) * 32 + ((e >> 1) & 1) * 16 + (e & 1) * 8); }
            int e0 = 0; float v0 = lg[0];
#pragma unroll
            for (int e = 1; e < 8; ++e) if (lg[e] > v0) { v0 = lg[e]; e0 = e; }
            int e1 = -1; float v1 = -3.0e38f;
#pragma unroll
            for (int e = 0; e < 8; ++e) if (e != e0 && lg[e] > v1) { v1 = lg[e]; e1 = e; }
            if (lane == 0) {
                const float g0 = 1.0f / (1.0f + __expf(v1 - v0)), g1 = 1.0f - g0;
                const int r0 = atomicAdd((int*)(cntl + e0), 1), r1 = atomicAdd((int*)(cntl + 8 + e1), 1);
                LAS int* sp = sel + (wid * rpw + rr) * 6;
                sp[0] = e0 | (e1 << 8); sp[1] = r0; sp[2] = r1; sp[3] = __float_as_int(g0); sp[4] = __float_as_int(g1); sp[5] = r;
            }
        }
      }
    }
    if constexpr (GATES) {
        asm volatile("s_waitcnt vmcnt(0)" ::: "memory");
        const int fr = lane & 15, fq = lane >> 4;
        int nr = nrows - rbase; nr = nr < 0 ? 0 : (nr > rpw ? rpw : nr);
        const f32x4 bias = *(const f32x4*)(bgate + 4 * fq);
        for (int g0 = 0; g0 < nr; g0 += 16) {
            int rl = g0 + fr; if (rl > nr - 1) rl = nr - 1;
            const bf16_t* up = U + (size_t)(rbase + rl) * D + 8 * fq;
            f32x4 a0 = (f32x4){0.f, 0.f, 0.f, 0.f}, a1 = a0;
#pragma unroll 8
            for (int ks = 0; ks < 32; ks += 2) {
                const bf16x8 u0 = *(const bf16x8*)(up + 32 * ks), u1 = *(const bf16x8*)(up + 32 * ks + 32);
                const bf16x8 w0 = *(const LAS bf16x8*)(F.lds + fr * WG_RB + (32 * ks + 8 * fq) * 2), w1 = *(const LAS bf16x8*)(F.lds + fr * WG_RB + (32 * ks + 32 + 8 * fq) * 2);
                a0 = __builtin_amdgcn_mfma_f32_16x16x32_bf16(w0, u0, a0, 0, 0, 0); a1 = __builtin_amdgcn_mfma_f32_16x16x32_bf16(w1, u1, a1, 0, 0, 0);
            }
            if (g0 + fr < nr) *(f32x4*)(GT + (size_t)(rbase + g0 + fr) * 16 + 4 * fq) = a0 + a1 + bias;
        }
    }
    if (ROUTER) {
        __syncthreads();
        unsigned char* const ws = KA()->ws;
        if (tid < 16) { unsigned* gc = (unsigned*)(ws + WS_CTL + CTL_GCNT); cntl[16 + tid] = (int)__hip_atomic_fetch_add(gc + tid, (unsigned)cntl[tid], __ATOMIC_RELAXED, __HIP_MEMORY_SCOPE_AGENT); }
        __syncthreads();
        int* rowtok = (int*)(ws + WS_RTOK); float* rowgate = (float*)(ws + WS_RGATE);
        for (int i = tid; i < 8 * rpw; i += 512) {
            const int w = i / rpw, rr = i % rpw; const int r = (F.wg * 8 + w) * rpw + rr;
            if (r < nrows) { const LAS int* sp = sel + i * 6; const int e0 = sp[0] & 255, e1 = sp[0] >> 8;
                const int p0 = cntl[16 + e0] + sp[1], p1 = cntl[16 + 8 + e1] + sp[2];
                rowtok[(size_t)e0 * RT_STRIDE + p0] = sp[5]; rowgate[(size_t)e0 * RT_STRIDE + p0] = __int_as_float(sp[3]);
                rowtok[(size_t)(8 + e1) * RT_STRIDE + p1] = sp[5]; rowgate[(size_t)(8 + e1) * RT_STRIDE + p1] = __int_as_float(sp[4]); }
        }
        __syncthreads();
    }
}

#undef NP_LOAD
__device__ __forceinline__ void unpack8(const u32x4 w, float (&v)[8]) { v[0] = bflo(w.x); v[1] = bfhi(w.x); v[2] = bflo(w.y); v[3] = bfhi(w.y); v[4] = bflo(w.z); v[5] = bfhi(w.z); v[6] = bflo(w.w); v[7] = bfhi(w.w); }
__device__ __forceinline__ u32x4 pack8(const float (&v)[8]) { u32x4 w; w.x = cvt_pk_bf16(v[0], v[1]); w.y = cvt_pk_bf16(v[2], v[3]); w.z = cvt_pk_bf16(v[4], v[5]); w.w = cvt_pk_bf16(v[6], v[7]); return w; }
__device__ __forceinline__ void mix_phase(const Frame& F, int nrows, const float* gnorm  ) {
    const int lane = F.lane(); unsigned char* const ws = KA()->ws;
    const bf16_t* P = (const bf16_t*)(ws + WS_PROJ); const bf16_t* HL = (const bf16_t*)KA()->out; bf16_t* A2 = (bf16_t*)(ws + WS_U);
    const int rpw = (nrows + F.G * 8 - 1) / (F.G * 8); const int rbase = (F.wg * 8 + F.wid) * rpw;
    if (rbase >= nrows) return;
    float gnv[8];
#pragma unroll
    for (int j = 0; j < 8; ++j) gnv[j] = gnorm[lane * 8 + j];
    u32x4 n_hf, n_hb, n_og;
#define MX_LOAD(r) do { n_og = *(const u32x4*)(P + (size_t)(r) * NPO + 2560 + lane * 8); n_hf = *(const u32x4*)(HL + (size_t)(r) * 512 + lane * 8); n_hb = *(const u32x4*)(HL + (size_t)(MT + (r)) * 512 + lane * 8); } while (0)
    MX_LOAD(rbase);
    for (int rr = 0; rr < rpw; ++rr) {
        const int r = rbase + rr; if (r >= nrows) break;
        const u32x4 c_hf = n_hf, c_hb = n_hb, c_og = n_og;
        if (rr + 1 < rpw && r + 1 < nrows) MX_LOAD(r + 1);
        float hf[8], hb[8], og[8], y[8];
        unpack8(c_hf, hf); unpack8(c_hb, hb); unpack8(c_og, og);
        float ss = 0.f;
#pragma unroll
        for (int j = 0; j < 8; ++j) { hf[j] += hb[j]; ss += hf[j] * hf[j]; }
        ss += __shfl_xor(ss, 1); ss += __shfl_xor(ss, 2); ss += __shfl_xor(ss, 4); ss += __shfl_xor(ss, 8);
        const float rstd = rsqrtf(ss * (1.0f / 128.0f) + EPS);
#pragma unroll
        for (int j = 0; j < 8; ++j) y[j] = hf[j] * rstd * gnv[j] * sigmoidf_(og[j]);
        *(u32x4*)(A2 + (size_t)r * D + 512 + lane * 8) = pack8(y);
    }
#undef MX_LOAD
}

__device__ __forceinline__ void final_phase(const Frame& F) {
    const int lane = F.lane(); KArgs ka = KA(); const float* gain = ka->in[I_FNG]; float* const outp = ka->out;
    const bf16_t* HB = (const bf16_t*)(ka->ws + WS_HB); const unsigned char* Y0 = (const unsigned char*)(ka->ws + WS_U); const unsigned char* Y1 = (const unsigned char*)(ka->ws + WS_Y1);
    const float* g2 = (const float*)(ka->ws + WS_MOD) + 33 * 6144 + 5 * 1024;
    const int rpw = (NL + F.G * 8 - 1) / (F.G * 8); const int rbase = (F.wg * 8 + F.wid) * rpw;
    f32x4 gn[4], gv[4];
#pragma unroll
    for (int j = 0; j < 4; ++j) { gn[j] = *(const f32x4*)(gain + j * 256 + lane * 4); gv[j] = (f32x4){0.f, 0.f, 0.f, 0.f}; }
    int cur_b = -1;
    for (int rr0 = 0; rr0 < rpw; rr0 += 4) {
      if (rbase + rr0 >= NL) break;
      { const int bidx = (rbase + rr0) >> 11;
        if (bidx != cur_b) { cur_b = bidx;
#pragma unroll
            for (int j = 0; j < 4; ++j) gv[j] = *(const f32x4*)(g2 + (size_t)bidx * 6144 + j * 256 + lane * 4) * (1.0f / S_Y);
#pragma unroll
            for (int j = 0; j < 4; ++j) asm volatile("" : "+v"(gv[j])); } }
      u32x2 bx[4][4]; int by[4][4], bz[4][4];
#pragma unroll
      for (int q = 0; q < 4; ++q) { int rl = rbase + rr0 + q; rl = rl < NL ? rl : NL - 1;
#pragma unroll
          for (int j = 0; j < 4; ++j) { bx[q][j] = *(const u32x2*)(HB + (size_t)rl * D + j * 256 + lane * 4); by[q][j] = *(const int*)(Y0 + (size_t)rl * D + j * 256 + lane * 4); bz[q][j] = *(const int*)(Y1 + (size_t)rl * D + j * 256 + lane * 4); } }
#pragma unroll
      for (int q = 0; q < 4; ++q) {
        const int rr = rr0 + q; const int r = rbase + rr; if (rr >= rpw || r >= NL) continue;
        u32x2 cr[4]; int cy[4], cz[4];
#pragma unroll
        for (int j = 0; j < 4; ++j) { cr[j] = bx[q][j]; cy[j] = by[q][j]; cz[j] = bz[q][j]; }
        f32x4 x[4]; float ss = 0.f;
#pragma unroll
        for (int j = 0; j < 4; ++j) { const u32x2 w = cr[j];
            const f32x2 y0 = __builtin_amdgcn_cvt_pk_f32_fp8(cy[j], false), y1 = __builtin_amdgcn_cvt_pk_f32_fp8(cy[j], true), z0 = __builtin_amdgcn_cvt_pk_f32_fp8(cz[j], false), z1 = __builtin_amdgcn_cvt_pk_f32_fp8(cz[j], true);
            x[j] = (f32x4){bflo(w.x), bfhi(w.x), bflo(w.y), bfhi(w.y)} + gv[j] * (f32x4){y0.x + z0.x, y0.y + z0.y, y1.x + z1.x, y1.y + z1.y};
            ss += x[j][0] * x[j][0] + x[j][1] * x[j][1] + x[j][2] * x[j][2] + x[j][3] * x[j][3]; }
        ss = wave_sum(ss);
        const float rstd = rsqrtf(ss * (1.0f / 1024.0f) + EPS);
        float* p = outp + (size_t)r * D;
#pragma unroll
        for (int j = 0; j < 4; ++j) *(f32x4*)(p + j * 256 + lane * 4) = x[j] * rstd * gn[j];
      }
    }
}

constexpr int ML_RB = 288;
constexpr int ML_RBC = 256;
constexpr int ML_Q = 0, ML_K = 36864, ML_V = 73728, ML_CT = 110592, ML_VEC = 145408, ML_CW = 151552;
__device__ __forceinline__ bf16x8 tr_frag2(const LAS unsigned char* base, int rowA, int rowB, int col0, int lane) {
    const int g = lane >> 4, q = (lane & 15) >> 2, p = lane & 3;
    const s16x4 v0 = __builtin_amdgcn_ds_read_tr16_b64_v4i16((LAS s16x4*)(base + (rowA + 4 * g + q) * ML_RB + (col0 + 4 * p) * 2));
    const s16x4 v1 = __builtin_amdgcn_ds_read_tr16_b64_v4i16((LAS s16x4*)(base + (rowB + 4 * g + q) * ML_RB + (col0 + 4 * p) * 2));
    return (bf16x8){v0[0], v0[1], v0[2], v0[3], v1[0], v1[1], v1[2], v1[3]};
}
__device__ __forceinline__ bf16x8 tr_frag(const LAS unsigned char* base, int row0, int col0, int lane) {
    const int g = lane >> 4, q = (lane & 15) >> 2, p = lane & 3;
    const LAS unsigned char* a = base + (row0 + 8 * g + q) * ML_RB + (col0 + 4 * p) * 2;
    const s16x4 v0 = __builtin_amdgcn_ds_read_tr16_b64_v4i16((LAS s16x4*)a);
    const s16x4 v1 = __builtin_amdgcn_ds_read_tr16_b64_v4i16((LAS s16x4*)(a + 4 * ML_RB));
    return (bf16x8){v0[0], v0[1], v0[2], v0[3], v1[0], v1[1], v1[2], v1[3]};
}
__device__ __forceinline__ void mlstm_phase(const Frame& F, bool ctx_out, int skip  ,
                                             int conv_rows  , const float* convw  ) {
    const int lane = F.lane(), wid = F.wid, tid = wid * 64 + lane, fr = lane & 15, fq = lane >> 4;
    LAS unsigned char* lds = F.lds;
    LAS float* ic = (LAS float*)(lds + ML_VEC); LAS float* fc = ic + 128; LAS float* av = ic + 256; LAS float* Mv = ic + 384; LAS float* bcv = ic + 512;
    LAS float* nvec = ic + 640; LAS float* wkv = ic + 768; LAS float* npart = ic + 896;
    LAS float* eav = ic + 1408;
    LAS float* cw = (LAS float*)(lds + ML_CW);
    for (int i = tid; i < 1536; i += 512) cw[i] = convw[i];
    unsigned char* const ws = KA()->ws;
    const bf16_t* P = (const bf16_t*)(ws + WS_PROJ); const float* GT = (const float*)(ws + WS_GATES); bf16_t* HL = (bf16_t*)KA()->out;
    bf16_t* A2 = (bf16_t*)(ws + WS_U);
    const int crpw = (conv_rows + F.G * 8 - 1) / (F.G * 8), crb = (F.wg * 8 + wid) * crpw; int cri = 0;
    int cnr = conv_rows - crb; cnr = cnr < 0 ? 0 : (cnr > crpw ? crpw : cnr);
#define MC_HASL(r) ((r) < NL ? (((r) & 63) != 0) : ((((r) - NL) & 255) != 0))
#define MC_HASR(r) ((r) < NL ? (((r) & 63) != 63) : ((((r) - NL) & 255) != 255))
    float zl[8], zc[8];
#pragma unroll
    for (int j = 0; j < 8; ++j) { zl[j] = 0.f; zc[j] = 0.f; }
    if (cnr > 0) { const bf16_t* pr = P + (size_t)crb * NPO + lane * 8;
        unpack8(*(const u32x4*)(pr + 512), zc);
        if (MC_HASL(crb)) unpack8(*(const u32x4*)(pr - NPO + 512), zl); }
    for (int unit = F.wg; unit < 256; unit += F.G) {
        const int b = unit >> 3, hd = (unit >> 1) & 3, dir = unit & 1;
        f32x4 Cacc[8];
#pragma unroll
        for (int a = 0; a < 8; ++a) Cacc[a] = (f32x4){0.f, 0.f, 0.f, 0.f};
        float m = 0.f, dec_prev = 0.f;
        if (tid < 128) nvec[tid] = 0.f;
        if (tid < 512) npart[tid] = 0.f;
        u32x4 st[12]; float gi = 0.f, gf = 0.f;
#define ML_ROW0(ci) ((ci) < 2 ? NL + b * 256 + (dir ? 1 - (ci) : (ci)) * 128 : b * 2048 + (dir ? 15 - ((ci) - 2) : ((ci) - 2)) * 128)
#define ML_LOAD(ci) do { const int _r0 = ML_ROW0(ci); _Pragma("unroll") for (int _p = 0; _p < 4; ++_p) { const int _id = tid + 512 * _p, _row = _id >> 4, _ch = _id & 15; \
            const bf16_t* _g = P + (size_t)(_r0 + _row) * NPO + 1024 + hd * 128 + _ch * 8; st[_p] = *(const u32x4*)_g; st[4 + _p] = *(const u32x4*)(_g + 512); st[8 + _p] = *(const u32x4*)(_g + 1024); } \
            if (tid < 128) { gi = GT[(size_t)(_r0 + tid) * 16 + (2 * dir) * 4 + hd]; gf = GT[(size_t)(_r0 + tid) * 16 + (2 * dir + 1) * 4 + hd]; } } while (0)
#define ML_BAR() do { asm volatile("s_waitcnt lgkmcnt(0)" ::: "memory"); __builtin_amdgcn_s_barrier(); asm volatile("" ::: "memory"); } while (0)
        ML_LOAD(0);
        __syncthreads();
        for (int ci = 0; ci < 18; ++ci) {
            const int row0 = ML_ROW0(ci);
            const bool need_out = ((ci >= 2) || ctx_out) && !(skip & 1);
            int lane_c = lane; asm volatile("" : "+v"(lane_c));
            const int lane = lane_c, fr = lane & 15, fq = lane >> 4, tid = wid * 64 + lane;
#pragma unroll
            for (int p = 0; p < 4; ++p) { const int id = tid + 512 * p, row = id >> 4, ch = id & 15; const int o = row * ML_RB + ch * 16;
                *(LAS u32x4*)(lds + ML_Q + o) = st[p]; *(LAS u32x4*)(lds + ML_K + o) = st[4 + p]; *(LAS u32x4*)(lds + ML_V + o) = st[8 + p]; }
#pragma unroll
            for (int a = 0; a < 8; ++a) { u32x2 w; w.x = cvt_pk_bf16(Cacc[a][0], Cacc[a][1]); w.y = cvt_pk_bf16(Cacc[a][2], Cacc[a][3]);
                *(LAS u32x2*)(lds + ML_CT + (16 * wid + fr) * ML_RBC + (((2 * a + (fq >> 1)) ^ fr) << 4) + (fq & 1) * 8) = w; }
            if (tid < 128) { ic[tid] = gi; fc[tid] = fminf(gf, 0.f) - __logf(1.0f + __expf(-fabsf(gf)));
                nvec[tid] = dec_prev * nvec[tid] + ((npart[tid] + npart[128 + tid]) + (npart[256 + tid] + npart[384 + tid])); }
            if (ci + 1 < 18 && !(skip & 4)) ML_LOAD(ci + 1);
            ML_BAR();
            float bL, Mlast, amax;
            { const int p0 = 2 * lane, p1 = p0 + 1, s0 = dir ? 127 - p0 : p0, s1 = dir ? 127 - p1 : p1;
              const float f0 = fc[s0], f1 = fc[s1], i0 = ic[s0], i1 = ic[s1];
              const float incl = wave_scan_add(f0 + f1);
              const float bc1 = incl, bc0 = incl - f1;
              const float a0 = i0 - bc0, a1 = i1 - bc1;
              const float im = wave_scan_max(fmaxf(a0, a1));
              float ex = __shfl_up(im, 1); if (lane == 0) ex = -3.0e38f;
              const float M0 = fmaxf(fmaxf(m, ex), a0), M1 = fmaxf(m, im);
              bL = __shfl(incl, 63); Mlast = __shfl(M1, 63); amax = __shfl(im, 63);
              av[s0] = a0; av[s1] = a1; Mv[s0] = M0; Mv[s1] = M1; bcv[s0] = bc0; bcv[s1] = bc1;
              wkv[s0] = __expf(a0 - Mlast); wkv[s1] = __expf(a1 - Mlast);
              eav[s0] = __expf(a0 - amax); eav[s1] = __expf(a1 - amax); }
            if (need_out) {
                int tq = __builtin_amdgcn_readfirstlane(wid < 4 ? 2 * wid : 15 - 2 * wid); asm volatile("" : "+s"(tq));
                const int t = 16 * tq + fr; const float Mt = Mv[t];
                bf16x8 Qf[4];
#pragma unroll
                for (int ks = 0; ks < 4; ++ks) Qf[ks] = *(const LAS bf16x8*)(lds + ML_Q + t * ML_RB + (32 * ks + 8 * fq) * 2);
                float rowsum = 0.f; u32x2 Sp[8];
#pragma unroll
                for (int j = 0; j < 8; ++j) {
                    Sp[j] = (u32x2){0u, 0u};
                    const bool act = dir ? (j >= tq) : (j <= tq);
                    if (act) {
                        f32x4 acc = (f32x4){0.f, 0.f, 0.f, 0.f};
#pragma unroll
                        for (int ks = 0; ks < 4; ++ks) { const bf16x8 Kf = *(const LAS bf16x8*)(lds + ML_K + (16 * j + fr) * ML_RB + (32 * ks + 8 * fq) * 2); acc = __builtin_amdgcn_mfma_f32_16x16x32_bf16(Kf, Qf[ks], acc, 0, 0, 0); }
                        const f32x4 e4 = *(const LAS f32x4*)(eav + 16 * j + 4 * fq);
                        float v[4];
#pragma unroll
                        for (int r = 0; r < 4; ++r) v[r] = acc[r] * e4[r];
                        if (j == tq) {
#pragma unroll
                            for (int r = 0; r < 4; ++r) { const bool valid = dir ? (4 * fq + r >= fr) : (4 * fq + r <= fr); v[r] = valid ? v[r] : 0.f; } }
                        rowsum += (v[0] + v[1]) + (v[2] + v[3]);
                        Sp[j].x = cvt_pk_bf16(v[0], v[1]); Sp[j].y = cvt_pk_bf16(v[2], v[3]);
                    }
                }
                rowsum += __shfl_xor(rowsum, 16); rowsum += __shfl_xor(rowsum, 32);
                float qn = 0.f;
#pragma unroll
                for (int ks = 0; ks < 4; ++ks) { const f32x4 n0 = *(const LAS f32x4*)(nvec + 32 * ks + 8 * fq), n1 = *(const LAS f32x4*)(nvec + 32 * ks + 8 * fq + 4);
#pragma unroll
                    for (int jj = 0; jj < 4; ++jj) { qn += bf2f((unsigned short)Qf[ks][jj]) * n0[jj]; qn += bf2f((unsigned short)Qf[ks][4 + jj]) * n1[jj]; } }
                qn += __shfl_xor(qn, 16); qn += __shfl_xor(qn, 32);
                const float em = __expf(amax - Mt), wi = __expf(m - Mt), den = em * rowsum + wi * qn, rd = 1.0f / fmaxf(fabsf(den), __expf(-(bcv[t] + Mt)));
                const float ems = em * rd, wis = wi * rd;
                bf16x8 Sf[4];
#pragma unroll
                for (int ks = 0; ks < 4; ++ks) { const u32x4 w = (u32x4){Sp[2 * ks].x, Sp[2 * ks].y, Sp[2 * ks + 1].x, Sp[2 * ks + 1].y}; Sf[ks] = __builtin_bit_cast(bf16x8, w); }
                LAS unsigned char* const obuf = lds + ML_Q + 16 * tq * ML_RB;
#pragma unroll 2
                for (int d = 0; d < 8; ++d) {
                    f32x4 aS = (f32x4){0.f, 0.f, 0.f, 0.f}, aC = (f32x4){0.f, 0.f, 0.f, 0.f};
#pragma unroll
                    for (int ks = 0; ks < 4; ++ks) { const bool act = dir ? (2 * ks + 1 >= tq) : (2 * ks <= tq);
                        if (act) { const bf16x8 Vt = tr_frag2(lds + ML_V, 32 * ks, 32 * ks + 16, 16 * d, lane); aS = __builtin_amdgcn_mfma_f32_16x16x32_bf16(Vt, Sf[ks], aS, 0, 0, 0); } }
#pragma unroll
                    for (int kp = 0; kp < 4; ++kp) { const bf16x8 Cf = *(const LAS bf16x8*)(lds + ML_CT + (16 * d + fr) * ML_RBC + (((4 * kp + fq) ^ fr) << 4)); aC = __builtin_amdgcn_mfma_f32_16x16x32_bf16(Cf, Qf[kp], aC, 0, 0, 0); }
                    u32x2 w; w.x = cvt_pk_bf16(ems * aS[0] + wis * aC[0], ems * aS[1] + wis * aC[1]); w.y = cvt_pk_bf16(ems * aS[2] + wis * aC[2], ems * aS[3] + wis * aC[3]);
                    *(LAS u32x2*)(obuf + fr * 272 + (16 * d + 4 * fq) * 2) = w;
                }
#pragma unroll
                for (int i = 0; i < 4; ++i) { const int orow = (lane >> 4) + 4 * i; const u32x4 v = *(const LAS u32x4*)(obuf + orow * 272 + (lane & 15) * 16);
                    *(u32x4*)(HL + ((size_t)dir * MT + row0 + 16 * tq + orow) * 512 + hd * 128 + (lane & 15) * 8) = v; }
            }
            u32x4 c_gb[2], c_gc[2]; int c_n = 0;
            {
                c_n = cnr - cri; c_n = c_n > 2 ? 2 : (c_n < 0 ? 0 : c_n); if (skip & 8) c_n = 0;
#pragma unroll
                for (int q = 0; q < 2; ++q) { int rc = crb + cri + q; rc = rc < conv_rows ? rc : conv_rows - 1;
                    const bf16_t* pr = P + (size_t)rc * NPO + lane * 8; c_gb[q] = *(const u32x4*)pr; c_gc[q] = *(const u32x4*)(pr + NPO + 512); }
                asm volatile("" ::: "memory");
                const float dec = __expf(m - Mlast);
                bf16x8 Vw[4], Wk[4];
#pragma unroll
                for (int ks = 0; ks < 4; ++ks) { const bf16x8 Vf = tr_frag2(lds + ML_V, 32 * ks, 32 * ks + 16, 16 * wid, lane);
                    const f32x4 k0 = *(const LAS f32x4*)(wkv + 32 * ks + 4 * fq), k1 = *(const LAS f32x4*)(wkv + 32 * ks + 16 + 4 * fq);
                    u32x4 w;
                    w.x = cvt_pk_bf16(bf2f((unsigned short)Vf[0]) * k0[0], bf2f((unsigned short)Vf[1]) * k0[1]); w.y = cvt_pk_bf16(bf2f((unsigned short)Vf[2]) * k0[2], bf2f((unsigned short)Vf[3]) * k0[3]);
                    w.z = cvt_pk_bf16(bf2f((unsigned short)Vf[4]) * k1[0], bf2f((unsigned short)Vf[5]) * k1[1]); w.w = cvt_pk_bf16(bf2f((unsigned short)Vf[6]) * k1[2], bf2f((unsigned short)Vf[7]) * k1[3]);
                    Vw[ks] = __builtin_bit_cast(bf16x8, w);
                    u32x4 wq = (u32x4){0u, 0u, 0u, 0u};
                    if (fr == 0) { wq.x = cvt_pk_bf16(k0[0], k0[1]); wq.y = cvt_pk_bf16(k0[2], k0[3]); wq.z = cvt_pk_bf16(k1[0], k1[1]); wq.w = cvt_pk_bf16(k1[2], k1[3]); }
                    Wk[ks] = __builtin_bit_cast(bf16x8, wq); }
                f32x4 nacc = (f32x4){0.f, 0.f, 0.f, 0.f};
                if (!(skip & 2)) {
#pragma unroll
                for (int a = 0; a < 8; ++a) { Cacc[a] = Cacc[a] * dec;
#pragma unroll
                    for (int ks = 0; ks < 4; ++ks) { const bf16x8 Kt = tr_frag2(lds + ML_K, 32 * ks, 32 * ks + 16, 16 * a, lane); Cacc[a] = __builtin_amdgcn_mfma_f32_16x16x32_bf16(Kt, Vw[ks], Cacc[a], 0, 0, 0);
                        if (a == wid) nacc = __builtin_amdgcn_mfma_f32_16x16x32_bf16(Kt, Wk[ks], nacc, 0, 0, 0); } } }
                if (fr == 0) *(LAS f32x4*)(npart + 16 * wid + 4 * fq) = nacc;
                dec_prev = dec;
                m = bL + Mlast;
            }
            asm volatile("" : "+v"(c_gb[0]), "+v"(c_gc[0]), "+v"(c_gb[1]), "+v"(c_gc[1]));
#pragma unroll
            for (int q = 0; q < 2; ++q) if (q < c_n) { const int r = crb + cri + q;
                float gb[8], zr[8], y[8];
                unpack8(c_gb[q], gb); unpack8(c_gc[q], zr);
                const f32x4 wa0 = *(const LAS f32x4*)(cw + lane * 8), wa1 = *(const LAS f32x4*)(cw + lane * 8 + 4), wb0 = *(const LAS f32x4*)(cw + 512 + lane * 8), wb1 = *(const LAS f32x4*)(cw + 512 + lane * 8 + 4),
                            wc0 = *(const LAS f32x4*)(cw + 1024 + lane * 8), wc1 = *(const LAS f32x4*)(cw + 1024 + lane * 8 + 4);
                const bool hasR = MC_HASR(r);
#pragma unroll
                for (int j = 0; j < 8; ++j) {
                    const float w0 = j < 4 ? wa0[j & 3] : wa1[j & 3], w1 = j < 4 ? wb0[j & 3] : wb1[j & 3], w2 = j < 4 ? wc0[j & 3] : wc1[j & 3];
                    y[j] = gb[j] * (w0 * zl[j] + w1 * zc[j] + (hasR ? w2 * zr[j] : 0.f)); }
                *(u32x4*)(A2 + (size_t)r * D + lane * 8) = pack8(y);
#pragma unroll
                for (int j = 0; j < 8; ++j) { zl[j] = hasR ? zc[j] : 0.f; zc[j] = zr[j]; } }
            cri += c_n;
            ML_BAR();
        }
#undef ML_ROW0
#undef ML_LOAD
#undef ML_BAR
#undef MC_HASL
#undef MC_HASR
    }
}

constexpr int NPH = 20;
constexpr int REP[NPH] = {1, 1, 1, 1, 1, 1, 1, 1, 1, 1, 1, 1, 1, 1, 1, 1, 1, 1, 1, 1};
#define REPEAT(k) for (int _r = 0; _r < REP[k]; ++_r)
#define GSCALE(k) ((_r == REP[k] - 1) ? 1.0f : 0.0f)
__global__ void __launch_bounds__(512, 2) mk_fwd(Args args_unused) {
    extern __shared__ __attribute__((aligned(16))) unsigned char smem[];
    Frame F;
    F.lds = (LAS unsigned char*)smem; F.wid = __builtin_amdgcn_readfirstlane((int)threadIdx.x >> 6); F.G = gridDim.x; F.wg = blockIdx.x;
    volatile LAS unsigned* misc = (volatile LAS unsigned*)(F.lds + MISC_OFF);
    if (F.tid() < 64) misc[F.tid()] = 0u;
    __syncthreads();
    int lo, hi;
    { KArgs ka = KA(); lo = ka->lo; hi = ka->hi; }
    XcdBarrier bar;
    { KArgs ka = KA(); bar.bar = (unsigned*)(ka->ws + WS_CTL); bar.x = 0; bar.st = misc; bar.wid = F.wid;
      if (hi - lo > 1) bar = xcd_barrier_post((unsigned*)(ka->ws + WS_CTL), misc, F.wid); }
#define IN(k) (lo <= (k) && (k) < hi)
#define SEAM(k) do { if (IN(k) && IN((k) + 1)) { KArgs _ka = KA(); bar.bar = (unsigned*)(_ka->ws + WS_CTL); xcd_barrier(bar); } } while (0)
    const volatile LAS int* tb = (const volatile LAS int*)(F.lds + MISC_OFF + 64);
    volatile LAS int* tbw = (volatile LAS int*)(F.lds + MISC_OFF + 64);

#ifdef PROBE_MFMA
    {
        f32x4 a0 = {0.f, 0.f, 0.f, 0.f}, a1 = a0, a2 = a0, a3 = a0; bf16x8 x = {1, 2, 3, 4, 5, 6, 7, 8}, y = {8, 7, 6, 5, 4, 3, 2, 1};
        asm volatile("" : "+v"(x), "+v"(y));
        for (int it = 0; it < 10000; ++it) {
            a0 = __builtin_amdgcn_mfma_f32_16x16x32_bf16(x, y, a0, 0, 0, 0); a1 = __builtin_amdgcn_mfma_f32_16x16x32_bf16(x, y, a1, 0, 0, 0);
            a2 = __builtin_amdgcn_mfma_f32_16x16x32_bf16(x, y, a2, 0, 0, 0); a3 = __builtin_amdgcn_mfma_f32_16x16x32_bf16(x, y, a3, 0, 0, 0); }
        asm volatile("" :: "v"(a0), "v"(a1), "v"(a2), "v"(a3));
    }
#endif
    if (IN(0)) REPEAT(0) { p0_prologue(F, _r < REP[0] - 1 ? PROBE_P0SKIP : 0); }
    SEAM(0);
    if (IN(1)) REPEAT(1) { KArgs ka = KA(); unsigned char* ws = ka->ws;
        norm_phase<false, false, false, true>(F, ka->in[I_X], ka->in[I_CTX], MT, ka->in[I_N1G], (const float*)(ws + WS_MOD), 0, (bf16_t*)(ws + WS_U), nullptr,
            (const bf16_t*)(ws + WS_WIN) + (size_t)NPROJ * D, ka->in[I_BG], (float*)(ws + WS_GATES), (bf16_t*)(ws + WS_HB)); }
    SEAM(1);
    if (IN(2)) REPEAT(2) { KArgs ka = KA(); unsigned char* ws = ka->ws;
        pg8::DenseSched S{MT / 256, NPROJ / 256, F.G, F.wg, 2 * D, 4};
        pg8::EpiProj E{(bf16_t*)(ws + WS_PROJ), GSCALE(2) == 0.0f};
        pg8::gemm_phase<false>(F.lds, F.wid, (const char*)(ws + WS_U), (const char*)(ws + WS_WIN), 2 * D, S, E, 0);
        tail_convert(F, (MT / 256) * (NPROJ / 256), 30, 31); }
    SEAM(2);
    if (IN(3)) REPEAT(3) { mlstm_phase(F, true, _r < REP[3] - 1 ? PROBE_MLSKIP : 0, MT, KA()->in[I_CONVW]); }
    SEAM(3);
    if (IN(4)) REPEAT(4) { KArgs ka = KA(); mix_phase(F, MT, ka->in[I_MNG]); }
    SEAM(4);
    if (IN(5)) REPEAT(5) { KArgs ka = KA(); unsigned char* ws = ka->ws;
        pg8::DenseSched S{MT / 256, D / 256, F.G, F.wg, 2 * D, 4};
        pg8::EpiResid E{(bf16_t*)(ws + WS_HB), (const float*)(ws + WS_MOD) + 2 * 1024, 1.0f};
        pg8::gemm_phase<false>(F.lds, F.wid, (const char*)(ws + WS_U), (const char*)(ws + WS_WOUT), 2 * D, S, E, 0);
        tail_convert(F, (MT / 256) * (D / 256), 27, 30); }
    SEAM(5);
    if (IN(6)) REPEAT(6) { KArgs ka = KA(); unsigned char* ws = ka->ws;
        norm_phase<false, true, true, false>(F, (const float*)(ws + WS_HB), nullptr, MT, ka->in[I_N2G], (const float*)(ws + WS_MOD), 3, (bf16_t*)(ws + WS_U), nullptr); }
    SEAM(6);
    if (IN(7)) REPEAT(7) { KArgs ka = KA(); unsigned char* ws = ka->ws;
        pg8::DenseSched S{MT / 256, 2 * DFF / 256, F.G, F.wg, D, 8};
        pg8::EpiSwiglu E{(unsigned char*)(ws + WS_PROJ), 1.0f / (S_A * S_W13), S_H * GSCALE(7)};
        pg8::gemm_phase<true>(F.lds, F.wid, (const char*)(ws + WS_U), (const char*)(ws + WS_WUP), D, S, E, 0);
        tail_convert(F, (MT / 256) * (2 * DFF / 256), 26, 27); }
    SEAM(7);
    if (IN(8)) REPEAT(8) { KArgs ka = KA(); unsigned char* ws = ka->ws;
        pg8::DenseSched S{MT / 256, D / 256, F.G, F.wg, DFF, 4};
        pg8::EpiResid E{(bf16_t*)(ws + WS_HB), (const float*)(ws + WS_MOD) + 5 * 1024, GSCALE(8) / (S_H * S_W2)};
        pg8::gemm_phase<true>(F.lds, F.wid, (const char*)(ws + WS_PROJ), (const char*)(ws + WS_WDN), DFF, S, E, 0);
        tail_convert(F, (MT / 256) * (D / 256), 21, 26); }
    SEAM(8);
    if (IN(9)) REPEAT(9) { KArgs ka = KA(); unsigned char* ws = ka->ws;
        norm_phase<false, false, true, true>(F, (const float*)(ws + WS_HB), nullptr, MT, ka->in[I_N1G] + D, (const float*)(ws + WS_MOD) + 33 * 6144, 0, (bf16_t*)(ws + WS_U), nullptr,
            (const bf16_t*)(ws + WS_WIN) + (size_t)(NPAD + NPROJ) * D, ka->in[I_BG] + 16, (float*)(ws + WS_GATES)); }
    SEAM(9);
    if (IN(10)) REPEAT(10) { KArgs ka = KA(); unsigned char* ws = ka->ws;
        pg8::InProjL1Sched S{F.G, F.wg};
        pg8::EpiProj E{(bf16_t*)(ws + WS_PROJ), GSCALE(10) == 0.0f};
        pg8::gemm_phase<false>(F.lds, F.wid, (const char*)(ws + WS_U), (const char*)(ws + WS_WIN) + (size_t)NPAD * D * 2, 2 * D, S, E, 0);
        tail_convert(F, 3584 + 192, 20, 21); }
    SEAM(10);
    if (IN(11)) REPEAT(11) { mlstm_phase(F, false, _r < REP[11] - 1 ? PROBE_MLSKIP : 0, NL, KA()->in[I_CONVW] + 3 * 512); }
    SEAM(11);
    if (IN(12)) REPEAT(12) { KArgs ka = KA(); mix_phase(F, NL, ka->in[I_MNG] + 512); }
    SEAM(12);
    if (IN(13)) REPEAT(13) { KArgs ka = KA(); unsigned char* ws = ka->ws;
        pg8::DenseSched S{NL / 256, D / 256, F.G, F.wg, 2 * D, 4};
        pg8::EpiResid E{(bf16_t*)(ws + WS_HB), (const float*)(ws + WS_MOD) + 33 * 6144 + 2 * 1024, GSCALE(13)};
        pg8::gemm_phase<false>(F.lds, F.wid, (const char*)(ws + WS_U), (const char*)(ws + WS_WOUT) + (size_t)D * D * 2, 2 * D, S, E, 0); }
    SEAM(13);
    if (IN(14)) REPEAT(14) { KArgs ka = KA(); unsigned char* ws = ka->ws;
        norm_phase<true, true, true, false>(F, (const float*)(ws + WS_HB), nullptr, NL, ka->in[I_N2G] + D, (const float*)(ws + WS_MOD) + 33 * 6144, 3, (bf16_t*)(ws + WS_U), ka->in[I_ROUTER]); }
    SEAM(14);
    if (IN(15) || IN(16)) {
        __syncthreads();
        { const int tidl = F.tid();
          if (tidl < 64) {
            KArgs ka = KA(); const unsigned* gc = (const unsigned*)(ka->ws + WS_CTL + CTL_GCNT);
            const int c = tidl < 16 ? (int)__hip_atomic_load(gc + tidl, __ATOMIC_RELAXED, __HIP_MEMORY_SCOPE_AGENT) : 0;
            const int nt_ = (c + 255) >> 8; int incl = nt_;
#pragma unroll
            for (int d = 1; d < 16; d <<= 1) { const int t = __shfl_up(incl, d); if (tidl >= d) incl += t; }
            if (tidl < 16) { tbw[tidl] = incl - nt_; tbw[32 + tidl] = c; }
            if (tidl == 15) tbw[16] = incl; } }
        __syncthreads();
    }
    if (IN(15)) REPEAT(15) { KArgs ka = KA(); unsigned char* ws = ka->ws;
        pg8::MoeUpSched S{F.G, F.wg, (const int*)(ws + WS_RTOK), tb};
        pg8::EpiSwiglu E{(unsigned char*)(ws + WS_PROJ), 1.0f / (S_A * S_W13), S_H};
        pg8::gemm_phase<true>(F.lds, F.wid, (const char*)(ws + WS_U), (const char*)(ws + WS_MUP), D, S, E, 0); }
    SEAM(15);
    if (IN(16)) { KArgs ka = KA(); unsigned char* ws = ka->ws;
        pg8::MoeDownSched S{F.G, F.wg, tb, (const int*)(ws + WS_RTOK), (const float*)(ws + WS_RGATE)};
        pg8::EpiMoeDown E{(unsigned char*)(ws + WS_U), (unsigned char*)(ws + WS_Y1), F.lds + pg8::STAGE_BYTES, tb, S_Y / (S_H * S_W2)};
        pg8::gemm_phase<true>(F.lds, F.wid, (const char*)(ws + WS_PROJ), (const char*)(ws + WS_MDN), DFF, S, E, 0); }
    SEAM(16);
    if (IN(19)) REPEAT(19) { final_phase(F); }
#undef IN
#undef SEAM
}

extern "C" void kernel_launch(void* const* d_in, const int* in_sizes, int n_in, void* d_out, int out_size, void* d_ws, size_t ws_size, hipStream_t stream) {
    static int grid = 0;
    if (grid == 0) {
        if (n_in != 21 || ws_size < WS_END) { fprintf(stderr, "kernel_launch: expected 21 inputs and >= %zu bytes of workspace; got %d, %zu\n", (size_t)WS_END, n_in, ws_size); grid = -1; return; }
        int dev = 0, cus = 0, per_cu = 0;
        if (hipGetDevice(&dev) != hipSuccess || hipDeviceGetAttribute(&cus, hipDeviceAttributeMultiprocessorCount, dev) != hipSuccess) { grid = -1; return; }
        if (hipFuncSetAttribute((const void*)mk_fwd, hipFuncAttributeMaxDynamicSharedMemorySize, LDS_BYTES) != hipSuccess) { fprintf(stderr, "kernel_launch: hipFuncSetAttribute failed\n"); grid = -1; return; }
        if (hipOccupancyMaxActiveBlocksPerMultiprocessor(&per_cu, (const void*)mk_fwd, 512, LDS_BYTES) != hipSuccess || per_cu < 1) fprintf(stderr, "kernel_launch: occupancy query reports %d\n", per_cu);
        (void)hipGetLastError();
        grid = cus;
    }
    if (grid < 0) return;
    (void)hipMemsetAsync((char*)d_ws + WS_CTL, 0, CTL_BYTES, stream);
    Args a{};
    for (int i = 0; i < 21; ++i) a.in[i] = (const float*)d_in[i];
    a.out = (float*)d_out; a.ws = (unsigned char*)d_ws;
#if MK_PER_PHASE
    for (int p = 0; p < NPH; ++p) { a.lo = p; a.hi = p + 1; hipLaunchKernelGGL(mk_fwd, dim3(grid), dim3(512), LDS_BYTES, stream, a); }
#else
    a.lo = 0; a.hi = NPH; hipLaunchKernelGGL(mk_fwd, dim3(grid), dim3(512), LDS_BYTES, stream, a);
#endif
}
```
